# Optimizing an MI355X kernel written in HIP

```python
import math
import jax, jax.numpy as jnp
from jax import lax
import numpy as np

D_MODEL = 1024
BATCH = 8
SEQ = 4096
DEPTH = 2

HEAD_DIM = 64
A_HEADS = D_MODEL // (2 * HEAD_DIM)
DILATED_BRANCHES = ((128, 1), (512, 4), (2048, 16))
DIFF_HALF = 64
DIFF_VDIM = 2 * DIFF_HALF
B_HEADS = D_MODEL // (2 * DIFF_VDIM)
C_HEADS = D_MODEL // HEAD_DIM
Q_BLOCK = 128
N_BUCKETS = 32
MAX_DISTANCE = 2048
BIAS_HEADS = A_HEADS + B_HEADS
PEER_HEADS = 8
N_KEYS = 128
N_EXPERTS = N_KEYS * N_KEYS
PEER_TOPK = 16
PEER_KEY_HALF = 128
PEER_CHUNK = 128
RMS_EPS = 1e-6
NEG_INF = -1e30
FORGET_BIAS_INIT = 3.0
A_WIDTH = A_HEADS * HEAD_DIM
B_QK_WIDTH = B_HEADS * 2 * DIFF_HALF
B_V_WIDTH = B_HEADS * DIFF_VDIM
EVEN_IN = 3 * A_WIDTH + 2 * B_QK_WIDTH + B_V_WIDTH
EVEN_MIX = A_WIDTH + B_V_WIDTH
C_WIDTH = C_HEADS * HEAD_DIM
ODD_IN = 3 * C_WIDTH + C_HEADS

kernel_name = 'hybrid_dilated_diff_fox_peer'


def rms_norm(x, g):
    x32 = x.astype(jnp.float32)
    y = x32 * lax.rsqrt(jnp.mean(x32 * x32, axis=-1, keepdims=True) + RMS_EPS)
    return (y * g.astype(jnp.float32)).astype(x.dtype)


def t5_bucket(dist):
    max_exact = N_BUCKETS // 2
    d = jnp.maximum(dist, 1).astype(jnp.float32)
    large = max_exact + (jnp.log(d / max_exact) / math.log(MAX_DISTANCE / max_exact)
                         * (N_BUCKETS - max_exact)).astype(jnp.int32)
    large = jnp.minimum(large, N_BUCKETS - 1)
    return jnp.where(dist < max_exact, dist, large)


def split_heads(t, n_heads):
    b, s, _ = t.shape
    return t.reshape(b, s, n_heads, -1).transpose(0, 2, 1, 3)


def sweep_query_blocks(fn, q):
    b, h, s, dq = q.shape
    nb = s // Q_BLOCK
    qb = q.reshape(b, h, nb, Q_BLOCK, dq).transpose(2, 0, 1, 3, 4)
    out = lax.map(lambda a: fn(a[0], a[1]), (jnp.arange(nb, dtype=jnp.int32), qb))
    out = out.transpose(1, 0, 3, 2, 4)
    return out.reshape(b, s, h * out.shape[-1])


def dilated_attention(q, k, v, bias_table):
    scale = HEAD_DIM ** -0.5
    branch_offs = [d * jnp.arange(w // d + 1, dtype=jnp.int32) for (w, d) in DILATED_BRANCHES]
    branch_bias = [bias_table[t5_bucket(o)].T for o in branch_offs]

    def block(bi, qblk):
        pos = bi * Q_BLOCK + jnp.arange(Q_BLOCK, dtype=jnp.int32)
        outs, lses = [], []
        for offs, bb in zip(branch_offs, branch_bias):
            idx = pos[:, None] - offs[None, :]
            valid = idx >= 0
            idx = jnp.maximum(idx, 0)
            kg = k[:, :, idx]
            vg = v[:, :, idx]
            logits = jnp.einsum('bhqd,bhqnd->bhqn', qblk, kg).astype(jnp.float32) * scale
            logits = jnp.where(valid, logits + bb[None, :, None, :].astype(jnp.float32), NEG_INF)
            lse = jax.nn.logsumexp(logits, axis=-1, keepdims=True)
            p = jnp.exp(logits - lse)
            outs.append(jnp.einsum('bhqn,bhqnd->bhqd', p.astype(v.dtype), vg).astype(jnp.float32))
            lses.append(lse)
        wts = jax.nn.softmax(jnp.stack(lses), axis=0)
        return jnp.sum(wts * jnp.stack(outs), axis=0).astype(v.dtype)

    return sweep_query_blocks(block, q)


def diff_attention(q, k, v, bias_table, lam, lam_init, ln_g):
    scale = DIFF_HALF ** -0.5
    s = q.shape[2]
    kpos = jnp.arange(s, dtype=jnp.int32)
    k1, k2 = k[..., :DIFF_HALF], k[..., DIFF_HALF:]

    def block(bi, qblk):
        qpos = bi * Q_BLOCK + jnp.arange(Q_BLOCK, dtype=jnp.int32)
        dist = qpos[:, None] - kpos[None, :]
        causal = dist >= 0
        bias = bias_table[t5_bucket(jnp.maximum(dist, 0))].transpose(2, 0, 1).astype(jnp.float32)

        def attn_map(qh, kh):
            l = jnp.einsum('bhqd,bhkd->bhqk', qh, kh).astype(jnp.float32) * scale + bias[None]
            return jax.nn.softmax(jnp.where(causal, l, NEG_INF), axis=-1)

        a = attn_map(qblk[..., :DIFF_HALF], k1) - lam * attn_map(qblk[..., DIFF_HALF:], k2)
        o = jnp.einsum('bhqk,bhkd->bhqd', a.astype(v.dtype), v)
        return (rms_norm(o, ln_g) * (1.0 - lam_init)).astype(v.dtype)

    return sweep_query_blocks(block, q)


def forgetting_attention(q, k, v, fg_logit):
    scale = HEAD_DIM ** -0.5
    s = q.shape[2]
    kpos = jnp.arange(s, dtype=jnp.int32)
    c = jnp.cumsum(jax.nn.log_sigmoid(fg_logit.astype(jnp.float32)), axis=-1)

    def block(bi, qblk):
        qpos = bi * Q_BLOCK + jnp.arange(Q_BLOCK, dtype=jnp.int32)
        causal = kpos[None, :] <= qpos[:, None]
        cq = lax.dynamic_slice_in_dim(c, bi * Q_BLOCK, Q_BLOCK, axis=2)
        l = jnp.einsum('bhqd,bhkd->bhqk', qblk, k).astype(jnp.float32) * scale
        l = l + cq[..., :, None] - c[..., None, :]
        p = jax.nn.softmax(jnp.where(causal, l, NEG_INF), axis=-1)
        return jnp.einsum('bhqk,bhkd->bhqd', p.astype(v.dtype), v)

    return sweep_query_blocks(block, q)


def even_mixer(h, w_in, w_out, rel_bias, lam_params, ln_g, layer):
    p = h @ w_in
    qa = split_heads(p[..., :A_WIDTH], A_HEADS)
    ka = split_heads(p[..., A_WIDTH:2 * A_WIDTH], A_HEADS)
    va = split_heads(p[..., 2 * A_WIDTH:3 * A_WIDTH], A_HEADS)
    off = 3 * A_WIDTH
    qb = split_heads(p[..., off:off + B_QK_WIDTH], B_HEADS)
    off = off + B_QK_WIDTH
    kb = split_heads(p[..., off:off + B_QK_WIDTH], B_HEADS)
    off = off + B_QK_WIDTH
    vb = split_heads(p[..., off:], B_HEADS)
    lam_init = 0.8 - 0.6 * math.exp(-0.3 * layer)
    lp = lam_params.astype(jnp.float32)
    lam = jnp.exp(jnp.sum(lp[0] * lp[1])) - jnp.exp(jnp.sum(lp[2] * lp[3])) + lam_init
    oa = dilated_attention(qa, ka, va, rel_bias[:, :A_HEADS])
    ob = diff_attention(qb, kb, vb, rel_bias[:, A_HEADS:], lam, lam_init, ln_g)
    return jnp.concatenate([oa, ob], axis=-1) @ w_out


def odd_mixer(h, w_in, b_f, w_out):
    p = h @ w_in
    q = split_heads(p[..., :C_WIDTH], C_HEADS)
    k = split_heads(p[..., C_WIDTH:2 * C_WIDTH], C_HEADS)
    v = split_heads(p[..., 2 * C_WIDTH:3 * C_WIDTH], C_HEADS)
    fg = (p[..., 3 * C_WIDTH:] + b_f).transpose(0, 2, 1)
    return forgetting_attention(q, k, v, fg) @ w_out


def peer_ffn(h, wq, subkeys, u, v):
    b, s, d = h.shape
    t = b * s
    ht = h.reshape(t, d)
    q = (ht @ wq).reshape(t, PEER_HEADS, 2, PEER_KEY_HALF)
    sc = jnp.einsum('thcd,hcnd->thcn', q, subkeys).astype(jnp.float32)
    top_s, top_i = lax.top_k(sc, PEER_TOPK)
    cand_s = (top_s[:, :, 0, :, None] + top_s[:, :, 1, None, :]).reshape(t, PEER_HEADS, -1)
    cand_i = (top_i[:, :, 0, :, None] * N_KEYS + top_i[:, :, 1, None, :]).reshape(t, PEER_HEADS, -1)
    best_s, best_j = lax.top_k(cand_s, PEER_TOPK)
    idx = jnp.take_along_axis(cand_i, best_j, axis=-1)
    gate = jax.nn.softmax(best_s, axis=-1)
    nc = t // PEER_CHUNK
    xs = (ht.reshape(nc, PEER_CHUNK, d),
          idx.reshape(nc, PEER_CHUNK, PEER_HEADS * PEER_TOPK),
          gate.reshape(nc, PEER_CHUNK, PEER_HEADS * PEER_TOPK).astype(h.dtype))

    def chunk(a):
        xc, ic, gc = a
        act = jax.nn.gelu(jnp.einsum('cd,ced->ce', xc, u[ic]), approximate=False)
        return jnp.einsum('ce,ced->cd', gc * act, v[ic])

    return lax.map(chunk, xs).reshape(b, s, d)


def setup_inputs(seed: int = 0) -> dict:
    key = jax.random.key(seed)
    ks = jax.random.split(key, 16)
    n_even = (DEPTH + 1) // 2
    n_odd = DEPTH // 2
    nrm = jax.random.normal
    f32 = jnp.float32
    return {
        'x': nrm(ks[0], (BATCH, SEQ, D_MODEL), f32),
        'norm_mix_g': 1.0 + 0.02 * nrm(ks[1], (DEPTH, D_MODEL), f32),
        'norm_ffn_g': 1.0 + 0.02 * nrm(ks[2], (DEPTH, D_MODEL), f32),
        'final_norm_g': 1.0 + 0.02 * nrm(ks[3], (D_MODEL,), f32),
        'rel_bias': 0.5 * nrm(ks[4], (N_BUCKETS, BIAS_HEADS), f32),
        'even_w_in': nrm(ks[5], (n_even, D_MODEL, EVEN_IN), f32) * D_MODEL ** -0.5,
        'even_w_out': nrm(ks[6], (n_even, EVEN_MIX, D_MODEL), f32) * EVEN_MIX ** -0.5,
        'diff_lambda': 0.1 * nrm(ks[7], (n_even, 4, DIFF_HALF), f32),
        'diff_ln_g': 1.0 + 0.02 * nrm(ks[8], (n_even, DIFF_VDIM), f32),
        'odd_w_in': nrm(ks[9], (n_odd, D_MODEL, ODD_IN), f32) * D_MODEL ** -0.5,
        'odd_b_f': FORGET_BIAS_INIT + 0.5 * nrm(ks[10], (n_odd, C_HEADS), f32),
        'odd_w_out': nrm(ks[11], (n_odd, C_WIDTH, D_MODEL), f32) * C_WIDTH ** -0.5,
        'peer_wq': nrm(ks[12], (DEPTH, D_MODEL, PEER_HEADS * 2 * PEER_KEY_HALF), f32) * D_MODEL ** -0.5,
        'peer_subkeys': nrm(ks[13], (DEPTH, PEER_HEADS, 2, N_KEYS, PEER_KEY_HALF), f32) * PEER_KEY_HALF ** -0.5,
        'peer_u': nrm(ks[14], (DEPTH, N_EXPERTS, D_MODEL), f32) * D_MODEL ** -0.5,
        'peer_v': nrm(ks[15], (DEPTH, N_EXPERTS, D_MODEL), f32) * PEER_HEADS ** -0.5,
    }


def reference(x, norm_mix_g, norm_ffn_g, final_norm_g, rel_bias, even_w_in, even_w_out,
              diff_lambda, diff_ln_g, odd_w_in, odd_b_f, odd_w_out, peer_wq, peer_subkeys,
              peer_u, peer_v):
    for layer in range(DEPTH):
        h = rms_norm(x, norm_mix_g[layer])
        i = layer // 2
        if layer % 2 == 0:
            x = x + even_mixer(h, even_w_in[i], even_w_out[i], rel_bias,
                               diff_lambda[i], diff_ln_g[i], layer)
        else:
            x = x + odd_mixer(h, odd_w_in[i], odd_b_f[i], odd_w_out[i])
        h = rms_norm(x, norm_ffn_g[layer])
        x = x + peer_ffn(h, peer_wq[layer], peer_subkeys[layer], peer_u[layer], peer_v[layer])
    return rms_norm(x, final_norm_g)
```

```cpp
#include <hip/hip_runtime.h>
#include <stdint.h>
#include <math.h>
#include <cstdio>

typedef unsigned short bf16_t;
#define DEV static __device__ __forceinline__
#define MDEV __device__ __forceinline__

constexpr int DM = 1024, NBATCH = 8, SEQ = 4096, NT = NBATCH * SEQ;
constexpr int EVEN_IN = 3072, ODD_IN = 3088;
constexpr int NEXP = 16384;
constexpr int NTHR = 512;
constexpr int LDS_BYTES = 144 * 1024;

constexpr size_t KB_ = 1024, MB_ = 1024 * 1024;
constexpr size_t WS_BAR   = 0;
constexpr size_t WS_WIN0  = 64 * KB_;
constexpr size_t WS_WOUT0 = WS_WIN0 + (size_t)3072 * 1024 * 2;
constexpr size_t WS_WIN1  = WS_WOUT0 + (size_t)1024 * 1024 * 2;
constexpr size_t WS_WOUT1 = WS_WIN1 + (size_t)3328 * 1024 * 2;
constexpr size_t WS_WQ    = WS_WOUT1 + (size_t)1024 * 1024 * 2;
constexpr size_t WS_SK    = WS_WQ + (size_t)2 * 2048 * 1024 * 2;
constexpr size_t WS_U     = WS_SK + (size_t)2 * 8 * 2 * 128 * 128 * 2;
constexpr size_t WS_V     = WS_U + (size_t)2 * NEXP * 1024 * 2;
constexpr size_t WS_HN    = WS_V + (size_t)2 * NEXP * 1024 * 2;
constexpr size_t WS_QKV   = WS_HN + (size_t)NT * 1024 * 2;
constexpr size_t WS_FG    = WS_QKV + (size_t)NT * 3072 * 2;
constexpr size_t WS_C     = WS_FG + (size_t)NT * 16 * 4;
constexpr size_t WS_AO    = WS_C + (size_t)NT * 16 * 4;
constexpr size_t WS_END   = WS_AO + (size_t)NT * 1024 * 2;

struct Params {
    const float *x, *norm_mix_g, *norm_ffn_g, *final_g, *rel_bias, *even_w_in, *even_w_out, *diff_lambda, *diff_ln_g,
                *odd_w_in, *odd_b_f, *odd_w_out, *peer_wq, *peer_sk, *peer_u, *peer_v;
    float* out;
    unsigned char* ws;
    int ph_lo, ph_hi;
};

DEV float bf2f(bf16_t v) { return __uint_as_float(((unsigned)v) << 16); }
DEV bf16_t f2bf(float f) { unsigned u = __float_as_uint(f); u += 0x7FFFu + ((u >> 16) & 1u); return (bf16_t)(u >> 16); }
DEV unsigned pk2(float lo, float hi) { return (unsigned)f2bf(lo) | ((unsigned)f2bf(hi) << 16); }
DEV float bflo(unsigned w) { return __uint_as_float(w << 16); }
DEV float bfhi(unsigned w) { return __uint_as_float(w & 0xFFFF0000u); }
DEV float wave_sum(float v) {
#pragma unroll
    for (int o = 32; o >= 1; o >>= 1) v += __shfl_xor(v, o);
    return v;
}
DEV float wave_max(float v) {
#pragma unroll
    for (int o = 32; o >= 1; o >>= 1) v = fmaxf(v, __shfl_xor(v, o));
    return v;
}
DEV void lds_fence() { asm volatile("s_waitcnt lgkmcnt(0)" ::: "memory"); }

DEV int t5_bucket(int d) {
    if (d < 16) return d;
    int b = 16;
    b += (d >= 22); b += (d >= 30); b += (d >= 40); b += (d >= 54); b += (d >= 73); b += (d >= 99); b += (d >= 134); b += (d >= 182);
    b += (d >= 246); b += (d >= 332); b += (d >= 450); b += (d >= 609); b += (d >= 825); b += (d >= 1117); b += (d >= 1513);
    return b;
}

DEV void conv_transpose(const float* src, bf16_t* dst, int K, int N, float* lds, int bid, int nb) {
    const int t = threadIdx.x;
    const int ntk = K / 64, ntn = (N + 63) / 64;
    for (int tile = bid; tile < ntk * ntn; tile += nb) {
        const int k0 = (tile / ntn) * 64, n0 = (tile % ntn) * 64;
        __syncthreads();
#pragma unroll
        for (int i = 0; i < 8; ++i) {
            const int r = (t >> 6) + 8 * i, c = t & 63;
            float v = 0.f;
            if (n0 + c < N) v = src[(size_t)(k0 + r) * N + n0 + c];
            lds[r * 65 + c] = v;
        }
        __syncthreads();
#pragma unroll
        for (int i = 0; i < 8; ++i) {
            const int r = (t >> 6) + 8 * i, c = t & 63;
            if (n0 + r < N) dst[(size_t)(n0 + r) * K + k0 + c] = f2bf(lds[c * 65 + r]);
        }
    }
}
DEV void conv_copy(const float* src, bf16_t* dst, size_t n, int bid, int nb) {
    const size_t n4 = n / 4;
    for (size_t i = (size_t)bid * NTHR + threadIdx.x; i < n4; i += (size_t)nb * NTHR) {
        const float4 v = ((const float4*)src)[i];
        uint2 o; o.x = pk2(v.x, v.y); o.y = pk2(v.z, v.w);
        ((uint2*)dst)[i] = o;
    }
}

DEV void phase_norm(const float* xin, const float* g, bf16_t* out, int bid, int nb) {
    const int wid = threadIdx.x >> 6, lane = threadIdx.x & 63;
    for (int row = bid * 8 + wid; row < NT; row += nb * 8) {
        const float4* xr = (const float4*)(xin + (size_t)row * DM);
        float4 v[4]; float ss = 0.f;
#pragma unroll
        for (int i = 0; i < 4; ++i) { v[i] = xr[lane + 64 * i]; ss += v[i].x * v[i].x + v[i].y * v[i].y + v[i].z * v[i].z + v[i].w * v[i].w; }
        ss = wave_sum(ss);
        const float rstd = 1.0f / sqrtf(ss * (1.0f / DM) + 1e-6f);
#pragma unroll
        for (int i = 0; i < 4; ++i) {
            const float4 gg = ((const float4*)g)[lane + 64 * i];
            uint2 o; o.x = pk2(v[i].x * rstd * gg.x, v[i].y * rstd * gg.y); o.y = pk2(v[i].z * rstd * gg.z, v[i].w * rstd * gg.w);
            ((uint2*)(out + (size_t)row * DM))[lane + 64 * i] = o;
        }
    }
}
DEV void phase_final_norm(float* x, const float* g, int bid, int nb) {
    const int wid = threadIdx.x >> 6, lane = threadIdx.x & 63;
    for (int row = bid * 8 + wid; row < NT; row += nb * 8) {
        float4* xr = (float4*)(x + (size_t)row * DM);
        float4 v[4]; float ss = 0.f;
#pragma unroll
        for (int i = 0; i < 4; ++i) { v[i] = xr[lane + 64 * i]; ss += v[i].x * v[i].x + v[i].y * v[i].y + v[i].z * v[i].z + v[i].w * v[i].w; }
        ss = wave_sum(ss);
        const float rstd = 1.0f / sqrtf(ss * (1.0f / DM) + 1e-6f);
#pragma unroll
        for (int i = 0; i < 4; ++i) {
            const float4 gg = ((const float4*)g)[lane + 64 * i];
            float4 o; o.x = v[i].x * rstd * gg.x; o.y = v[i].y * rstd * gg.y; o.z = v[i].z * rstd * gg.z; o.w = v[i].w * rstd * gg.w;
            xr[lane + 64 * i] = o;
        }
    }
}

struct EpiBf16 { bf16_t* out; int ld;
    MDEV void operator()(int r, int c, float v) const { out[(size_t)r * ld + c] = f2bf(v); } };
struct EpiOddIn { bf16_t* out; float* fg; const float* bfv;
    MDEV void operator()(int r, int c, float v) const { if (c < 3072) out[(size_t)r * 3072 + c] = f2bf(v); else fg[(size_t)r * 16 + (c - 3072)] = v + bfv[c - 3072]; } };
struct EpiRes { const float* xin; float* xout;
    MDEV void operator()(int r, int c, float v) const { xout[(size_t)r * DM + c] = xin[(size_t)r * DM + c] + v; } };

template <class Epi>
DEV void phase_gemm_naive(const bf16_t* A, const bf16_t* Bt, int M, int N, int K, const Epi epi, float* lds, int bid, int nb) {
    float* As = lds;
    float* Bs = lds + 16 * 132;
    const int t = threadIdx.x, tx = t & 31, ty = t >> 5;
    const int ntm = M / 128, ntn = (N + 127) / 128;
    const int lr = t >> 2, lk = (t & 3) * 4;
    for (int tile = bid; tile < ntm * ntn; tile += nb) {
        const int m0 = (tile / ntn) * 128, n0 = (tile % ntn) * 128;
        float acc[8][4];
#pragma unroll
        for (int i = 0; i < 8; ++i)
#pragma unroll
            for (int j = 0; j < 4; ++j) acc[i][j] = 0.f;
        for (int k0 = 0; k0 < K; k0 += 16) {
            const uint2 av = *(const uint2*)(A + (size_t)(m0 + lr) * K + k0 + lk);
            uint2 bv = make_uint2(0u, 0u);
            if (n0 + lr < N) bv = *(const uint2*)(Bt + (size_t)(n0 + lr) * K + k0 + lk);
            __syncthreads();
            As[(lk + 0) * 132 + lr] = bflo(av.x); As[(lk + 1) * 132 + lr] = bfhi(av.x); As[(lk + 2) * 132 + lr] = bflo(av.y); As[(lk + 3) * 132 + lr] = bfhi(av.y);
            Bs[(lk + 0) * 132 + lr] = bflo(bv.x); Bs[(lk + 1) * 132 + lr] = bfhi(bv.x); Bs[(lk + 2) * 132 + lr] = bflo(bv.y); Bs[(lk + 3) * 132 + lr] = bfhi(bv.y);
            __syncthreads();
#pragma unroll
            for (int k = 0; k < 16; ++k) {
                const float4 a0 = *(const float4*)&As[k * 132 + ty * 8], a1 = *(const float4*)&As[k * 132 + ty * 8 + 4];
                const float4 b0 = *(const float4*)&Bs[k * 132 + tx * 4];
                const float a[8] = {a0.x, a0.y, a0.z, a0.w, a1.x, a1.y, a1.z, a1.w};
                const float b[4] = {b0.x, b0.y, b0.z, b0.w};
#pragma unroll
                for (int i = 0; i < 8; ++i)
#pragma unroll
                    for (int j = 0; j < 4; ++j) acc[i][j] += a[i] * b[j];
            }
        }
#pragma unroll
        for (int i = 0; i < 8; ++i)
#pragma unroll
            for (int j = 0; j < 4; ++j) { const int row = m0 + ty * 8 + i, col = n0 + tx * 4 + j; if (col < N) epi(row, col, acc[i][j]); }
    }
}

DEV void phase_dilated_naive(const bf16_t* qkv, const float* rel_bias, bf16_t* ao, float* lds, int bid, int nb) {
    const int t = threadIdx.x, wid = t >> 6, lane = t & 63;
    float* lut = lds;
    __syncthreads();
    for (int i = t; i < 8 * 3 * 129; i += NTHR) {
        const int h = i / (3 * 129), r = i % (3 * 129), br = r / 129, n = r % 129;
        const int dl = br == 0 ? 1 : (br == 1 ? 4 : 16);
        lut[(h * 3 + br) * 132 + n] = rel_bias[t5_bucket(dl * n) * 12 + h];
    }
    __syncthreads();
    for (int task = bid * 8 + wid; task < NT * 8; task += nb * 8) {
        const int tok = task >> 3, h = task & 7, b = tok >> 12, pos = tok & 4095;
        const float q = bf2f(qkv[(size_t)tok * 3072 + h * 64 + lane]) * 0.125f;
        float m = -INFINITY, l = 0.f, o = 0.f;
#pragma unroll
        for (int br = 0; br < 3; ++br) {
            const int dl = br == 0 ? 1 : (br == 1 ? 4 : 16);
            const int nvalid = min(128, pos / dl) + 1;
            const float* lb = lut + (h * 3 + br) * 132;
            for (int n0 = 0; n0 < nvalid; n0 += 4) {
                float kv[4], vv[4];
#pragma unroll
                for (int j = 0; j < 4; ++j) {
                    const int key = max(pos - dl * (n0 + j), 0);
                    const size_t base = (size_t)(b * SEQ + key) * 3072 + h * 64 + lane;
                    kv[j] = bf2f(qkv[base + 512]); vv[j] = bf2f(qkv[base + 1024]);
                }
#pragma unroll
                for (int j = 0; j < 4; ++j) {
                    if (n0 + j < nvalid) {
                        const float s = wave_sum(q * kv[j]) + lb[n0 + j];
                        if (s > m) { const float f = __expf(m - s); l *= f; o *= f; m = s; }
                        const float p = __expf(s - m);
                        l += p; o += p * vv[j];
                    }
                }
            }
        }
        ao[(size_t)tok * DM + h * 64 + lane] = f2bf(o / l);
    }
}

DEV void phase_diff_naive(const bf16_t* qkv, const float* rel_bias, const float* lamp, const float* ln_g, bf16_t* ao, float* lds, int bid, int nb) {
    const int t = threadIdx.x;
    float* Ks = lds;
    float* Vs = lds + 8192;
    float* lut = lds + 16384 + 512;
    float* X = lds;
    float lam;
    { float s1 = 0.f, s2 = 0.f;
      for (int i = 0; i < 64; ++i) { s1 += lamp[i] * lamp[64 + i]; s2 += lamp[128 + i] * lamp[192 + i]; }
      lam = expf(s1) - expf(s2) + 0.2f; }
    const int qi = t & 127, map = (t >> 7) & 1, vh = t >> 8;
    for (int unit = bid; unit < 1024; unit += nb) {
        const int qblk = 31 - unit / 32, bh = unit % 32, b = bh >> 2, hd = bh & 3;
        const int qpos = qblk * 128 + qi;
        const size_t tok = (size_t)b * SEQ + qpos;
        __syncthreads();
        for (int i = t; i < 4096; i += NTHR) lut[i] = rel_bias[t5_bucket(i) * 12 + 8 + hd];
        float q[64], o[64];
        { const uint4* qp = (const uint4*)(qkv + tok * 3072 + 1536 + hd * 128 + map * 64);
#pragma unroll
          for (int i = 0; i < 8; ++i) { const uint4 w = qp[i];
              q[i * 8 + 0] = bflo(w.x) * 0.125f; q[i * 8 + 1] = bfhi(w.x) * 0.125f; q[i * 8 + 2] = bflo(w.y) * 0.125f; q[i * 8 + 3] = bfhi(w.y) * 0.125f;
              q[i * 8 + 4] = bflo(w.z) * 0.125f; q[i * 8 + 5] = bfhi(w.z) * 0.125f; q[i * 8 + 6] = bflo(w.w) * 0.125f; q[i * 8 + 7] = bfhi(w.w) * 0.125f; } }
#pragma unroll
        for (int d = 0; d < 64; ++d) o[d] = 0.f;
        float m = -INFINITY, l = 0.f;
        const int nkt = 2 * qblk + 2;
        for (int kt = 0; kt < nkt; ++kt) {
            __syncthreads();
#pragma unroll
            for (int i = 0; i < 2; ++i) {
                const int e = (t + i * NTHR) * 8, j = e >> 7, d0 = e & 127;
                const size_t base = ((size_t)b * SEQ + kt * 64 + j) * 3072 + hd * 128 + d0;
                const uint4 kw = *(const uint4*)(qkv + base + 2048), vw = *(const uint4*)(qkv + base + 2560);
                float* kd = Ks + j * 128 + d0; float* vd = Vs + j * 128 + d0;
                kd[0] = bflo(kw.x); kd[1] = bfhi(kw.x); kd[2] = bflo(kw.y); kd[3] = bfhi(kw.y); kd[4] = bflo(kw.z); kd[5] = bfhi(kw.z); kd[6] = bflo(kw.w); kd[7] = bfhi(kw.w);
                vd[0] = bflo(vw.x); vd[1] = bfhi(vw.x); vd[2] = bflo(vw.y); vd[3] = bfhi(vw.y); vd[4] = bflo(vw.z); vd[5] = bfhi(vw.z); vd[6] = bflo(vw.w); vd[7] = bfhi(vw.w);
            }
            __syncthreads();
            for (int j = 0; j < 64; ++j) {
                const int key = kt * 64 + j;
                if (key <= qpos) {
                    const float4* kr = (const float4*)(Ks + j * 128 + map * 64);
                    float s = 0.f;
#pragma unroll
                    for (int d4 = 0; d4 < 16; ++d4) { const float4 kk = kr[d4]; s += q[d4 * 4] * kk.x + q[d4 * 4 + 1] * kk.y + q[d4 * 4 + 2] * kk.z + q[d4 * 4 + 3] * kk.w; }
                    s += lut[qpos - key];
                    if (s > m) { const float f = __expf(m - s); l *= f;
#pragma unroll
                        for (int d = 0; d < 64; ++d) o[d] *= f;
                        m = s; }
                    const float p = __expf(s - m);
                    l += p;
                    const float4* vr = (const float4*)(Vs + j * 128 + vh * 64);
#pragma unroll
                    for (int d4 = 0; d4 < 16; ++d4) { const float4 vv = vr[d4]; o[d4 * 4] += p * vv.x; o[d4 * 4 + 1] += p * vv.y; o[d4 * 4 + 2] += p * vv.z; o[d4 * 4 + 3] += p * vv.w; }
                }
            }
        }
        const float inv = 1.0f / l;
        __syncthreads();
        if (map == 1) {
#pragma unroll
            for (int d = 0; d < 64; ++d) X[qi * 129 + vh * 64 + d] = lam * o[d] * inv;
        }
        __syncthreads();
        if (map == 0) {
#pragma unroll
            for (int d = 0; d < 64; ++d) X[qi * 129 + vh * 64 + d] = o[d] * inv - X[qi * 129 + vh * 64 + d];
        }
        __syncthreads();
        {
            const int qq = t >> 2, part = t & 3;
            float ss = 0.f;
            for (int i = 0; i < 32; ++i) { const float v = X[qq * 129 + part * 32 + i]; ss += v * v; }
            ss += __shfl_xor(ss, 1); ss += __shfl_xor(ss, 2);
            const float rstd = 1.0f / sqrtf(ss * (1.0f / 128.0f) + 1e-6f);
            const size_t tk = (size_t)b * SEQ + qblk * 128 + qq;
            for (int i = 0; i < 32; ++i) { const int v = part * 32 + i;
                ao[tk * DM + 512 + hd * 128 + v] = f2bf(X[qq * 129 + v] * rstd * ln_g[v] * 0.8f); }
        }
    }
}

DEV void phase_cumsum(const float* fg, float* c, int bid, int nb) {
    const int wid = threadIdx.x >> 6, lane = threadIdx.x & 63;
    for (int task = bid * 8 + wid; task < 128; task += nb * 8) {
        const int b = task >> 4, h = task & 15;
        float carry = 0.f;
        for (int s0 = 0; s0 < SEQ; s0 += 64) {
            const float xv = fg[((size_t)b * SEQ + s0 + lane) * 16 + h];
            float v = fminf(xv, 0.f) - log1pf(expf(-fabsf(xv)));
#pragma unroll
            for (int o = 1; o < 64; o <<= 1) { const float u = __shfl_up(v, o); if (lane >= o) v += u; }
            v += carry;
            c[(size_t)task * SEQ + s0 + lane] = v;
            carry = __shfl(v, 63);
        }
    }
}

DEV void phase_fox_naive(const bf16_t* qkv, const float* carr, bf16_t* ao, float* lds, int bid, int nb) {
    const int t = threadIdx.x;
    float* Ks = lds;
    float* Vs = lds + 4096;
    float* cks = lds + 8192;
    for (int unit = bid; unit < 1024; unit += nb) {
        const int qblk = 7 - unit / 128, bh = unit % 128, b = bh >> 4, h = bh & 15;
        const int qpos = qblk * 512 + t;
        const size_t tok = (size_t)b * SEQ + qpos;
        float q[64], o[64];
        { const uint4* qp = (const uint4*)(qkv + tok * 3072 + h * 64);
#pragma unroll
          for (int i = 0; i < 8; ++i) { const uint4 w = qp[i];
              q[i * 8 + 0] = bflo(w.x) * 0.125f; q[i * 8 + 1] = bfhi(w.x) * 0.125f; q[i * 8 + 2] = bflo(w.y) * 0.125f; q[i * 8 + 3] = bfhi(w.y) * 0.125f;
              q[i * 8 + 4] = bflo(w.z) * 0.125f; q[i * 8 + 5] = bfhi(w.z) * 0.125f; q[i * 8 + 6] = bflo(w.w) * 0.125f; q[i * 8 + 7] = bfhi(w.w) * 0.125f; } }
#pragma unroll
        for (int d = 0; d < 64; ++d) o[d] = 0.f;
        const float cq = carr[(size_t)bh * SEQ + qpos];
        float m = -INFINITY, l = 0.f;
        const int nkt = (qblk + 1) * 8;
        for (int kt = 0; kt < nkt; ++kt) {
            __syncthreads();
            {
                const int e = t * 8, j = e >> 6, d0 = e & 63;
                const size_t base = ((size_t)b * SEQ + kt * 64 + j) * 3072 + h * 64 + d0;
                const uint4 kw = *(const uint4*)(qkv + base + 1024), vw = *(const uint4*)(qkv + base + 2048);
                float* kd = Ks + j * 64 + d0; float* vd = Vs + j * 64 + d0;
                kd[0] = bflo(kw.x); kd[1] = bfhi(kw.x); kd[2] = bflo(kw.y); kd[3] = bfhi(kw.y); kd[4] = bflo(kw.z); kd[5] = bfhi(kw.z); kd[6] = bflo(kw.w); kd[7] = bfhi(kw.w);
                vd[0] = bflo(vw.x); vd[1] = bfhi(vw.x); vd[2] = bflo(vw.y); vd[3] = bfhi(vw.y); vd[4] = bflo(vw.z); vd[5] = bfhi(vw.z); vd[6] = bflo(vw.w); vd[7] = bfhi(vw.w);
                if (t < 64) cks[t] = carr[(size_t)bh * SEQ + kt * 64 + t];
            }
            __syncthreads();
            for (int j = 0; j < 64; ++j) {
                const int key = kt * 64 + j;
                if (key <= qpos) {
                    const float4* kr = (const float4*)(Ks + j * 64);
                    float s = 0.f;
#pragma unroll
                    for (int d4 = 0; d4 < 16; ++d4) { const float4 kk = kr[d4]; s += q[d4 * 4] * kk.x + q[d4 * 4 + 1] * kk.y + q[d4 * 4 + 2] * kk.z + q[d4 * 4 + 3] * kk.w; }
                    s += cq - cks[j];
                    if (s > m) { const float f = __expf(m - s); l *= f;
#pragma unroll
                        for (int d = 0; d < 64; ++d) o[d] *= f;
                        m = s; }
                    const float p = __expf(s - m);
                    l += p;
                    const float4* vr = (const float4*)(Vs + j * 64);
#pragma unroll
                    for (int d4 = 0; d4 < 16; ++d4) { const float4 vv = vr[d4]; o[d4 * 4] += p * vv.x; o[d4 * 4 + 1] += p * vv.y; o[d4 * 4 + 2] += p * vv.z; o[d4 * 4 + 3] += p * vv.w; }
                }
            }
        }
        const float inv = 1.0f / l;
        uint4* op = (uint4*)(ao + tok * DM + h * 64);
#pragma unroll
        for (int i = 0; i < 8; ++i) { uint4 w; w.x = pk2(o[i * 8] * inv, o[i * 8 + 1] * inv); w.y = pk2(o[i * 8 + 2] * inv, o[i * 8 + 3] * inv);
            w.z = pk2(o[i * 8 + 4] * inv, o[i * 8 + 5] * inv); w.w = pk2(o[i * 8 + 6] * inv, o[i * 8 + 7] * inv); op[i] = w; }
    }
}

DEV void wave_argmax(float& bv, int& bi) {
#pragma unroll
    for (int o = 32; o >= 1; o >>= 1) {
        const float ov = __shfl_xor(bv, o); const int oi = __shfl_xor(bi, o);
        if (ov > bv || (ov == bv && oi < bi)) { bv = ov; bi = oi; }
    }
}
DEV void phase_topk_naive(const bf16_t* pq, const bf16_t* sk, int* idx_out, float* gate_out, float* lds, int bid, int nb) {
    const int wid = threadIdx.x >> 6, lane = threadIdx.x & 63;
    float* wq = lds + wid * 320;
    float* wts = wq + 256;
    int* wti = (int*)(wq + 288);
    for (int task = bid * 8 + wid; task < NT * 8; task += nb * 8) {
        const int tok = task >> 3, h = task & 7;
        lds_fence();
        { const uint2 r = *(const uint2*)(pq + (size_t)tok * 2048 + h * 256 + lane * 4);
          wq[lane * 4 + 0] = bflo(r.x); wq[lane * 4 + 1] = bfhi(r.x); wq[lane * 4 + 2] = bflo(r.y); wq[lane * 4 + 3] = bfhi(r.y); }
        lds_fence();
#pragma unroll 1
        for (int c = 0; c < 2; ++c) {
            float v0, v1;
            const float* qq = wq + c * 128;
            {
                const uint4* row = (const uint4*)(sk + ((size_t)(h * 2 + c) * 128 + lane) * 128);
                float s = 0.f;
#pragma unroll
                for (int i = 0; i < 16; ++i) { const uint4 w = row[i];
                    s += qq[i * 8] * bflo(w.x) + qq[i * 8 + 1] * bfhi(w.x) + qq[i * 8 + 2] * bflo(w.y) + qq[i * 8 + 3] * bfhi(w.y)
                       + qq[i * 8 + 4] * bflo(w.z) + qq[i * 8 + 5] * bfhi(w.z) + qq[i * 8 + 6] * bflo(w.w) + qq[i * 8 + 7] * bfhi(w.w); }
                v0 = s;
            }
            asm volatile("" : "+v"(v0) :: "memory");
            {
                const uint4* row = (const uint4*)(sk + ((size_t)(h * 2 + c) * 128 + lane + 64) * 128);
                float s = 0.f;
#pragma unroll
                for (int i = 0; i < 16; ++i) { const uint4 w = row[i];
                    s += qq[i * 8] * bflo(w.x) + qq[i * 8 + 1] * bfhi(w.x) + qq[i * 8 + 2] * bflo(w.y) + qq[i * 8 + 3] * bfhi(w.y)
                       + qq[i * 8 + 4] * bflo(w.z) + qq[i * 8 + 5] * bfhi(w.z) + qq[i * 8 + 6] * bflo(w.w) + qq[i * 8 + 7] * bfhi(w.w); }
                v1 = s;
            }
            asm volatile("" : "+v"(v1) :: "memory");
            float ts = 0.f; int ti = 0;
            for (int r = 0; r < 16; ++r) {
                float bv; int bi;
                if (v1 > v0) { bv = v1; bi = lane + 64; } else { bv = v0; bi = lane; }
                wave_argmax(bv, bi);
                if (lane == r) { ts = bv; ti = bi; }
                if (bi == lane) v0 = -INFINITY;
                if (bi == lane + 64) v1 = -INFINITY;
            }
            if (lane < 16) { wts[c * 16 + lane] = ts; wti[c * 16 + lane] = ti; }
        }
        lds_fence();
        float cs[4];
#pragma unroll
        for (int jj = 0; jj < 4; ++jj) { const int j = lane * 4 + jj; cs[jj] = wts[j >> 4] + wts[16 + (j & 15)]; }
        float bs = 0.f; int be = 0;
        for (int r = 0; r < 16; ++r) {
            float bv = cs[0]; int bi = lane * 4;
#pragma unroll
            for (int jj = 1; jj < 4; ++jj) if (cs[jj] > bv) { bv = cs[jj]; bi = lane * 4 + jj; }
            wave_argmax(bv, bi);
            if (lane == r) { bs = bv; be = wti[bi >> 4] * 128 + wti[16 + (bi & 15)]; }
#pragma unroll
            for (int jj = 0; jj < 4; ++jj) if (bi == lane * 4 + jj) cs[jj] = -INFINITY;
        }
        float mv = lane < 16 ? bs : -INFINITY;
        mv = wave_max(mv);
        float e = lane < 16 ? __expf(bs - mv) : 0.f;
        const float sum = wave_sum(e);
        if (lane < 16) { idx_out[(size_t)tok * 128 + h * 16 + lane] = be; gate_out[(size_t)tok * 128 + h * 16 + lane] = e / sum; }
    }
}

DEV void phase_expert_naive(const bf16_t* hn, const bf16_t* ut, const bf16_t* vt, const int* idx, const float* gate, float* xres, int bid, int nb) {
    const int wid = threadIdx.x >> 6, lane = threadIdx.x & 63;
    for (int tok = bid * 8 + wid; tok < NT; tok += nb * 8) {
        float hv[16], acc[16];
#pragma unroll
        for (int i = 0; i < 4; ++i) { const uint2 r = *(const uint2*)(hn + (size_t)tok * DM + i * 256 + lane * 4);
            hv[i * 4] = bflo(r.x); hv[i * 4 + 1] = bfhi(r.x); hv[i * 4 + 2] = bflo(r.y); hv[i * 4 + 3] = bfhi(r.y); }
#pragma unroll
        for (int i = 0; i < 16; ++i) acc[i] = 0.f;
        for (int k0 = 0; k0 < 128; k0 += 4) {
            int e[4]; float g[4]; uint2 ur[4][4], vr[4][4];
#pragma unroll
            for (int j = 0; j < 4; ++j) { e[j] = __builtin_amdgcn_readfirstlane(idx[(size_t)tok * 128 + k0 + j]); g[j] = gate[(size_t)tok * 128 + k0 + j]; }
#pragma unroll
            for (int j = 0; j < 4; ++j)
#pragma unroll
                for (int i = 0; i < 4; ++i) ur[j][i] = *(const uint2*)(ut + (size_t)e[j] * DM + i * 256 + lane * 4);
#pragma unroll
            for (int j = 0; j < 4; ++j)
#pragma unroll
                for (int i = 0; i < 4; ++i) vr[j][i] = *(const uint2*)(vt + (size_t)e[j] * DM + i * 256 + lane * 4);
#pragma unroll
            for (int j = 0; j < 4; ++j) {
                float d = 0.f;
#pragma unroll
                for (int i = 0; i < 4; ++i) d += hv[i * 4] * bflo(ur[j][i].x) + hv[i * 4 + 1] * bfhi(ur[j][i].x) + hv[i * 4 + 2] * bflo(ur[j][i].y) + hv[i * 4 + 3] * bfhi(ur[j][i].y);
                d = wave_sum(d);
                const float act = 0.5f * d * (1.0f + erff(d * 0.70710678118654752f));
                const float w = g[j] * act;
#pragma unroll
                for (int i = 0; i < 4; ++i) { acc[i * 4] += w * bflo(vr[j][i].x); acc[i * 4 + 1] += w * bfhi(vr[j][i].x); acc[i * 4 + 2] += w * bflo(vr[j][i].y); acc[i * 4 + 3] += w * bfhi(vr[j][i].y); }
            }
        }
#pragma unroll
        for (int i = 0; i < 4; ++i) { float4* p = (float4*)(xres + (size_t)tok * DM + i * 256 + lane * 4); float4 v = *p;
            v.x += acc[i * 4]; v.y += acc[i * 4 + 1]; v.z += acc[i * 4 + 2]; v.w += acc[i * 4 + 3]; *p = v; }
    }
}

constexpr int N_PHASES = 18;
__global__ void __launch_bounds__(NTHR, 2) fwd_kernel(Params p) {
    extern __shared__ __attribute__((aligned(16))) unsigned char lds_raw[];
    float* lds = (float*)lds_raw;
    const int bid = blockIdx.x, nb = gridDim.x;
    unsigned char* ws = p.ws;
    bf16_t* w_in0 = (bf16_t*)(ws + WS_WIN0); bf16_t* w_out0 = (bf16_t*)(ws + WS_WOUT0);
    bf16_t* w_in1 = (bf16_t*)(ws + WS_WIN1); bf16_t* w_out1 = (bf16_t*)(ws + WS_WOUT1);
    bf16_t* wq = (bf16_t*)(ws + WS_WQ); bf16_t* skb = (bf16_t*)(ws + WS_SK);
    bf16_t* ub = (bf16_t*)(ws + WS_U); bf16_t* vb = (bf16_t*)(ws + WS_V);
    bf16_t* hn = (bf16_t*)(ws + WS_HN); bf16_t* qkv = (bf16_t*)(ws + WS_QKV); bf16_t* pq = (bf16_t*)(ws + WS_QKV);
    float* fg = (float*)(ws + WS_FG); float* carr = (float*)(ws + WS_C);
    bf16_t* ao = (bf16_t*)(ws + WS_AO); int* idxb = (int*)(ws + WS_AO); float* gateb = (float*)(ws + WS_AO + (size_t)NT * 128 * 4);
    float* xres = p.out;
    const int lo = p.ph_lo, hi = p.ph_hi;
#define IN(k) (lo <= (k) && (k) < hi)
#define SEAM(k) do { if (IN(k) && IN((k) + 1)) {   } } while (0)

    if (IN(0)) {
        conv_transpose(p.even_w_in, w_in0, 1024, 3072, lds, bid, nb);
        conv_transpose(p.even_w_out, w_out0, 1024, 1024, lds, bid, nb);
        conv_transpose(p.odd_w_in, w_in1, 1024, 3088, lds, bid, nb);
        conv_transpose(p.odd_w_out, w_out1, 1024, 1024, lds, bid, nb);
        conv_transpose(p.peer_wq, wq, 1024, 2048, lds, bid, nb);
        conv_transpose(p.peer_wq + (size_t)1024 * 2048, wq + (size_t)2048 * 1024, 1024, 2048, lds, bid, nb);
        conv_copy(p.peer_sk, skb, (size_t)2 * 8 * 2 * 128 * 128, bid, nb);
        conv_copy(p.peer_u, ub, (size_t)2 * NEXP * 1024, bid, nb);
        conv_copy(p.peer_v, vb, (size_t)2 * NEXP * 1024, bid, nb);
        phase_norm(p.x, p.norm_mix_g, hn, bid, nb);
    }
    SEAM(0);
    if (IN(1)) phase_gemm_naive(hn, w_in0, NT, 3072, 1024, EpiBf16{qkv, 3072}, lds, bid, nb);
    SEAM(1);
    if (IN(2)) {
        phase_dilated_naive(qkv, p.rel_bias, ao, lds, bid, nb);
        phase_diff_naive(qkv, p.rel_bias, p.diff_lambda, p.diff_ln_g, ao, lds, bid, nb);
    }
    SEAM(2);
    if (IN(3)) phase_gemm_naive(ao, w_out0, NT, 1024, 1024, EpiRes{p.x, xres}, lds, bid, nb);
    SEAM(3);
    if (IN(4)) phase_norm(xres, p.norm_ffn_g, hn, bid, nb);
    SEAM(4);
    if (IN(5)) phase_gemm_naive(hn, wq, NT, 2048, 1024, EpiBf16{pq, 2048}, lds, bid, nb);
    SEAM(5);
    if (IN(6)) phase_topk_naive(pq, skb, idxb, gateb, lds, bid, nb);
    SEAM(6);
    if (IN(7)) phase_expert_naive(hn, ub, vb, idxb, gateb, xres, bid, nb);
    SEAM(7);
    if (IN(8)) phase_norm(xres, p.norm_mix_g + DM, hn, bid, nb);
    SEAM(8);
    if (IN(9)) phase_gemm_naive(hn, w_in1, NT, ODD_IN, 1024, EpiOddIn{qkv, fg, p.odd_b_f}, lds, bid, nb);
    SEAM(9);
    if (IN(10)) phase_cumsum(fg, carr, bid, nb);
    SEAM(10);
    if (IN(11)) phase_fox_naive(qkv, carr, ao, lds, bid, nb);
    SEAM(11);
    if (IN(12)) phase_gemm_naive(ao, w_out1, NT, 1024, 1024, EpiRes{xres, xres}, lds, bid, nb);
    SEAM(12);
    if (IN(13)) phase_norm(xres, p.norm_ffn_g + DM, hn, bid, nb);
    SEAM(13);
    if (IN(14)) phase_gemm_naive(hn, wq + (size_t)2048 * 1024, NT, 2048, 1024, EpiBf16{pq, 2048}, lds, bid, nb);
    SEAM(14);
    if (IN(15)) phase_topk_naive(pq, skb + (size_t)8 * 2 * 128 * 128, idxb, gateb, lds, bid, nb);
    SEAM(15);
    if (IN(16)) phase_expert_naive(hn, ub + (size_t)NEXP * 1024, vb + (size_t)NEXP * 1024, idxb, gateb, xres, bid, nb);
    SEAM(16);
    if (IN(17)) phase_final_norm(xres, p.final_g, bid, nb);
}

extern "C" void kernel_launch(void* const* d_in, const int* in_sizes, int n_in, void* d_out, int out_size, void* d_ws, size_t ws_size, hipStream_t stream) {
    static int grid = 0;
    if (grid == 0) {
        if (n_in != 16 || out_size != NT * DM || ws_size < WS_END) { fprintf(stderr, "kernel_launch: unexpected sizes n_in %d out %d ws %zu (need %zu)\n", n_in, out_size, ws_size, (size_t)WS_END); grid = -1; return; }
        int dev = 0, cus = 0;
        hipGetDevice(&dev); hipDeviceGetAttribute(&cus, hipDeviceAttributeMultiprocessorCount, dev);
        if (hipFuncSetAttribute((const void*)fwd_kernel, hipFuncAttributeMaxDynamicSharedMemorySize, LDS_BYTES) != hipSuccess) { fprintf(stderr, "hipFuncSetAttribute failed\n"); grid = -1; return; }
        grid = cus > 0 ? cus : 256;
    }
    if (grid < 0) return;
    Params p{};
    p.x = (const float*)d_in[0]; p.norm_mix_g = (const float*)d_in[1]; p.norm_ffn_g = (const float*)d_in[2]; p.final_g = (const float*)d_in[3];
    p.rel_bias = (const float*)d_in[4]; p.even_w_in = (const float*)d_in[5]; p.even_w_out = (const float*)d_in[6]; p.diff_lambda = (const float*)d_in[7];
    p.diff_ln_g = (const float*)d_in[8]; p.odd_w_in = (const float*)d_in[9]; p.odd_b_f = (const float*)d_in[10]; p.odd_w_out = (const float*)d_in[11];
    p.peer_wq = (const float*)d_in[12]; p.peer_sk = (const float*)d_in[13]; p.peer_u = (const float*)d_in[14]; p.peer_v = (const float*)d_in[15];
    p.out = (float*)d_out; p.ws = (unsigned char*)d_ws;
    for (int k = 0; k < N_PHASES; ++k) {
        p.ph_lo = k; p.ph_hi = k + 1;
        hipLaunchKernelGGL(fwd_kernel, dim3(grid), dim3(NTHR), LDS_BYTES, stream, p);
    }
}
```

```cpp
#include <hip/hip_runtime.h>
#include <stdint.h>
#include <math.h>
#include <cstdio>

typedef unsigned short bf16_t;
#define DEV static __device__ __forceinline__
#define MDEV __device__ __forceinline__

#ifndef PROBE_DUP
#define PROBE_DUP 0
#endif
constexpr int DM = 1024, NBATCH = 8, SEQ = 4096, NT = NBATCH * SEQ;
constexpr int EVEN_IN = 3072, ODD_IN = 3088;
constexpr int NEXP = 16384;
constexpr int NTHR = 512;
constexpr int LDS_BYTES = 144 * 1024;

constexpr size_t KB_ = 1024, MB_ = 1024 * 1024;
constexpr size_t WS_BAR   = 0;
constexpr size_t WS_KMAX  = 32768;
constexpr size_t WS_CTOT  = 33792;
constexpr size_t WS_WIN0  = 64 * KB_;
constexpr size_t WS_WOUT0 = WS_WIN0 + (size_t)3072 * 1024 * 2;
constexpr size_t WS_WIN1  = WS_WOUT0 + (size_t)1024 * 1024 * 2;
constexpr size_t WS_WOUT1 = WS_WIN1 + (size_t)3328 * 1024 * 2;
constexpr size_t WS_WQ    = WS_WOUT1 + (size_t)1024 * 1024 * 2;
constexpr size_t WS_SK    = WS_WQ + (size_t)2 * 2048 * 1024 * 2;
constexpr size_t WS_U     = WS_SK + (size_t)2 * 8 * 2 * 128 * 128 * 2;
constexpr size_t WS_V     = WS_U + (size_t)2 * NEXP * 1024;
constexpr size_t WS_USC   = WS_V + (size_t)2 * NEXP * 1024;
constexpr size_t WS_VSC   = WS_USC + (size_t)2 * NEXP * 4;
constexpr size_t WS_HN    = WS_VSC + (size_t)2 * NEXP * 4;
constexpr size_t WS_QKV   = WS_HN + (size_t)NT * 1024 * 2;
constexpr size_t WS_FG    = WS_QKV + (size_t)NT * 3072 * 2;
constexpr size_t WS_C     = WS_FG + (size_t)NT * 16 * 4;
constexpr size_t WS_AO    = WS_C + (size_t)NT * 16 * 4;
constexpr size_t WS_DPO   = WS_AO + (size_t)NT * 1024 * 2;
constexpr size_t WS_DLSE  = WS_HN;
constexpr size_t WS_END   = WS_DPO + (size_t)3 * NT * 512 * 2;
static_assert(WS_END <= (size_t)512 * 1024 * 1024, "workspace map exceeds the guaranteed 512 MiB");

struct Params {
    const float *x, *norm_mix_g, *norm_ffn_g, *final_g, *rel_bias, *even_w_in, *even_w_out, *diff_lambda, *diff_ln_g,
                *odd_w_in, *odd_b_f, *odd_w_out, *peer_wq, *peer_sk, *peer_u, *peer_v;
    float* out;
    unsigned char* ws;
    int ph_lo, ph_hi;
};

DEV float bf2f(bf16_t v) { return __uint_as_float(((unsigned)v) << 16); }
DEV bf16_t f2bf(float f) { unsigned u = __float_as_uint(f); u += 0x7FFFu + ((u >> 16) & 1u); return (bf16_t)(u >> 16); }
DEV unsigned pk2(float lo, float hi) { return (unsigned)f2bf(lo) | ((unsigned)f2bf(hi) << 16); }
DEV unsigned cvtpk2(float lo, float hi) { unsigned r; asm("v_cvt_pk_bf16_f32 %0, %1, %2" : "=v"(r) : "v"(lo), "v"(hi)); return r; }
DEV float bflo(unsigned w) { return __uint_as_float(w << 16); }
DEV float bfhi(unsigned w) { return __uint_as_float(w & 0xFFFF0000u); }
DEV float wave_sum(float v) {
#pragma unroll
    for (int o = 32; o >= 1; o >>= 1) v += __shfl_xor(v, o);
    return v;
}
DEV float wave_max(float v) {
#pragma unroll
    for (int o = 32; o >= 1; o >>= 1) v = fmaxf(v, __shfl_xor(v, o));
    return v;
}
DEV int opaque_tid() { int t = threadIdx.x; asm volatile("" : "+v"(t)); return t; }
typedef const __attribute__((address_space(4))) struct Params* cparams_t;
DEV cparams_t kernarg_ptr() {
#if defined(__HIP_DEVICE_COMPILE__)
    return (cparams_t)__builtin_amdgcn_kernarg_segment_ptr();
#else
    return (cparams_t)0;
#endif
}
DEV void lds_fence() { asm volatile("s_waitcnt lgkmcnt(0)" ::: "memory"); }

DEV unsigned queue_next(unsigned* q, volatile unsigned* sh) {
    __syncthreads();
    if (threadIdx.x == 0) sh[0] = __hip_atomic_fetch_add(q, 1u, __ATOMIC_RELAXED, __HIP_MEMORY_SCOPE_AGENT);
    __syncthreads();
    return sh[0];
}
DEV int t5_bucket(int d) {
    if (d < 16) return d;
    int b = 16;
    b += (d >= 22); b += (d >= 30); b += (d >= 40); b += (d >= 54); b += (d >= 73); b += (d >= 99); b += (d >= 134); b += (d >= 182);
    b += (d >= 246); b += (d >= 332); b += (d >= 450); b += (d >= 609); b += (d >= 825); b += (d >= 1117); b += (d >= 1513);
    return b;
}

DEV void conv_transpose(const float* src, bf16_t* dst, int K, int N, float* lds, int bid, int nb) {
    const int tid_ = opaque_tid();
    const int t = tid_;
    const int ntk = K / 64, ntn = (N + 63) / 64;
    for (int tile = bid; tile < ntk * ntn; tile += nb) {
        const int k0 = (tile / ntn) * 64, n0 = (tile % ntn) * 64;
        __syncthreads();
#pragma unroll
        for (int i = 0; i < 8; ++i) {
            const int r = (t >> 6) + 8 * i, c = t & 63;
            float v = 0.f;
            if (n0 + c < N) v = src[(size_t)(k0 + r) * N + n0 + c];
            lds[r * 65 + c] = v;
        }
        __syncthreads();
#pragma unroll
        for (int i = 0; i < 8; ++i) {
            const int r = (t >> 6) + 8 * i, c = t & 63;
            if (n0 + r < N) dst[(size_t)(n0 + r) * K + k0 + c] = f2bf(lds[c * 65 + r]);
        }
    }
}
DEV void conv_copy(const float* src, bf16_t* dst, size_t n, int bid, int nb) {
    const int tid_ = opaque_tid();
    const size_t n4 = n / 4;
    for (size_t i = (size_t)bid * NTHR + tid_; i < n4; i += (size_t)nb * NTHR) {
        const float4 v = ((const float4*)src)[i];
        uint2 o; o.x = pk2(v.x, v.y); o.y = pk2(v.z, v.w);
        ((uint2*)dst)[i] = o;
    }
}

DEV void conv_fp8_rows(const float* src, unsigned char* dst, float* inv, int rows, int bid, int nb) {
    const int tid_ = opaque_tid();
    const int wid = tid_ >> 6, lane = tid_ & 63;
    for (int row = bid * 8 + wid; row < rows; row += nb * 8) {
        const float4* xr = (const float4*)(src + (size_t)row * DM) + lane;
        float4 v[4]; float mx = 0.f;
#pragma unroll
        for (int i = 0; i < 4; ++i) { v[i] = xr[64 * i]; mx = fmaxf(mx, fmaxf(fmaxf(fabsf(v[i].x), fabsf(v[i].y)), fmaxf(fabsf(v[i].z), fabsf(v[i].w)))); }
        mx = wave_max(mx);
        int e = 0; if (mx > 0.f) (void)frexpf(mx, &e);
        e = min(max(e, -100), 100);
        const float sc = ldexpf(1.0f, 8 - e), isc = ldexpf(1.0f, e - 8);
        const int layer = row / NEXP, ex = row % NEXP;
#pragma unroll
        for (int i = 0; i < 4; ++i) {
            unsigned w = __builtin_amdgcn_cvt_pk_fp8_f32(v[i].x * sc, v[i].y * sc, 0, false); w = __builtin_amdgcn_cvt_pk_fp8_f32(v[i].z * sc, v[i].w * sc, w, true);
            const int col = 4 * lane + 256 * i, x = col >> 7, off = col & 127;
            *(unsigned*)(dst + (((size_t)layer * 8 + x) * NEXP + ex) * 128 + off) = w;
        }
        if (lane == 0) inv[row] = isc;
    }
}

DEV void phase_norm(const float* xin, const float* g, bf16_t* out, int bid, int nb) {
    const int tid_ = opaque_tid();
    const int wid = tid_ >> 6, lane = tid_ & 63;
    for (int row = bid * 8 + wid; row < NT; row += nb * 8) {
        const float4* xr = (const float4*)(xin + (size_t)row * DM);
        float4 v[4]; float ss = 0.f;
#pragma unroll
        for (int i = 0; i < 4; ++i) { v[i] = xr[lane + 64 * i]; ss += v[i].x * v[i].x + v[i].y * v[i].y + v[i].z * v[i].z + v[i].w * v[i].w; }
        ss = wave_sum(ss);
        const float rstd = 1.0f / sqrtf(ss * (1.0f / DM) + 1e-6f);
#pragma unroll
        for (int i = 0; i < 4; ++i) {
            const float4 gg = ((const float4*)g)[lane + 64 * i];
            uint2 o; o.x = pk2(v[i].x * rstd * gg.x, v[i].y * rstd * gg.y); o.y = pk2(v[i].z * rstd * gg.z, v[i].w * rstd * gg.w);
            ((uint2*)(out + (size_t)row * DM))[lane + 64 * i] = o;
        }
    }
}
DEV void phase_res_norm(const float* xin, const bf16_t* delta, const float* g, float* xout, bf16_t* out, int bid, int nb) {
    const int tid_ = opaque_tid();
    const int wid = tid_ >> 6, lane = tid_ & 63;
    for (int row = bid * 8 + wid; row < NT; row += nb * 8) {
        const float4* xr = (const float4*)(xin + (size_t)row * DM);
        const uint2* dr = (const uint2*)(delta + (size_t)row * DM);
        float4 v[4]; float ss = 0.f;
#pragma unroll
        for (int i = 0; i < 4; ++i) { v[i] = xr[lane + 64 * i]; const uint2 d = dr[lane + 64 * i];
            v[i].x += bflo(d.x); v[i].y += bfhi(d.x); v[i].z += bflo(d.y); v[i].w += bfhi(d.y);
            ss += v[i].x * v[i].x + v[i].y * v[i].y + v[i].z * v[i].z + v[i].w * v[i].w; }
        ss = wave_sum(ss);
        const float rstd = 1.0f / sqrtf(ss * (1.0f / DM) + 1e-6f);
#pragma unroll
        for (int i = 0; i < 4; ++i) {
            ((float4*)(xout + (size_t)row * DM))[lane + 64 * i] = v[i];
            const float4 gg = ((const float4*)g)[lane + 64 * i];
            uint2 o; o.x = pk2(v[i].x * rstd * gg.x, v[i].y * rstd * gg.y); o.y = pk2(v[i].z * rstd * gg.z, v[i].w * rstd * gg.w);
            ((uint2*)(out + (size_t)row * DM))[lane + 64 * i] = o;
        }
    }
}
DEV void phase_final_norm(float* x, const float* g, int bid, int nb) {
    const int tid_ = opaque_tid();
    const int wid = tid_ >> 6, lane = tid_ & 63;
    for (int row = bid * 8 + wid; row < NT; row += nb * 8) {
        float4* xr = (float4*)(x + (size_t)row * DM);
        float4 v[4]; float ss = 0.f;
#pragma unroll
        for (int i = 0; i < 4; ++i) { v[i] = xr[lane + 64 * i]; ss += v[i].x * v[i].x + v[i].y * v[i].y + v[i].z * v[i].z + v[i].w * v[i].w; }
        ss = wave_sum(ss);
        const float rstd = 1.0f / sqrtf(ss * (1.0f / DM) + 1e-6f);
#pragma unroll
        for (int i = 0; i < 4; ++i) {
            const float4 gg = ((const float4*)g)[lane + 64 * i];
            float4 o; o.x = v[i].x * rstd * gg.x; o.y = v[i].y * rstd * gg.y; o.z = v[i].z * rstd * gg.z; o.w = v[i].w * rstd * gg.w;
            xr[lane + 64 * i] = o;
        }
    }
}

struct EpiBf16 { bf16_t* out; int ld;
    MDEV void operator()(int r, int c, float v) const { out[(size_t)r * ld + c] = f2bf(v); } };
struct EpiOddIn { bf16_t* out; float* fg; const float* bfv;
    MDEV void operator()(int r, int c, float v) const { if (c < 3072) out[(size_t)r * 3072 + c] = f2bf(v); else fg[(size_t)r * 16 + (c - 3072)] = v + bfv[c - 3072]; } };
struct EpiRes { const float* xin; float* xout;
    MDEV void operator()(int r, int c, float v) const { xout[(size_t)r * DM + c] = xin[(size_t)r * DM + c] + v; } };

template <class Epi>
DEV void phase_gemm_naive(const bf16_t* A, const bf16_t* Bt, int M, int N, int K, const Epi epi, float* lds, int bid, int nb) {
    float* As = lds;
    float* Bs = lds + 16 * 132;
    const int t = threadIdx.x, tx = t & 31, ty = t >> 5;
    const int ntm = M / 128, ntn = (N + 127) / 128;
    const int lr = t >> 2, lk = (t & 3) * 4;
    for (int tile = bid; tile < ntm * ntn; tile += nb) {
        const int m0 = (tile / ntn) * 128, n0 = (tile % ntn) * 128;
        float acc[8][4];
#pragma unroll
        for (int i = 0; i < 8; ++i)
#pragma unroll
            for (int j = 0; j < 4; ++j) acc[i][j] = 0.f;
        for (int k0 = 0; k0 < K; k0 += 16) {
            const uint2 av = *(const uint2*)(A + (size_t)(m0 + lr) * K + k0 + lk);
            uint2 bv = make_uint2(0u, 0u);
            if (n0 + lr < N) bv = *(const uint2*)(Bt + (size_t)(n0 + lr) * K + k0 + lk);
            __syncthreads();
            As[(lk + 0) * 132 + lr] = bflo(av.x); As[(lk + 1) * 132 + lr] = bfhi(av.x); As[(lk + 2) * 132 + lr] = bflo(av.y); As[(lk + 3) * 132 + lr] = bfhi(av.y);
            Bs[(lk + 0) * 132 + lr] = bflo(bv.x); Bs[(lk + 1) * 132 + lr] = bfhi(bv.x); Bs[(lk + 2) * 132 + lr] = bflo(bv.y); Bs[(lk + 3) * 132 + lr] = bfhi(bv.y);
            __syncthreads();
#pragma unroll
            for (int k = 0; k < 16; ++k) {
                const float4 a0 = *(const float4*)&As[k * 132 + ty * 8], a1 = *(const float4*)&As[k * 132 + ty * 8 + 4];
                const float4 b0 = *(const float4*)&Bs[k * 132 + tx * 4];
                const float a[8] = {a0.x, a0.y, a0.z, a0.w, a1.x, a1.y, a1.z, a1.w};
                const float b[4] = {b0.x, b0.y, b0.z, b0.w};
#pragma unroll
                for (int i = 0; i < 8; ++i)
#pragma unroll
                    for (int j = 0; j < 4; ++j) acc[i][j] += a[i] * b[j];
            }
        }
#pragma unroll
        for (int i = 0; i < 8; ++i)
#pragma unroll
            for (int j = 0; j < 4; ++j) { const int row = m0 + ty * 8 + i, col = n0 + tx * 4 + j; if (col < N) epi(row, col, acc[i][j]); }
    }
}

typedef short bf16x8 __attribute__((ext_vector_type(8)));
typedef float f32x4 __attribute__((ext_vector_type(4)));
namespace g8 {
constexpr int BM = 256, BK = 64, HALF = 128, NXCD = 8, WGM = 8, HT = HALF * BK, KD = 1024;
DEV int lds_byte(int r, int c) { const int st = (r >> 4) * 2 + (c >> 5), rr = r & 15, cc = c & 31, ob = rr * 64 + cc * 2; return st * 1024 + (ob ^ (((ob >> 9) & 1) << 5)); }
DEV void stage_rc(int b, int& R, int& C) { const int st = b / 1024, sb = b % 1024, swz = sb ^ (((sb >> 9) & 1) << 5); R = (st >> 1) * 16 + swz / 64; C = (st & 1) * 32 + (swz % 64) / 2; }
}
struct MEpiBf16 { static constexpr bool PERM = true; bf16_t* out; int ld;
    MDEV void operator()(int r, int c, f32x4 v0, f32x4 v1) const { uint4 o; o.x = cvtpk2(v0[0], v0[1]); o.y = cvtpk2(v0[2], v0[3]); o.z = cvtpk2(v1[0], v1[1]); o.w = cvtpk2(v1[2], v1[3]);
        *(uint4*)(out + (size_t)r * ld + c) = o; } };
struct MEpiQKV { static constexpr bool PERM = true; bf16_t* out; int s0_hi, s1_lo, s1_hi;
    MDEV void operator()(int r, int c, f32x4 v0, f32x4 v1) const { const float sc = (c < s0_hi || (c >= s1_lo && c < s1_hi)) ? 0.125f * 1.4426950408889634f : 1.0f;
        uint4 o; o.x = cvtpk2(v0[0] * sc, v0[1] * sc); o.y = cvtpk2(v0[2] * sc, v0[3] * sc); o.z = cvtpk2(v1[0] * sc, v1[1] * sc); o.w = cvtpk2(v1[2] * sc, v1[3] * sc);
        *(uint4*)(out + (size_t)r * 3072 + c) = o; } };
struct MEpiRes { static constexpr bool PERM = false; const float* xin; float* xout;
    MDEV void operator()(int r, int c, f32x4 v) const { const f32x4 b = *(const f32x4*)(xin + (size_t)r * DM + c); *(f32x4*)(xout + (size_t)r * DM + c) = b + v; } };

template <class Epi>
DEV void phase_gemm_mfma(const bf16_t* A, const bf16_t* Bt, int M, int N, const Epi epi, unsigned char* shm_raw, int bid, int nb) {
    using namespace g8;
    typedef __attribute__((address_space(3))) unsigned char* ldsp_t;
    ldsp_t lds = (ldsp_t)shm_raw;
    constexpr int K = KD, nt = K / BK, HTB = HALF * BK * 2;
    int tid = threadIdx.x; asm volatile("" : "+v"(tid));
    const int wid = __builtin_amdgcn_readfirstlane(tid >> 6), lane = tid & 63, wr = wid >> 2, wc = wid & 3, fr = lane & 15, fq = lane >> 4;
    const int nM = M / BM, nN = N / BM, nwg = nM * nN;
    auto unit_of = [&](int i, int& pm, int& pn) -> bool {
        const long L = (long)i * nb + bid; if (L >= nwg) return false;
        int wgid = (int)L;
        { const int q = nwg / NXCD, r = nwg % NXCD, xcd = wgid % NXCD, off = wgid / NXCD; wgid = (xcd < r ? xcd * (q + 1) : r * (q + 1) + (xcd - r) * q) + off; }
        const int nig = WGM * nN, gid = wgid / nig, fm = gid * WGM, gsz = min(nM - fm, WGM);
        pm = fm + ((wgid % nig) % gsz); pn = (wgid % nig) / gsz; return true; };
    unsigned voffA[2], voffB[2];
#pragma unroll
    for (int i = 0; i < 2; ++i) { int R, C; stage_rc(tid * 16 + i * 8192, R, C); const int rho = R & 31, pr = 8 * ((rho & 15) >> 2) + 4 * (rho >> 4) + (rho & 3);
        const int Rb = Epi::PERM ? ((R & ~31) + pr) : R;
        voffA[i] = (unsigned)(R * K + C) * 2u; voffB[i] = (unsigned)(Rb * K + C) * 2u; }
    constexpr size_t kstep = (size_t)(BK * 2), hstep = (size_t)HALF * K * 2, tstep = 2 * hstep;
    const unsigned ldsw = (unsigned)wid * 1024u;
    const int aoff = lds_byte(wr * 64 + fr, fq * 8), boff = lds_byte(wc * 32 + fr, fq * 8);
#define SA(b, h) (((b) * 2 + (h)) * HTB)
#define SB(b, h) ((4 + (b) * 2 + (h)) * HTB)
#define STAGE(bufoff, gbase, voff) do { _Pragma("unroll") for (int _i = 0; _i < 2; ++_i) \
        __builtin_amdgcn_global_load_lds((const unsigned*)((const char*)(gbase) + (voff)[_i]), (__attribute__((address_space(3))) unsigned*)(lds + (bufoff) + ldsw + _i * 8192), 16, 0, 0); } while (0)
#define LDA(dst, b, h) do { _Pragma("unroll") for (int m = 0; m < 4; ++m) _Pragma("unroll") for (int k = 0; k < 2; ++k) dst[m][k] = *(const __attribute__((address_space(3))) bf16x8*)(lds + SA(b, h) + aoff + m * 2048 + k * 1024); } while (0)
#define LDB(dst, b, h) do { _Pragma("unroll") for (int n = 0; n < 2; ++n) _Pragma("unroll") for (int k = 0; k < 2; ++k) dst[n][k] = *(const __attribute__((address_space(3))) bf16x8*)(lds + SB(b, h) + boff + n * 2048 + k * 1024); } while (0)
#define MMA(ai, bj, At, Bt_) do { __builtin_amdgcn_s_setprio(1); _Pragma("unroll") for (int m = 0; m < 4; ++m) _Pragma("unroll") for (int n = 0; n < 2; ++n) _Pragma("unroll") for (int k = 0; k < 2; ++k) \
        acc[ai][bj][m][n] = __builtin_amdgcn_mfma_f32_16x16x32_bf16(Bt_[n][k], At[m][k], acc[ai][bj][m][n], 0, 0, 0); __builtin_amdgcn_s_setprio(0); } while (0)
#define WAIT_V(n) asm volatile("s_waitcnt vmcnt(" #n ")" ::: "memory")
#define WAIT_L(n) asm volatile("s_waitcnt lgkmcnt(" #n ")" ::: "memory")
#define BAR __builtin_amdgcn_s_barrier()
#define SCHED __builtin_amdgcn_sched_barrier(0)
    int cpm, cpn, npm = 0, npn = 0, ui = 0;
    if (!unit_of(0, cpm, cpn)) return;
    f32x4 acc[2][2][4][2];
#pragma unroll
    for (int a = 0; a < 2; ++a)
#pragma unroll
        for (int b = 0; b < 2; ++b)
#pragma unroll
            for (int m = 0; m < 4; ++m)
#pragma unroll
                for (int n = 0; n < 2; ++n) acc[a][b][m][n] = (f32x4){0.f, 0.f, 0.f, 0.f};
    bf16x8 At[4][2], B0[2][2], B1[2][2];
    const char* cA = (const char*)A + (size_t)cpm * tstep; const char* cB = (const char*)Bt + (size_t)cpn * tstep;
    __syncthreads();
    STAGE(SB(0, 0), cB, voffB); STAGE(SA(0, 0), cA, voffA); STAGE(SB(0, 1), cB + hstep, voffB); STAGE(SA(0, 1), cA + hstep, voffA);
    if (wr == 1) BAR;
    WAIT_V(4); BAR;
    STAGE(SB(1, 0), cB + kstep, voffB); STAGE(SA(1, 0), cA + kstep, voffA); STAGE(SB(1, 1), cB + hstep + kstep, voffB);
    WAIT_V(6); BAR;
    for (;;) {
        const bool has_next = unit_of(ui + 1, npm, npn);
        const char* nA = has_next ? (const char*)A + (size_t)npm * tstep : cA; const char* nB = has_next ? (const char*)Bt + (size_t)npn * tstep : cB;
#pragma unroll 1
        for (int t = 0; t < nt; t += 2) {
            const bool last = (t == nt - 2);
            const char* a1 = cA + (size_t)(t + 1) * kstep;
            const char* a2 = last ? nA : cA + (size_t)(t + 2) * kstep; const char* b2 = last ? nB : cB + (size_t)(t + 2) * kstep;
            const char* a3 = a2 + kstep; const char* b3 = b2 + kstep;
            LDB(B0, 0, 0); SCHED; LDA(At, 0, 0); STAGE(SA(1, 1), a1 + hstep, voffA);
            WAIT_L(8); BAR; WAIT_L(0); MMA(0, 0, At, B0); BAR; SCHED;
            LDB(B1, 0, 1); STAGE(SB(0, 0), b2, voffB);
            BAR; WAIT_L(0); MMA(0, 1, At, B1); BAR;
            LDA(At, 0, 1); STAGE(SA(0, 0), a2, voffA);
            BAR; WAIT_L(0); MMA(1, 0, At, B0); BAR; SCHED;
            STAGE(SB(0, 1), b2 + hstep, voffB);
            WAIT_V(6); BAR; MMA(1, 1, At, B1); BAR;
            LDB(B0, 1, 0); SCHED; LDA(At, 1, 0); STAGE(SA(0, 1), a2 + hstep, voffA);
            WAIT_L(8); BAR; WAIT_L(0); MMA(0, 0, At, B0); BAR; SCHED;
            LDB(B1, 1, 1); STAGE(SB(1, 0), b3, voffB);
            BAR; WAIT_L(0); MMA(0, 1, At, B1); BAR;
            LDA(At, 1, 1); STAGE(SA(1, 0), a3, voffA);
            BAR; WAIT_L(0); MMA(1, 0, At, B0); BAR; SCHED;
            STAGE(SB(1, 1), b3 + hstep, voffB);
            WAIT_V(6); BAR; MMA(1, 1, At, B1); BAR;
        }
        {
            const int brow = cpm * BM, bcol = cpn * BM;
#pragma unroll
            for (int ai = 0; ai < 2; ++ai)
#pragma unroll
                for (int m = 0; m < 4; ++m)
#pragma unroll
                    for (int bj = 0; bj < 2; ++bj) {
                        const int row = brow + ai * HALF + wr * 64 + m * 16 + fr;
                        if constexpr (Epi::PERM) epi(row, bcol + bj * HALF + wc * 32 + 8 * fq, acc[ai][bj][m][0], acc[ai][bj][m][1]);
                        else { epi(row, bcol + bj * HALF + wc * 32 + 4 * fq, acc[ai][bj][m][0]); epi(row, bcol + bj * HALF + wc * 32 + 16 + 4 * fq, acc[ai][bj][m][1]); }
                    }
        }
        if (!has_next) break;
#pragma unroll
        for (int a = 0; a < 2; ++a)
#pragma unroll
            for (int b = 0; b < 2; ++b)
#pragma unroll
                for (int m = 0; m < 4; ++m)
#pragma unroll
                    for (int n = 0; n < 2; ++n) acc[a][b][m][n] = (f32x4){0.f, 0.f, 0.f, 0.f};
        cpm = npm; cpn = npn; cA = nA; cB = nB; ++ui;
    }
    WAIT_V(0);
    if (wr == 0) BAR;
    BAR;
#undef SA
#undef SB
#undef STAGE
#undef LDA
#undef LDB
#undef MMA
#undef WAIT_V
#undef WAIT_L
#undef BAR
#undef SCHED
}

DEV void phase_fg(const bf16_t* hn, const bf16_t* wfg, const float* bfv, float* fg, int bid, int nb) {
    const int tid_ = opaque_tid();
    const int wid = tid_ >> 6, lane = tid_ & 63, fr = lane & 15, fq = lane >> 4;
    for (int task = bid * 8 + wid; task < NT / 16; task += nb * 8) {
        const int row0 = task * 16;
        f32x4 acc = (f32x4){0.f, 0.f, 0.f, 0.f};
        const bf16x8* ap = (const bf16x8*)(hn + (size_t)(row0 + fr) * DM + fq * 8);
        const bf16x8* bp = (const bf16x8*)(wfg + (size_t)fr * DM + fq * 8);
#pragma unroll 8
        for (int kk = 0; kk < 32; ++kk) acc = __builtin_amdgcn_mfma_f32_16x16x32_bf16(ap[kk * 4], bp[kk * 4], acc, 0, 0, 0);
        const float bb = bfv[fr];
#pragma unroll
        for (int j = 0; j < 4; ++j) fg[(size_t)(row0 + fq * 4 + j) * 16 + fr] = acc[j] + bb;
    }
}

typedef float f32x16 __attribute__((ext_vector_type(16)));
typedef short s16x4 __attribute__((ext_vector_type(4)));
typedef __attribute__((address_space(3))) const unsigned char* ldsc_t;
typedef __attribute__((address_space(3))) unsigned char* lptr_t;
#define MFMA32(a, b, c) __builtin_amdgcn_mfma_f32_32x32x16_bf16(a, b, c, 0, 0, 0)
constexpr float NEG_BIG = -1e30f;
constexpr float LOG2E = 1.4426950408889634f;
constexpr float QSCALE = 0.125f * LOG2E;
constexpr int ATT_LUT_OFF = 0;
constexpr int ATT_TILE_OFF = 24576;
DEV unsigned cvtpk(float lo, float hi) { unsigned r; asm("v_cvt_pk_bf16_f32 %0, %1, %2" : "=v"(r) : "v"(lo), "v"(hi)); return r; }
DEV s16x4 vtr(ldsc_t p) { typedef short v4i16_t __attribute__((ext_vector_type(4))); return __builtin_bit_cast(s16x4, __builtin_amdgcn_ds_read_tr16_b64_v4i16((__attribute__((address_space(3))) v4i16_t*)p)); }
DEV float xhalf_max(float m) { auto rr = __builtin_amdgcn_permlane32_swap(__float_as_uint(m), __float_as_uint(m), false, false); return fmaxf(__uint_as_float(rr[0]), __uint_as_float(rr[1])); }
DEV float xhalf_sum(float m) { auto rr = __builtin_amdgcn_permlane32_swap(__float_as_uint(m), __float_as_uint(m), false, false); return __uint_as_float(rr[0]) + __uint_as_float(rr[1]); }

#define MXX3(a, b, c) __builtin_fmaxf(__builtin_fmaxf((a), (b)), (c))
template <int W, int MODE, int WIN  >
DEV void attn_unit(const bf16_t* qg  , const bf16_t* kg  , const bf16_t* vg, int kt_lo, int kt_hi,
                   int qrow, int qmin, int qmax, int kmap, unsigned char* lds_raw, f32x16 (&o)[W / 32], float kbound = 0.f, int rs = 3072, float* lse_out = nullptr, int rmax = 4127) {
    constexpr bool BAND = (WIN != 0);
    constexpr bool REV = (MODE == 1);
    constexpr int NC = W / 32, ROWB = W * 2, TILEB = 64 * ROWB, CPR = W / 8, NLD = (64 * CPR) / NTHR;
    int tid = threadIdx.x; asm volatile("" : "+v"(tid));
    const int lane = tid & 63, l31 = lane & 31, hi = lane >> 5;
    ldsc_t lds = (ldsc_t)lds_raw;
    const float* lut = (const float*)(lds_raw + ATT_LUT_OFF);
    bf16x8 qf[4];
#pragma unroll
    for (int ks = 0; ks < 4; ++ks) qf[ks] = *(const bf16x8*)(qg + ks * 16 + hi * 8);
#pragma unroll
    for (int c = 0; c < NC; ++c)
#pragma unroll
        for (int r = 0; r < 16; ++r) o[c][r] = 0.f;
    float m = NEG_BIG, l = 0.f;
    float brow = 0.f; bool wdone = false;
    volatile __attribute__((address_space(3))) unsigned* flg = (volatile __attribute__((address_space(3))) unsigned*)((lptr_t)lds_raw + ATT_LUT_OFF + 20480);
    if (REV) { float ss = 0.f;
#pragma unroll
        for (int ks = 0; ks < 4; ++ks)
#pragma unroll
            for (int j = 0; j < 8; ++j) { const float v = bf2f((bf16_t)qf[ks][j]); ss += v * v; }
        brow = sqrtf(xhalf_sum(ss)) * kbound; }
    const int wv = __builtin_amdgcn_readfirstlane(tid >> 6);
    unsigned ksrc[NLD], vsrc[NLD];
#pragma unroll
    for (int i = 0; i < NLD; ++i) { const int id = tid + NTHR * i, row = id / CPR, chp = id % CPR;
        const int kch = (W == 64) ? (chp ^ ((row >> 1) & 7)) : (chp ^ (row & 15));
        const int vch = (W == 64) ? (chp ^ (((row >> 1) & 1) << 2)) : (chp ^ ((row & 3) << 2));
        ksrc[i] = (unsigned)(row * rs + kch * 8); vsrc[i] = (unsigned)(row * rs + vch * 8); }
#define stage_issue(kt_, buf_) do { _Pragma("unroll") for (int i = 0; i < NLD; ++i) { \
        __builtin_amdgcn_global_load_lds((const unsigned*)(kg + (size_t)(kt_) * 64 * rs + ksrc[i]), (__attribute__((address_space(3))) unsigned*)((lptr_t)lds_raw + ATT_TILE_OFF + (buf_) * (2 * TILEB) + (wv * 64 + NTHR * i) * 16), 16, 0, 0); \
        __builtin_amdgcn_global_load_lds((const unsigned*)(vg + (size_t)(kt_) * 64 * rs + vsrc[i]), (__attribute__((address_space(3))) unsigned*)((lptr_t)lds_raw + ATT_TILE_OFF + (buf_) * (2 * TILEB) + TILEB + (wv * 64 + NTHR * i) * 16), 16, 0, 0); } } while (0)
    int koff[4];
#pragma unroll
    for (int ks = 0; ks < 4; ++ks) { const int ch = (kmap >> 3) + 2 * ks + hi; const int kch = (W == 64) ? (ch ^ ((l31 >> 1) & 7)) : (ch ^ (l31 & 15)); koff[ks] = l31 * ROWB + kch * 16; }
    int voff[NC];
    { const int q4 = (lane & 15) >> 2, blk = (lane >> 4) & 1, p = lane & 3;
#pragma unroll
      for (int c = 0; c < NC; ++c) { const int ch = 4 * c + 2 * blk + (p >> 1); const int vch = (W == 64) ? (ch ^ (((q4 >> 1) & 1) << 2)) : (ch ^ (q4 << 2));
          voff[c] = (4 * hi + q4) * ROWB + vch * 16 + 8 * (p & 1); } }
    __syncthreads();
    stage_issue(REV ? kt_hi : kt_lo, 0);
    __syncthreads();
    const int ntile = kt_hi - kt_lo + 1;
    for (int it = 0; it < ntile; ++it) {
        const int kt = REV ? kt_hi - it : kt_lo + it, ktn = REV ? kt - 1 : kt + 1;
        const bool has_next = it + 1 < ntile;
        const int buf = it & 1;
        if (has_next) stage_issue(ktn, buf ^ 1);
        const int k0 = kt * 64;
        bool active = (k0 <= qmax);
        if (BAND) active = active && (k0 + 63 >= qmin - WIN);
        if (REV) active = active && !wdone;
        if (active) {
            ldsc_t kb_ = lds + ATT_TILE_OFF + buf * (2 * TILEB); ldsc_t vb_ = kb_ + TILEB;
            f32x16 s0, s1;
            if (MODE == 0) {
                const bool far = !BAND && (qmin - (k0 + 63) >= 1513);
                const int ib = far ? (rmax - 3000) : (rmax - (qrow - k0 - 4 * hi));
                const __attribute__((address_space(3))) float* lp = (const __attribute__((address_space(3))) float*)((lptr_t)lds_raw + ATT_LUT_OFF) + ib;
#pragma unroll
                for (int r = 0; r < 16; ++r) { const int cr = (r & 3) + 8 * (r >> 2); s0[r] = lp[cr]; s1[r] = lp[32 + cr]; }
            } else {
                const f32x4* cp = (const f32x4*)(lut + k0 + 4 * hi);
#pragma unroll
                for (int g = 0; g < 4; ++g) { const f32x4 a = cp[2 * g], b = cp[2 * g + 8];
                    s0[4 * g] = a[0]; s0[4 * g + 1] = a[1]; s0[4 * g + 2] = a[2]; s0[4 * g + 3] = a[3];
                    s1[4 * g] = b[0]; s1[4 * g + 1] = b[1]; s1[4 * g + 2] = b[2]; s1[4 * g + 3] = b[3]; }
            }
#pragma unroll
            for (int ks = 0; ks < 4; ++ks) {
                const bf16x8 k0f = *(const __attribute__((address_space(3))) bf16x8*)(kb_ + koff[ks]);
                const bf16x8 k1f = *(const __attribute__((address_space(3))) bf16x8*)(kb_ + koff[ks] + 32 * ROWB);
                s0 = MFMA32(k0f, qf[ks], s0); s1 = MFMA32(k1f, qf[ks], s1);
            }
            if (MODE == 1) {
                if (k0 + 63 > qmin) {
#pragma unroll
                    for (int r = 0; r < 16; ++r) { const int kv = k0 + 4 * hi + (r & 3) + 8 * (r >> 2); if (kv > qrow) s0[r] = NEG_BIG; if (kv + 32 > qrow) s1[r] = NEG_BIG; }
                }
            }
            float mx;
            { const float a0 = MXX3(s0[0], s0[1], s0[2]), a1 = MXX3(s0[3], s0[4], s0[5]), a2 = MXX3(s0[6], s0[7], s0[8]), a3 = MXX3(s0[9], s0[10], s0[11]), a4 = MXX3(s0[12], s0[13], s0[14]);
              const float b0 = MXX3(s1[0], s1[1], s1[2]), b1 = MXX3(s1[3], s1[4], s1[5]), b2 = MXX3(s1[6], s1[7], s1[8]), b3 = MXX3(s1[9], s1[10], s1[11]), b4 = MXX3(s1[12], s1[13], s1[14]);
              mx = MXX3(MXX3(MXX3(a0, a1, a2), MXX3(a3, a4, s0[15]), MXX3(b0, b1, b2)), MXX3(b3, b4, s1[15]), a0); }
            mx = xhalf_max(mx);
            if (!__all(mx - m <= 8.0f)) {
                const float mn = fmaxf(m, mx), alpha = __builtin_amdgcn_exp2f(m - mn);
                m = mn; l *= alpha;
#pragma unroll
                for (int c = 0; c < NC; ++c)
#pragma unroll
                    for (int r = 0; r < 16; ++r) o[c][r] *= alpha;
            }
            float ls = 0.f;
#pragma unroll
            for (int r = 0; r < 16; ++r) { s0[r] = __builtin_amdgcn_exp2f(s0[r] - m); s1[r] = __builtin_amdgcn_exp2f(s1[r] - m); ls += s0[r] + s1[r]; }
            l += ls;
            bf16x8 pf[2][2];
#pragma unroll
            for (int s_ = 0; s_ < 2; ++s_) {
                typedef unsigned u32x4_t __attribute__((ext_vector_type(4)));
                u32x4_t w0, w1;
                w0[0] = cvtpk(s0[8 * s_ + 0], s0[8 * s_ + 1]); w0[1] = cvtpk(s0[8 * s_ + 2], s0[8 * s_ + 3]); w0[2] = cvtpk(s0[8 * s_ + 4], s0[8 * s_ + 5]); w0[3] = cvtpk(s0[8 * s_ + 6], s0[8 * s_ + 7]);
                w1[0] = cvtpk(s1[8 * s_ + 0], s1[8 * s_ + 1]); w1[1] = cvtpk(s1[8 * s_ + 2], s1[8 * s_ + 3]); w1[2] = cvtpk(s1[8 * s_ + 4], s1[8 * s_ + 5]); w1[3] = cvtpk(s1[8 * s_ + 6], s1[8 * s_ + 7]);
                pf[0][s_] = __builtin_bit_cast(bf16x8, w0); pf[1][s_] = __builtin_bit_cast(bf16x8, w1);
            }
#pragma unroll
            for (int c = 0; c < NC; ++c)
#pragma unroll
                for (int kb = 0; kb < 2; ++kb)
#pragma unroll
                    for (int s_ = 0; s_ < 2; ++s_) {
                        const s16x4 lo = vtr(vb_ + voff[c] + (32 * kb + 16 * s_) * ROWB), hi4 = vtr(vb_ + voff[c] + (32 * kb + 16 * s_ + 8) * ROWB);
                        bf16x8 vf; vf[0] = lo[0]; vf[1] = lo[1]; vf[2] = lo[2]; vf[3] = lo[3]; vf[4] = hi4[0]; vf[5] = hi4[1]; vf[6] = hi4[2]; vf[7] = hi4[3];
                        o[c] = MFMA32(vf, pf[kb][s_], o[c]);
                    }
        }
        if (REV) {
            if (!wdone && has_next) { const float nb = lut[k0 - 1]; wdone = __all((m > -1e29f) && (brow + nb < m - 30.0f)); }
            if (lane == 0) flg[(it & 1) * 8 + (tid >> 6)] = wdone ? 1u : 0u;
        }
        __syncthreads();
        if (REV) { const volatile __attribute__((address_space(3))) unsigned* f = flg + (it & 1) * 8;
            if ((f[0] & f[1] & f[2] & f[3] & f[4] & f[5] & f[6] & f[7]) != 0u) break; }
    }
#undef stage_issue
    const float lt = xhalf_sum(l), inv = 1.0f / lt;
    if (lse_out) *lse_out = m + __log2f(lt);
#pragma unroll
    for (int c = 0; c < NC; ++c)
#pragma unroll
        for (int r = 0; r < 16; ++r) o[c][r] *= inv;
}

template <int NC>
DEV void attn_store(const f32x16 (&o)[NC], bf16_t* orow, int hi) {
#pragma unroll
    for (int c = 0; c < NC; ++c)
#pragma unroll
        for (int g = 0; g < 4; ++g) { uint2 w; w.x = cvtpk(o[c][4 * g], o[c][4 * g + 1]); w.y = cvtpk(o[c][4 * g + 2], o[c][4 * g + 3]);
            *(uint2*)(orow + 32 * c + 8 * g + 4 * hi) = w; }
}

DEV void phase_fox_mfma(const bf16_t* qkv, const float* cloc, const float* ctot, const unsigned* kmax_u, bf16_t* ao, unsigned char* lds_raw, unsigned* qwork) {
    const int tid_ = opaque_tid();
    const int tid = tid_, wid = tid >> 6, lane = tid & 63, l31 = lane & 31, hi = lane >> 5;
    float* nck = (float*)(lds_raw + ATT_LUT_OFF);
    volatile unsigned* qsh = (volatile unsigned*)(lds_raw + ATT_LUT_OFF + 20480 + 128);
    for (;;) {
        const unsigned u = queue_next(qwork, qsh);
        if (u >= 2048u) break;
        const int qblk = 15 - (int)(u >> 7), st = (int)(u & 127), b = st >> 4, h = st & 15;
        const int q0 = qblk * 256, qend = q0 + 255;
        __syncthreads();
        { float coff[8]; float run = 0.f;
#pragma unroll
          for (int j = 0; j < 8; ++j) { coff[j] = run; run += ctot[st * 8 + j]; }
          float cq = 0.f;
#pragma unroll
          for (int j = 0; j < 8; ++j) cq = ((qend >> 9) == j) ? coff[j] : cq;
          const float cref = cloc[(size_t)st * SEQ + qend] + cq;
          for (int i = tid; i <= qend; i += NTHR) { float co = 0.f;
#pragma unroll
              for (int j = 0; j < 8; ++j) co = ((i >> 9) == j) ? coff[j] : co;
              nck[i] = (cref - (cloc[(size_t)st * SEQ + i] + co)) * LOG2E; } }
        const float kbound = __uint_as_float(kmax_u[st]);
        const int qrow = q0 + wid * 32 + l31;
        const size_t tokb = (size_t)b * SEQ;
        f32x16 o[2];
        attn_unit<64, 1, 0>(qkv + (tokb + qrow) * 3072 + h * 64, qkv + tokb * 3072 + 1024 + h * 64, qkv + tokb * 3072 + 2048 + h * 64,
                                0, qend >> 6, qrow, q0 + wid * 32, q0 + wid * 32 + 31, 0, lds_raw, o, kbound);
        attn_store<2>(o, ao + (tokb + qrow) * DM + h * 64, hi);
    }
}

DEV void phase_mix0_mfma(const bf16_t* qkv, const float* rel_bias, const float* lamp, const float* ln_g, bf16_t* ao, bf16_t* dpo, float* dlse, unsigned char* lds_raw, unsigned* qwork) {
    const int tid_ = opaque_tid();
    const int tid = tid_, wid = tid >> 6, lane = tid & 63, l31 = lane & 31, hi = lane >> 5;
    float* lut = (float*)(lds_raw + ATT_LUT_OFF);
    volatile unsigned* qsh = (volatile unsigned*)(lds_raw + ATT_LUT_OFF + 20480 + 128);
    float lam;
    { float s1 = 0.f, s2 = 0.f;
      for (int i = 0; i < 64; ++i) { s1 += lamp[i] * lamp[64 + i]; s2 += lamp[128 + i] * lamp[192 + i]; }
      lam = expf(s1) - expf(s2) + 0.2f; }
    for (;;) {
        const unsigned uq = queue_next(qwork, qsh);
        if (uq >= 1024u + 3072u) break;
      if (uq >= 1024u) {
        const int u = (int)uq - 1024;
        const int st = u & 63, v48 = u >> 6, b = st >> 3, h = st & 7;
        int br, r, iblk;
        if (v48 < 16) { br = 0; r = 0; iblk = 15 - v48; } else if (v48 < 32) { br = 1; r = (v48 - 16) & 3; iblk = 3 - ((v48 - 16) >> 2); } else { br = 2; r = v48 - 32; iblk = 0; }
        const int dl = (br == 0) ? 1 : (br == 1) ? 4 : 16;
        const int q0 = iblk * 256, qend = q0 + 255;
        __syncthreads();
        for (int i = tid; i < 640; i += NTHR) { const int dd = 320 - i; lut[i] = (dd >= 0 && dd <= 128) ? rel_bias[t5_bucket(dl * dd) * 12 + h] * LOG2E : NEG_BIG; }
        const int qrow = q0 + wid * 32 + l31;
        const size_t tokb = (size_t)b * SEQ;
        const int klo = max(q0 - 128, 0) >> 6;
        f32x16 o[2]; float lse;
        attn_unit<64, 0, 128>(qkv + (tokb + r + (size_t)dl * qrow) * 3072 + h * 64, qkv + (tokb + r) * 3072 + 512 + h * 64, qkv + (tokb + r) * 3072 + 1024 + h * 64,
                              klo, qend >> 6, qrow, q0 + wid * 32, q0 + wid * 32 + 31, 0, lds_raw, o, 0.f, dl * 3072, &lse, 320);
        const size_t tok = tokb + r + (size_t)dl * qrow;
        attn_store<2>(o, dpo + ((size_t)br * NT + tok) * 512 + h * 64, hi);
        if (hi == 0) dlse[((size_t)br * NT + tok) * 8 + h] = lse;
      } else {
        const int u = (int)uq;
        const int qblk = 31 - (u >> 5), st = u & 31;
        const int b = st >> 2, hd = st & 3;
        const int q0 = qblk * 128, qend = q0 + 127;
        __syncthreads();
        for (int i = tid; i < 4224; i += NTHR) { const int dist = 4127 - i; lut[i] = (dist >= 0 && dist <= 4095) ? rel_bias[t5_bucket(dist) * 12 + 8 + hd] * LOG2E : NEG_BIG; }
        const int qg_ = wid >> 1, map = wid & 1;
        const int qrow = q0 + qg_ * 32 + l31;
        const size_t tokb = (size_t)b * SEQ;
        f32x16 o[4];
        attn_unit<128, 0, 0>(qkv + (tokb + qrow) * 3072 + 1536 + hd * 128 + map * 64, qkv + tokb * 3072 + 2048 + hd * 128, qkv + tokb * 3072 + 2560 + hd * 128,
                                 0, qend >> 6, qrow, q0 + qg_ * 32, q0 + qg_ * 32 + 31, map * 64, lds_raw, o);
        float* X = (float*)(lds_raw + ATT_TILE_OFF) + qg_ * 4096;
        if (map == 1) {
#pragma unroll
            for (int c = 0; c < 4; ++c)
#pragma unroll
                for (int r = 0; r < 16; ++r) X[(c * 16 + r) * 64 + lane] = lam * o[c][r];
        }
        __syncthreads();
        if (map == 0) {
            float ss = 0.f;
#pragma unroll
            for (int c = 0; c < 4; ++c)
#pragma unroll
                for (int r = 0; r < 16; ++r) { o[c][r] -= X[(c * 16 + r) * 64 + lane]; ss += o[c][r] * o[c][r]; }
            ss = xhalf_sum(ss);
            const float rstd = 0.8f / sqrtf(ss * (1.0f / 128.0f) + 1e-6f);
            bf16_t* orow = ao + (tokb + qrow) * DM + 512 + hd * 128;
#pragma unroll
            for (int c = 0; c < 4; ++c)
#pragma unroll
                for (int g = 0; g < 4; ++g) { const int d0 = 32 * c + 8 * g + 4 * hi; const f32x4 gg = *(const f32x4*)(ln_g + d0);
                    uint2 wv; wv.x = cvtpk(o[c][4 * g] * rstd * gg[0], o[c][4 * g + 1] * rstd * gg[1]); wv.y = cvtpk(o[c][4 * g + 2] * rstd * gg[2], o[c][4 * g + 3] * rstd * gg[3]);
                    *(uint2*)(orow + d0) = wv; }
        }
      }
    }
}

DEV void phase_dilated_naive(const bf16_t* qkv, const float* rel_bias, bf16_t* ao, float* lds, int bid, int nb) {
    const int t = threadIdx.x, wid = t >> 6, lane = t & 63;
    float* lut = lds;
    __syncthreads();
    for (int i = t; i < 8 * 3 * 129; i += NTHR) {
        const int h = i / (3 * 129), r = i % (3 * 129), br = r / 129, n = r % 129;
        const int dl = br == 0 ? 1 : (br == 1 ? 4 : 16);
        lut[(h * 3 + br) * 132 + n] = rel_bias[t5_bucket(dl * n) * 12 + h];
    }
    __syncthreads();
    for (int task = bid * 8 + wid; task < NT * 8; task += nb * 8) {
        const int tok = task >> 3, h = task & 7, b = tok >> 12, pos = tok & 4095;
        const float q = bf2f(qkv[(size_t)tok * 3072 + h * 64 + lane]) * 0.125f;
        float m = -INFINITY, l = 0.f, o = 0.f;
#pragma unroll
        for (int br = 0; br < 3; ++br) {
            const int dl = br == 0 ? 1 : (br == 1 ? 4 : 16);
            const int nvalid = min(128, pos / dl) + 1;
            const float* lb = lut + (h * 3 + br) * 132;
            for (int n0 = 0; n0 < nvalid; n0 += 4) {
                float kv[4], vv[4];
#pragma unroll
                for (int j = 0; j < 4; ++j) {
                    const int key = max(pos - dl * (n0 + j), 0);
                    const size_t base = (size_t)(b * SEQ + key) * 3072 + h * 64 + lane;
                    kv[j] = bf2f(qkv[base + 512]); vv[j] = bf2f(qkv[base + 1024]);
                }
#pragma unroll
                for (int j = 0; j < 4; ++j) {
                    if (n0 + j < nvalid) {
                        const float s = wave_sum(q * kv[j]) + lb[n0 + j];
                        if (s > m) { const float f = __expf(m - s); l *= f; o *= f; m = s; }
                        const float p = __expf(s - m);
                        l += p; o += p * vv[j];
                    }
                }
            }
        }
        ao[(size_t)tok * DM + h * 64 + lane] = f2bf(o / l);
    }
}

DEV void phase_diff_naive(const bf16_t* qkv, const float* rel_bias, const float* lamp, const float* ln_g, bf16_t* ao, float* lds, int bid, int nb) {
    const int t = threadIdx.x;
    float* Ks = lds;
    float* Vs = lds + 8192;
    float* lut = lds + 16384 + 512;
    float* X = lds;
    float lam;
    { float s1 = 0.f, s2 = 0.f;
      for (int i = 0; i < 64; ++i) { s1 += lamp[i] * lamp[64 + i]; s2 += lamp[128 + i] * lamp[192 + i]; }
      lam = expf(s1) - expf(s2) + 0.2f; }
    const int qi = t & 127, map = (t >> 7) & 1, vh = t >> 8;
    for (int unit = bid; unit < 1024; unit += nb) {
        const int qblk = 31 - unit / 32, bh = unit % 32, b = bh >> 2, hd = bh & 3;
        const int qpos = qblk * 128 + qi;
        const size_t tok = (size_t)b * SEQ + qpos;
        __syncthreads();
        for (int i = t; i < 4096; i += NTHR) lut[i] = rel_bias[t5_bucket(i) * 12 + 8 + hd];
        float q[64], o[64];
        { const uint4* qp = (const uint4*)(qkv + tok * 3072 + 1536 + hd * 128 + map * 64);
#pragma unroll
          for (int i = 0; i < 8; ++i) { const uint4 w = qp[i];
              q[i * 8 + 0] = bflo(w.x) * 0.125f; q[i * 8 + 1] = bfhi(w.x) * 0.125f; q[i * 8 + 2] = bflo(w.y) * 0.125f; q[i * 8 + 3] = bfhi(w.y) * 0.125f;
              q[i * 8 + 4] = bflo(w.z) * 0.125f; q[i * 8 + 5] = bfhi(w.z) * 0.125f; q[i * 8 + 6] = bflo(w.w) * 0.125f; q[i * 8 + 7] = bfhi(w.w) * 0.125f; } }
#pragma unroll
        for (int d = 0; d < 64; ++d) o[d] = 0.f;
        float m = -INFINITY, l = 0.f;
        const int nkt = 2 * qblk + 2;
        for (int kt = 0; kt < nkt; ++kt) {
            __syncthreads();
#pragma unroll
            for (int i = 0; i < 2; ++i) {
                const int e = (t + i * NTHR) * 8, j = e >> 7, d0 = e & 127;
                const size_t base = ((size_t)b * SEQ + kt * 64 + j) * 3072 + hd * 128 + d0;
                const uint4 kw = *(const uint4*)(qkv + base + 2048), vw = *(const uint4*)(qkv + base + 2560);
                float* kd = Ks + j * 128 + d0; float* vd = Vs + j * 128 + d0;
                kd[0] = bflo(kw.x); kd[1] = bfhi(kw.x); kd[2] = bflo(kw.y); kd[3] = bfhi(kw.y); kd[4] = bflo(kw.z); kd[5] = bfhi(kw.z); kd[6] = bflo(kw.w); kd[7] = bfhi(kw.w);
                vd[0] = bflo(vw.x); vd[1] = bfhi(vw.x); vd[2] = bflo(vw.y); vd[3] = bfhi(vw.y); vd[4] = bflo(vw.z); vd[5] = bfhi(vw.z); vd[6] = bflo(vw.w); vd[7] = bfhi(vw.w);
            }
            __syncthreads();
            for (int j = 0; j < 64; ++j) {
                const int key = kt * 64 + j;
                if (key <= qpos) {
                    const float4* kr = (const float4*)(Ks + j * 128 + map * 64);
                    float s = 0.f;
#pragma unroll
                    for (int d4 = 0; d4 < 16; ++d4) { const float4 kk = kr[d4]; s += q[d4 * 4] * kk.x + q[d4 * 4 + 1] * kk.y + q[d4 * 4 + 2] * kk.z + q[d4 * 4 + 3] * kk.w; }
                    s += lut[qpos - key];
                    if (s > m) { const float f = __expf(m - s); l *= f;
#pragma unroll
                        for (int d = 0; d < 64; ++d) o[d] *= f;
                        m = s; }
                    const float p = __expf(s - m);
                    l += p;
                    const float4* vr = (const float4*)(Vs + j * 128 + vh * 64);
#pragma unroll
                    for (int d4 = 0; d4 < 16; ++d4) { const float4 vv = vr[d4]; o[d4 * 4] += p * vv.x; o[d4 * 4 + 1] += p * vv.y; o[d4 * 4 + 2] += p * vv.z; o[d4 * 4 + 3] += p * vv.w; }
                }
            }
        }
        const float inv = 1.0f / l;
        __syncthreads();
        if (map == 1) {
#pragma unroll
            for (int d = 0; d < 64; ++d) X[qi * 129 + vh * 64 + d] = lam * o[d] * inv;
        }
        __syncthreads();
        if (map == 0) {
#pragma unroll
            for (int d = 0; d < 64; ++d) X[qi * 129 + vh * 64 + d] = o[d] * inv - X[qi * 129 + vh * 64 + d];
        }
        __syncthreads();
        {
            const int qq = t >> 2, part = t & 3;
            float ss = 0.f;
            for (int i = 0; i < 32; ++i) { const float v = X[qq * 129 + part * 32 + i]; ss += v * v; }
            ss += __shfl_xor(ss, 1); ss += __shfl_xor(ss, 2);
            const float rstd = 1.0f / sqrtf(ss * (1.0f / 128.0f) + 1e-6f);
            const size_t tk = (size_t)b * SEQ + qblk * 128 + qq;
            for (int i = 0; i < 32; ++i) { const int v = part * 32 + i;
                ao[tk * DM + 512 + hd * 128 + v] = f2bf(X[qq * 129 + v] * rstd * ln_g[v] * 0.8f); }
        }
    }
}

DEV void phase_dilated_merge(const bf16_t* dpo, const float* dlse, bf16_t* ao, int bid, int nb) {
    const int tid_ = opaque_tid();
    const int wid = tid_ >> 6, lane = tid_ & 63, h = lane >> 3;
    for (int tok = bid * 8 + wid; tok < NT; tok += nb * 8) {
        float ls[3]; uint4 ov[3];
#pragma unroll
        for (int br = 0; br < 3; ++br) { ls[br] = dlse[((size_t)br * NT + tok) * 8 + h]; ov[br] = *(const uint4*)(dpo + ((size_t)br * NT + tok) * 512 + lane * 8); }
        const float mx = fmaxf(fmaxf(ls[0], ls[1]), ls[2]);
        float w[3]; float sum = 0.f;
#pragma unroll
        for (int br = 0; br < 3; ++br) { w[br] = __builtin_amdgcn_exp2f(ls[br] - mx); sum += w[br]; }
        const float inv = 1.0f / sum;
        float acc[8];
#pragma unroll
        for (int i = 0; i < 8; ++i) acc[i] = 0.f;
#pragma unroll
        for (int br = 0; br < 3; ++br) { const float ww = w[br] * inv;
            acc[0] += ww * bflo(ov[br].x); acc[1] += ww * bfhi(ov[br].x); acc[2] += ww * bflo(ov[br].y); acc[3] += ww * bfhi(ov[br].y);
            acc[4] += ww * bflo(ov[br].z); acc[5] += ww * bfhi(ov[br].z); acc[6] += ww * bflo(ov[br].w); acc[7] += ww * bfhi(ov[br].w); }
        uint4 o; o.x = pk2(acc[0], acc[1]); o.y = pk2(acc[2], acc[3]); o.z = pk2(acc[4], acc[5]); o.w = pk2(acc[6], acc[7]);
        *(uint4*)(ao + (size_t)tok * DM + lane * 8) = o;
    }
}

DEV void phase_cumsum(const float* fg, const bf16_t* qkv, float* cloc, float* ctot, unsigned* kmax_u, int bid, int nb) {
    const int tid_ = opaque_tid();
    const int wid = tid_ >> 6, lane = tid_ & 63;
    for (int task = bid * 8 + wid; task < 1024; task += nb * 8) {
        const int bh = task >> 3, chunk = task & 7, b = bh >> 4, h = bh & 15;
        float carry = 0.f, kmx = 0.f;
        for (int s0 = chunk * 512; s0 < chunk * 512 + 512; s0 += 64) {
            const size_t tok = (size_t)b * SEQ + s0 + lane;
            const float xv = fg[tok * 16 + h];
            float v = fminf(xv, 0.f) - log1pf(expf(-fabsf(xv)));
#pragma unroll
            for (int o = 1; o < 64; o <<= 1) { const float u = __shfl_up(v, o); if (lane >= o) v += u; }
            v += carry;
            cloc[(size_t)bh * SEQ + s0 + lane] = v;
            carry = __shfl(v, 63);
            const uint4* kp = (const uint4*)(qkv + tok * 3072 + 1024 + h * 64);
            float ss = 0.f;
#pragma unroll
            for (int i = 0; i < 8; ++i) { const uint4 w = kp[i];
                ss += bflo(w.x) * bflo(w.x) + bfhi(w.x) * bfhi(w.x) + bflo(w.y) * bflo(w.y) + bfhi(w.y) * bfhi(w.y) + bflo(w.z) * bflo(w.z) + bfhi(w.z) * bfhi(w.z) + bflo(w.w) * bflo(w.w) + bfhi(w.w) * bfhi(w.w); }
            kmx = fmaxf(kmx, ss);
        }
        kmx = wave_max(kmx);
        if (lane == 0) { ctot[bh * 8 + chunk] = carry; atomicMax(kmax_u + bh, __float_as_uint(sqrtf(kmx) * 1.0001f)); }
    }
}

DEV void phase_fox_naive(const bf16_t* qkv, const float* carr, bf16_t* ao, float* lds, int bid, int nb) {
    const int t = threadIdx.x;
    float* Ks = lds;
    float* Vs = lds + 4096;
    float* cks = lds + 8192;
    for (int unit = bid; unit < 1024; unit += nb) {
        const int qblk = 7 - unit / 128, bh = unit % 128, b = bh >> 4, h = bh & 15;
        const int qpos = qblk * 512 + t;
        const size_t tok = (size_t)b * SEQ + qpos;
        float q[64], o[64];
        { const uint4* qp = (const uint4*)(qkv + tok * 3072 + h * 64);
#pragma unroll
          for (int i = 0; i < 8; ++i) { const uint4 w = qp[i];
              q[i * 8 + 0] = bflo(w.x) * 0.125f; q[i * 8 + 1] = bfhi(w.x) * 0.125f; q[i * 8 + 2] = bflo(w.y) * 0.125f; q[i * 8 + 3] = bfhi(w.y) * 0.125f;
              q[i * 8 + 4] = bflo(w.z) * 0.125f; q[i * 8 + 5] = bfhi(w.z) * 0.125f; q[i * 8 + 6] = bflo(w.w) * 0.125f; q[i * 8 + 7] = bfhi(w.w) * 0.125f; } }
#pragma unroll
        for (int d = 0; d < 64; ++d) o[d] = 0.f;
        const float cq = carr[(size_t)bh * SEQ + qpos];
        float m = -INFINITY, l = 0.f;
        const int nkt = (qblk + 1) * 8;
        for (int kt = 0; kt < nkt; ++kt) {
            __syncthreads();
            {
                const int e = t * 8, j = e >> 6, d0 = e & 63;
                const size_t base = ((size_t)b * SEQ + kt * 64 + j) * 3072 + h * 64 + d0;
                const uint4 kw = *(const uint4*)(qkv + base + 1024), vw = *(const uint4*)(qkv + base + 2048);
                float* kd = Ks + j * 64 + d0; float* vd = Vs + j * 64 + d0;
                kd[0] = bflo(kw.x); kd[1] = bfhi(kw.x); kd[2] = bflo(kw.y); kd[3] = bfhi(kw.y); kd[4] = bflo(kw.z); kd[5] = bfhi(kw.z); kd[6] = bflo(kw.w); kd[7] = bfhi(kw.w);
                vd[0] = bflo(vw.x); vd[1] = bfhi(vw.x); vd[2] = bflo(vw.y); vd[3] = bfhi(vw.y); vd[4] = bflo(vw.z); vd[5] = bfhi(vw.z); vd[6] = bflo(vw.w); vd[7] = bfhi(vw.w);
                if (t < 64) cks[t] = carr[(size_t)bh * SEQ + kt * 64 + t];
            }
            __syncthreads();
            for (int j = 0; j < 64; ++j) {
                const int key = kt * 64 + j;
                if (key <= qpos) {
                    const float4* kr = (const float4*)(Ks + j * 64);
                    float s = 0.f;
#pragma unroll
                    for (int d4 = 0; d4 < 16; ++d4) { const float4 kk = kr[d4]; s += q[d4 * 4] * kk.x + q[d4 * 4 + 1] * kk.y + q[d4 * 4 + 2] * kk.z + q[d4 * 4 + 3] * kk.w; }
                    s += cq - cks[j];
                    if (s > m) { const float f = __expf(m - s); l *= f;
#pragma unroll
                        for (int d = 0; d < 64; ++d) o[d] *= f;
                        m = s; }
                    const float p = __expf(s - m);
                    l += p;
                    const float4* vr = (const float4*)(Vs + j * 64);
#pragma unroll
                    for (int d4 = 0; d4 < 16; ++d4) { const float4 vv = vr[d4]; o[d4 * 4] += p * vv.x; o[d4 * 4 + 1] += p * vv.y; o[d4 * 4 + 2] += p * vv.z; o[d4 * 4 + 3] += p * vv.w; }
                }
            }
        }
        const float inv = 1.0f / l;
        uint4* op = (uint4*)(ao + tok * DM + h * 64);
#pragma unroll
        for (int i = 0; i < 8; ++i) { uint4 w; w.x = pk2(o[i * 8] * inv, o[i * 8 + 1] * inv); w.y = pk2(o[i * 8 + 2] * inv, o[i * 8 + 3] * inv);
            w.z = pk2(o[i * 8 + 4] * inv, o[i * 8 + 5] * inv); w.w = pk2(o[i * 8 + 6] * inv, o[i * 8 + 7] * inv); op[i] = w; }
    }
}

DEV void wave_argmax(float& bv, int& bi) {
#pragma unroll
    for (int o = 32; o >= 1; o >>= 1) {
        const float ov = __shfl_xor(bv, o); const int oi = __shfl_xor(bi, o);
        if (ov > bv || (ov == bv && oi < bi)) { bv = ov; bi = oi; }
    }
}
DEV void phase_topk_naive(const bf16_t* pq, const bf16_t* sk, int* idx_out, float* gate_out, float* lds, int bid, int nb) {
    const int wid = threadIdx.x >> 6, lane = threadIdx.x & 63;
    float* wq = lds + wid * 320;
    float* wts = wq + 256;
    int* wti = (int*)(wq + 288);
    for (int task = bid * 8 + wid; task < NT * 8; task += nb * 8) {
        const int tok = task >> 3, h = task & 7;
        lds_fence();
        { const uint2 r = *(const uint2*)(pq + (size_t)tok * 2048 + h * 256 + lane * 4);
          wq[lane * 4 + 0] = bflo(r.x); wq[lane * 4 + 1] = bfhi(r.x); wq[lane * 4 + 2] = bflo(r.y); wq[lane * 4 + 3] = bfhi(r.y); }
        lds_fence();
#pragma unroll 1
        for (int c = 0; c < 2; ++c) {
            float v0, v1;
            const float* qq = wq + c * 128;
            {
                const uint4* row = (const uint4*)(sk + ((size_t)(h * 2 + c) * 128 + lane) * 128);
                float s = 0.f;
#pragma unroll
                for (int i = 0; i < 16; ++i) { const uint4 w = row[i];
                    s += qq[i * 8] * bflo(w.x) + qq[i * 8 + 1] * bfhi(w.x) + qq[i * 8 + 2] * bflo(w.y) + qq[i * 8 + 3] * bfhi(w.y)
                       + qq[i * 8 + 4] * bflo(w.z) + qq[i * 8 + 5] * bfhi(w.z) + qq[i * 8 + 6] * bflo(w.w) + qq[i * 8 + 7] * bfhi(w.w); }
                v0 = s;
            }
            asm volatile("" : "+v"(v0) :: "memory");
            {
                const uint4* row = (const uint4*)(sk + ((size_t)(h * 2 + c) * 128 + lane + 64) * 128);
                float s = 0.f;
#pragma unroll
                for (int i = 0; i < 16; ++i) { const uint4 w = row[i];
                    s += qq[i * 8] * bflo(w.x) + qq[i * 8 + 1] * bfhi(w.x) + qq[i * 8 + 2] * bflo(w.y) + qq[i * 8 + 3] * bfhi(w.y)
                       + qq[i * 8 + 4] * bflo(w.z) + qq[i * 8 + 5] * bfhi(w.z) + qq[i * 8 + 6] * bflo(w.w) + qq[i * 8 + 7] * bfhi(w.w); }
                v1 = s;
            }
            asm volatile("" : "+v"(v1) :: "memory");
            float ts = 0.f; int ti = 0;
            for (int r = 0; r < 16; ++r) {
                float bv; int bi;
                if (v1 > v0) { bv = v1; bi = lane + 64; } else { bv = v0; bi = lane; }
                wave_argmax(bv, bi);
                if (lane == r) { ts = bv; ti = bi; }
                if (bi == lane) v0 = -INFINITY;
                if (bi == lane + 64) v1 = -INFINITY;
            }
            if (lane < 16) { wts[c * 16 + lane] = ts; wti[c * 16 + lane] = ti; }
        }
        lds_fence();
        float cs[4];
#pragma unroll
        for (int jj = 0; jj < 4; ++jj) { const int j = lane * 4 + jj; cs[jj] = wts[j >> 4] + wts[16 + (j & 15)]; }
        float bs = 0.f; int be = 0;
        for (int r = 0; r < 16; ++r) {
            float bv = cs[0]; int bi = lane * 4;
#pragma unroll
            for (int jj = 1; jj < 4; ++jj) if (cs[jj] > bv) { bv = cs[jj]; bi = lane * 4 + jj; }
            wave_argmax(bv, bi);
            if (lane == r) { bs = bv; be = wti[bi >> 4] * 128 + wti[16 + (bi & 15)]; }
#pragma unroll
            for (int jj = 0; jj < 4; ++jj) if (bi == lane * 4 + jj) cs[jj] = -INFINITY;
        }
        float mv = lane < 16 ? bs : -INFINITY;
        mv = wave_max(mv);
        float e = lane < 16 ? __expf(bs - mv) : 0.f;
        const float sum = wave_sum(e);
        if (lane < 16) { idx_out[(size_t)tok * 128 + h * 16 + lane] = be; gate_out[(size_t)tok * 128 + h * 16 + lane] = e / sum; }
    }
}

struct PairTab { int a[50], b[50]; };
constexpr PairTab make_pairs() { PairTab t{}; int n = 0; for (int a = 0; a < 16; ++a) for (int b = 0; b < 16; ++b) if ((a + 1) * (b + 1) <= 16) { t.a[n] = a; t.b[n] = b; ++n; } return t; }
constexpr PairTab PAIRS = make_pairs();
#define MX3(a, b, c) __builtin_fmaxf(__builtin_fmaxf((a), (b)), (c))
DEV unsigned xhalf_or(unsigned v) { auto rr = __builtin_amdgcn_permlane32_swap(v, v, false, false); return rr[0] | rr[1]; }
template <int J, int N, class T> DEV void bstage(T& v, const int k) {
#pragma clang loop unroll(full)
    for (int i = 0; i < N; ++i) { const int l = i ^ J; if (l > i) { const bool d = ((i & k) == 0); const float hi_ = fmaxf(v[i], v[l]), lo_ = fminf(v[i], v[l]); v[i] = d ? hi_ : lo_; v[l] = d ? lo_ : hi_; } }
}
template <int N, class T> DEV void bmerge_desc(T& v) {
    if constexpr (N >= 32) bstage<16, N>(v, N);
    if constexpr (N >= 16) bstage<8, N>(v, N);
    bstage<4, N>(v, N); bstage<2, N>(v, N); bstage<1, N>(v, N);
}
template <int N, class T> DEV void bsort_desc(T& v) {
    bstage<1, N>(v, 2);
    bstage<2, N>(v, 4); bstage<1, N>(v, 4);
    bstage<4, N>(v, 8); bstage<2, N>(v, 8); bstage<1, N>(v, 8);
    bstage<8, N>(v, 16); bstage<4, N>(v, 16); bstage<2, N>(v, 16); bstage<1, N>(v, 16);
    if constexpr (N >= 32) { bstage<16, N>(v, 32); bstage<8, N>(v, 32); bstage<4, N>(v, 32); bstage<2, N>(v, 32); bstage<1, N>(v, 32); }
}
template <class T> DEV void merge_top16(T& a, const T& b) {
#pragma unroll
    for (int i = 0; i < 16; ++i) a[i] = fmaxf(a[i], b[15 - i]);
    bmerge_desc<16>(a);
}
DEV float xhalf_other(float v, int hi) { auto rr = __builtin_amdgcn_permlane32_swap(__float_as_uint(v), __float_as_uint(v), false, false); return __uint_as_float(hi ? rr[0] : rr[1]); }
DEV void phase_topk_mfma(const bf16_t* pq, const bf16_t* skl, const float* uinv, const float* vinv, int* idx_out, float* gate_out, float* usc_out, unsigned char* lds_raw, int bid, int nb) {
    int tid = threadIdx.x; asm volatile("" : "+v"(tid));
    const int wid = tid >> 6, lane = tid & 63, l31 = lane & 31, hi = lane >> 5;
    ldsc_t lds = (ldsc_t)lds_raw;
    int cur_h = -1;
    for (int u = bid; u < 1024; u += nb) {
        const int h = u & 7, tg = u >> 3;
        if (h != cur_h) {
            __syncthreads();
#pragma unroll
            for (int i = 0; i < 8; ++i) { const int id = tid + NTHR * i, crow_ = id >> 4, ch = id & 15;
                const uint4 v = *(const uint4*)(skl + ((size_t)h * 256 + crow_) * 128 + ch * 8);
                *(uint4*)(lds_raw + crow_ * 256 + ((ch ^ (crow_ & 15)) * 16)) = v; }
            __syncthreads();
            cur_h = h;
        }
        const int tok = tg * 256 + wid * 32 + l31;
        const bf16_t* qp = pq + (size_t)tok * 2048 + h * 256;
        __attribute__((address_space(3))) unsigned* nt = (__attribute__((address_space(3))) unsigned*)((lptr_t)lds_raw + 65536 + wid * 8192 + l31 * 256);
#pragma unroll
        for (int c = 0; c < 2; ++c) {
            f32x16 acc[4];
#pragma unroll
            for (int kb = 0; kb < 4; ++kb)
#pragma unroll
                for (int r = 0; r < 16; ++r) acc[kb][r] = 0.f;
#pragma unroll
            for (int ks = 0; ks < 8; ++ks) {
                const bf16x8 qf = *(const bf16x8*)(qp + c * 128 + ks * 16 + hi * 8);
#pragma unroll
                for (int kb = 0; kb < 4; ++kb) {
                    const int row = c * 128 + 32 * kb + l31, ch = 2 * ks + hi;
                    const bf16x8 af = *(const __attribute__((address_space(3))) bf16x8*)(lds + row * 256 + ((ch ^ (l31 & 15)) * 16));
                    acc[kb] = MFMA32(af, qf, acc[kb]);
                }
            }
#pragma unroll
            for (int kb = 0; kb < 4; ++kb)
#pragma unroll
                for (int r = 0; r < 16; ++r) { const unsigned n = 32u * kb + (r & 3) + 8 * (r >> 2) + 4u * hi;
                    acc[kb][r] = __uint_as_float((__float_as_uint(acc[kb][r]) & ~127u) | n); }
            bsort_desc<16>(acc[0]); bsort_desc<16>(acc[1]); bsort_desc<16>(acc[2]); bsort_desc<16>(acc[3]);
            merge_top16(acc[0], acc[1]); merge_top16(acc[2], acc[3]); merge_top16(acc[0], acc[2]);
            { float t_[16];
#pragma unroll
              for (int i = 0; i < 16; ++i) t_[i] = fmaxf(acc[0][i], xhalf_other(acc[0][15 - i], hi));
              bmerge_desc<16>(t_);
#pragma unroll
              for (int i = 0; i < 16; ++i) nt[c * 16 + i] = __float_as_uint(t_[i]); }
        }
        lds_fence();
        float cs[32];
#pragma unroll
        for (int i = 0; i < 25; ++i) {
            const int ai = hi ? PAIRS.a[2 * i + 1] : PAIRS.a[2 * i], bi = hi ? PAIRS.b[2 * i + 1] : PAIRS.b[2 * i];
            const float sum = __uint_as_float(nt[ai]) + __uint_as_float(nt[16 + bi]);
            cs[i] = __uint_as_float((__float_as_uint(sum) & ~255u) | (unsigned)(ai * 16 + bi));
        }
#pragma unroll
        for (int i = 25; i < 32; ++i) cs[i] = -INFINITY;
        bsort_desc<32>(cs);
        float bs[16];
#pragma unroll
        for (int i = 0; i < 16; ++i) bs[i] = fmaxf(cs[i], xhalf_other(cs[15 - i], hi));
        bmerge_desc<16>(bs);
        unsigned be8[8]; float bs8[8];
#pragma unroll
        for (int i = 0; i < 16; ++i) (nt + 32 + 64 * 0)[i + 0] = __float_as_uint(bs[i]);
        lds_fence();
#pragma unroll
        for (int j = 0; j < 8; ++j) { const float w_ = __uint_as_float(nt[32 + 8 * hi + j]); const unsigned tg = __float_as_uint(w_) & 255u; bs8[j] = w_;
            be8[j] = (nt[tg >> 4] & 127u) * 128u + (nt[16 + (tg & 15u)] & 127u); }
        float sum = 0.f; const float bmax = bs[0];
#pragma unroll
        for (int rd = 0; rd < 16; ++rd) sum += __builtin_amdgcn_exp2f((bs[rd] - bmax) * LOG2E);
        const float inv = 1.0f / sum;
        uint4 i0, i1; float4 g0, g1;
        i0.x = be8[0]; i0.y = be8[1]; i0.z = be8[2]; i0.w = be8[3]; i1.x = be8[4]; i1.y = be8[5]; i1.z = be8[6]; i1.w = be8[7];
        g0.x = __builtin_amdgcn_exp2f((bs8[0] - bmax) * LOG2E) * inv; g0.y = __builtin_amdgcn_exp2f((bs8[1] - bmax) * LOG2E) * inv; g0.z = __builtin_amdgcn_exp2f((bs8[2] - bmax) * LOG2E) * inv; g0.w = __builtin_amdgcn_exp2f((bs8[3] - bmax) * LOG2E) * inv;
        g1.x = __builtin_amdgcn_exp2f((bs8[4] - bmax) * LOG2E) * inv; g1.y = __builtin_amdgcn_exp2f((bs8[5] - bmax) * LOG2E) * inv; g1.z = __builtin_amdgcn_exp2f((bs8[6] - bmax) * LOG2E) * inv; g1.w = __builtin_amdgcn_exp2f((bs8[7] - bmax) * LOG2E) * inv;
        float4 s0, s1;
        s0.x = uinv[i0.x]; s0.y = uinv[i0.y]; s0.z = uinv[i0.z]; s0.w = uinv[i0.w]; s1.x = uinv[i1.x]; s1.y = uinv[i1.y]; s1.z = uinv[i1.z]; s1.w = uinv[i1.w];
        g0.x *= vinv[i0.x]; g0.y *= vinv[i0.y]; g0.z *= vinv[i0.z]; g0.w *= vinv[i0.w]; g1.x *= vinv[i1.x]; g1.y *= vinv[i1.y]; g1.z *= vinv[i1.z]; g1.w *= vinv[i1.w];
        uint4* ip = (uint4*)(idx_out + (size_t)tok * 128 + h * 16 + 8 * hi); ip[0] = i0; ip[1] = i1;
        float4* gp = (float4*)(gate_out + (size_t)tok * 128 + h * 16 + 8 * hi); gp[0] = g0; gp[1] = g1;
        float4* sp = (float4*)(usc_out + (size_t)tok * 128 + h * 16 + 8 * hi); sp[0] = s0; sp[1] = s1;
    }
}

typedef __bf16 bf16x2_t __attribute__((ext_vector_type(2)));
DEV float dot2bf(unsigned a, unsigned b, float acc) { return __builtin_amdgcn_fdot2_f32_bf16(__builtin_bit_cast(bf16x2_t, a), __builtin_bit_cast(bf16x2_t, b), acc, false); }
DEV float gelu_as(float v) {
    const float av = fabsf(v), t = __builtin_amdgcn_rcpf(av * 0.2316418882f + 1.0f);
    float q = t * 0.5307027145f + (-0.7265760135f); q = q * t + 0.7107068705f; q = q * t + (-0.142248368f); q = q * t + 0.127414796f; q = q * t;
    const float e = __builtin_amdgcn_exp2f((v * v) * (-0.72134752044f));
    const float m = v * (q * e);
    return v < 0.f ? m : v - m;
}
DEV void phase_expert_v2(const bf16_t* hn, const bf16_t* ut, const bf16_t* vt, const int* idx, const float* gate, float* xres, int bid, int nb, float oscale = 1.0f) {
    const int wid = threadIdx.x >> 6, lane = threadIdx.x & 63;
    for (int tok = bid * 8 + wid; tok < NT; tok += nb * 8) {
        const uint4 h0 = *(const uint4*)(hn + (size_t)tok * DM + lane * 8), h1 = *(const uint4*)(hn + (size_t)tok * DM + 512 + lane * 8);
        float acc[16];
#pragma unroll
        for (int i = 0; i < 16; ++i) acc[i] = 0.f;
        uint4 uA[4][2], vA[4][2], uB[4][2], vB[4][2];
#define XLOAD(U, V, k_) do { _Pragma("unroll") for (int j = 0; j < 4; ++j) { const int e_ = __builtin_amdgcn_readfirstlane(idx[(size_t)tok * 128 + (k_) + j]); \
            const bf16_t* up = ut + (size_t)e_ * DM + lane * 8; const bf16_t* vp = vt + (size_t)e_ * DM + lane * 8; \
            U[j][0] = *(const uint4*)up; U[j][1] = *(const uint4*)(up + 512); V[j][0] = *(const uint4*)vp; V[j][1] = *(const uint4*)(vp + 512); } } while (0)
#define XCOMP(U, V, k_) do { float d_[4]; \
        _Pragma("unroll") for (int j = 0; j < 4; ++j) { float d = 0.f; \
            d = dot2bf(U[j][0].x, h0.x, d); d = dot2bf(U[j][0].y, h0.y, d); d = dot2bf(U[j][0].z, h0.z, d); d = dot2bf(U[j][0].w, h0.w, d); \
            d = dot2bf(U[j][1].x, h1.x, d); d = dot2bf(U[j][1].y, h1.y, d); d = dot2bf(U[j][1].z, h1.z, d); d = dot2bf(U[j][1].w, h1.w, d); d_[j] = d; } \
        { const bool b0 = lane & 1, b1 = lane & 2; \
          float x0 = b0 ? d_[1] : d_[0], y0 = b0 ? d_[0] : d_[1], x1 = b0 ? d_[3] : d_[2], y1 = b0 ? d_[2] : d_[3]; \
          x0 += __shfl_xor(y0, 1); x1 += __shfl_xor(y1, 1);                   \
          float x = b1 ? x1 : x0, y = b1 ? x0 : x1; x += __shfl_xor(y, 2);      \
          x += __shfl_xor(x, 4); x += __shfl_xor(x, 8); x += __shfl_xor(x, 16); x += __shfl_xor(x, 32); \
          const float wl = gelu_as(x) * gate[(size_t)tok * 128 + (k_) + (lane & 3)]; \
          _Pragma("unroll") for (int j = 0; j < 4; ++j) { const float w = __uint_as_float(__builtin_amdgcn_readlane(__float_as_uint(wl), j)); \
              acc[0] += w * bflo(V[j][0].x); acc[1] += w * bfhi(V[j][0].x); acc[2] += w * bflo(V[j][0].y); acc[3] += w * bfhi(V[j][0].y); \
              acc[4] += w * bflo(V[j][0].z); acc[5] += w * bfhi(V[j][0].z); acc[6] += w * bflo(V[j][0].w); acc[7] += w * bfhi(V[j][0].w); \
              acc[8] += w * bflo(V[j][1].x); acc[9] += w * bfhi(V[j][1].x); acc[10] += w * bflo(V[j][1].y); acc[11] += w * bfhi(V[j][1].y); \
              acc[12] += w * bflo(V[j][1].z); acc[13] += w * bfhi(V[j][1].z); acc[14] += w * bflo(V[j][1].w); acc[15] += w * bfhi(V[j][1].w); } } } while (0)
        XLOAD(uA, vA, 0);
#pragma unroll 1
        for (int k0 = 0; k0 < 128; k0 += 8) {
            XLOAD(uB, vB, k0 + 4);
            XCOMP(uA, vA, k0);
            if (k0 + 8 < 128) XLOAD(uA, vA, k0 + 8);
            XCOMP(uB, vB, k0 + 4);
        }
#undef XLOAD
#undef XCOMP
        float4* p0 = (float4*)(xres + (size_t)tok * DM + lane * 8); float4* p1 = (float4*)(xres + (size_t)tok * DM + 512 + lane * 8);
        float4 a = p0[0], b = p0[1], c = p1[0], d = p1[1];
        a.x += oscale * acc[0]; a.y += oscale * acc[1]; a.z += oscale * acc[2]; a.w += oscale * acc[3]; b.x += oscale * acc[4]; b.y += oscale * acc[5]; b.z += oscale * acc[6]; b.w += oscale * acc[7];
        c.x += oscale * acc[8]; c.y += oscale * acc[9]; c.z += oscale * acc[10]; c.w += oscale * acc[11]; d.x += oscale * acc[12]; d.y += oscale * acc[13]; d.z += oscale * acc[14]; d.w += oscale * acc[15];
        p0[0] = a; p0[1] = b; p1[0] = c; p1[1] = d;
    }
}

typedef float f32x2_t __attribute__((ext_vector_type(2)));
#define FP8LO(w) __builtin_amdgcn_cvt_pk_f32_fp8((int)(w), false)
#define FP8HI(w) __builtin_amdgcn_cvt_pk_f32_fp8((int)(w), true)
DEV float dot16_fp8(const uint4 u, const float (&h)[16]) {
    float d = 0.f; f32x2_t a;
    a = FP8LO(u.x); d += a[0] * h[0] + a[1] * h[1]; a = FP8HI(u.x); d += a[0] * h[2] + a[1] * h[3];
    a = FP8LO(u.y); d += a[0] * h[4] + a[1] * h[5]; a = FP8HI(u.y); d += a[0] * h[6] + a[1] * h[7];
    a = FP8LO(u.z); d += a[0] * h[8] + a[1] * h[9]; a = FP8HI(u.z); d += a[0] * h[10] + a[1] * h[11];
    a = FP8LO(u.w); d += a[0] * h[12] + a[1] * h[13]; a = FP8HI(u.w); d += a[0] * h[14] + a[1] * h[15];
    return d;
}
#define PIN4(u) asm volatile("" : "+v"((u).x), "+v"((u).y), "+v"((u).z), "+v"((u).w))
DEV void fma16_fp8(const uint4 v, const float w, float (&acc)[16]) {
    f32x2_t a;
    a = FP8LO(v.x); acc[0] += w * a[0]; acc[1] += w * a[1]; a = FP8HI(v.x); acc[2] += w * a[0]; acc[3] += w * a[1];
    a = FP8LO(v.y); acc[4] += w * a[0]; acc[5] += w * a[1]; a = FP8HI(v.y); acc[6] += w * a[0]; acc[7] += w * a[1];
    a = FP8LO(v.z); acc[8] += w * a[0]; acc[9] += w * a[1]; a = FP8HI(v.z); acc[10] += w * a[0]; acc[11] += w * a[1];
    a = FP8LO(v.w); acc[12] += w * a[0]; acc[13] += w * a[1]; a = FP8HI(v.w); acc[14] += w * a[0]; acc[15] += w * a[1];
}
template <int CTRL> DEV float dppf(float x) { return __builtin_bit_cast(float, __builtin_amdgcn_mov_dpp(__builtin_bit_cast(int, x), CTRL, 0xf, 0xf, true)); }
DEV float x1632_sum(float x) {
    auto s = __builtin_amdgcn_permlane16_swap(__float_as_uint(x), __float_as_uint(x), false, false);
    x = __uint_as_float(s[0]) + __uint_as_float(s[1]);
    auto t = __builtin_amdgcn_permlane32_swap(__float_as_uint(x), __float_as_uint(x), false, false);
    return __uint_as_float(t[0]) + __uint_as_float(t[1]);
}
DEV void phase_expert_v3(const bf16_t* hn, const unsigned char* ut, const unsigned char* vt, const int* idx, const float* gate, const float* usc, float* xres, int bid, int nb, float oscale = 1.0f) {
    constexpr int XOR1 = 0xB1, XOR2 = 0x4E, ROR4 = 0x124, ROR8 = 0x128;
    int tid = threadIdx.x; asm volatile("" : "+v"(tid));
    const unsigned wid = tid >> 6, lane = tid & 63;
    const bool b0 = lane & 1, b1 = lane & 2, b2 = lane & 4;
    for (unsigned tok = bid * 8 + wid; tok < (unsigned)NT; tok += nb * 8) {
        float hf[16], acc[16];
        { const uint4* hp = (const uint4*)((const char*)hn + (tok * 2048u + lane * 32u)); const uint4 h0 = hp[0], h1 = hp[1];
          hf[0] = bflo(h0.x); hf[1] = bfhi(h0.x); hf[2] = bflo(h0.y); hf[3] = bfhi(h0.y); hf[4] = bflo(h0.z); hf[5] = bfhi(h0.z); hf[6] = bflo(h0.w); hf[7] = bfhi(h0.w);
          hf[8] = bflo(h1.x); hf[9] = bfhi(h1.x); hf[10] = bflo(h1.y); hf[11] = bfhi(h1.y); hf[12] = bflo(h1.z); hf[13] = bfhi(h1.z); hf[14] = bflo(h1.w); hf[15] = bfhi(h1.w); }
#pragma unroll
        for (int i = 0; i < 16; ++i) acc[i] = 0.f;
        const unsigned pbase = tok * 128u;
        uint4 uA[4], vA[4], uB[4], vB[4];
#define XLOAD(U, V, k_) do { _Pragma("unroll") for (int j = 0; j < 4; ++j) { const unsigned eo_ = (unsigned)idx[pbase + (k_) + j] * 1024u + lane * 16u; U[j] = *(const uint4*)(ut + eo_); V[j] = *(const uint4*)(vt + eo_); } } while (0)
#define XCOMP(U, V, k_) do { float d_[4]; \
        _Pragma("unroll") for (int j = 0; j < 4; ++j) d_[j] = dot16_fp8(U[j], hf); \
        const float x0_ = (b0 ? d_[1] : d_[0]) + dppf<XOR1>(b0 ? d_[0] : d_[1]), x1_ = (b0 ? d_[3] : d_[2]) + dppf<XOR1>(b0 ? d_[2] : d_[3]); \
        float x = (b1 ? x1_ : x0_) + dppf<XOR2>(b1 ? x0_ : x1_);            \
        x += dppf<ROR4>(x); x += dppf<ROR8>(x); x = x1632_sum(x); \
        const unsigned o_ = pbase + (k_) + (lane & 3u); \
        const float wl = gelu_as(x * usc[o_]) * gate[o_]; \
        _Pragma("unroll") for (int j = 0; j < 4; ++j) { const float w = __uint_as_float(__builtin_amdgcn_readlane(__float_as_uint(wl), j)); fma16_fp8(V[j], w, acc); } } while (0)
        XLOAD(uA, vA, 0);
#pragma unroll 1
        for (int k0 = 0; k0 < 128; k0 += 8) {
            XLOAD(uB, vB, k0 + 4);
            XCOMP(uA, vA, k0);
            if (k0 + 8 < 128) XLOAD(uA, vA, k0 + 8);
            XCOMP(uB, vB, k0 + 4);
        }
#undef XLOAD
#undef XCOMP
        float4* p0 = (float4*)((char*)xres + (tok * 4096u + lane * 64u));
        float4 a = p0[0], b = p0[1], c = p0[2], d = p0[3];
        a.x += oscale * acc[0]; a.y += oscale * acc[1]; a.z += oscale * acc[2]; a.w += oscale * acc[3]; b.x += oscale * acc[4]; b.y += oscale * acc[5]; b.z += oscale * acc[6]; b.w += oscale * acc[7];
        c.x += oscale * acc[8]; c.y += oscale * acc[9]; c.z += oscale * acc[10]; c.w += oscale * acc[11]; d.x += oscale * acc[12]; d.y += oscale * acc[13]; d.z += oscale * acc[14]; d.w += oscale * acc[15];
        p0[0] = a; p0[1] = b; p0[2] = c; p0[3] = d;
    }
}

constexpr int PEER_UNIT_TOK = 256, PEER_UNITS = NT / PEER_UNIT_TOK, PEER_WTOK = PEER_UNIT_TOK / 8;
constexpr size_t WS_QCTR = 16384;
constexpr size_t WS_CTL_BYTES = 16384 + 32 * 256;
DEV unsigned peer_next_unit(unsigned* q, volatile unsigned* sh) { return queue_next(q, sh); }
typedef float f32x2p __attribute__((ext_vector_type(2)));
DEV float dot16_fp8_pk(const uint4 u, const f32x2p (&h)[8]) {
    f32x2p d = __builtin_amdgcn_cvt_pk_f32_fp8((int)u.x, false) * h[0];
    d = __builtin_elementwise_fma(__builtin_amdgcn_cvt_pk_f32_fp8((int)u.x, true), h[1], d);
    d = __builtin_elementwise_fma(__builtin_amdgcn_cvt_pk_f32_fp8((int)u.y, false), h[2], d);
    d = __builtin_elementwise_fma(__builtin_amdgcn_cvt_pk_f32_fp8((int)u.y, true), h[3], d);
    d = __builtin_elementwise_fma(__builtin_amdgcn_cvt_pk_f32_fp8((int)u.z, false), h[4], d);
    d = __builtin_elementwise_fma(__builtin_amdgcn_cvt_pk_f32_fp8((int)u.z, true), h[5], d);
    d = __builtin_elementwise_fma(__builtin_amdgcn_cvt_pk_f32_fp8((int)u.w, false), h[6], d);
    d = __builtin_elementwise_fma(__builtin_amdgcn_cvt_pk_f32_fp8((int)u.w, true), h[7], d);
    return d[0] + d[1];
}
DEV void fma16_fp8_pk(const uint4 v, const float w, f32x2p (&acc)[8]) {
    const f32x2p wv = {w, w};
    acc[0] = __builtin_elementwise_fma(__builtin_amdgcn_cvt_pk_f32_fp8((int)v.x, false), wv, acc[0]);
    acc[1] = __builtin_elementwise_fma(__builtin_amdgcn_cvt_pk_f32_fp8((int)v.x, true), wv, acc[1]);
    acc[2] = __builtin_elementwise_fma(__builtin_amdgcn_cvt_pk_f32_fp8((int)v.y, false), wv, acc[2]);
    acc[3] = __builtin_elementwise_fma(__builtin_amdgcn_cvt_pk_f32_fp8((int)v.y, true), wv, acc[3]);
    acc[4] = __builtin_elementwise_fma(__builtin_amdgcn_cvt_pk_f32_fp8((int)v.z, false), wv, acc[4]);
    acc[5] = __builtin_elementwise_fma(__builtin_amdgcn_cvt_pk_f32_fp8((int)v.z, true), wv, acc[5]);
    acc[6] = __builtin_elementwise_fma(__builtin_amdgcn_cvt_pk_f32_fp8((int)v.w, false), wv, acc[6]);
    acc[7] = __builtin_elementwise_fma(__builtin_amdgcn_cvt_pk_f32_fp8((int)v.w, true), wv, acc[7]);
}
DEV void phase_peer_dots(const bf16_t* hn, const unsigned char* u8s, const int* idx, float* partial, unsigned* qctr, unsigned char* lds_raw, unsigned xcc) {
    constexpr int XOR1 = 0xB1, XOR2 = 0x4E, HMIR = 0x141;
    int tid = threadIdx.x; asm volatile("" : "+v"(tid));
    const unsigned wid = tid >> 6, lane = tid & 63, g = lane >> 3, sub = lane & 7;
    volatile unsigned* sh = (volatile unsigned*)(lds_raw + 256);
    for (unsigned s_ = 0; s_ < 8; ++s_) {
        const unsigned x = (xcc + s_) & 7;
        const unsigned char* ux = u8s + (size_t)x * NEXP * 128;
        const unsigned sub16 = sub * 16u;
        for (;;) {
            const unsigned unit = peer_next_unit(qctr + 64 * x, sh);
            if (unit >= (unsigned)PEER_UNITS) break;
            const unsigned tok0 = unit * PEER_UNIT_TOK + wid * PEER_WTOK;
            uint4 ixn[4]; uint4 hn0, hn1;
            { const uint4* ip = (const uint4*)((const char*)idx + (tok0 * 512u + g * 64u)); ixn[0] = ip[0]; ixn[1] = ip[1]; ixn[2] = ip[2]; ixn[3] = ip[3];
              const uint4* hp = (const uint4*)((const char*)hn + (tok0 * 2048u + x * 256u + sub * 32u)); hn0 = hp[0]; hn1 = hp[1]; }
            uint4 Ua[8], Ub[8];
#define ROWS(U, e0, e1, e2, e3, e4, e5, e6, e7) do { U[0] = *(const uint4*)(ux + ((e0) * 128u + sub16)); U[1] = *(const uint4*)(ux + ((e1) * 128u + sub16)); U[2] = *(const uint4*)(ux + ((e2) * 128u + sub16)); \
            U[3] = *(const uint4*)(ux + ((e3) * 128u + sub16)); U[4] = *(const uint4*)(ux + ((e4) * 128u + sub16)); U[5] = *(const uint4*)(ux + ((e5) * 128u + sub16)); \
            U[6] = *(const uint4*)(ux + ((e6) * 128u + sub16)); U[7] = *(const uint4*)(ux + ((e7) * 128u + sub16)); } while (0)
            ROWS(Ua, ixn[0].x, ixn[0].y, ixn[0].z, ixn[0].w, ixn[1].x, ixn[1].y, ixn[1].z, ixn[1].w);
#pragma unroll 1
            for (unsigned i = 0; i < (unsigned)PEER_WTOK; ++i) {
                const unsigned tok = tok0 + i;
                ROWS(Ub, ixn[2].x, ixn[2].y, ixn[2].z, ixn[2].w, ixn[3].x, ixn[3].y, ixn[3].z, ixn[3].w);
                f32x2p hf[8];
                hf[0] = (f32x2p){bflo(hn0.x), bfhi(hn0.x)}; hf[1] = (f32x2p){bflo(hn0.y), bfhi(hn0.y)}; hf[2] = (f32x2p){bflo(hn0.z), bfhi(hn0.z)}; hf[3] = (f32x2p){bflo(hn0.w), bfhi(hn0.w)};
                hf[4] = (f32x2p){bflo(hn1.x), bfhi(hn1.x)}; hf[5] = (f32x2p){bflo(hn1.y), bfhi(hn1.y)}; hf[6] = (f32x2p){bflo(hn1.z), bfhi(hn1.z)}; hf[7] = (f32x2p){bflo(hn1.w), bfhi(hn1.w)};
                { const unsigned tn = (i + 1 < (unsigned)PEER_WTOK) ? tok + 1 : tok;
                  const uint4* ip = (const uint4*)((const char*)idx + (tn * 512u + g * 64u)); ixn[0] = ip[0]; ixn[1] = ip[1]; ixn[2] = ip[2]; ixn[3] = ip[3];
                  const uint4* hp = (const uint4*)((const char*)hn + (tn * 2048u + x * 256u + sub * 32u)); hn0 = hp[0]; hn1 = hp[1]; }
                float sm[16];
#pragma unroll
                for (int j = 0; j < 8; ++j) { uint4 u_ = Ua[j]; PIN4(u_); float d = dot16_fp8_pk(u_, hf); asm volatile("" : "+v"(d)); d += dppf<XOR1>(d); d += dppf<XOR2>(d); d += dppf<HMIR>(d); sm[j] = d; }
                ROWS(Ua, ixn[0].x, ixn[0].y, ixn[0].z, ixn[0].w, ixn[1].x, ixn[1].y, ixn[1].z, ixn[1].w);
#pragma unroll
                for (int j = 0; j < 8; ++j) { uint4 u_ = Ub[j]; PIN4(u_); float d = dot16_fp8_pk(u_, hf); asm volatile("" : "+v"(d)); d += dppf<XOR1>(d); d += dppf<XOR2>(d); d += dppf<HMIR>(d); sm[8 + j] = d; }
                float v0 = sm[0], v1 = sm[1];
#pragma unroll
                for (int q = 1; q < 8; ++q) { v0 = (sub == (unsigned)q) ? sm[2 * q] : v0; v1 = (sub == (unsigned)q) ? sm[2 * q + 1] : v1; }
                float2 o; o.x = v0; o.y = v1;
                *(float2*)(partial + ((size_t)x * NT + tok) * 128u + 2u * lane) = o;
            }
#undef ROWS
        }
    }
}
DEV void phase_peer_weights(const float* partial, const float* gate, const float* usc, float* wts, int bid, int nb) {
    const int tid_ = opaque_tid();
    for (unsigned i = bid * NTHR + tid_; i < (unsigned)NT * 32u; i += nb * NTHR) {
        float4 sacc = ((const float4*)partial)[i];
#pragma unroll
        for (int x = 1; x < 8; ++x) { const float4 p = ((const float4*)(partial + (size_t)x * NT * 128))[i]; sacc.x += p.x; sacc.y += p.y; sacc.z += p.z; sacc.w += p.w; }
        const float4 gt = ((const float4*)gate)[i], us = ((const float4*)usc)[i];
        float4 o; o.x = gt.x * gelu_as(sacc.x * us.x); o.y = gt.y * gelu_as(sacc.y * us.y); o.z = gt.z * gelu_as(sacc.z * us.z); o.w = gt.w * gelu_as(sacc.w * us.w);
        ((float4*)wts)[i] = o;
    }
}
template <bool LOADONLY = false>
DEV void phase_peer_acc(const unsigned char* v8s, const int* idx, const float* wts, float* xres, unsigned* qctr, unsigned char* lds_raw, unsigned xcc, float oscale = 1.0f) {
    constexpr int ROR8 = 0x128;
    constexpr unsigned EMASK = LOADONLY ? 2047u : 0xFFFFFFFFu;
    int tid = threadIdx.x; asm volatile("" : "+v"(tid));
    const unsigned wid = tid >> 6, lane = tid & 63, g = lane >> 3, sub = lane & 7;
    volatile unsigned* sh = (volatile unsigned*)(lds_raw + 256);
    for (unsigned s_ = 0; s_ < 8; ++s_) {
        const unsigned x = (xcc + s_) & 7;
        const unsigned char* vx = v8s + (size_t)x * NEXP * 128;
        const unsigned sub16 = sub * 16u;
        for (;;) {
            const unsigned unit = peer_next_unit(qctr + 64 * x, sh);
            if (unit >= (unsigned)PEER_UNITS) break;
            const unsigned tok0 = unit * PEER_UNIT_TOK + wid * PEER_WTOK;
            uint4 ixn[4]; float4 wn[4];
            { const uint4* ip = (const uint4*)((const char*)idx + (tok0 * 512u + g * 64u)); ixn[0] = ip[0]; ixn[1] = ip[1]; ixn[2] = ip[2]; ixn[3] = ip[3];
              const float4* wp = (const float4*)((const char*)wts + (tok0 * 512u + g * 64u)); wn[0] = wp[0]; wn[1] = wp[1]; wn[2] = wp[2]; wn[3] = wp[3]; }
            uint4 Va[8], Vb[8];
#define ROWS(U, e0, e1, e2, e3, e4, e5, e6, e7) do { U[0] = *(const uint4*)(vx + ((((e0) & EMASK)) * 128u + sub16)); U[1] = *(const uint4*)(vx + ((((e1) & EMASK)) * 128u + sub16)); U[2] = *(const uint4*)(vx + ((((e2) & EMASK)) * 128u + sub16)); \
            U[3] = *(const uint4*)(vx + ((((e3) & EMASK)) * 128u + sub16)); U[4] = *(const uint4*)(vx + ((((e4) & EMASK)) * 128u + sub16)); U[5] = *(const uint4*)(vx + ((((e5) & EMASK)) * 128u + sub16)); \
            U[6] = *(const uint4*)(vx + ((((e6) & EMASK)) * 128u + sub16)); U[7] = *(const uint4*)(vx + ((((e7) & EMASK)) * 128u + sub16)); } while (0)
            ROWS(Va, ixn[0].x, ixn[0].y, ixn[0].z, ixn[0].w, ixn[1].x, ixn[1].y, ixn[1].z, ixn[1].w);
#pragma unroll 1
            for (unsigned i = 0; i < (unsigned)PEER_WTOK; ++i) {
                const unsigned tok = tok0 + i;
                ROWS(Vb, ixn[2].x, ixn[2].y, ixn[2].z, ixn[2].w, ixn[3].x, ixn[3].y, ixn[3].z, ixn[3].w);
                const float ww[16] = {wn[0].x, wn[0].y, wn[0].z, wn[0].w, wn[1].x, wn[1].y, wn[1].z, wn[1].w, wn[2].x, wn[2].y, wn[2].z, wn[2].w, wn[3].x, wn[3].y, wn[3].z, wn[3].w};
                { const unsigned tn = (i + 1 < (unsigned)PEER_WTOK) ? tok + 1 : tok;
                  const uint4* ip = (const uint4*)((const char*)idx + (tn * 512u + g * 64u)); ixn[0] = ip[0]; ixn[1] = ip[1]; ixn[2] = ip[2]; ixn[3] = ip[3];
                  const float4* wp = (const float4*)((const char*)wts + (tn * 512u + g * 64u)); wn[0] = wp[0]; wn[1] = wp[1]; wn[2] = wp[2]; wn[3] = wp[3]; }
                f32x2p acc[8];
#pragma unroll
                for (int c = 0; c < 8; ++c) acc[c] = (f32x2p){0.f, 0.f};
#pragma unroll
                for (int j = 0; j < 8; ++j) { uint4 v_ = Va[j]; PIN4(v_); if (LOADONLY) { acc[0][0] += __uint_as_float((v_.x ^ v_.y ^ v_.z ^ v_.w) & 0x007fffffu) * ww[j]; } else fma16_fp8_pk(v_, ww[j], acc); asm volatile("" : "+v"(acc[0]), "+v"(acc[7])); }
                ROWS(Va, ixn[0].x, ixn[0].y, ixn[0].z, ixn[0].w, ixn[1].x, ixn[1].y, ixn[1].z, ixn[1].w);
#pragma unroll
                for (int j = 0; j < 8; ++j) { uint4 v_ = Vb[j]; PIN4(v_); if (LOADONLY) { acc[0][0] += __uint_as_float((v_.x ^ v_.y ^ v_.z ^ v_.w) & 0x007fffffu) * ww[8 + j]; } else fma16_fp8_pk(v_, ww[8 + j], acc); asm volatile("" : "+v"(acc[0]), "+v"(acc[7])); }
                float r[16];
#pragma unroll
                for (int c = 0; c < 8; ++c) { float a0 = acc[c][0], a1 = acc[c][1]; a0 += dppf<ROR8>(a0); a1 += dppf<ROR8>(a1); r[2 * c] = x1632_sum(a0); r[2 * c + 1] = x1632_sum(a1); }
                if (g == 0) {
                    float4* p0 = (float4*)((char*)xres + (tok * 4096u + x * 512u + sub * 64u));
                    float4 a = p0[0], b = p0[1], c = p0[2], d = p0[3];
                    a.x += oscale * r[0]; a.y += oscale * r[1]; a.z += oscale * r[2]; a.w += oscale * r[3]; b.x += oscale * r[4]; b.y += oscale * r[5]; b.z += oscale * r[6]; b.w += oscale * r[7];
                    c.x += oscale * r[8]; c.y += oscale * r[9]; c.z += oscale * r[10]; c.w += oscale * r[11]; d.x += oscale * r[12]; d.y += oscale * r[13]; d.z += oscale * r[14]; d.w += oscale * r[15];
                    p0[0] = a; p0[1] = b; p0[2] = c; p0[3] = d;
                }
            }
#undef ROWS
        }
    }
}

DEV void phase_expert_naive(const bf16_t* hn, const bf16_t* ut, const bf16_t* vt, const int* idx, const float* gate, float* xres, int bid, int nb) {
    const int wid = threadIdx.x >> 6, lane = threadIdx.x & 63;
    for (int tok = bid * 8 + wid; tok < NT; tok += nb * 8) {
        float hv[16], acc[16];
#pragma unroll
        for (int i = 0; i < 4; ++i) { const uint2 r = *(const uint2*)(hn + (size_t)tok * DM + i * 256 + lane * 4);
            hv[i * 4] = bflo(r.x); hv[i * 4 + 1] = bfhi(r.x); hv[i * 4 + 2] = bflo(r.y); hv[i * 4 + 3] = bfhi(r.y); }
#pragma unroll
        for (int i = 0; i < 16; ++i) acc[i] = 0.f;
        for (int k0 = 0; k0 < 128; k0 += 4) {
            int e[4]; float g[4]; uint2 ur[4][4], vr[4][4];
#pragma unroll
            for (int j = 0; j < 4; ++j) { e[j] = __builtin_amdgcn_readfirstlane(idx[(size_t)tok * 128 + k0 + j]); g[j] = gate[(size_t)tok * 128 + k0 + j]; }
#pragma unroll
            for (int j = 0; j < 4; ++j)
#pragma unroll
                for (int i = 0; i < 4; ++i) ur[j][i] = *(const uint2*)(ut + (size_t)e[j] * DM + i * 256 + lane * 4);
#pragma unroll
            for (int j = 0; j < 4; ++j)
#pragma unroll
                for (int i = 0; i < 4; ++i) vr[j][i] = *(const uint2*)(vt + (size_t)e[j] * DM + i * 256 + lane * 4);
#pragma unroll
            for (int j = 0; j < 4; ++j) {
                float d = 0.f;
#pragma unroll
                for (int i = 0; i < 4; ++i) d += hv[i * 4] * bflo(ur[j][i].x) + hv[i * 4 + 1] * bfhi(ur[j][i].x) + hv[i * 4 + 2] * bflo(ur[j][i].y) + hv[i * 4 + 3] * bfhi(ur[j][i].y);
                d = wave_sum(d);
                const float act = 0.5f * d * (1.0f + erff(d * 0.70710678118654752f));
                const float w = g[j] * act;
#pragma unroll
                for (int i = 0; i < 4; ++i) { acc[i * 4] += w * bflo(vr[j][i].x); acc[i * 4 + 1] += w * bfhi(vr[j][i].x); acc[i * 4 + 2] += w * bflo(vr[j][i].y); acc[i * 4 + 3] += w * bfhi(vr[j][i].y); }
            }
        }
#pragma unroll
        for (int i = 0; i < 4; ++i) { float4* p = (float4*)(xres + (size_t)tok * DM + i * 256 + lane * 4); float4 v = *p;
            v.x += acc[i * 4]; v.y += acc[i * 4 + 1]; v.z += acc[i * 4 + 2]; v.w += acc[i * 4 + 3]; *p = v; }
    }
}

#define XB_TMO      128
#define XB_XCNT(j)  (256  + 64 * (j))
#define XB_XSUB(j)  (1280 + 64 * (j))
#define XB_XGEN(j)  (2304 + 64 * (j))
#define XB_TOP      3328
#define XB_TOPGEN   3392
#define XCD_BAR_WORDS 3456
#define XB_SPIN_CAP (1u << 18)
#define LAS __attribute__((address_space(3)))

__device__ __forceinline__ unsigned xb_ld(unsigned* p)              { return __hip_atomic_load(p, __ATOMIC_RELAXED, __HIP_MEMORY_SCOPE_AGENT); }
__device__ __forceinline__ unsigned xb_add(unsigned* p, unsigned v) { return __hip_atomic_fetch_add(p, v, __ATOMIC_RELAXED, __HIP_MEMORY_SCOPE_AGENT); }
__device__ __forceinline__ unsigned xb_xcc_id() { return (unsigned)__builtin_amdgcn_s_getreg((3 << 11) | 20) & 0xFu; }
#define XB_SPIN(cond, bar) do { unsigned _sp = 0; while (cond) { __builtin_amdgcn_s_sleep(1); \
    if ((++_sp & 255u) == 0u) { if (xb_ld(&(bar)[XB_TMO])) break; if (_sp > XB_SPIN_CAP) { atomicAdd(&(bar)[XB_TMO], 1u); break; } } } } while (0)

struct XcdBarrier {
    unsigned* bar; unsigned x;
    volatile LAS unsigned* st;
};

__device__ __forceinline__ XcdBarrier xcd_barrier_post(unsigned* bar, volatile LAS unsigned* st) {
    XcdBarrier b; b.bar = bar; b.x = xb_xcc_id(); b.st = st;
    if (threadIdx.x == 0) (void)xb_add(&bar[XB_XCNT(b.x)], 1u);
    return b;
}
__device__ __forceinline__ void xcd_barrier_complete(unsigned* bar, unsigned x, unsigned& nloc, unsigned& nx) {
    const unsigned G = gridDim.x * gridDim.y * gridDim.z;
    unsigned sum, cnt, mine, sp = 0u;
    for (;;) {
        sum = 0u; cnt = 0u; mine = 0u;
#pragma unroll
        for (unsigned j = 0; j < 16; ++j) { const unsigned c = xb_ld(&bar[XB_XCNT(j)]); sum += c; cnt += (c > 0u) ? 1u : 0u; mine = (j == x) ? c : mine; }
        if (sum == G) break;
        __builtin_amdgcn_s_sleep(1);
        if ((++sp & 255u) == 0u) { if (xb_ld(&bar[XB_TMO])) break; if (sp > XB_SPIN_CAP) { atomicAdd(&bar[XB_TMO], 1u); break; } }
    }
    nloc = mine > 0u ? mine : 1u; nx = cnt > 0u ? cnt : 1u;
}

__device__ __forceinline__ void xcd_barrier(const XcdBarrier& b) {
    asm volatile("s_waitcnt vmcnt(0)" ::: "memory");
    __syncthreads();
    if (threadIdx.x == 0) {
        unsigned* bar = b.bar;
        __builtin_amdgcn_s_waitcnt(0);
        unsigned nloc = b.st[0], nx = b.st[1];
        if (nloc == 0u) { xcd_barrier_complete(bar, b.x, nloc, nx); b.st[0] = nloc; b.st[1] = nx; }
        const unsigned old = xb_add(&bar[XB_XSUB(b.x)], 1u);
        const unsigned gen = old / nloc;
        if (old + 1u == (gen + 1u) * nloc) {
            __builtin_amdgcn_fence(__ATOMIC_RELEASE, "agent");
            asm volatile("s_waitcnt vmcnt(0)" ::: "memory");
            const unsigned og = xb_add(&bar[XB_TOP], 1u);
            const unsigned tg = og / nx;
            if (og + 1u == (tg + 1u) * nx) xb_add(&bar[XB_TOPGEN], 1u);
            else XB_SPIN(xb_ld(&bar[XB_TOPGEN]) == tg, bar);
            __builtin_amdgcn_fence(__ATOMIC_ACQUIRE, "agent");
            xb_add(&bar[XB_XGEN(b.x)], 1u);
            asm volatile("s_waitcnt vmcnt(0)" ::: "memory");
        } else {
            XB_SPIN(xb_ld(&bar[XB_XGEN(b.x)]) == gen, bar);
            __builtin_amdgcn_fence(__ATOMIC_ACQUIRE, "agent");
            asm volatile("s_waitcnt vmcnt(0)" ::: "memory");
        }
    }
    __syncthreads();
}


constexpr int N_PHASES = 24;
__global__ void __launch_bounds__(NTHR, 2) fwd_kernel(Params p_unused) {
    extern __shared__ __attribute__((aligned(16))) unsigned char lds_raw[];
    float* lds = (float*)lds_raw;
    const int bid = blockIdx.x, nb = gridDim.x;
#define PHASE_ARGS() cparams_t pp = kernarg_ptr(); asm volatile("" : "+s"(pp)); \
    unsigned char* ws = pp->ws; (void)ws; \
    bf16_t* w_in0 = (bf16_t*)(ws + WS_WIN0); bf16_t* w_out0 = (bf16_t*)(ws + WS_WOUT0); bf16_t* w_in1 = (bf16_t*)(ws + WS_WIN1); bf16_t* w_out1 = (bf16_t*)(ws + WS_WOUT1); \
    bf16_t* wq = (bf16_t*)(ws + WS_WQ); bf16_t* skb = (bf16_t*)(ws + WS_SK); unsigned char* ub = ws + WS_U; unsigned char* vb = ws + WS_V; \
    float* uscale = (float*)(ws + WS_USC); float* vscale = (float*)(ws + WS_VSC); \
    bf16_t* hn = (bf16_t*)(ws + WS_HN); bf16_t* qkv = (bf16_t*)(ws + WS_QKV); bf16_t* pq = (bf16_t*)(ws + WS_QKV); \
    float* fg = (float*)(ws + WS_FG); float* carr = (float*)(ws + WS_C); \
    bf16_t* ao = (bf16_t*)(ws + WS_AO); int* idxb = (int*)(ws + WS_AO); float* gateb = (float*)(ws + WS_AO + (size_t)NT * 128 * 4); float* uscb = (float*)(ws + WS_AO + (size_t)NT * 128 * 8); \
    float* xres = pp->out; unsigned* qctr = (unsigned*)(ws + WS_QCTR); \
    float* partial = (float*)(ws + WS_QKV); float* wts = (float*)(ws + WS_QKV + (size_t)8 * NT * 128 * 4); \
    (void)w_in0; (void)w_out0; (void)w_in1; (void)w_out1; (void)wq; (void)skb; (void)ub; (void)vb; (void)uscale; (void)vscale; (void)hn; (void)qkv; (void)pq; (void)fg; (void)carr; (void)ao; \
    (void)idxb; (void)gateb; (void)uscb; (void)xres; (void)qctr; (void)partial; (void)wts
    int lo, hi;
    { cparams_t pp = kernarg_ptr(); asm volatile("" : "+s"(pp)); lo = pp->ph_lo; hi = pp->ph_hi;
      volatile LAS unsigned* xbw = (volatile LAS unsigned*)(lds_raw + LDS_BYTES - 16);
      if (threadIdx.x == 0) { xbw[0] = 0u; xbw[1] = 0u; xbw[2] = 0u; xbw[3] = 0u; }
      __syncthreads();
      if (hi - lo > 1) (void)xcd_barrier_post((unsigned*)(pp->ws + WS_BAR), xbw); }
#define IN(k) (lo <= (k) && (k) < hi)
#define SEAM(k) do { if (IN(k) && IN((k) + 1)) { PHASE_ARGS(); XcdBarrier b_; b_.bar = (unsigned*)(ws + WS_BAR); b_.x = xb_xcc_id(); b_.st = (volatile LAS unsigned*)(lds_raw + LDS_BYTES - 16); xcd_barrier(b_); } } while (0)

    if (IN(0)) { PHASE_ARGS();
        conv_transpose(pp->even_w_in, w_in0, 1024, 3072, lds, bid, nb);
        conv_transpose(pp->even_w_out, w_out0, 1024, 1024, lds, bid, nb);
        conv_transpose(pp->odd_w_in, w_in1, 1024, 3088, lds, bid, nb);
        conv_transpose(pp->odd_w_out, w_out1, 1024, 1024, lds, bid, nb);
        conv_transpose(pp->peer_wq, wq, 1024, 2048, lds, bid, nb);
        conv_transpose(pp->peer_wq + (size_t)1024 * 2048, wq + (size_t)2048 * 1024, 1024, 2048, lds, bid, nb);
        conv_copy(pp->peer_sk, skb, (size_t)2 * 8 * 2 * 128 * 128, bid, nb);
        conv_fp8_rows(pp->peer_u, ub, uscale, 2 * NEXP, bid, nb);
        conv_fp8_rows(pp->peer_v, vb, vscale, 2 * NEXP, bid, nb);
        phase_norm(pp->x, pp->norm_mix_g, hn, bid, nb);
    }
    SEAM(0);
#pragma unroll 1
    for (int layer = 0; layer < 2; ++layer) {
        const int pb = 1 + 11 * layer;
        if (layer == 1) {
            if (IN(pb + 0)) { PHASE_ARGS(); phase_norm(xres, pp->norm_mix_g + DM, hn, bid, nb); }
            SEAM(pb + 0);
        }
        if (IN(pb + 1)) { PHASE_ARGS();
            phase_gemm_mfma(hn, layer ? w_in1 : w_in0, NT, 3072, MEpiQKV{qkv, layer ? 1024 : 512, layer ? 0 : 1536, layer ? 0 : 2048}, lds_raw, bid, nb);
            if (layer == 1) phase_fg(hn, w_in1 + (size_t)3072 * 1024, pp->odd_b_f, fg, bid, nb);
        }
        SEAM(pb + 1);
        if (IN(pb + 2)) { PHASE_ARGS();
            if (layer == 0) phase_mix0_mfma(qkv, pp->rel_bias, pp->diff_lambda, pp->diff_ln_g, ao, (bf16_t*)(ws + WS_DPO), (float*)(ws + WS_DLSE), lds_raw, qctr + 5 * 512);
            else phase_cumsum(fg, qkv, carr, (float*)(ws + WS_CTOT), (unsigned*)(ws + WS_KMAX), bid, nb);
        }
        SEAM(pb + 2);
        if (IN(pb + 3)) { PHASE_ARGS();
            if (layer == 0) phase_dilated_merge((const bf16_t*)(ws + WS_DPO), (const float*)(ws + WS_DLSE), ao, bid, nb);
            else phase_fox_mfma(qkv, carr, (const float*)(ws + WS_CTOT), (const unsigned*)(ws + WS_KMAX), ao, lds_raw, qctr + 5 * 512 + 64);
        }
        SEAM(pb + 3);
        if (IN(pb + 4)) { PHASE_ARGS(); phase_gemm_mfma(ao, layer ? w_out1 : w_out0, NT, 1024, MEpiBf16{qkv, 1024}, lds_raw, bid, nb); }
        SEAM(pb + 4);
        if (IN(pb + 5)) { PHASE_ARGS(); phase_res_norm(layer ? (const float*)xres : pp->x, qkv, pp->norm_ffn_g + layer * DM, xres, hn, bid, nb); }
        SEAM(pb + 5);
        if (IN(pb + 6)) { PHASE_ARGS(); phase_gemm_mfma(hn, wq + (size_t)layer * 2048 * 1024, NT, 2048, MEpiBf16{pq, 2048}, lds_raw, bid, nb); }
        SEAM(pb + 6);
        if (IN(pb + 7)) { PHASE_ARGS(); phase_topk_mfma(pq, skb + (size_t)layer * 8 * 2 * 128 * 128, uscale + layer * NEXP, vscale + layer * NEXP, idxb, gateb, uscb, lds_raw, bid, nb); }
        SEAM(pb + 7);
        if (IN(pb + 8)) { PHASE_ARGS(); phase_peer_dots(hn, ub + (size_t)layer * NEXP * 1024, idxb, partial, qctr + (2 * layer) * 512, lds_raw, xb_xcc_id() & 7u); }
        SEAM(pb + 8);
        if (IN(pb + 9)) { PHASE_ARGS(); phase_peer_weights(partial, gateb, uscb, wts, bid, nb); }
        SEAM(pb + 9);
        if (IN(pb + 10)) { PHASE_ARGS(); phase_peer_acc(vb + (size_t)layer * NEXP * 1024, idxb, wts, xres, qctr + (2 * layer + 1) * 512, lds_raw, xb_xcc_id() & 7u); }
        SEAM(pb + 10);
    }
    if (IN(23)) { PHASE_ARGS(); phase_final_norm(xres, pp->final_g, bid, nb); }
}

extern "C" void kernel_launch(void* const* d_in, const int* in_sizes, int n_in, void* d_out, int out_size, void* d_ws, size_t ws_size, hipStream_t stream) {
    static int grid = 0;
    if (grid == 0) {
        if (n_in != 16 || out_size != NT * DM || ws_size < WS_END) { fprintf(stderr, "kernel_launch: unexpected sizes n_in %d out %d ws %zu (need %zu)\n", n_in, out_size, ws_size, (size_t)WS_END); grid = -1; return; }
        int dev = 0, cus = 0;
        (void)hipGetDevice(&dev); (void)hipDeviceGetAttribute(&cus, hipDeviceAttributeMultiprocessorCount, dev);
        if (hipFuncSetAttribute((const void*)fwd_kernel, hipFuncAttributeMaxDynamicSharedMemorySize, LDS_BYTES) != hipSuccess) { fprintf(stderr, "hipFuncSetAttribute failed\n"); grid = -1; return; }
        grid = cus > 0 ? cus : 256;
    }
    if (grid < 0) return;
    Params p{};
    p.x = (const float*)d_in[0]; p.norm_mix_g = (const float*)d_in[1]; p.norm_ffn_g = (const float*)d_in[2]; p.final_g = (const float*)d_in[3];
    p.rel_bias = (const float*)d_in[4]; p.even_w_in = (const float*)d_in[5]; p.even_w_out = (const float*)d_in[6]; p.diff_lambda = (const float*)d_in[7];
    p.diff_ln_g = (const float*)d_in[8]; p.odd_w_in = (const float*)d_in[9]; p.odd_b_f = (const float*)d_in[10]; p.odd_w_out = (const float*)d_in[11];
    p.peer_wq = (const float*)d_in[12]; p.peer_sk = (const float*)d_in[13]; p.peer_u = (const float*)d_in[14]; p.peer_v = (const float*)d_in[15];
    p.out = (float*)d_out; p.ws = (unsigned char*)d_ws;
#if defined(MK_MULTI)
    for (int k = 0; k < N_PHASES; ++k) {
        p.ph_lo = k; p.ph_hi = k + 1;
        hipLaunchKernelGGL(fwd_kernel, dim3(grid), dim3(NTHR), LDS_BYTES, stream, p);
    }
#else
    (void)hipMemsetAsync((unsigned char*)d_ws + WS_BAR, 0, WS_CTL_BYTES + 8 * 8 * 256, stream);
    p.ph_lo = 0; p.ph_hi = N_PHASES;
    hipLaunchKernelGGL(fwd_kernel, dim3(grid), dim3(NTHR), LDS_BYTES, stream, p);
#endif
}
```

```cpp
#include <hip/hip_runtime.h>
#include <stdint.h>
#include <math.h>
#include <cstdio>

typedef unsigned short bf16_t;
#define DEV static __device__ __forceinline__
#define MDEV __device__ __forceinline__

#ifndef PROBE_DUP
#define PROBE_DUP 0
#endif
constexpr int DM = 1024, NBATCH = 8, SEQ = 4096, NT = NBATCH * SEQ;
constexpr int EVEN_IN = 3072, ODD_IN = 3088;
constexpr int NEXP = 16384;
constexpr int NTHR = 512;
constexpr int LDS_BYTES = 144 * 1024;

constexpr size_t KB_ = 1024, MB_ = 1024 * 1024;
constexpr size_t WS_BAR   = 0;
constexpr size_t WS_KMAX  = 32768;
constexpr size_t WS_CTOT  = 33792;
constexpr size_t WS_WIN0  = 64 * KB_;
constexpr size_t WS_WOUT0 = WS_WIN0 + (size_t)3072 * 1024 * 2;
constexpr size_t WS_WIN1  = WS_WOUT0 + (size_t)1024 * 1024 * 2;
constexpr size_t WS_WOUT1 = WS_WIN1 + (size_t)3328 * 1024 * 2;
constexpr size_t WS_WQ    = WS_WOUT1 + (size_t)1024 * 1024 * 2;
constexpr size_t WS_SK    = WS_WQ + (size_t)2 * 2048 * 1024 * 2;
constexpr size_t WS_U     = WS_SK + (size_t)2 * 8 * 2 * 128 * 128 * 2;
constexpr size_t WS_V     = WS_U + (size_t)2 * NEXP * 1024;
constexpr size_t WS_USC   = WS_V + (size_t)2 * NEXP * 1024;
constexpr size_t WS_VSC   = WS_USC + (size_t)2 * NEXP * 4;
constexpr size_t WS_HN    = WS_VSC + (size_t)2 * NEXP * 4;
constexpr size_t WS_QKV   = WS_HN + (size_t)NT * 1024 * 2;
constexpr size_t WS_FG    = WS_QKV + (size_t)NT * 3072 * 2;
constexpr size_t WS_C     = WS_FG + (size_t)NT * 16 * 4;
constexpr size_t WS_AO    = WS_C + (size_t)NT * 16 * 4;
constexpr size_t WS_DPO   = WS_AO + (size_t)NT * 1024 * 2;
constexpr size_t WS_DLSE  = WS_HN;
constexpr size_t WS_END   = WS_DPO + (size_t)3 * NT * 512 * 2;
static_assert(WS_END <= (size_t)512 * 1024 * 1024, "workspace map exceeds the guaranteed 512 MiB");

struct Params {
    const float *x, *norm_mix_g, *norm_ffn_g, *final_g, *rel_bias, *even_w_in, *even_w_out, *diff_lambda, *diff_ln_g,
                *odd_w_in, *odd_b_f, *odd_w_out, *peer_wq, *peer_sk, *peer_u, *peer_v;
    float* out;
    unsigned char* ws;
    int ph_lo, ph_hi;
};

DEV float bf2f(bf16_t v) { return __uint_as_float(((unsigned)v) << 16); }
DEV bf16_t f2bf(float f) { unsigned u = __float_as_uint(f); u += 0x7FFFu + ((u >> 16) & 1u); return (bf16_t)(u >> 16); }
DEV unsigned pk2(float lo, float hi) { return (unsigned)f2bf(lo) | ((unsigned)f2bf(hi) << 16); }
DEV unsigned cvtpk2(float lo, float hi) { unsigned r; asm("v_cvt_pk_bf16_f32 %0, %1, %2" : "=v"(r) : "v"(lo), "v"(hi)); return r; }
DEV float bflo(unsigned w) { return __uint_as_float(w << 16); }
DEV float bfhi(unsigned w) { return __uint_as_float(w & 0xFFFF0000u); }
DEV float wave_sum(float v) {
#pragma unroll
    for (int o = 32; o >= 1; o >>= 1) v += __shfl_xor(v, o);
    return v;
}
DEV float wave_max(float v) {
#pragma unroll
    for (int o = 32; o >= 1; o >>= 1) v = fmaxf(v, __shfl_xor(v, o));
    return v;
}
DEV int opaque_tid() { int t = threadIdx.x; asm volatile("" : "+v"(t)); return t; }
typedef const __attribute__((address_space(4))) struct Params* cparams_t;
DEV cparams_t kernarg_ptr() {
#if defined(__HIP_DEVICE_COMPILE__)
    return (cparams_t)__builtin_amdgcn_kernarg_segment_ptr();
#else
    return (cparams_t)0;
#endif
}
DEV void lds_fence() { asm volatile("s_waitcnt lgkmcnt(0)" ::: "memory"); }

DEV unsigned queue_next(unsigned* q, volatile unsigned* sh) {
    __syncthreads();
    if (threadIdx.x == 0) sh[0] = __hip_atomic_fetch_add(q, 1u, __ATOMIC_RELAXED, __HIP_MEMORY_SCOPE_AGENT);
    __syncthreads();
    return sh[0];
}
DEV int t5_bucket(int d) {
    if (d < 16) return d;
    int b = 16;
    b += (d >= 22); b += (d >= 30); b += (d >= 40); b += (d >= 54); b += (d >= 73); b += (d >= 99); b += (d >= 134); b += (d >= 182);
    b += (d >= 246); b += (d >= 332); b += (d >= 450); b += (d >= 609); b += (d >= 825); b += (d >= 1117); b += (d >= 1513);
    return b;
}

DEV void conv_transpose(const float* src, bf16_t* dst, int K, int N, float* lds, int bid, int nb) {
    const int tid_ = opaque_tid();
    const int t = tid_;
    const int ntk = K / 64, ntn = (N + 63) / 64;
    for (int tile = bid; tile < ntk * ntn; tile += nb) {
        const int k0 = (tile / ntn) * 64, n0 = (tile % ntn) * 64;
        __syncthreads();
#pragma unroll
        for (int i = 0; i < 8; ++i) {
            const int r = (t >> 6) + 8 * i, c = t & 63;
            float v = 0.f;
            if (n0 + c < N) v = src[(size_t)(k0 + r) * N + n0 + c];
            lds[r * 65 + c] = v;
        }
        __syncthreads();
#pragma unroll
        for (int i = 0; i < 8; ++i) {
            const int r = (t >> 6) + 8 * i, c = t & 63;
            if (n0 + r < N) dst[(size_t)(n0 + r) * K + k0 + c] = f2bf(lds[c * 65 + r]);
        }
    }
}
DEV void conv_copy(const float* src, bf16_t* dst, size_t n, int bid, int nb) {
    const int tid_ = opaque_tid();
    const size_t n4 = n / 4;
    for (size_t i = (size_t)bid * NTHR + tid_; i < n4; i += (size_t)nb * NTHR) {
        const float4 v = ((const float4*)src)[i];
        uint2 o; o.x = pk2(v.x, v.y); o.y = pk2(v.z, v.w);
        ((uint2*)dst)[i] = o;
    }
}

DEV void conv_fp8_rows(const float* src, unsigned char* dst, float* inv, int rows, int bid, int nb) {
    const int tid_ = opaque_tid();
    const int wid = tid_ >> 6, lane = tid_ & 63;
    for (int row = bid * 8 + wid; row < rows; row += nb * 8) {
        const float4* xr = (const float4*)(src + (size_t)row * DM) + lane;
        float4 v[4]; float mx = 0.f;
#pragma unroll
        for (int i = 0; i < 4; ++i) { v[i] = xr[64 * i]; mx = fmaxf(mx, fmaxf(fmaxf(fabsf(v[i].x), fabsf(v[i].y)), fmaxf(fabsf(v[i].z), fabsf(v[i].w)))); }
        mx = wave_max(mx);
        int e = 0; if (mx > 0.f) (void)frexpf(mx, &e);
        e = min(max(e, -100), 100);
        const float sc = ldexpf(1.0f, 8 - e), isc = ldexpf(1.0f, e - 8);
        const int layer = row / NEXP, ex = row % NEXP;
#pragma unroll
        for (int i = 0; i < 4; ++i) {
            unsigned w = __builtin_amdgcn_cvt_pk_fp8_f32(v[i].x * sc, v[i].y * sc, 0, false); w = __builtin_amdgcn_cvt_pk_fp8_f32(v[i].z * sc, v[i].w * sc, w, true);
            const int col = 4 * lane + 256 * i, x = col >> 7, off = col & 127;
            *(unsigned*)(dst + (((size_t)layer * 8 + x) * NEXP + ex) * 128 + off) = w;
        }
        if (lane == 0) inv[row] = isc;
    }
}

DEV void phase_norm(const float* xin, const float* g, bf16_t* out, int bid, int nb) {
    const int tid_ = opaque_tid();
    const int wid = tid_ >> 6, lane = tid_ & 63;
    for (int row = bid * 8 + wid; row < NT; row += nb * 8) {
        const float4* xr = (const float4*)(xin + (size_t)row * DM);
        float4 v[4]; float ss = 0.f;
#pragma unroll
        for (int i = 0; i < 4; ++i) { v[i] = xr[lane + 64 * i]; ss += v[i].x * v[i].x + v[i].y * v[i].y + v[i].z * v[i].z + v[i].w * v[i].w; }
        ss = wave_sum(ss);
        const float rstd = 1.0f / sqrtf(ss * (1.0f / DM) + 1e-6f);
#pragma unroll
        for (int i = 0; i < 4; ++i) {
            const float4 gg = ((const float4*)g)[lane + 64 * i];
            uint2 o; o.x = pk2(v[i].x * rstd * gg.x, v[i].y * rstd * gg.y); o.y = pk2(v[i].z * rstd * gg.z, v[i].w * rstd * gg.w);
            ((uint2*)(out + (size_t)row * DM))[lane + 64 * i] = o;
        }
    }
}
DEV void phase_res_norm(const float* xin, const bf16_t* delta, const float* g, float* xout, bf16_t* out, int bid, int nb) {
    const int tid_ = opaque_tid();
    const int wid = tid_ >> 6, lane = tid_ & 63;
    for (int row = bid * 8 + wid; row < NT; row += nb * 8) {
        const float4* xr = (const float4*)(xin + (size_t)row * DM);
        const uint2* dr = (const uint2*)(delta + (size_t)row * DM);
        float4 v[4]; float ss = 0.f;
#pragma unroll
        for (int i = 0; i < 4; ++i) { v[i] = xr[lane + 64 * i]; const uint2 d = dr[lane + 64 * i];
            v[i].x += bflo(d.x); v[i].y += bfhi(d.x); v[i].z += bflo(d.y); v[i].w += bfhi(d.y);
            ss += v[i].x * v[i].x + v[i].y * v[i].y + v[i].z * v[i].z + v[i].w * v[i].w; }
        ss = wave_sum(ss);
        const float rstd = 1.0f / sqrtf(ss * (1.0f / DM) + 1e-6f);
#pragma unroll
        for (int i = 0; i < 4; ++i) {
            ((float4*)(xout + (size_t)row * DM))[lane + 64 * i] = v[i];
            const float4 gg = ((const float4*)g)[lane + 64 * i];
            uint2 o; o.x = pk2(v[i].x * rstd * gg.x, v[i].y * rstd * gg.y); o.y = pk2(v[i].z * rstd * gg.z, v[i].w * rstd * gg.w);
            ((uint2*)(out + (size_t)row * DM))[lane + 64 * i] = o;
        }
    }
}
DEV void phase_final_norm(float* x, const bf16_t* delta, const float* g, int bid, int nb) {
    const int tid_ = opaque_tid();
    const int wid = tid_ >> 6, lane = tid_ & 63;
    for (int row = bid * 8 + wid; row < NT; row += nb * 8) {
        float4* xr = (float4*)(x + (size_t)row * DM);
        const uint2* dr = (const uint2*)(delta + (size_t)row * DM);
        float4 v[4]; float ss = 0.f;
#pragma unroll
        for (int i = 0; i < 4; ++i) { v[i] = xr[lane + 64 * i]; const uint2 d = dr[lane + 64 * i];
            v[i].x += bflo(d.x); v[i].y += bfhi(d.x); v[i].z += bflo(d.y); v[i].w += bfhi(d.y);
            ss += v[i].x * v[i].x + v[i].y * v[i].y + v[i].z * v[i].z + v[i].w * v[i].w; }
        ss = wave_sum(ss);
        const float rstd = 1.0f / sqrtf(ss * (1.0f / DM) + 1e-6f);
#pragma unroll
        for (int i = 0; i < 4; ++i) {
            const float4 gg = ((const float4*)g)[lane + 64 * i];
            float4 o; o.x = v[i].x * rstd * gg.x; o.y = v[i].y * rstd * gg.y; o.z = v[i].z * rstd * gg.z; o.w = v[i].w * rstd * gg.w;
            xr[lane + 64 * i] = o;
        }
    }
}

struct EpiBf16 { bf16_t* out; int ld;
    MDEV void operator()(int r, int c, float v) const { out[(size_t)r * ld + c] = f2bf(v); } };
struct EpiOddIn { bf16_t* out; float* fg; const float* bfv;
    MDEV void operator()(int r, int c, float v) const { if (c < 3072) out[(size_t)r * 3072 + c] = f2bf(v); else fg[(size_t)r * 16 + (c - 3072)] = v + bfv[c - 3072]; } };
struct EpiRes { const float* xin; float* xout;
    MDEV void operator()(int r, int c, float v) const { xout[(size_t)r * DM + c] = xin[(size_t)r * DM + c] + v; } };

template <class Epi>
DEV void phase_gemm_naive(const bf16_t* A, const bf16_t* Bt, int M, int N, int K, const Epi epi, float* lds, int bid, int nb) {
    float* As = lds;
    float* Bs = lds + 16 * 132;
    const int t = threadIdx.x, tx = t & 31, ty = t >> 5;
    const int ntm = M / 128, ntn = (N + 127) / 128;
    const int lr = t >> 2, lk = (t & 3) * 4;
    for (int tile = bid; tile < ntm * ntn; tile += nb) {
        const int m0 = (tile / ntn) * 128, n0 = (tile % ntn) * 128;
        float acc[8][4];
#pragma unroll
        for (int i = 0; i < 8; ++i)
#pragma unroll
            for (int j = 0; j < 4; ++j) acc[i][j] = 0.f;
        for (int k0 = 0; k0 < K; k0 += 16) {
            const uint2 av = *(const uint2*)(A + (size_t)(m0 + lr) * K + k0 + lk);
            uint2 bv = make_uint2(0u, 0u);
            if (n0 + lr < N) bv = *(const uint2*)(Bt + (size_t)(n0 + lr) * K + k0 + lk);
            __syncthreads();
            As[(lk + 0) * 132 + lr] = bflo(av.x); As[(lk + 1) * 132 + lr] = bfhi(av.x); As[(lk + 2) * 132 + lr] = bflo(av.y); As[(lk + 3) * 132 + lr] = bfhi(av.y);
            Bs[(lk + 0) * 132 + lr] = bflo(bv.x); Bs[(lk + 1) * 132 + lr] = bfhi(bv.x); Bs[(lk + 2) * 132 + lr] = bflo(bv.y); Bs[(lk + 3) * 132 + lr] = bfhi(bv.y);
            __syncthreads();
#pragma unroll
            for (int k = 0; k < 16; ++k) {
                const float4 a0 = *(const float4*)&As[k * 132 + ty * 8], a1 = *(const float4*)&As[k * 132 + ty * 8 + 4];
                const float4 b0 = *(const float4*)&Bs[k * 132 + tx * 4];
                const float a[8] = {a0.x, a0.y, a0.z, a0.w, a1.x, a1.y, a1.z, a1.w};
                const float b[4] = {b0.x, b0.y, b0.z, b0.w};
#pragma unroll
                for (int i = 0; i < 8; ++i)
#pragma unroll
                    for (int j = 0; j < 4; ++j) acc[i][j] += a[i] * b[j];
            }
        }
#pragma unroll
        for (int i = 0; i < 8; ++i)
#pragma unroll
            for (int j = 0; j < 4; ++j) { const int row = m0 + ty * 8 + i, col = n0 + tx * 4 + j; if (col < N) epi(row, col, acc[i][j]); }
    }
}

typedef short bf16x8 __attribute__((ext_vector_type(8)));
typedef float f32x4 __attribute__((ext_vector_type(4)));
namespace g8 {
constexpr int BM = 256, BK = 64, HALF = 128, NXCD = 8, WGM = 8, HT = HALF * BK, KD = 1024;
DEV int lds_byte(int r, int c) { const int st = (r >> 4) * 2 + (c >> 5), rr = r & 15, cc = c & 31, ob = rr * 64 + cc * 2; return st * 1024 + (ob ^ (((ob >> 9) & 1) << 5)); }
DEV void stage_rc(int b, int& R, int& C) { const int st = b / 1024, sb = b % 1024, swz = sb ^ (((sb >> 9) & 1) << 5); R = (st >> 1) * 16 + swz / 64; C = (st & 1) * 32 + (swz % 64) / 2; }
}
struct MEpiBf16 { static constexpr bool PERM = true; bf16_t* out; int ld;
    MDEV void operator()(int r, int c, f32x4 v0, f32x4 v1) const { uint4 o; o.x = cvtpk2(v0[0], v0[1]); o.y = cvtpk2(v0[2], v0[3]); o.z = cvtpk2(v1[0], v1[1]); o.w = cvtpk2(v1[2], v1[3]);
        *(uint4*)(out + (size_t)r * ld + c) = o; } };
struct MEpiQKV { static constexpr bool PERM = true; bf16_t* out; int s0_hi, s1_lo, s1_hi;
    MDEV void operator()(int r, int c, f32x4 v0, f32x4 v1) const { const float sc = (c < s0_hi || (c >= s1_lo && c < s1_hi)) ? 0.125f * 1.4426950408889634f : 1.0f;
        uint4 o; o.x = cvtpk2(v0[0] * sc, v0[1] * sc); o.y = cvtpk2(v0[2] * sc, v0[3] * sc); o.z = cvtpk2(v1[0] * sc, v1[1] * sc); o.w = cvtpk2(v1[2] * sc, v1[3] * sc);
        *(uint4*)(out + (size_t)r * 3072 + c) = o; } };
struct MEpiRes { static constexpr bool PERM = false; const float* xin; float* xout;
    MDEV void operator()(int r, int c, f32x4 v) const { const f32x4 b = *(const f32x4*)(xin + (size_t)r * DM + c); *(f32x4*)(xout + (size_t)r * DM + c) = b + v; } };

template <class Epi>
DEV void phase_gemm_mfma(const bf16_t* A, const bf16_t* Bt, int M, int N, const Epi epi, unsigned char* shm_raw, int bid, int nb) {
    using namespace g8;
    typedef __attribute__((address_space(3))) unsigned char* ldsp_t;
    ldsp_t lds = (ldsp_t)shm_raw;
    constexpr int K = KD, nt = K / BK, HTB = HALF * BK * 2;
    int tid = threadIdx.x; asm volatile("" : "+v"(tid));
    const int wid = __builtin_amdgcn_readfirstlane(tid >> 6), lane = tid & 63, wr = wid >> 2, wc = wid & 3, fr = lane & 15, fq = lane >> 4;
    const int nM = M / BM, nN = N / BM, nwg = nM * nN;
    auto unit_of = [&](int i, int& pm, int& pn) -> bool {
        const long L = (long)i * nb + bid; if (L >= nwg) return false;
        int wgid = (int)L;
        { const int q = nwg / NXCD, r = nwg % NXCD, xcd = wgid % NXCD, off = wgid / NXCD; wgid = (xcd < r ? xcd * (q + 1) : r * (q + 1) + (xcd - r) * q) + off; }
        const int nig = WGM * nN, gid = wgid / nig, fm = gid * WGM, gsz = min(nM - fm, WGM);
        pm = fm + ((wgid % nig) % gsz); pn = (wgid % nig) / gsz; return true; };
    unsigned voffA[2], voffB[2];
#pragma unroll
    for (int i = 0; i < 2; ++i) { int R, C; stage_rc(tid * 16 + i * 8192, R, C); const int rho = R & 31, pr = 8 * ((rho & 15) >> 2) + 4 * (rho >> 4) + (rho & 3);
        const int Rb = Epi::PERM ? ((R & ~31) + pr) : R;
        voffA[i] = (unsigned)(R * K + C) * 2u; voffB[i] = (unsigned)(Rb * K + C) * 2u; }
    constexpr size_t kstep = (size_t)(BK * 2), hstep = (size_t)HALF * K * 2, tstep = 2 * hstep;
    const unsigned ldsw = (unsigned)wid * 1024u;
    const int aoff = lds_byte(wr * 64 + fr, fq * 8), boff = lds_byte(wc * 32 + fr, fq * 8);
#define SA(b, h) (((b) * 2 + (h)) * HTB)
#define SB(b, h) ((4 + (b) * 2 + (h)) * HTB)
#define STAGE(bufoff, gbase, voff) do { _Pragma("unroll") for (int _i = 0; _i < 2; ++_i) \
        __builtin_amdgcn_global_load_lds((const unsigned*)((const char*)(gbase) + (voff)[_i]), (__attribute__((address_space(3))) unsigned*)(lds + (bufoff) + ldsw + _i * 8192), 16, 0, 0); } while (0)
#define LDA(dst, b, h) do { _Pragma("unroll") for (int m = 0; m < 4; ++m) _Pragma("unroll") for (int k = 0; k < 2; ++k) dst[m][k] = *(const __attribute__((address_space(3))) bf16x8*)(lds + SA(b, h) + aoff + m * 2048 + k * 1024); } while (0)
#define LDB(dst, b, h) do { _Pragma("unroll") for (int n = 0; n < 2; ++n) _Pragma("unroll") for (int k = 0; k < 2; ++k) dst[n][k] = *(const __attribute__((address_space(3))) bf16x8*)(lds + SB(b, h) + boff + n * 2048 + k * 1024); } while (0)
#define MMA(ai, bj, At, Bt_) do { __builtin_amdgcn_s_setprio(1); _Pragma("unroll") for (int m = 0; m < 4; ++m) _Pragma("unroll") for (int n = 0; n < 2; ++n) _Pragma("unroll") for (int k = 0; k < 2; ++k) \
        acc[ai][bj][m][n] = __builtin_amdgcn_mfma_f32_16x16x32_bf16(Bt_[n][k], At[m][k], acc[ai][bj][m][n], 0, 0, 0); __builtin_amdgcn_s_setprio(0); } while (0)
#define WAIT_V(n) asm volatile("s_waitcnt vmcnt(" #n ")" ::: "memory")
#define WAIT_L(n) asm volatile("s_waitcnt lgkmcnt(" #n ")" ::: "memory")
#define BAR __builtin_amdgcn_s_barrier()
#define SCHED __builtin_amdgcn_sched_barrier(0)
    int cpm, cpn, npm = 0, npn = 0, ui = 0;
    if (!unit_of(0, cpm, cpn)) return;
    f32x4 acc[2][2][4][2];
#pragma unroll
    for (int a = 0; a < 2; ++a)
#pragma unroll
        for (int b = 0; b < 2; ++b)
#pragma unroll
            for (int m = 0; m < 4; ++m)
#pragma unroll
                for (int n = 0; n < 2; ++n) acc[a][b][m][n] = (f32x4){0.f, 0.f, 0.f, 0.f};
    bf16x8 At[4][2], B0[2][2], B1[2][2];
    const char* cA = (const char*)A + (size_t)cpm * tstep; const char* cB = (const char*)Bt + (size_t)cpn * tstep;
    __syncthreads();
    STAGE(SB(0, 0), cB, voffB); STAGE(SA(0, 0), cA, voffA); STAGE(SB(0, 1), cB + hstep, voffB); STAGE(SA(0, 1), cA + hstep, voffA);
    if (wr == 1) BAR;
    WAIT_V(4); BAR;
    STAGE(SB(1, 0), cB + kstep, voffB); STAGE(SA(1, 0), cA + kstep, voffA); STAGE(SB(1, 1), cB + hstep + kstep, voffB);
    WAIT_V(6); BAR;
    for (;;) {
        const bool has_next = unit_of(ui + 1, npm, npn);
        const char* nA = has_next ? (const char*)A + (size_t)npm * tstep : cA; const char* nB = has_next ? (const char*)Bt + (size_t)npn * tstep : cB;
#pragma unroll 1
        for (int t = 0; t < nt; t += 2) {
            const bool last = (t == nt - 2);
            const char* a1 = cA + (size_t)(t + 1) * kstep;
            const char* a2 = last ? nA : cA + (size_t)(t + 2) * kstep; const char* b2 = last ? nB : cB + (size_t)(t + 2) * kstep;
            const char* a3 = a2 + kstep; const char* b3 = b2 + kstep;
            LDB(B0, 0, 0); SCHED; LDA(At, 0, 0); STAGE(SA(1, 1), a1 + hstep, voffA);
            WAIT_L(8); BAR; WAIT_L(0); MMA(0, 0, At, B0); BAR; SCHED;
            LDB(B1, 0, 1); STAGE(SB(0, 0), b2, voffB);
            BAR; WAIT_L(0); MMA(0, 1, At, B1); BAR;
            LDA(At, 0, 1); STAGE(SA(0, 0), a2, voffA);
            BAR; WAIT_L(0); MMA(1, 0, At, B0); BAR; SCHED;
            STAGE(SB(0, 1), b2 + hstep, voffB);
            WAIT_V(6); BAR; MMA(1, 1, At, B1); BAR;
            LDB(B0, 1, 0); SCHED; LDA(At, 1, 0); STAGE(SA(0, 1), a2 + hstep, voffA);
            WAIT_L(8); BAR; WAIT_L(0); MMA(0, 0, At, B0); BAR; SCHED;
            LDB(B1, 1, 1); STAGE(SB(1, 0), b3, voffB);
            BAR; WAIT_L(0); MMA(0, 1, At, B1); BAR;
            LDA(At, 1, 1); STAGE(SA(1, 0), a3, voffA);
            BAR; WAIT_L(0); MMA(1, 0, At, B0); BAR; SCHED;
            STAGE(SB(1, 1), b3 + hstep, voffB);
            WAIT_V(6); BAR; MMA(1, 1, At, B1); BAR;
        }
        {
            const int brow = cpm * BM, bcol = cpn * BM;
#pragma unroll
            for (int ai = 0; ai < 2; ++ai)
#pragma unroll
                for (int m = 0; m < 4; ++m)
#pragma unroll
                    for (int bj = 0; bj < 2; ++bj) {
                        const int row = brow + ai * HALF + wr * 64 + m * 16 + fr;
                        if constexpr (Epi::PERM) epi(row, bcol + bj * HALF + wc * 32 + 8 * fq, acc[ai][bj][m][0], acc[ai][bj][m][1]);
                        else { epi(row, bcol + bj * HALF + wc * 32 + 4 * fq, acc[ai][bj][m][0]); epi(row, bcol + bj * HALF + wc * 32 + 16 + 4 * fq, acc[ai][bj][m][1]); }
                    }
        }
        if (!has_next) break;
#pragma unroll
        for (int a = 0; a < 2; ++a)
#pragma unroll
            for (int b = 0; b < 2; ++b)
#pragma unroll
                for (int m = 0; m < 4; ++m)
#pragma unroll
                    for (int n = 0; n < 2; ++n) acc[a][b][m][n] = (f32x4){0.f, 0.f, 0.f, 0.f};
        cpm = npm; cpn = npn; cA = nA; cB = nB; ++ui;
    }
    WAIT_V(0);
    if (wr == 0) BAR;
    BAR;
#undef SA
#undef SB
#undef STAGE
#undef LDA
#undef LDB
#undef MMA
#undef WAIT_V
#undef WAIT_L
#undef BAR
#undef SCHED
}

DEV void phase_fg(const bf16_t* hn, const bf16_t* wfg, const float* bfv, float* fg, int bid, int nb) {
    const int tid_ = opaque_tid();
    const int wid = tid_ >> 6, lane = tid_ & 63, fr = lane & 15, fq = lane >> 4;
    for (int task = bid * 8 + wid; task < NT / 16; task += nb * 8) {
        const int row0 = task * 16;
        f32x4 acc = (f32x4){0.f, 0.f, 0.f, 0.f};
        const bf16x8* ap = (const bf16x8*)(hn + (size_t)(row0 + fr) * DM + fq * 8);
        const bf16x8* bp = (const bf16x8*)(wfg + (size_t)fr * DM + fq * 8);
#pragma unroll 8
        for (int kk = 0; kk < 32; ++kk) acc = __builtin_amdgcn_mfma_f32_16x16x32_bf16(ap[kk * 4], bp[kk * 4], acc, 0, 0, 0);
        const float bb = bfv[fr];
#pragma unroll
        for (int j = 0; j < 4; ++j) fg[(size_t)(row0 + fq * 4 + j) * 16 + fr] = acc[j] + bb;
    }
}

typedef float f32x16 __attribute__((ext_vector_type(16)));
typedef short s16x4 __attribute__((ext_vector_type(4)));
typedef __attribute__((address_space(3))) const unsigned char* ldsc_t;
typedef __attribute__((address_space(3))) unsigned char* lptr_t;
#define MFMA32(a, b, c) __builtin_amdgcn_mfma_f32_32x32x16_bf16(a, b, c, 0, 0, 0)
constexpr float NEG_BIG = -1e30f;
constexpr float LOG2E = 1.4426950408889634f;
constexpr float QSCALE = 0.125f * LOG2E;
constexpr int ATT_LUT_OFF = 0;
constexpr int ATT_TILE_OFF = 24576;
DEV unsigned cvtpk(float lo, float hi) { unsigned r; asm("v_cvt_pk_bf16_f32 %0, %1, %2" : "=v"(r) : "v"(lo), "v"(hi)); return r; }
DEV s16x4 vtr(ldsc_t p) { typedef short v4i16_t __attribute__((ext_vector_type(4))); return __builtin_bit_cast(s16x4, __builtin_amdgcn_ds_read_tr16_b64_v4i16((__attribute__((address_space(3))) v4i16_t*)p)); }
DEV float xhalf_max(float m) { auto rr = __builtin_amdgcn_permlane32_swap(__float_as_uint(m), __float_as_uint(m), false, false); return fmaxf(__uint_as_float(rr[0]), __uint_as_float(rr[1])); }
DEV float xhalf_sum(float m) { auto rr = __builtin_amdgcn_permlane32_swap(__float_as_uint(m), __float_as_uint(m), false, false); return __uint_as_float(rr[0]) + __uint_as_float(rr[1]); }

#define MXX3(a, b, c) __builtin_fmaxf(__builtin_fmaxf((a), (b)), (c))
template <int W, int MODE, int WIN  >
DEV void attn_unit(const bf16_t* qg  , const bf16_t* kg  , const bf16_t* vg, int kt_lo, int kt_hi,
                   int qrow, int qmin, int qmax, int kmap, unsigned char* lds_raw, f32x16 (&o)[W / 32], float kbound = 0.f, int rs = 3072, float* lse_out = nullptr, int rmax = 4127) {
    constexpr bool BAND = (WIN != 0);
    constexpr bool REV = (MODE == 1);
    constexpr int NC = W / 32, ROWB = W * 2, TILEB = 64 * ROWB, CPR = W / 8, NLD = (64 * CPR) / NTHR;
    int tid = threadIdx.x; asm volatile("" : "+v"(tid));
    const int lane = tid & 63, l31 = lane & 31, hi = lane >> 5;
    ldsc_t lds = (ldsc_t)lds_raw;
    const float* lut = (const float*)(lds_raw + ATT_LUT_OFF);
    bf16x8 qf[4];
#pragma unroll
    for (int ks = 0; ks < 4; ++ks) qf[ks] = *(const bf16x8*)(qg + ks * 16 + hi * 8);
#pragma unroll
    for (int c = 0; c < NC; ++c)
#pragma unroll
        for (int r = 0; r < 16; ++r) o[c][r] = 0.f;
    float m = NEG_BIG, l = 0.f;
    float brow = 0.f; bool wdone = false;
    volatile __attribute__((address_space(3))) unsigned* flg = (volatile __attribute__((address_space(3))) unsigned*)((lptr_t)lds_raw + ATT_LUT_OFF + 20480);
    if (REV) { float ss = 0.f;
#pragma unroll
        for (int ks = 0; ks < 4; ++ks)
#pragma unroll
            for (int j = 0; j < 8; ++j) { const float v = bf2f((bf16_t)qf[ks][j]); ss += v * v; }
        brow = sqrtf(xhalf_sum(ss)) * kbound; }
    const int wv = __builtin_amdgcn_readfirstlane(tid >> 6);
    unsigned ksrc[NLD], vsrc[NLD];
#pragma unroll
    for (int i = 0; i < NLD; ++i) { const int id = tid + NTHR * i, row = id / CPR, chp = id % CPR;
        const int kch = (W == 64) ? (chp ^ ((row >> 1) & 7)) : (chp ^ (row & 15));
        const int vch = (W == 64) ? (chp ^ (((row >> 1) & 1) << 2)) : (chp ^ ((row & 3) << 2));
        ksrc[i] = (unsigned)(row * rs + kch * 8); vsrc[i] = (unsigned)(row * rs + vch * 8); }
#define stage_issue(kt_, buf_) do { _Pragma("unroll") for (int i = 0; i < NLD; ++i) { \
        __builtin_amdgcn_global_load_lds((const unsigned*)(kg + (size_t)(kt_) * 64 * rs + ksrc[i]), (__attribute__((address_space(3))) unsigned*)((lptr_t)lds_raw + ATT_TILE_OFF + (buf_) * (2 * TILEB) + (wv * 64 + NTHR * i) * 16), 16, 0, 0); \
        __builtin_amdgcn_global_load_lds((const unsigned*)(vg + (size_t)(kt_) * 64 * rs + vsrc[i]), (__attribute__((address_space(3))) unsigned*)((lptr_t)lds_raw + ATT_TILE_OFF + (buf_) * (2 * TILEB) + TILEB + (wv * 64 + NTHR * i) * 16), 16, 0, 0); } } while (0)
    int koff[4];
#pragma unroll
    for (int ks = 0; ks < 4; ++ks) { const int ch = (kmap >> 3) + 2 * ks + hi; const int kch = (W == 64) ? (ch ^ ((l31 >> 1) & 7)) : (ch ^ (l31 & 15)); koff[ks] = l31 * ROWB + kch * 16; }
    int voff[NC];
    { const int q4 = (lane & 15) >> 2, blk = (lane >> 4) & 1, p = lane & 3;
#pragma unroll
      for (int c = 0; c < NC; ++c) { const int ch = 4 * c + 2 * blk + (p >> 1); const int vch = (W == 64) ? (ch ^ (((q4 >> 1) & 1) << 2)) : (ch ^ (q4 << 2));
          voff[c] = (4 * hi + q4) * ROWB + vch * 16 + 8 * (p & 1); } }
    __syncthreads();
    stage_issue(REV ? kt_hi : kt_lo, 0);
    __syncthreads();
    const int ntile = kt_hi - kt_lo + 1;
    for (int it = 0; it < ntile; ++it) {
        const int kt = REV ? kt_hi - it : kt_lo + it, ktn = REV ? kt - 1 : kt + 1;
        const bool has_next = it + 1 < ntile;
        const int buf = it & 1;
        if (has_next) stage_issue(ktn, buf ^ 1);
        const int k0 = kt * 64;
        bool active = (k0 <= qmax);
        if (BAND) active = active && (k0 + 63 >= qmin - WIN);
        if (REV) active = active && !wdone;
        if (active) {
            ldsc_t kb_ = lds + ATT_TILE_OFF + buf * (2 * TILEB); ldsc_t vb_ = kb_ + TILEB;
            f32x16 s0, s1;
            if (MODE == 0) {
                const bool far = !BAND && (qmin - (k0 + 63) >= 1513);
                const int ib = far ? (rmax - 3000) : (rmax - (qrow - k0 - 4 * hi));
                const __attribute__((address_space(3))) float* lp = (const __attribute__((address_space(3))) float*)((lptr_t)lds_raw + ATT_LUT_OFF) + ib;
#pragma unroll
                for (int r = 0; r < 16; ++r) { const int cr = (r & 3) + 8 * (r >> 2); s0[r] = lp[cr]; s1[r] = lp[32 + cr]; }
            } else {
                const f32x4* cp = (const f32x4*)(lut + k0 + 4 * hi);
#pragma unroll
                for (int g = 0; g < 4; ++g) { const f32x4 a = cp[2 * g], b = cp[2 * g + 8];
                    s0[4 * g] = a[0]; s0[4 * g + 1] = a[1]; s0[4 * g + 2] = a[2]; s0[4 * g + 3] = a[3];
                    s1[4 * g] = b[0]; s1[4 * g + 1] = b[1]; s1[4 * g + 2] = b[2]; s1[4 * g + 3] = b[3]; }
            }
#pragma unroll
            for (int ks = 0; ks < 4; ++ks) {
                const bf16x8 k0f = *(const __attribute__((address_space(3))) bf16x8*)(kb_ + koff[ks]);
                const bf16x8 k1f = *(const __attribute__((address_space(3))) bf16x8*)(kb_ + koff[ks] + 32 * ROWB);
                s0 = MFMA32(k0f, qf[ks], s0); s1 = MFMA32(k1f, qf[ks], s1);
            }
            if (MODE == 1) {
                if (k0 + 63 > qmin) {
#pragma unroll
                    for (int r = 0; r < 16; ++r) { const int kv = k0 + 4 * hi + (r & 3) + 8 * (r >> 2); if (kv > qrow) s0[r] = NEG_BIG; if (kv + 32 > qrow) s1[r] = NEG_BIG; }
                }
            }
            float mx;
            { const float a0 = MXX3(s0[0], s0[1], s0[2]), a1 = MXX3(s0[3], s0[4], s0[5]), a2 = MXX3(s0[6], s0[7], s0[8]), a3 = MXX3(s0[9], s0[10], s0[11]), a4 = MXX3(s0[12], s0[13], s0[14]);
              const float b0 = MXX3(s1[0], s1[1], s1[2]), b1 = MXX3(s1[3], s1[4], s1[5]), b2 = MXX3(s1[6], s1[7], s1[8]), b3 = MXX3(s1[9], s1[10], s1[11]), b4 = MXX3(s1[12], s1[13], s1[14]);
              mx = MXX3(MXX3(MXX3(a0, a1, a2), MXX3(a3, a4, s0[15]), MXX3(b0, b1, b2)), MXX3(b3, b4, s1[15]), a0); }
            mx = xhalf_max(mx);
            if (!__all(mx - m <= 8.0f)) {
                const float mn = fmaxf(m, mx), alpha = __builtin_amdgcn_exp2f(m - mn);
                m = mn; l *= alpha;
#pragma unroll
                for (int c = 0; c < NC; ++c)
#pragma unroll
                    for (int r = 0; r < 16; ++r) o[c][r] *= alpha;
            }
            float ls = 0.f;
#pragma unroll
            for (int r = 0; r < 16; ++r) { s0[r] = __builtin_amdgcn_exp2f(s0[r] - m); s1[r] = __builtin_amdgcn_exp2f(s1[r] - m); ls += s0[r] + s1[r]; }
            l += ls;
            bf16x8 pf[2][2];
#pragma unroll
            for (int s_ = 0; s_ < 2; ++s_) {
                typedef unsigned u32x4_t __attribute__((ext_vector_type(4)));
                u32x4_t w0, w1;
                w0[0] = cvtpk(s0[8 * s_ + 0], s0[8 * s_ + 1]); w0[1] = cvtpk(s0[8 * s_ + 2], s0[8 * s_ + 3]); w0[2] = cvtpk(s0[8 * s_ + 4], s0[8 * s_ + 5]); w0[3] = cvtpk(s0[8 * s_ + 6], s0[8 * s_ + 7]);
                w1[0] = cvtpk(s1[8 * s_ + 0], s1[8 * s_ + 1]); w1[1] = cvtpk(s1[8 * s_ + 2], s1[8 * s_ + 3]); w1[2] = cvtpk(s1[8 * s_ + 4], s1[8 * s_ + 5]); w1[3] = cvtpk(s1[8 * s_ + 6], s1[8 * s_ + 7]);
                pf[0][s_] = __builtin_bit_cast(bf16x8, w0); pf[1][s_] = __builtin_bit_cast(bf16x8, w1);
            }
#pragma unroll
            for (int c = 0; c < NC; ++c)
#pragma unroll
                for (int kb = 0; kb < 2; ++kb)
#pragma unroll
                    for (int s_ = 0; s_ < 2; ++s_) {
                        const s16x4 lo = vtr(vb_ + voff[c] + (32 * kb + 16 * s_) * ROWB), hi4 = vtr(vb_ + voff[c] + (32 * kb + 16 * s_ + 8) * ROWB);
                        bf16x8 vf; vf[0] = lo[0]; vf[1] = lo[1]; vf[2] = lo[2]; vf[3] = lo[3]; vf[4] = hi4[0]; vf[5] = hi4[1]; vf[6] = hi4[2]; vf[7] = hi4[3];
                        o[c] = MFMA32(vf, pf[kb][s_], o[c]);
                    }
        }
        if (REV) {
            if (!wdone && has_next) { const float nb = lut[k0 - 1]; wdone = __all((m > -1e29f) && (brow + nb < m - 30.0f)); }
            if (lane == 0) flg[(it & 1) * 8 + (tid >> 6)] = wdone ? 1u : 0u;
        }
        __syncthreads();
        if (REV) { const volatile __attribute__((address_space(3))) unsigned* f = flg + (it & 1) * 8;
            if ((f[0] & f[1] & f[2] & f[3] & f[4] & f[5] & f[6] & f[7]) != 0u) break; }
    }
#undef stage_issue
    const float lt = xhalf_sum(l), inv = 1.0f / lt;
    if (lse_out) *lse_out = m + __log2f(lt);
#pragma unroll
    for (int c = 0; c < NC; ++c)
#pragma unroll
        for (int r = 0; r < 16; ++r) o[c][r] *= inv;
}

template <int NC>
DEV void attn_store(const f32x16 (&o)[NC], bf16_t* orow, int hi) {
#pragma unroll
    for (int c = 0; c < NC; ++c)
#pragma unroll
        for (int g = 0; g < 4; ++g) { uint2 w; w.x = cvtpk(o[c][4 * g], o[c][4 * g + 1]); w.y = cvtpk(o[c][4 * g + 2], o[c][4 * g + 3]);
            *(uint2*)(orow + 32 * c + 8 * g + 4 * hi) = w; }
}

DEV void phase_fox_mfma(const bf16_t* qkv, const float* cloc, const float* ctot, const unsigned* kmax_u, bf16_t* ao, unsigned char* lds_raw, unsigned* qwork) {
    const int tid_ = opaque_tid();
    const int tid = tid_, wid = tid >> 6, lane = tid & 63, l31 = lane & 31, hi = lane >> 5;
    float* nck = (float*)(lds_raw + ATT_LUT_OFF);
    volatile unsigned* qsh = (volatile unsigned*)(lds_raw + ATT_LUT_OFF + 20480 + 128);
    for (;;) {
        const unsigned u = queue_next(qwork, qsh);
        if (u >= 2048u) break;
        const int qblk = 15 - (int)(u >> 7), st = (int)(u & 127), b = st >> 4, h = st & 15;
        const int q0 = qblk * 256, qend = q0 + 255;
        __syncthreads();
        { float coff[8]; float run = 0.f;
#pragma unroll
          for (int j = 0; j < 8; ++j) { coff[j] = run; run += ctot[st * 8 + j]; }
          float cq = 0.f;
#pragma unroll
          for (int j = 0; j < 8; ++j) cq = ((qend >> 9) == j) ? coff[j] : cq;
          const float cref = cloc[(size_t)st * SEQ + qend] + cq;
          for (int i = tid; i <= qend; i += NTHR) { float co = 0.f;
#pragma unroll
              for (int j = 0; j < 8; ++j) co = ((i >> 9) == j) ? coff[j] : co;
              nck[i] = (cref - (cloc[(size_t)st * SEQ + i] + co)) * LOG2E; } }
        const float kbound = __uint_as_float(kmax_u[st]);
        const int qrow = q0 + wid * 32 + l31;
        const size_t tokb = (size_t)b * SEQ;
        f32x16 o[2];
        attn_unit<64, 1, 0>(qkv + (tokb + qrow) * 3072 + h * 64, qkv + tokb * 3072 + 1024 + h * 64, qkv + tokb * 3072 + 2048 + h * 64,
                                0, qend >> 6, qrow, q0 + wid * 32, q0 + wid * 32 + 31, 0, lds_raw, o, kbound);
        attn_store<2>(o, ao + (tokb + qrow) * DM + h * 64, hi);
    }
}

DEV void phase_mix0_mfma(const bf16_t* qkv, const float* rel_bias, const float* lamp, const float* ln_g, bf16_t* ao, bf16_t* dpo, float* dlse, unsigned char* lds_raw, unsigned* qwork) {
    const int tid_ = opaque_tid();
    const int tid = tid_, wid = tid >> 6, lane = tid & 63, l31 = lane & 31, hi = lane >> 5;
    float* lut = (float*)(lds_raw + ATT_LUT_OFF);
    volatile unsigned* qsh = (volatile unsigned*)(lds_raw + ATT_LUT_OFF + 20480 + 128);
    float lam;
    { float s1 = 0.f, s2 = 0.f;
      for (int i = 0; i < 64; ++i) { s1 += lamp[i] * lamp[64 + i]; s2 += lamp[128 + i] * lamp[192 + i]; }
      lam = expf(s1) - expf(s2) + 0.2f; }
    for (;;) {
        const unsigned uq = queue_next(qwork, qsh);
        if (uq >= 1024u + 3072u) break;
      if (uq >= 1024u) {
        const int u = (int)uq - 1024;
        const int st = u & 63, v48 = u >> 6, b = st >> 3, h = st & 7;
        int br, r, iblk;
        if (v48 < 16) { br = 0; r = 0; iblk = 15 - v48; } else if (v48 < 32) { br = 1; r = (v48 - 16) & 3; iblk = 3 - ((v48 - 16) >> 2); } else { br = 2; r = v48 - 32; iblk = 0; }
        const int dl = (br == 0) ? 1 : (br == 1) ? 4 : 16;
        const int q0 = iblk * 256, qend = q0 + 255;
        __syncthreads();
        for (int i = tid; i < 640; i += NTHR) { const int dd = 320 - i; lut[i] = (dd >= 0 && dd <= 128) ? rel_bias[t5_bucket(dl * dd) * 12 + h] * LOG2E : NEG_BIG; }
        const int qrow = q0 + wid * 32 + l31;
        const size_t tokb = (size_t)b * SEQ;
        const int klo = max(q0 - 128, 0) >> 6;
        f32x16 o[2]; float lse;
        attn_unit<64, 0, 128>(qkv + (tokb + r + (size_t)dl * qrow) * 3072 + h * 64, qkv + (tokb + r) * 3072 + 512 + h * 64, qkv + (tokb + r) * 3072 + 1024 + h * 64,
                              klo, qend >> 6, qrow, q0 + wid * 32, q0 + wid * 32 + 31, 0, lds_raw, o, 0.f, dl * 3072, &lse, 320);
        const size_t tok = tokb + r + (size_t)dl * qrow;
        attn_store<2>(o, dpo + ((size_t)br * NT + tok) * 512 + h * 64, hi);
        if (hi == 0) dlse[((size_t)br * NT + tok) * 8 + h] = lse;
      } else {
        const int u = (int)uq;
        const int qblk = 31 - (u >> 5), st = u & 31;
        const int b = st >> 2, hd = st & 3;
        const int q0 = qblk * 128, qend = q0 + 127;
        __syncthreads();
        for (int i = tid; i < 4224; i += NTHR) { const int dist = 4127 - i; lut[i] = (dist >= 0 && dist <= 4095) ? rel_bias[t5_bucket(dist) * 12 + 8 + hd] * LOG2E : NEG_BIG; }
        const int qg_ = wid >> 1, map = wid & 1;
        const int qrow = q0 + qg_ * 32 + l31;
        const size_t tokb = (size_t)b * SEQ;
        f32x16 o[4];
        attn_unit<128, 0, 0>(qkv + (tokb + qrow) * 3072 + 1536 + hd * 128 + map * 64, qkv + tokb * 3072 + 2048 + hd * 128, qkv + tokb * 3072 + 2560 + hd * 128,
                                 0, qend >> 6, qrow, q0 + qg_ * 32, q0 + qg_ * 32 + 31, map * 64, lds_raw, o);
        float* X = (float*)(lds_raw + ATT_TILE_OFF) + qg_ * 4096;
        if (map == 1) {
#pragma unroll
            for (int c = 0; c < 4; ++c)
#pragma unroll
                for (int r = 0; r < 16; ++r) X[(c * 16 + r) * 64 + lane] = lam * o[c][r];
        }
        __syncthreads();
        if (map == 0) {
            float ss = 0.f;
#pragma unroll
            for (int c = 0; c < 4; ++c)
#pragma unroll
                for (int r = 0; r < 16; ++r) { o[c][r] -= X[(c * 16 + r) * 64 + lane]; ss += o[c][r] * o[c][r]; }
            ss = xhalf_sum(ss);
            const float rstd = 0.8f / sqrtf(ss * (1.0f / 128.0f) + 1e-6f);
            bf16_t* orow = ao + (tokb + qrow) * DM + 512 + hd * 128;
#pragma unroll
            for (int c = 0; c < 4; ++c)
#pragma unroll
                for (int g = 0; g < 4; ++g) { const int d0 = 32 * c + 8 * g + 4 * hi; const f32x4 gg = *(const f32x4*)(ln_g + d0);
                    uint2 wv; wv.x = cvtpk(o[c][4 * g] * rstd * gg[0], o[c][4 * g + 1] * rstd * gg[1]); wv.y = cvtpk(o[c][4 * g + 2] * rstd * gg[2], o[c][4 * g + 3] * rstd * gg[3]);
                    *(uint2*)(orow + d0) = wv; }
        }
      }
    }
}

DEV void phase_dilated_naive(const bf16_t* qkv, const float* rel_bias, bf16_t* ao, float* lds, int bid, int nb) {
    const int t = threadIdx.x, wid = t >> 6, lane = t & 63;
    float* lut = lds;
    __syncthreads();
    for (int i = t; i < 8 * 3 * 129; i += NTHR) {
        const int h = i / (3 * 129), r = i % (3 * 129), br = r / 129, n = r % 129;
        const int dl = br == 0 ? 1 : (br == 1 ? 4 : 16);
        lut[(h * 3 + br) * 132 + n] = rel_bias[t5_bucket(dl * n) * 12 + h];
    }
    __syncthreads();
    for (int task = bid * 8 + wid; task < NT * 8; task += nb * 8) {
        const int tok = task >> 3, h = task & 7, b = tok >> 12, pos = tok & 4095;
        const float q = bf2f(qkv[(size_t)tok * 3072 + h * 64 + lane]) * 0.125f;
        float m = -INFINITY, l = 0.f, o = 0.f;
#pragma unroll
        for (int br = 0; br < 3; ++br) {
            const int dl = br == 0 ? 1 : (br == 1 ? 4 : 16);
            const int nvalid = min(128, pos / dl) + 1;
            const float* lb = lut + (h * 3 + br) * 132;
            for (int n0 = 0; n0 < nvalid; n0 += 4) {
                float kv[4], vv[4];
#pragma unroll
                for (int j = 0; j < 4; ++j) {
                    const int key = max(pos - dl * (n0 + j), 0);
                    const size_t base = (size_t)(b * SEQ + key) * 3072 + h * 64 + lane;
                    kv[j] = bf2f(qkv[base + 512]); vv[j] = bf2f(qkv[base + 1024]);
                }
#pragma unroll
                for (int j = 0; j < 4; ++j) {
                    if (n0 + j < nvalid) {
                        const float s = wave_sum(q * kv[j]) + lb[n0 + j];
                        if (s > m) { const float f = __expf(m - s); l *= f; o *= f; m = s; }
                        const float p = __expf(s - m);
                        l += p; o += p * vv[j];
                    }
                }
            }
        }
        ao[(size_t)tok * DM + h * 64 + lane] = f2bf(o / l);
    }
}

DEV void phase_diff_naive(const bf16_t* qkv, const float* rel_bias, const float* lamp, const float* ln_g, bf16_t* ao, float* lds, int bid, int nb) {
    const int t = threadIdx.x;
    float* Ks = lds;
    float* Vs = lds + 8192;
    float* lut = lds + 16384 + 512;
    float* X = lds;
    float lam;
    { float s1 = 0.f, s2 = 0.f;
      for (int i = 0; i < 64; ++i) { s1 += lamp[i] * lamp[64 + i]; s2 += lamp[128 + i] * lamp[192 + i]; }
      lam = expf(s1) - expf(s2) + 0.2f; }
    const int qi = t & 127, map = (t >> 7) & 1, vh = t >> 8;
    for (int unit = bid; unit < 1024; unit += nb) {
        const int qblk = 31 - unit / 32, bh = unit % 32, b = bh >> 2, hd = bh & 3;
        const int qpos = qblk * 128 + qi;
        const size_t tok = (size_t)b * SEQ + qpos;
        __syncthreads();
        for (int i = t; i < 4096; i += NTHR) lut[i] = rel_bias[t5_bucket(i) * 12 + 8 + hd];
        float q[64], o[64];
        { const uint4* qp = (const uint4*)(qkv + tok * 3072 + 1536 + hd * 128 + map * 64);
#pragma unroll
          for (int i = 0; i < 8; ++i) { const uint4 w = qp[i];
              q[i * 8 + 0] = bflo(w.x) * 0.125f; q[i * 8 + 1] = bfhi(w.x) * 0.125f; q[i * 8 + 2] = bflo(w.y) * 0.125f; q[i * 8 + 3] = bfhi(w.y) * 0.125f;
              q[i * 8 + 4] = bflo(w.z) * 0.125f; q[i * 8 + 5] = bfhi(w.z) * 0.125f; q[i * 8 + 6] = bflo(w.w) * 0.125f; q[i * 8 + 7] = bfhi(w.w) * 0.125f; } }
#pragma unroll
        for (int d = 0; d < 64; ++d) o[d] = 0.f;
        float m = -INFINITY, l = 0.f;
        const int nkt = 2 * qblk + 2;
        for (int kt = 0; kt < nkt; ++kt) {
            __syncthreads();
#pragma unroll
            for (int i = 0; i < 2; ++i) {
                const int e = (t + i * NTHR) * 8, j = e >> 7, d0 = e & 127;
                const size_t base = ((size_t)b * SEQ + kt * 64 + j) * 3072 + hd * 128 + d0;
                const uint4 kw = *(const uint4*)(qkv + base + 2048), vw = *(const uint4*)(qkv + base + 2560);
                float* kd = Ks + j * 128 + d0; float* vd = Vs + j * 128 + d0;
                kd[0] = bflo(kw.x); kd[1] = bfhi(kw.x); kd[2] = bflo(kw.y); kd[3] = bfhi(kw.y); kd[4] = bflo(kw.z); kd[5] = bfhi(kw.z); kd[6] = bflo(kw.w); kd[7] = bfhi(kw.w);
                vd[0] = bflo(vw.x); vd[1] = bfhi(vw.x); vd[2] = bflo(vw.y); vd[3] = bfhi(vw.y); vd[4] = bflo(vw.z); vd[5] = bfhi(vw.z); vd[6] = bflo(vw.w); vd[7] = bfhi(vw.w);
            }
            __syncthreads();
            for (int j = 0; j < 64; ++j) {
                const int key = kt * 64 + j;
                if (key <= qpos) {
                    const float4* kr = (const float4*)(Ks + j * 128 + map * 64);
                    float s = 0.f;
#pragma unroll
                    for (int d4 = 0; d4 < 16; ++d4) { const float4 kk = kr[d4]; s += q[d4 * 4] * kk.x + q[d4 * 4 + 1] * kk.y + q[d4 * 4 + 2] * kk.z + q[d4 * 4 + 3] * kk.w; }
                    s += lut[qpos - key];
                    if (s > m) { const float f = __expf(m - s); l *= f;
#pragma unroll
                        for (int d = 0; d < 64; ++d) o[d] *= f;
                        m = s; }
                    const float p = __expf(s - m);
                    l += p;
                    const float4* vr = (const float4*)(Vs + j * 128 + vh * 64);
#pragma unroll
                    for (int d4 = 0; d4 < 16; ++d4) { const float4 vv = vr[d4]; o[d4 * 4] += p * vv.x; o[d4 * 4 + 1] += p * vv.y; o[d4 * 4 + 2] += p * vv.z; o[d4 * 4 + 3] += p * vv.w; }
                }
            }
        }
        const float inv = 1.0f / l;
        __syncthreads();
        if (map == 1) {
#pragma unroll
            for (int d = 0; d < 64; ++d) X[qi * 129 + vh * 64 + d] = lam * o[d] * inv;
        }
        __syncthreads();
        if (map == 0) {
#pragma unroll
            for (int d = 0; d < 64; ++d) X[qi * 129 + vh * 64 + d] = o[d] * inv - X[qi * 129 + vh * 64 + d];
        }
        __syncthreads();
        {
            const int qq = t >> 2, part = t & 3;
            float ss = 0.f;
            for (int i = 0; i < 32; ++i) { const float v = X[qq * 129 + part * 32 + i]; ss += v * v; }
            ss += __shfl_xor(ss, 1); ss += __shfl_xor(ss, 2);
            const float rstd = 1.0f / sqrtf(ss * (1.0f / 128.0f) + 1e-6f);
            const size_t tk = (size_t)b * SEQ + qblk * 128 + qq;
            for (int i = 0; i < 32; ++i) { const int v = part * 32 + i;
                ao[tk * DM + 512 + hd * 128 + v] = f2bf(X[qq * 129 + v] * rstd * ln_g[v] * 0.8f); }
        }
    }
}

DEV void phase_dilated_merge(const bf16_t* dpo, const float* dlse, bf16_t* ao, int bid, int nb) {
    const int tid_ = opaque_tid();
    const int wid = tid_ >> 6, lane = tid_ & 63, h = lane >> 3;
    for (int tok = bid * 8 + wid; tok < NT; tok += nb * 8) {
        float ls[3]; uint4 ov[3];
#pragma unroll
        for (int br = 0; br < 3; ++br) { ls[br] = dlse[((size_t)br * NT + tok) * 8 + h]; ov[br] = *(const uint4*)(dpo + ((size_t)br * NT + tok) * 512 + lane * 8); }
        const float mx = fmaxf(fmaxf(ls[0], ls[1]), ls[2]);
        float w[3]; float sum = 0.f;
#pragma unroll
        for (int br = 0; br < 3; ++br) { w[br] = __builtin_amdgcn_exp2f(ls[br] - mx); sum += w[br]; }
        const float inv = 1.0f / sum;
        float acc[8];
#pragma unroll
        for (int i = 0; i < 8; ++i) acc[i] = 0.f;
#pragma unroll
        for (int br = 0; br < 3; ++br) { const float ww = w[br] * inv;
            acc[0] += ww * bflo(ov[br].x); acc[1] += ww * bfhi(ov[br].x); acc[2] += ww * bflo(ov[br].y); acc[3] += ww * bfhi(ov[br].y);
            acc[4] += ww * bflo(ov[br].z); acc[5] += ww * bfhi(ov[br].z); acc[6] += ww * bflo(ov[br].w); acc[7] += ww * bfhi(ov[br].w); }
        uint4 o; o.x = pk2(acc[0], acc[1]); o.y = pk2(acc[2], acc[3]); o.z = pk2(acc[4], acc[5]); o.w = pk2(acc[6], acc[7]);
        *(uint4*)(ao + (size_t)tok * DM + lane * 8) = o;
    }
}

DEV void phase_cumsum(const float* fg, const bf16_t* qkv, float* cloc, float* ctot, unsigned* kmax_u, int bid, int nb) {
    const int tid_ = opaque_tid();
    const int wid = tid_ >> 6, lane = tid_ & 63;
    for (int task = bid * 8 + wid; task < 1024; task += nb * 8) {
        const int bh = task >> 3, chunk = task & 7, b = bh >> 4, h = bh & 15;
        float carry = 0.f, kmx = 0.f;
        for (int s0 = chunk * 512; s0 < chunk * 512 + 512; s0 += 64) {
            const size_t tok = (size_t)b * SEQ + s0 + lane;
            const float xv = fg[tok * 16 + h];
            float v = fminf(xv, 0.f) - log1pf(expf(-fabsf(xv)));
#pragma unroll
            for (int o = 1; o < 64; o <<= 1) { const float u = __shfl_up(v, o); if (lane >= o) v += u; }
            v += carry;
            cloc[(size_t)bh * SEQ + s0 + lane] = v;
            carry = __shfl(v, 63);
            const uint4* kp = (const uint4*)(qkv + tok * 3072 + 1024 + h * 64);
            float ss = 0.f;
#pragma unroll
            for (int i = 0; i < 8; ++i) { const uint4 w = kp[i];
                ss += bflo(w.x) * bflo(w.x) + bfhi(w.x) * bfhi(w.x) + bflo(w.y) * bflo(w.y) + bfhi(w.y) * bfhi(w.y) + bflo(w.z) * bflo(w.z) + bfhi(w.z) * bfhi(w.z) + bflo(w.w) * bflo(w.w) + bfhi(w.w) * bfhi(w.w); }
            kmx = fmaxf(kmx, ss);
        }
        kmx = wave_max(kmx);
        if (lane == 0) { ctot[bh * 8 + chunk] = carry; atomicMax(kmax_u + bh, __float_as_uint(sqrtf(kmx) * 1.0001f)); }
    }
}

DEV void phase_fox_naive(const bf16_t* qkv, const float* carr, bf16_t* ao, float* lds, int bid, int nb) {
    const int t = threadIdx.x;
    float* Ks = lds;
    float* Vs = lds + 4096;
    float* cks = lds + 8192;
    for (int unit = bid; unit < 1024; unit += nb) {
        const int qblk = 7 - unit / 128, bh = unit % 128, b = bh >> 4, h = bh & 15;
        const int qpos = qblk * 512 + t;
        const size_t tok = (size_t)b * SEQ + qpos;
        float q[64], o[64];
        { const uint4* qp = (const uint4*)(qkv + tok * 3072 + h * 64);
#pragma unroll
          for (int i = 0; i < 8; ++i) { const uint4 w = qp[i];
              q[i * 8 + 0] = bflo(w.x) * 0.125f; q[i * 8 + 1] = bfhi(w.x) * 0.125f; q[i * 8 + 2] = bflo(w.y) * 0.125f; q[i * 8 + 3] = bfhi(w.y) * 0.125f;
              q[i * 8 + 4] = bflo(w.z) * 0.125f; q[i * 8 + 5] = bfhi(w.z) * 0.125f; q[i * 8 + 6] = bflo(w.w) * 0.125f; q[i * 8 + 7] = bfhi(w.w) * 0.125f; } }
#pragma unroll
        for (int d = 0; d < 64; ++d) o[d] = 0.f;
        const float cq = carr[(size_t)bh * SEQ + qpos];
        float m = -INFINITY, l = 0.f;
        const int nkt = (qblk + 1) * 8;
        for (int kt = 0; kt < nkt; ++kt) {
            __syncthreads();
            {
                const int e = t * 8, j = e >> 6, d0 = e & 63;
                const size_t base = ((size_t)b * SEQ + kt * 64 + j) * 3072 + h * 64 + d0;
                const uint4 kw = *(const uint4*)(qkv + base + 1024), vw = *(const uint4*)(qkv + base + 2048);
                float* kd = Ks + j * 64 + d0; float* vd = Vs + j * 64 + d0;
                kd[0] = bflo(kw.x); kd[1] = bfhi(kw.x); kd[2] = bflo(kw.y); kd[3] = bfhi(kw.y); kd[4] = bflo(kw.z); kd[5] = bfhi(kw.z); kd[6] = bflo(kw.w); kd[7] = bfhi(kw.w);
                vd[0] = bflo(vw.x); vd[1] = bfhi(vw.x); vd[2] = bflo(vw.y); vd[3] = bfhi(vw.y); vd[4] = bflo(vw.z); vd[5] = bfhi(vw.z); vd[6] = bflo(vw.w); vd[7] = bfhi(vw.w);
                if (t < 64) cks[t] = carr[(size_t)bh * SEQ + kt * 64 + t];
            }
            __syncthreads();
            for (int j = 0; j < 64; ++j) {
                const int key = kt * 64 + j;
                if (key <= qpos) {
                    const float4* kr = (const float4*)(Ks + j * 64);
                    float s = 0.f;
#pragma unroll
                    for (int d4 = 0; d4 < 16; ++d4) { const float4 kk = kr[d4]; s += q[d4 * 4] * kk.x + q[d4 * 4 + 1] * kk.y + q[d4 * 4 + 2] * kk.z + q[d4 * 4 + 3] * kk.w; }
                    s += cq - cks[j];
                    if (s > m) { const float f = __expf(m - s); l *= f;
#pragma unroll
                        for (int d = 0; d < 64; ++d) o[d] *= f;
                        m = s; }
                    const float p = __expf(s - m);
                    l += p;
                    const float4* vr = (const float4*)(Vs + j * 64);
#pragma unroll
                    for (int d4 = 0; d4 < 16; ++d4) { const float4 vv = vr[d4]; o[d4 * 4] += p * vv.x; o[d4 * 4 + 1] += p * vv.y; o[d4 * 4 + 2] += p * vv.z; o[d4 * 4 + 3] += p * vv.w; }
                }
            }
        }
        const float inv = 1.0f / l;
        uint4* op = (uint4*)(ao + tok * DM + h * 64);
#pragma unroll
        for (int i = 0; i < 8; ++i) { uint4 w; w.x = pk2(o[i * 8] * inv, o[i * 8 + 1] * inv); w.y = pk2(o[i * 8 + 2] * inv, o[i * 8 + 3] * inv);
            w.z = pk2(o[i * 8 + 4] * inv, o[i * 8 + 5] * inv); w.w = pk2(o[i * 8 + 6] * inv, o[i * 8 + 7] * inv); op[i] = w; }
    }
}

DEV void wave_argmax(float& bv, int& bi) {
#pragma unroll
    for (int o = 32; o >= 1; o >>= 1) {
        const float ov = __shfl_xor(bv, o); const int oi = __shfl_xor(bi, o);
        if (ov > bv || (ov == bv && oi < bi)) { bv = ov; bi = oi; }
    }
}
DEV void phase_topk_naive(const bf16_t* pq, const bf16_t* sk, int* idx_out, float* gate_out, float* lds, int bid, int nb) {
    const int wid = threadIdx.x >> 6, lane = threadIdx.x & 63;
    float* wq = lds + wid * 320;
    float* wts = wq + 256;
    int* wti = (int*)(wq + 288);
    for (int task = bid * 8 + wid; task < NT * 8; task += nb * 8) {
        const int tok = task >> 3, h = task & 7;
        lds_fence();
        { const uint2 r = *(const uint2*)(pq + (size_t)tok * 2048 + h * 256 + lane * 4);
          wq[lane * 4 + 0] = bflo(r.x); wq[lane * 4 + 1] = bfhi(r.x); wq[lane * 4 + 2] = bflo(r.y); wq[lane * 4 + 3] = bfhi(r.y); }
        lds_fence();
#pragma unroll 1
        for (int c = 0; c < 2; ++c) {
            float v0, v1;
            const float* qq = wq + c * 128;
            {
                const uint4* row = (const uint4*)(sk + ((size_t)(h * 2 + c) * 128 + lane) * 128);
                float s = 0.f;
#pragma unroll
                for (int i = 0; i < 16; ++i) { const uint4 w = row[i];
                    s += qq[i * 8] * bflo(w.x) + qq[i * 8 + 1] * bfhi(w.x) + qq[i * 8 + 2] * bflo(w.y) + qq[i * 8 + 3] * bfhi(w.y)
                       + qq[i * 8 + 4] * bflo(w.z) + qq[i * 8 + 5] * bfhi(w.z) + qq[i * 8 + 6] * bflo(w.w) + qq[i * 8 + 7] * bfhi(w.w); }
                v0 = s;
            }
            asm volatile("" : "+v"(v0) :: "memory");
            {
                const uint4* row = (const uint4*)(sk + ((size_t)(h * 2 + c) * 128 + lane + 64) * 128);
                float s = 0.f;
#pragma unroll
                for (int i = 0; i < 16; ++i) { const uint4 w = row[i];
                    s += qq[i * 8] * bflo(w.x) + qq[i * 8 + 1] * bfhi(w.x) + qq[i * 8 + 2] * bflo(w.y) + qq[i * 8 + 3] * bfhi(w.y)
                       + qq[i * 8 + 4] * bflo(w.z) + qq[i * 8 + 5] * bfhi(w.z) + qq[i * 8 + 6] * bflo(w.w) + qq[i * 8 + 7] * bfhi(w.w); }
                v1 = s;
            }
            asm volatile("" : "+v"(v1) :: "memory");
            float ts = 0.f; int ti = 0;
            for (int r = 0; r < 16; ++r) {
                float bv; int bi;
                if (v1 > v0) { bv = v1; bi = lane + 64; } else { bv = v0; bi = lane; }
                wave_argmax(bv, bi);
                if (lane == r) { ts = bv; ti = bi; }
                if (bi == lane) v0 = -INFINITY;
                if (bi == lane + 64) v1 = -INFINITY;
            }
            if (lane < 16) { wts[c * 16 + lane] = ts; wti[c * 16 + lane] = ti; }
        }
        lds_fence();
        float cs[4];
#pragma unroll
        for (int jj = 0; jj < 4; ++jj) { const int j = lane * 4 + jj; cs[jj] = wts[j >> 4] + wts[16 + (j & 15)]; }
        float bs = 0.f; int be = 0;
        for (int r = 0; r < 16; ++r) {
            float bv = cs[0]; int bi = lane * 4;
#pragma unroll
            for (int jj = 1; jj < 4; ++jj) if (cs[jj] > bv) { bv = cs[jj]; bi = lane * 4 + jj; }
            wave_argmax(bv, bi);
            if (lane == r) { bs = bv; be = wti[bi >> 4] * 128 + wti[16 + (bi & 15)]; }
#pragma unroll
            for (int jj = 0; jj < 4; ++jj) if (bi == lane * 4 + jj) cs[jj] = -INFINITY;
        }
        float mv = lane < 16 ? bs : -INFINITY;
        mv = wave_max(mv);
        float e = lane < 16 ? __expf(bs - mv) : 0.f;
        const float sum = wave_sum(e);
        if (lane < 16) { idx_out[(size_t)tok * 128 + h * 16 + lane] = be; gate_out[(size_t)tok * 128 + h * 16 + lane] = e / sum; }
    }
}

struct PairTab { int a[50], b[50]; };
constexpr PairTab make_pairs() { PairTab t{}; int n = 0; for (int a = 0; a < 16; ++a) for (int b = 0; b < 16; ++b) if ((a + 1) * (b + 1) <= 16) { t.a[n] = a; t.b[n] = b; ++n; } return t; }
constexpr PairTab PAIRS = make_pairs();
#define MX3(a, b, c) __builtin_fmaxf(__builtin_fmaxf((a), (b)), (c))
DEV unsigned xhalf_or(unsigned v) { auto rr = __builtin_amdgcn_permlane32_swap(v, v, false, false); return rr[0] | rr[1]; }
template <int J, int N, class T> DEV void bstage(T& v, const int k) {
#pragma clang loop unroll(full)
    for (int i = 0; i < N; ++i) { const int l = i ^ J; if (l > i) { const bool d = ((i & k) == 0); const float hi_ = fmaxf(v[i], v[l]), lo_ = fminf(v[i], v[l]); v[i] = d ? hi_ : lo_; v[l] = d ? lo_ : hi_; } }
}
template <int N, class T> DEV void bmerge_desc(T& v) {
    if constexpr (N >= 32) bstage<16, N>(v, N);
    if constexpr (N >= 16) bstage<8, N>(v, N);
    bstage<4, N>(v, N); bstage<2, N>(v, N); bstage<1, N>(v, N);
}
template <int N, class T> DEV void bsort_desc(T& v) {
    bstage<1, N>(v, 2);
    bstage<2, N>(v, 4); bstage<1, N>(v, 4);
    bstage<4, N>(v, 8); bstage<2, N>(v, 8); bstage<1, N>(v, 8);
    bstage<8, N>(v, 16); bstage<4, N>(v, 16); bstage<2, N>(v, 16); bstage<1, N>(v, 16);
    if constexpr (N >= 32) { bstage<16, N>(v, 32); bstage<8, N>(v, 32); bstage<4, N>(v, 32); bstage<2, N>(v, 32); bstage<1, N>(v, 32); }
}
template <class T> DEV void merge_top16(T& a, const T& b) {
#pragma unroll
    for (int i = 0; i < 16; ++i) a[i] = fmaxf(a[i], b[15 - i]);
    bmerge_desc<16>(a);
}
DEV float xhalf_other(float v, int hi) { auto rr = __builtin_amdgcn_permlane32_swap(__float_as_uint(v), __float_as_uint(v), false, false); return __uint_as_float(hi ? rr[0] : rr[1]); }
DEV void phase_topk_mfma(const bf16_t* pq, const bf16_t* skl, const float* uinv, const float* vinv, int* idx_out, float* gate_out, float* usc_out, unsigned char* lds_raw, int bid, int nb) {
    int tid = threadIdx.x; asm volatile("" : "+v"(tid));
    const int wid = tid >> 6, lane = tid & 63, l31 = lane & 31, hi = lane >> 5;
    ldsc_t lds = (ldsc_t)lds_raw;
    int cur_h = -1;
    for (int u = bid; u < 1024; u += nb) {
        const int h = u & 7, tg = u >> 3;
        if (h != cur_h) {
            __syncthreads();
#pragma unroll
            for (int i = 0; i < 8; ++i) { const int id = tid + NTHR * i, crow_ = id >> 4, ch = id & 15;
                const uint4 v = *(const uint4*)(skl + ((size_t)h * 256 + crow_) * 128 + ch * 8);
                *(uint4*)(lds_raw + crow_ * 256 + ((ch ^ (crow_ & 15)) * 16)) = v; }
            __syncthreads();
            cur_h = h;
        }
        const int tok = tg * 256 + wid * 32 + l31;
        const bf16_t* qp = pq + (size_t)tok * 2048 + h * 256;
        __attribute__((address_space(3))) unsigned* nt = (__attribute__((address_space(3))) unsigned*)((lptr_t)lds_raw + 65536 + wid * 8192 + l31 * 256);
#pragma unroll
        for (int c = 0; c < 2; ++c) {
            f32x16 acc[4];
#pragma unroll
            for (int kb = 0; kb < 4; ++kb)
#pragma unroll
                for (int r = 0; r < 16; ++r) acc[kb][r] = 0.f;
#pragma unroll
            for (int ks = 0; ks < 8; ++ks) {
                const bf16x8 qf = *(const bf16x8*)(qp + c * 128 + ks * 16 + hi * 8);
#pragma unroll
                for (int kb = 0; kb < 4; ++kb) {
                    const int row = c * 128 + 32 * kb + l31, ch = 2 * ks + hi;
                    const bf16x8 af = *(const __attribute__((address_space(3))) bf16x8*)(lds + row * 256 + ((ch ^ (l31 & 15)) * 16));
                    acc[kb] = MFMA32(af, qf, acc[kb]);
                }
            }
#pragma unroll
            for (int kb = 0; kb < 4; ++kb)
#pragma unroll
                for (int r = 0; r < 16; ++r) { const unsigned n = 32u * kb + (r & 3) + 8 * (r >> 2) + 4u * hi;
                    acc[kb][r] = __uint_as_float((__float_as_uint(acc[kb][r]) & ~127u) | n); }
            bsort_desc<16>(acc[0]); bsort_desc<16>(acc[1]); bsort_desc<16>(acc[2]); bsort_desc<16>(acc[3]);
            merge_top16(acc[0], acc[1]); merge_top16(acc[2], acc[3]); merge_top16(acc[0], acc[2]);
            { float t_[16];
#pragma unroll
              for (int i = 0; i < 16; ++i) t_[i] = fmaxf(acc[0][i], xhalf_other(acc[0][15 - i], hi));
              bmerge_desc<16>(t_);
#pragma unroll
              for (int i = 0; i < 16; ++i) nt[c * 16 + i] = __float_as_uint(t_[i]); }
        }
        lds_fence();
        float cs[32];
#pragma unroll
        for (int i = 0; i < 25; ++i) {
            const int ai = hi ? PAIRS.a[2 * i + 1] : PAIRS.a[2 * i], bi = hi ? PAIRS.b[2 * i + 1] : PAIRS.b[2 * i];
            const float sum = __uint_as_float(nt[ai]) + __uint_as_float(nt[16 + bi]);
            cs[i] = __uint_as_float((__float_as_uint(sum) & ~255u) | (unsigned)(ai * 16 + bi));
        }
#pragma unroll
        for (int i = 25; i < 32; ++i) cs[i] = -INFINITY;
        bsort_desc<32>(cs);
        float bs[16];
#pragma unroll
        for (int i = 0; i < 16; ++i) bs[i] = fmaxf(cs[i], xhalf_other(cs[15 - i], hi));
        bmerge_desc<16>(bs);
        unsigned be8[8]; float bs8[8];
#pragma unroll
        for (int i = 0; i < 16; ++i) (nt + 32 + 64 * 0)[i + 0] = __float_as_uint(bs[i]);
        lds_fence();
#pragma unroll
        for (int j = 0; j < 8; ++j) { const float w_ = __uint_as_float(nt[32 + 8 * hi + j]); const unsigned tg = __float_as_uint(w_) & 255u; bs8[j] = w_;
            be8[j] = (nt[tg >> 4] & 127u) * 128u + (nt[16 + (tg & 15u)] & 127u); }
        float sum = 0.f; const float bmax = bs[0];
#pragma unroll
        for (int rd = 0; rd < 16; ++rd) sum += __builtin_amdgcn_exp2f((bs[rd] - bmax) * LOG2E);
        const float inv = 1.0f / sum;
        uint4 i0, i1; float4 g0, g1;
        i0.x = be8[0]; i0.y = be8[1]; i0.z = be8[2]; i0.w = be8[3]; i1.x = be8[4]; i1.y = be8[5]; i1.z = be8[6]; i1.w = be8[7];
        g0.x = __builtin_amdgcn_exp2f((bs8[0] - bmax) * LOG2E) * inv; g0.y = __builtin_amdgcn_exp2f((bs8[1] - bmax) * LOG2E) * inv; g0.z = __builtin_amdgcn_exp2f((bs8[2] - bmax) * LOG2E) * inv; g0.w = __builtin_amdgcn_exp2f((bs8[3] - bmax) * LOG2E) * inv;
        g1.x = __builtin_amdgcn_exp2f((bs8[4] - bmax) * LOG2E) * inv; g1.y = __builtin_amdgcn_exp2f((bs8[5] - bmax) * LOG2E) * inv; g1.z = __builtin_amdgcn_exp2f((bs8[6] - bmax) * LOG2E) * inv; g1.w = __builtin_amdgcn_exp2f((bs8[7] - bmax) * LOG2E) * inv;
        float4 s0, s1;
        s0.x = uinv[i0.x]; s0.y = uinv[i0.y]; s0.z = uinv[i0.z]; s0.w = uinv[i0.w]; s1.x = uinv[i1.x]; s1.y = uinv[i1.y]; s1.z = uinv[i1.z]; s1.w = uinv[i1.w];
        g0.x *= vinv[i0.x]; g0.y *= vinv[i0.y]; g0.z *= vinv[i0.z]; g0.w *= vinv[i0.w]; g1.x *= vinv[i1.x]; g1.y *= vinv[i1.y]; g1.z *= vinv[i1.z]; g1.w *= vinv[i1.w];
        uint4* ip = (uint4*)(idx_out + (size_t)tok * 128 + h * 16 + 8 * hi); ip[0] = i0; ip[1] = i1;
        float4* gp = (float4*)(gate_out + (size_t)tok * 128 + h * 16 + 8 * hi); gp[0] = g0; gp[1] = g1;
        float4* sp = (float4*)(usc_out + (size_t)tok * 128 + h * 16 + 8 * hi); sp[0] = s0; sp[1] = s1;
    }
}

typedef __bf16 bf16x2_t __attribute__((ext_vector_type(2)));
DEV float dot2bf(unsigned a, unsigned b, float acc) { return __builtin_amdgcn_fdot2_f32_bf16(__builtin_bit_cast(bf16x2_t, a), __builtin_bit_cast(bf16x2_t, b), acc, false); }
DEV float gelu_as(float v) {
    const float av = fabsf(v), t = __builtin_amdgcn_rcpf(av * 0.2316418882f + 1.0f);
    float q = t * 0.5307027145f + (-0.7265760135f); q = q * t + 0.7107068705f; q = q * t + (-0.142248368f); q = q * t + 0.127414796f; q = q * t;
    const float e = __builtin_amdgcn_exp2f((v * v) * (-0.72134752044f));
    const float m = v * (q * e);
    return v < 0.f ? m : v - m;
}
DEV void phase_expert_v2(const bf16_t* hn, const bf16_t* ut, const bf16_t* vt, const int* idx, const float* gate, float* xres, int bid, int nb, float oscale = 1.0f) {
    const int wid = threadIdx.x >> 6, lane = threadIdx.x & 63;
    for (int tok = bid * 8 + wid; tok < NT; tok += nb * 8) {
        const uint4 h0 = *(const uint4*)(hn + (size_t)tok * DM + lane * 8), h1 = *(const uint4*)(hn + (size_t)tok * DM + 512 + lane * 8);
        float acc[16];
#pragma unroll
        for (int i = 0; i < 16; ++i) acc[i] = 0.f;
        uint4 uA[4][2], vA[4][2], uB[4][2], vB[4][2];
#define XLOAD(U, V, k_) do { _Pragma("unroll") for (int j = 0; j < 4; ++j) { const int e_ = __builtin_amdgcn_readfirstlane(idx[(size_t)tok * 128 + (k_) + j]); \
            const bf16_t* up = ut + (size_t)e_ * DM + lane * 8; const bf16_t* vp = vt + (size_t)e_ * DM + lane * 8; \
            U[j][0] = *(const uint4*)up; U[j][1] = *(const uint4*)(up + 512); V[j][0] = *(const uint4*)vp; V[j][1] = *(const uint4*)(vp + 512); } } while (0)
#define XCOMP(U, V, k_) do { float d_[4]; \
        _Pragma("unroll") for (int j = 0; j < 4; ++j) { float d = 0.f; \
            d = dot2bf(U[j][0].x, h0.x, d); d = dot2bf(U[j][0].y, h0.y, d); d = dot2bf(U[j][0].z, h0.z, d); d = dot2bf(U[j][0].w, h0.w, d); \
            d = dot2bf(U[j][1].x, h1.x, d); d = dot2bf(U[j][1].y, h1.y, d); d = dot2bf(U[j][1].z, h1.z, d); d = dot2bf(U[j][1].w, h1.w, d); d_[j] = d; } \
        { const bool b0 = lane & 1, b1 = lane & 2; \
          float x0 = b0 ? d_[1] : d_[0], y0 = b0 ? d_[0] : d_[1], x1 = b0 ? d_[3] : d_[2], y1 = b0 ? d_[2] : d_[3]; \
          x0 += __shfl_xor(y0, 1); x1 += __shfl_xor(y1, 1);                   \
          float x = b1 ? x1 : x0, y = b1 ? x0 : x1; x += __shfl_xor(y, 2);      \
          x += __shfl_xor(x, 4); x += __shfl_xor(x, 8); x += __shfl_xor(x, 16); x += __shfl_xor(x, 32); \
          const float wl = gelu_as(x) * gate[(size_t)tok * 128 + (k_) + (lane & 3)]; \
          _Pragma("unroll") for (int j = 0; j < 4; ++j) { const float w = __uint_as_float(__builtin_amdgcn_readlane(__float_as_uint(wl), j)); \
              acc[0] += w * bflo(V[j][0].x); acc[1] += w * bfhi(V[j][0].x); acc[2] += w * bflo(V[j][0].y); acc[3] += w * bfhi(V[j][0].y); \
              acc[4] += w * bflo(V[j][0].z); acc[5] += w * bfhi(V[j][0].z); acc[6] += w * bflo(V[j][0].w); acc[7] += w * bfhi(V[j][0].w); \
              acc[8] += w * bflo(V[j][1].x); acc[9] += w * bfhi(V[j][1].x); acc[10] += w * bflo(V[j][1].y); acc[11] += w * bfhi(V[j][1].y); \
              acc[12] += w * bflo(V[j][1].z); acc[13] += w * bfhi(V[j][1].z); acc[14] += w * bflo(V[j][1].w); acc[15] += w * bfhi(V[j][1].w); } } } while (0)
        XLOAD(uA, vA, 0);
#pragma unroll 1
        for (int k0 = 0; k0 < 128; k0 += 8) {
            XLOAD(uB, vB, k0 + 4);
            XCOMP(uA, vA, k0);
            if (k0 + 8 < 128) XLOAD(uA, vA, k0 + 8);
            XCOMP(uB, vB, k0 + 4);
        }
#undef XLOAD
#undef XCOMP
        float4* p0 = (float4*)(xres + (size_t)tok * DM + lane * 8); float4* p1 = (float4*)(xres + (size_t)tok * DM + 512 + lane * 8);
        float4 a = p0[0], b = p0[1], c = p1[0], d = p1[1];
        a.x += oscale * acc[0]; a.y += oscale * acc[1]; a.z += oscale * acc[2]; a.w += oscale * acc[3]; b.x += oscale * acc[4]; b.y += oscale * acc[5]; b.z += oscale * acc[6]; b.w += oscale * acc[7];
        c.x += oscale * acc[8]; c.y += oscale * acc[9]; c.z += oscale * acc[10]; c.w += oscale * acc[11]; d.x += oscale * acc[12]; d.y += oscale * acc[13]; d.z += oscale * acc[14]; d.w += oscale * acc[15];
        p0[0] = a; p0[1] = b; p1[0] = c; p1[1] = d;
    }
}

typedef float f32x2_t __attribute__((ext_vector_type(2)));
#define FP8LO(w) __builtin_amdgcn_cvt_pk_f32_fp8((int)(w), false)
#define FP8HI(w) __builtin_amdgcn_cvt_pk_f32_fp8((int)(w), true)
DEV float dot16_fp8(const uint4 u, const float (&h)[16]) {
    float d = 0.f; f32x2_t a;
    a = FP8LO(u.x); d += a[0] * h[0] + a[1] * h[1]; a = FP8HI(u.x); d += a[0] * h[2] + a[1] * h[3];
    a = FP8LO(u.y); d += a[0] * h[4] + a[1] * h[5]; a = FP8HI(u.y); d += a[0] * h[6] + a[1] * h[7];
    a = FP8LO(u.z); d += a[0] * h[8] + a[1] * h[9]; a = FP8HI(u.z); d += a[0] * h[10] + a[1] * h[11];
    a = FP8LO(u.w); d += a[0] * h[12] + a[1] * h[13]; a = FP8HI(u.w); d += a[0] * h[14] + a[1] * h[15];
    return d;
}
#define PIN4(u) asm volatile("" : "+v"((u).x), "+v"((u).y), "+v"((u).z), "+v"((u).w))
DEV void fma16_fp8(const uint4 v, const float w, float (&acc)[16]) {
    f32x2_t a;
    a = FP8LO(v.x); acc[0] += w * a[0]; acc[1] += w * a[1]; a = FP8HI(v.x); acc[2] += w * a[0]; acc[3] += w * a[1];
    a = FP8LO(v.y); acc[4] += w * a[0]; acc[5] += w * a[1]; a = FP8HI(v.y); acc[6] += w * a[0]; acc[7] += w * a[1];
    a = FP8LO(v.z); acc[8] += w * a[0]; acc[9] += w * a[1]; a = FP8HI(v.z); acc[10] += w * a[0]; acc[11] += w * a[1];
    a = FP8LO(v.w); acc[12] += w * a[0]; acc[13] += w * a[1]; a = FP8HI(v.w); acc[14] += w * a[0]; acc[15] += w * a[1];
}
template <int CTRL> DEV float dppf(float x) { return __builtin_bit_cast(float, __builtin_amdgcn_mov_dpp(__builtin_bit_cast(int, x), CTRL, 0xf, 0xf, true)); }
DEV float x1632_sum(float x) {
    auto s = __builtin_amdgcn_permlane16_swap(__float_as_uint(x), __float_as_uint(x), false, false);
    x = __uint_as_float(s[0]) + __uint_as_float(s[1]);
    auto t = __builtin_amdgcn_permlane32_swap(__float_as_uint(x), __float_as_uint(x), false, false);
    return __uint_as_float(t[0]) + __uint_as_float(t[1]);
}
DEV void phase_expert_v3(const bf16_t* hn, const unsigned char* ut, const unsigned char* vt, const int* idx, const float* gate, const float* usc, float* xres, int bid, int nb, float oscale = 1.0f) {
    constexpr int XOR1 = 0xB1, XOR2 = 0x4E, ROR4 = 0x124, ROR8 = 0x128;
    int tid = threadIdx.x; asm volatile("" : "+v"(tid));
    const unsigned wid = tid >> 6, lane = tid & 63;
    const bool b0 = lane & 1, b1 = lane & 2, b2 = lane & 4;
    for (unsigned tok = bid * 8 + wid; tok < (unsigned)NT; tok += nb * 8) {
        float hf[16], acc[16];
        { const uint4* hp = (const uint4*)((const char*)hn + (tok * 2048u + lane * 32u)); const uint4 h0 = hp[0], h1 = hp[1];
          hf[0] = bflo(h0.x); hf[1] = bfhi(h0.x); hf[2] = bflo(h0.y); hf[3] = bfhi(h0.y); hf[4] = bflo(h0.z); hf[5] = bfhi(h0.z); hf[6] = bflo(h0.w); hf[7] = bfhi(h0.w);
          hf[8] = bflo(h1.x); hf[9] = bfhi(h1.x); hf[10] = bflo(h1.y); hf[11] = bfhi(h1.y); hf[12] = bflo(h1.z); hf[13] = bfhi(h1.z); hf[14] = bflo(h1.w); hf[15] = bfhi(h1.w); }
#pragma unroll
        for (int i = 0; i < 16; ++i) acc[i] = 0.f;
        const unsigned pbase = tok * 128u;
        uint4 uA[4], vA[4], uB[4], vB[4];
#define XLOAD(U, V, k_) do { _Pragma("unroll") for (int j = 0; j < 4; ++j) { const unsigned eo_ = (unsigned)idx[pbase + (k_) + j] * 1024u + lane * 16u; U[j] = *(const uint4*)(ut + eo_); V[j] = *(const uint4*)(vt + eo_); } } while (0)
#define XCOMP(U, V, k_) do { float d_[4]; \
        _Pragma("unroll") for (int j = 0; j < 4; ++j) d_[j] = dot16_fp8(U[j], hf); \
        const float x0_ = (b0 ? d_[1] : d_[0]) + dppf<XOR1>(b0 ? d_[0] : d_[1]), x1_ = (b0 ? d_[3] : d_[2]) + dppf<XOR1>(b0 ? d_[2] : d_[3]); \
        float x = (b1 ? x1_ : x0_) + dppf<XOR2>(b1 ? x0_ : x1_);            \
        x += dppf<ROR4>(x); x += dppf<ROR8>(x); x = x1632_sum(x); \
        const unsigned o_ = pbase + (k_) + (lane & 3u); \
        const float wl = gelu_as(x * usc[o_]) * gate[o_]; \
        _Pragma("unroll") for (int j = 0; j < 4; ++j) { const float w = __uint_as_float(__builtin_amdgcn_readlane(__float_as_uint(wl), j)); fma16_fp8(V[j], w, acc); } } while (0)
        XLOAD(uA, vA, 0);
#pragma unroll 1
        for (int k0 = 0; k0 < 128; k0 += 8) {
            XLOAD(uB, vB, k0 + 4);
            XCOMP(uA, vA, k0);
            if (k0 + 8 < 128) XLOAD(uA, vA, k0 + 8);
            XCOMP(uB, vB, k0 + 4);
        }
#undef XLOAD
#undef XCOMP
        float4* p0 = (float4*)((char*)xres + (tok * 4096u + lane * 64u));
        float4 a = p0[0], b = p0[1], c = p0[2], d = p0[3];
        a.x += oscale * acc[0]; a.y += oscale * acc[1]; a.z += oscale * acc[2]; a.w += oscale * acc[3]; b.x += oscale * acc[4]; b.y += oscale * acc[5]; b.z += oscale * acc[6]; b.w += oscale * acc[7];
        c.x += oscale * acc[8]; c.y += oscale * acc[9]; c.z += oscale * acc[10]; c.w += oscale * acc[11]; d.x += oscale * acc[12]; d.y += oscale * acc[13]; d.z += oscale * acc[14]; d.w += oscale * acc[15];
        p0[0] = a; p0[1] = b; p0[2] = c; p0[3] = d;
    }
}

constexpr int PEER_UNIT_TOK = 256, PEER_UNITS = NT / PEER_UNIT_TOK, PEER_WTOK = PEER_UNIT_TOK / 8;
constexpr size_t WS_QCTR = 16384;
constexpr size_t WS_CTL_BYTES = 16384 + 32 * 256;
DEV unsigned peer_next_unit(unsigned* q, volatile unsigned* sh) { return queue_next(q, sh); }
typedef float f32x2p __attribute__((ext_vector_type(2)));
DEV float dot16_fp8_pk(const uint4 u, const f32x2p (&h)[8]) {
    f32x2p d = __builtin_amdgcn_cvt_pk_f32_fp8((int)u.x, false) * h[0];
    d = __builtin_elementwise_fma(__builtin_amdgcn_cvt_pk_f32_fp8((int)u.x, true), h[1], d);
    d = __builtin_elementwise_fma(__builtin_amdgcn_cvt_pk_f32_fp8((int)u.y, false), h[2], d);
    d = __builtin_elementwise_fma(__builtin_amdgcn_cvt_pk_f32_fp8((int)u.y, true), h[3], d);
    d = __builtin_elementwise_fma(__builtin_amdgcn_cvt_pk_f32_fp8((int)u.z, false), h[4], d);
    d = __builtin_elementwise_fma(__builtin_amdgcn_cvt_pk_f32_fp8((int)u.z, true), h[5], d);
    d = __builtin_elementwise_fma(__builtin_amdgcn_cvt_pk_f32_fp8((int)u.w, false), h[6], d);
    d = __builtin_elementwise_fma(__builtin_amdgcn_cvt_pk_f32_fp8((int)u.w, true), h[7], d);
    return d[0] + d[1];
}
DEV void fma16_fp8_pk(const uint4 v, const float w, f32x2p (&acc)[8]) {
    const f32x2p wv = {w, w};
    acc[0] = __builtin_elementwise_fma(__builtin_amdgcn_cvt_pk_f32_fp8((int)v.x, false), wv, acc[0]);
    acc[1] = __builtin_elementwise_fma(__builtin_amdgcn_cvt_pk_f32_fp8((int)v.x, true), wv, acc[1]);
    acc[2] = __builtin_elementwise_fma(__builtin_amdgcn_cvt_pk_f32_fp8((int)v.y, false), wv, acc[2]);
    acc[3] = __builtin_elementwise_fma(__builtin_amdgcn_cvt_pk_f32_fp8((int)v.y, true), wv, acc[3]);
    acc[4] = __builtin_elementwise_fma(__builtin_amdgcn_cvt_pk_f32_fp8((int)v.z, false), wv, acc[4]);
    acc[5] = __builtin_elementwise_fma(__builtin_amdgcn_cvt_pk_f32_fp8((int)v.z, true), wv, acc[5]);
    acc[6] = __builtin_elementwise_fma(__builtin_amdgcn_cvt_pk_f32_fp8((int)v.w, false), wv, acc[6]);
    acc[7] = __builtin_elementwise_fma(__builtin_amdgcn_cvt_pk_f32_fp8((int)v.w, true), wv, acc[7]);
}
DEV void phase_peer_dots(const bf16_t* hn, const unsigned char* u8s, const int* idx, float* partial, unsigned* qctr, unsigned char* lds_raw, unsigned xcc) {
    constexpr int XOR1 = 0xB1, XOR2 = 0x4E, HMIR = 0x141;
    int tid = threadIdx.x; asm volatile("" : "+v"(tid));
    const unsigned wid = tid >> 6, lane = tid & 63, g = lane >> 3, sub = lane & 7;
    volatile unsigned* sh = (volatile unsigned*)(lds_raw + 256);
    for (unsigned s_ = 0; s_ < 8; ++s_) {
        const unsigned x = (xcc + s_) & 7;
        const unsigned char* ux = u8s + (size_t)x * NEXP * 128;
        const unsigned sub16 = sub * 16u;
        for (;;) {
            const unsigned unit = peer_next_unit(qctr + 64 * x, sh);
            if (unit >= (unsigned)PEER_UNITS) break;
            const unsigned tok0 = unit * PEER_UNIT_TOK + wid * PEER_WTOK;
            uint4 ixn[4]; uint4 hn0, hn1;
            { const uint4* ip = (const uint4*)((const char*)idx + (tok0 * 512u + g * 64u)); ixn[0] = ip[0]; ixn[1] = ip[1]; ixn[2] = ip[2]; ixn[3] = ip[3];
              const uint4* hp = (const uint4*)((const char*)hn + (tok0 * 2048u + x * 256u + sub * 32u)); hn0 = hp[0]; hn1 = hp[1]; }
            uint4 Ua[8], Ub[8];
#define ROWS(U, e0, e1, e2, e3, e4, e5, e6, e7) do { U[0] = *(const uint4*)(ux + ((e0) * 128u + sub16)); U[1] = *(const uint4*)(ux + ((e1) * 128u + sub16)); U[2] = *(const uint4*)(ux + ((e2) * 128u + sub16)); \
            U[3] = *(const uint4*)(ux + ((e3) * 128u + sub16)); U[4] = *(const uint4*)(ux + ((e4) * 128u + sub16)); U[5] = *(const uint4*)(ux + ((e5) * 128u + sub16)); \
            U[6] = *(const uint4*)(ux + ((e6) * 128u + sub16)); U[7] = *(const uint4*)(ux + ((e7) * 128u + sub16)); } while (0)
            ROWS(Ua, ixn[0].x, ixn[0].y, ixn[0].z, ixn[0].w, ixn[1].x, ixn[1].y, ixn[1].z, ixn[1].w);
#pragma unroll 1
            for (unsigned i = 0; i < (unsigned)PEER_WTOK; ++i) {
                const unsigned tok = tok0 + i;
                ROWS(Ub, ixn[2].x, ixn[2].y, ixn[2].z, ixn[2].w, ixn[3].x, ixn[3].y, ixn[3].z, ixn[3].w);
                f32x2p hf[8];
                hf[0] = (f32x2p){bflo(hn0.x), bfhi(hn0.x)}; hf[1] = (f32x2p){bflo(hn0.y), bfhi(hn0.y)}; hf[2] = (f32x2p){bflo(hn0.z), bfhi(hn0.z)}; hf[3] = (f32x2p){bflo(hn0.w), bfhi(hn0.w)};
                hf[4] = (f32x2p){bflo(hn1.x), bfhi(hn1.x)}; hf[5] = (f32x2p){bflo(hn1.y), bfhi(hn1.y)}; hf[6] = (f32x2p){bflo(hn1.z), bfhi(hn1.z)}; hf[7] = (f32x2p){bflo(hn1.w), bfhi(hn1.w)};
                { const unsigned tn = (i + 1 < (unsigned)PEER_WTOK) ? tok + 1 : tok;
                  const uint4* ip = (const uint4*)((const char*)idx + (tn * 512u + g * 64u)); ixn[0] = ip[0]; ixn[1] = ip[1]; ixn[2] = ip[2]; ixn[3] = ip[3];
                  const uint4* hp = (const uint4*)((const char*)hn + (tn * 2048u + x * 256u + sub * 32u)); hn0 = hp[0]; hn1 = hp[1]; }
                float sm[16];
#pragma unroll
                for (int j = 0; j < 8; ++j) { uint4 u_ = Ua[j]; PIN4(u_); float d = dot16_fp8_pk(u_, hf); asm volatile("" : "+v"(d)); d += dppf<XOR1>(d); d += dppf<XOR2>(d); d += dppf<HMIR>(d); sm[j] = d; }
                ROWS(Ua, ixn[0].x, ixn[0].y, ixn[0].z, ixn[0].w, ixn[1].x, ixn[1].y, ixn[1].z, ixn[1].w);
#pragma unroll
                for (int j = 0; j < 8; ++j) { uint4 u_ = Ub[j]; PIN4(u_); float d = dot16_fp8_pk(u_, hf); asm volatile("" : "+v"(d)); d += dppf<XOR1>(d); d += dppf<XOR2>(d); d += dppf<HMIR>(d); sm[8 + j] = d; }
                float v0 = sm[0], v1 = sm[1];
#pragma unroll
                for (int q = 1; q < 8; ++q) { v0 = (sub == (unsigned)q) ? sm[2 * q] : v0; v1 = (sub == (unsigned)q) ? sm[2 * q + 1] : v1; }
                float2 o; o.x = v0; o.y = v1;
                *(float2*)(partial + ((size_t)x * NT + tok) * 128u + 2u * lane) = o;
            }
#undef ROWS
        }
    }
}
DEV void phase_peer_weights(const float* partial, const float* gate, const float* usc, const int* idx, unsigned* wpk, int bid, int nb) {
    const int tid_ = opaque_tid();
    for (unsigned i = bid * NTHR + tid_; i < (unsigned)NT * 32u; i += nb * NTHR) {
        float4 sacc = ((const float4*)partial)[i];
#pragma unroll
        for (int x = 1; x < 8; ++x) { const float4 p = ((const float4*)(partial + (size_t)x * NT * 128))[i]; sacc.x += p.x; sacc.y += p.y; sacc.z += p.z; sacc.w += p.w; }
        const float4 gt = ((const float4*)gate)[i], us = ((const float4*)usc)[i];
        float4 o; o.x = gt.x * gelu_as(sacc.x * us.x); o.y = gt.y * gelu_as(sacc.y * us.y); o.z = gt.z * gelu_as(sacc.z * us.z); o.w = gt.w * gelu_as(sacc.w * us.w);
        const uint4 ix = ((const uint4*)idx)[i];
        uint4 w; w.x = ((unsigned)f2bf(o.x) << 16) | ix.x; w.y = ((unsigned)f2bf(o.y) << 16) | ix.y; w.z = ((unsigned)f2bf(o.z) << 16) | ix.z; w.w = ((unsigned)f2bf(o.w) << 16) | ix.w;
        ((uint4*)wpk)[i] = w;
    }
}
DEV void phase_peer_acc2(const unsigned char* v8s, const unsigned* wpk, bf16_t* pdelta, unsigned* qctr, unsigned char* lds_raw, unsigned xcc) {
    constexpr unsigned CROW = 144, CHB = 8 * CROW;
    int tid = threadIdx.x; asm volatile("" : "+v"(tid));
    const unsigned wid = tid >> 6, lane = tid & 63, g = lane >> 3, sub = lane & 7;
    volatile unsigned* sh = (volatile unsigned*)(lds_raw + 256);
    unsigned char* lw = lds_raw + 1024 + wid * (4 * CHB);
    const unsigned st_off = g * CROW + sub * 16;
    const unsigned rd_off = g * CROW;
    for (unsigned s_ = 0; s_ < 8; ++s_) {
        const unsigned x = (xcc + s_) & 7;
        const unsigned char* vx = v8s + (size_t)x * NEXP * 128;
        const unsigned sub16 = sub * 16u;
#define GROW(pn) (*(const uint4*)(vx + ((((pn) & 0xFFFFu) << 7) | sub16)))
#define E2STEP(R, r) do { \
            const uint4 c0_ = *(const uint4*)(cur + (r) * 32), c1_ = *(const uint4*)(cur + (r) * 32 + 16); \
            const uint4 n0_ = *(const uint4*)(nxt + (r) * 32), n1_ = *(const uint4*)(nxt + (r) * 32 + 16); \
            const unsigned cs_[8] = {c0_.x, c0_.y, c0_.z, c0_.w, c1_.x, c1_.y, c1_.z, c1_.w}; const unsigned ns_[8] = {n0_.x, n0_.y, n0_.z, n0_.w, n1_.x, n1_.y, n1_.z, n1_.w}; \
            _Pragma("unroll") for (int j = 0; j < 8; ++j) { uint4 v_ = R[j]; PIN4(v_); fma16_fp8_pk(v_, __uint_as_float(cs_[j] & 0xFFFF0000u), acc); unsigned o_ = (((ns_[j]) & 0xFFFFu) << 7) | sub16; \
                asm volatile("" : "+v"(acc[0]), "+v"(acc[1]), "+v"(acc[2]), "+v"(acc[3]), "+v"(acc[4]), "+v"(acc[5]), "+v"(acc[6]), "+v"(acc[7]), "+v"(o_));     \
                R[j] = *(const uint4*)(vx + o_); } \
            asm volatile("" ::: "memory"); } while (0)
        for (;;) {
            const unsigned unit = peer_next_unit(qctr + 64 * x, sh);
            if (unit >= (unsigned)PEER_UNITS) break;
            const unsigned tok0 = unit * PEER_UNIT_TOK + wid * PEER_WTOK;
            const unsigned char* wsrc = (const unsigned char*)wpk + ((tok0 + g) * 512u + sub * 16u);
            { const uint4 p0 = *(const uint4*)(wsrc), p1 = *(const uint4*)(wsrc + 128);
              *(uint4*)(lw + st_off) = p0; *(uint4*)(lw + CHB + st_off) = p1; }
            uint4 R0[8], R1[8], R2[8], R3[8];
            { const unsigned char* cur = lw + rd_off;
#define E2FILL(R, r) do { const uint4 n0_ = *(const uint4*)(cur + (r) * 32), n1_ = *(const uint4*)(cur + (r) * 32 + 16); \
                R[0] = GROW(n0_.x); R[1] = GROW(n0_.y); R[2] = GROW(n0_.z); R[3] = GROW(n0_.w); R[4] = GROW(n1_.x); R[5] = GROW(n1_.y); R[6] = GROW(n1_.z); R[7] = GROW(n1_.w); } while (0)
              E2FILL(R0, 0); E2FILL(R1, 1); E2FILL(R2, 2); E2FILL(R3, 3); }
#undef E2FILL
            f32x2p acc[8];
#pragma unroll
            for (int c = 0; c < 8; ++c) acc[c] = (f32x2p){0.f, 0.f};
#pragma unroll 1
            for (unsigned it = 0; it < 16; ++it) {
                const unsigned char* cur = lw + (it & 3) * CHB + rd_off;
                const unsigned char* nxt = lw + ((it + 1) & 3) * CHB + rd_off;
                const unsigned ns = (it + 2 < 16) ? it + 2 : 15;
                const uint4 pst = *(const uint4*)(wsrc + (ns >> 2) * 4096u + (ns & 3) * 128u);
                E2STEP(R0, 0); E2STEP(R1, 1); E2STEP(R2, 2); E2STEP(R3, 3);
                *(uint4*)(lw + ((it + 2) & 3) * CHB + st_off) = pst;
                if ((it & 3) == 3) {
                    uint4* p0 = (uint4*)((char*)pdelta + ((tok0 + (it >> 2) * 8 + g) * 2048u + x * 256u + sub * 32u));
                    uint4 o0, o1;
                    o0.x = pk2(acc[0][0], acc[0][1]); o0.y = pk2(acc[1][0], acc[1][1]); o0.z = pk2(acc[2][0], acc[2][1]); o0.w = pk2(acc[3][0], acc[3][1]);
                    o1.x = pk2(acc[4][0], acc[4][1]); o1.y = pk2(acc[5][0], acc[5][1]); o1.z = pk2(acc[6][0], acc[6][1]); o1.w = pk2(acc[7][0], acc[7][1]);
                    p0[0] = o0; p0[1] = o1;
#pragma unroll
                    for (int c = 0; c < 8; ++c) acc[c] = (f32x2p){0.f, 0.f};
                }
            }
        }
#undef E2STEP
#undef GROW
    }
}
template <bool LOADONLY = false>
DEV void phase_peer_acc(const unsigned char* v8s, const int* idx, const float* wts, float* xres, unsigned* qctr, unsigned char* lds_raw, unsigned xcc, float oscale = 1.0f) {
    constexpr int ROR8 = 0x128;
    constexpr unsigned EMASK = LOADONLY ? 2047u : 0xFFFFFFFFu;
    int tid = threadIdx.x; asm volatile("" : "+v"(tid));
    const unsigned wid = tid >> 6, lane = tid & 63, g = lane >> 3, sub = lane & 7;
    volatile unsigned* sh = (volatile unsigned*)(lds_raw + 256);
    for (unsigned s_ = 0; s_ < 8; ++s_) {
        const unsigned x = (xcc + s_) & 7;
        const unsigned char* vx = v8s + (size_t)x * NEXP * 128;
        const unsigned sub16 = sub * 16u;
        for (;;) {
            const unsigned unit = peer_next_unit(qctr + 64 * x, sh);
            if (unit >= (unsigned)PEER_UNITS) break;
            const unsigned tok0 = unit * PEER_UNIT_TOK + wid * PEER_WTOK;
            uint4 ixn[4]; float4 wn[4];
            { const uint4* ip = (const uint4*)((const char*)idx + (tok0 * 512u + g * 64u)); ixn[0] = ip[0]; ixn[1] = ip[1]; ixn[2] = ip[2]; ixn[3] = ip[3];
              const float4* wp = (const float4*)((const char*)wts + (tok0 * 512u + g * 64u)); wn[0] = wp[0]; wn[1] = wp[1]; wn[2] = wp[2]; wn[3] = wp[3]; }
            uint4 Va[8], Vb[8];
#define ROWS(U, e0, e1, e2, e3, e4, e5, e6, e7) do { U[0] = *(const uint4*)(vx + ((((e0) & EMASK)) * 128u + sub16)); U[1] = *(const uint4*)(vx + ((((e1) & EMASK)) * 128u + sub16)); U[2] = *(const uint4*)(vx + ((((e2) & EMASK)) * 128u + sub16)); \
            U[3] = *(const uint4*)(vx + ((((e3) & EMASK)) * 128u + sub16)); U[4] = *(const uint4*)(vx + ((((e4) & EMASK)) * 128u + sub16)); U[5] = *(const uint4*)(vx + ((((e5) & EMASK)) * 128u + sub16)); \
            U[6] = *(const uint4*)(vx + ((((e6) & EMASK)) * 128u + sub16)); U[7] = *(const uint4*)(vx + ((((e7) & EMASK)) * 128u + sub16)); } while (0)
            ROWS(Va, ixn[0].x, ixn[0].y, ixn[0].z, ixn[0].w, ixn[1].x, ixn[1].y, ixn[1].z, ixn[1].w);
#pragma unroll 1
            for (unsigned i = 0; i < (unsigned)PEER_WTOK; ++i) {
                const unsigned tok = tok0 + i;
                ROWS(Vb, ixn[2].x, ixn[2].y, ixn[2].z, ixn[2].w, ixn[3].x, ixn[3].y, ixn[3].z, ixn[3].w);
                const float ww[16] = {wn[0].x, wn[0].y, wn[0].z, wn[0].w, wn[1].x, wn[1].y, wn[1].z, wn[1].w, wn[2].x, wn[2].y, wn[2].z, wn[2].w, wn[3].x, wn[3].y, wn[3].z, wn[3].w};
                { const unsigned tn = (i + 1 < (unsigned)PEER_WTOK) ? tok + 1 : tok;
                  const uint4* ip = (const uint4*)((const char*)idx + (tn * 512u + g * 64u)); ixn[0] = ip[0]; ixn[1] = ip[1]; ixn[2] = ip[2]; ixn[3] = ip[3];
                  const float4* wp = (const float4*)((const char*)wts + (tn * 512u + g * 64u)); wn[0] = wp[0]; wn[1] = wp[1]; wn[2] = wp[2]; wn[3] = wp[3]; }
                f32x2p acc[8];
#pragma unroll
                for (int c = 0; c < 8; ++c) acc[c] = (f32x2p){0.f, 0.f};
#pragma unroll
                for (int j = 0; j < 8; ++j) { uint4 v_ = Va[j]; PIN4(v_); if (LOADONLY) { acc[0][0] += __uint_as_float((v_.x ^ v_.y ^ v_.z ^ v_.w) & 0x007fffffu) * ww[j]; } else fma16_fp8_pk(v_, ww[j], acc); asm volatile("" : "+v"(acc[0]), "+v"(acc[7])); }
                ROWS(Va, ixn[0].x, ixn[0].y, ixn[0].z, ixn[0].w, ixn[1].x, ixn[1].y, ixn[1].z, ixn[1].w);
#pragma unroll
                for (int j = 0; j < 8; ++j) { uint4 v_ = Vb[j]; PIN4(v_); if (LOADONLY) { acc[0][0] += __uint_as_float((v_.x ^ v_.y ^ v_.z ^ v_.w) & 0x007fffffu) * ww[8 + j]; } else fma16_fp8_pk(v_, ww[8 + j], acc); asm volatile("" : "+v"(acc[0]), "+v"(acc[7])); }
                float r[16];
#pragma unroll
                for (int c = 0; c < 8; ++c) { float a0 = acc[c][0], a1 = acc[c][1]; a0 += dppf<ROR8>(a0); a1 += dppf<ROR8>(a1); r[2 * c] = x1632_sum(a0); r[2 * c + 1] = x1632_sum(a1); }
                if (g == 0) {
                    float4* p0 = (float4*)((char*)xres + (tok * 4096u + x * 512u + sub * 64u));
                    float4 a = p0[0], b = p0[1], c = p0[2], d = p0[3];
                    a.x += oscale * r[0]; a.y += oscale * r[1]; a.z += oscale * r[2]; a.w += oscale * r[3]; b.x += oscale * r[4]; b.y += oscale * r[5]; b.z += oscale * r[6]; b.w += oscale * r[7];
                    c.x += oscale * r[8]; c.y += oscale * r[9]; c.z += oscale * r[10]; c.w += oscale * r[11]; d.x += oscale * r[12]; d.y += oscale * r[13]; d.z += oscale * r[14]; d.w += oscale * r[15];
                    p0[0] = a; p0[1] = b; p0[2] = c; p0[3] = d;
                }
            }
#undef ROWS
        }
    }
}

DEV void phase_expert_naive(const bf16_t* hn, const bf16_t* ut, const bf16_t* vt, const int* idx, const float* gate, float* xres, int bid, int nb) {
    const int wid = threadIdx.x >> 6, lane = threadIdx.x & 63;
    for (int tok = bid * 8 + wid; tok < NT; tok += nb * 8) {
        float hv[16], acc[16];
#pragma unroll
        for (int i = 0; i < 4; ++i) { const uint2 r = *(const uint2*)(hn + (size_t)tok * DM + i * 256 + lane * 4);
            hv[i * 4] = bflo(r.x); hv[i * 4 + 1] = bfhi(r.x); hv[i * 4 + 2] = bflo(r.y); hv[i * 4 + 3] = bfhi(r.y); }
#pragma unroll
        for (int i = 0; i < 16; ++i) acc[i] = 0.f;
        for (int k0 = 0; k0 < 128; k0 += 4) {
            int e[4]; float g[4]; uint2 ur[4][4], vr[4][4];
#pragma unroll
            for (int j = 0; j < 4; ++j) { e[j] = __builtin_amdgcn_readfirstlane(idx[(size_t)tok * 128 + k0 + j]); g[j] = gate[(size_t)tok * 128 + k0 + j]; }
#pragma unroll
            for (int j = 0; j < 4; ++j)
#pragma unroll
                for (int i = 0; i < 4; ++i) ur[j][i] = *(const uint2*)(ut + (size_t)e[j] * DM + i * 256 + lane * 4);
#pragma unroll
            for (int j = 0; j < 4; ++j)
#pragma unroll
                for (int i = 0; i < 4; ++i) vr[j][i] = *(const uint2*)(vt + (size_t)e[j] * DM + i * 256 + lane * 4);
#pragma unroll
            for (int j = 0; j < 4; ++j) {
                float d = 0.f;
#pragma unroll
                for (int i = 0; i < 4; ++i) d += hv[i * 4] * bflo(ur[j][i].x) + hv[i * 4 + 1] * bfhi(ur[j][i].x) + hv[i * 4 + 2] * bflo(ur[j][i].y) + hv[i * 4 + 3] * bfhi(ur[j][i].y);
                d = wave_sum(d);
                const float act = 0.5f * d * (1.0f + erff(d * 0.70710678118654752f));
                const float w = g[j] * act;
#pragma unroll
                for (int i = 0; i < 4; ++i) { acc[i * 4] += w * bflo(vr[j][i].x); acc[i * 4 + 1] += w * bfhi(vr[j][i].x); acc[i * 4 + 2] += w * bflo(vr[j][i].y); acc[i * 4 + 3] += w * bfhi(vr[j][i].y); }
            }
        }
#pragma unroll
        for (int i = 0; i < 4; ++i) { float4* p = (float4*)(xres + (size_t)tok * DM + i * 256 + lane * 4); float4 v = *p;
            v.x += acc[i * 4]; v.y += acc[i * 4 + 1]; v.z += acc[i * 4 + 2]; v.w += acc[i * 4 + 3]; *p = v; }
    }
}

#define XB_TMO      128
#define XB_XCNT(j)  (256  + 64 * (j))
#define XB_XSUB(j)  (1280 + 64 * (j))
#define XB_XGEN(j)  (2304 + 64 * (j))
#define XB_TOP      3328
#define XB_TOPGEN   3392
#define XCD_BAR_WORDS 3456
#define XB_SPIN_CAP (1u << 18)
#define LAS __attribute__((address_space(3)))

__device__ __forceinline__ unsigned xb_ld(unsigned* p)              { return __hip_atomic_load(p, __ATOMIC_RELAXED, __HIP_MEMORY_SCOPE_AGENT); }
__device__ __forceinline__ unsigned xb_add(unsigned* p, unsigned v) { return __hip_atomic_fetch_add(p, v, __ATOMIC_RELAXED, __HIP_MEMORY_SCOPE_AGENT); }
__device__ __forceinline__ unsigned xb_xcc_id() { return (unsigned)__builtin_amdgcn_s_getreg((3 << 11) | 20) & 0xFu; }
#define XB_SPIN(cond, bar) do { unsigned _sp = 0; while (cond) { __builtin_amdgcn_s_sleep(1); \
    if ((++_sp & 255u) == 0u) { if (xb_ld(&(bar)[XB_TMO])) break; if (_sp > XB_SPIN_CAP) { atomicAdd(&(bar)[XB_TMO], 1u); break; } } } } while (0)

struct XcdBarrier {
    unsigned* bar; unsigned x;
    volatile LAS unsigned* st;
};

__device__ __forceinline__ XcdBarrier xcd_barrier_post(unsigned* bar, volatile LAS unsigned* st) {
    XcdBarrier b; b.bar = bar; b.x = xb_xcc_id(); b.st = st;
    if (threadIdx.x == 0) (void)xb_add(&bar[XB_XCNT(b.x)], 1u);
    return b;
}
__device__ __forceinline__ void xcd_barrier_complete(unsigned* bar, unsigned x, unsigned& nloc, unsigned& nx) {
    const unsigned G = gridDim.x * gridDim.y * gridDim.z;
    unsigned sum, cnt, mine, sp = 0u;
    for (;;) {
        sum = 0u; cnt = 0u; mine = 0u;
#pragma unroll
        for (unsigned j = 0; j < 16; ++j) { const unsigned c = xb_ld(&bar[XB_XCNT(j)]); sum += c; cnt += (c > 0u) ? 1u : 0u; mine = (j == x) ? c : mine; }
        if (sum == G) break;
        __builtin_amdgcn_s_sleep(1);
        if ((++sp & 255u) == 0u) { if (xb_ld(&bar[XB_TMO])) break; if (sp > XB_SPIN_CAP) { atomicAdd(&bar[XB_TMO], 1u); break; } }
    }
    nloc = mine > 0u ? mine : 1u; nx = cnt > 0u ? cnt : 1u;
}

__device__ __forceinline__ void xcd_barrier(const XcdBarrier& b) {
    asm volatile("s_waitcnt vmcnt(0)" ::: "memory");
    __syncthreads();
    if (threadIdx.x == 0) {
        unsigned* bar = b.bar;
        __builtin_amdgcn_s_waitcnt(0);
        unsigned nloc = b.st[0], nx = b.st[1];
        if (nloc == 0u) { xcd_barrier_complete(bar, b.x, nloc, nx); b.st[0] = nloc; b.st[1] = nx; }
        const unsigned old = xb_add(&bar[XB_XSUB(b.x)], 1u);
        const unsigned gen = old / nloc;
        if (old + 1u == (gen + 1u) * nloc) {
            __builtin_amdgcn_fence(__ATOMIC_RELEASE, "agent");
            asm volatile("s_waitcnt vmcnt(0)" ::: "memory");
            const unsigned og = xb_add(&bar[XB_TOP], 1u);
            const unsigned tg = og / nx;
            if (og + 1u == (tg + 1u) * nx) xb_add(&bar[XB_TOPGEN], 1u);
            else XB_SPIN(xb_ld(&bar[XB_TOPGEN]) == tg, bar);
            __builtin_amdgcn_fence(__ATOMIC_ACQUIRE, "agent");
            xb_add(&bar[XB_XGEN(b.x)], 1u);
            asm volatile("s_waitcnt vmcnt(0)" ::: "memory");
        } else {
            XB_SPIN(xb_ld(&bar[XB_XGEN(b.x)]) == gen, bar);
            __builtin_amdgcn_fence(__ATOMIC_ACQUIRE, "agent");
            asm volatile("s_waitcnt vmcnt(0)" ::: "memory");
        }
    }
    __syncthreads();
}


constexpr int N_PHASES = 23;
__global__ void __launch_bounds__(NTHR, 2) fwd_kernel(Params p_unused) {
    extern __shared__ __attribute__((aligned(16))) unsigned char lds_raw[];
    float* lds = (float*)lds_raw;
    const int bid = blockIdx.x, nb = gridDim.x;
#define PHASE_ARGS() cparams_t pp = kernarg_ptr(); asm volatile("" : "+s"(pp)); \
    unsigned char* ws = pp->ws; (void)ws; \
    bf16_t* w_in0 = (bf16_t*)(ws + WS_WIN0); bf16_t* w_out0 = (bf16_t*)(ws + WS_WOUT0); bf16_t* w_in1 = (bf16_t*)(ws + WS_WIN1); bf16_t* w_out1 = (bf16_t*)(ws + WS_WOUT1); \
    bf16_t* wq = (bf16_t*)(ws + WS_WQ); bf16_t* skb = (bf16_t*)(ws + WS_SK); unsigned char* ub = ws + WS_U; unsigned char* vb = ws + WS_V; \
    float* uscale = (float*)(ws + WS_USC); float* vscale = (float*)(ws + WS_VSC); \
    bf16_t* hn = (bf16_t*)(ws + WS_HN); bf16_t* qkv = (bf16_t*)(ws + WS_QKV); bf16_t* pq = (bf16_t*)(ws + WS_QKV); \
    float* fg = (float*)(ws + WS_FG); float* carr = (float*)(ws + WS_C); \
    bf16_t* ao = (bf16_t*)(ws + WS_AO); int* idxb = (int*)(ws + WS_AO); float* gateb = (float*)(ws + WS_AO + (size_t)NT * 128 * 4); float* uscb = (float*)(ws + WS_AO + (size_t)NT * 128 * 8); \
    float* xres = pp->out; unsigned* qctr = (unsigned*)(ws + WS_QCTR); \
    float* partial = (float*)(ws + WS_QKV); float* wts = (float*)(ws + WS_QKV + (size_t)8 * NT * 128 * 4); \
    (void)w_in0; (void)w_out0; (void)w_in1; (void)w_out1; (void)wq; (void)skb; (void)ub; (void)vb; (void)uscale; (void)vscale; (void)hn; (void)qkv; (void)pq; (void)fg; (void)carr; (void)ao; \
    (void)idxb; (void)gateb; (void)uscb; (void)xres; (void)qctr; (void)partial; (void)wts
    int lo, hi;
    { cparams_t pp = kernarg_ptr(); asm volatile("" : "+s"(pp)); lo = pp->ph_lo; hi = pp->ph_hi;
      volatile LAS unsigned* xbw = (volatile LAS unsigned*)(lds_raw + LDS_BYTES - 16);
      if (threadIdx.x == 0) { xbw[0] = 0u; xbw[1] = 0u; xbw[2] = 0u; xbw[3] = 0u; }
      __syncthreads();
      if (hi - lo > 1) (void)xcd_barrier_post((unsigned*)(pp->ws + WS_BAR), xbw); }
#define IN(k) (lo <= (k) && (k) < hi)
#define SEAM(k) do { if (IN(k) && IN((k) + 1)) { PHASE_ARGS(); XcdBarrier b_; b_.bar = (unsigned*)(ws + WS_BAR); b_.x = xb_xcc_id(); b_.st = (volatile LAS unsigned*)(lds_raw + LDS_BYTES - 16); xcd_barrier(b_); } } while (0)

    if (IN(0)) { PHASE_ARGS();
        conv_transpose(pp->even_w_in, w_in0, 1024, 3072, lds, bid, nb);
        conv_transpose(pp->even_w_out, w_out0, 1024, 1024, lds, bid, nb);
        conv_transpose(pp->odd_w_in, w_in1, 1024, 3088, lds, bid, nb);
        conv_transpose(pp->odd_w_out, w_out1, 1024, 1024, lds, bid, nb);
        conv_transpose(pp->peer_wq, wq, 1024, 2048, lds, bid, nb);
        conv_transpose(pp->peer_wq + (size_t)1024 * 2048, wq + (size_t)2048 * 1024, 1024, 2048, lds, bid, nb);
        conv_copy(pp->peer_sk, skb, (size_t)2 * 8 * 2 * 128 * 128, bid, nb);
        conv_fp8_rows(pp->peer_u, ub, uscale, 2 * NEXP, bid, nb);
        conv_fp8_rows(pp->peer_v, vb, vscale, 2 * NEXP, bid, nb);
        phase_norm(pp->x, pp->norm_mix_g, hn, bid, nb);
    #if PROBE_DUP == 8

        conv_transpose(pp->even_w_in, w_in0, 1024, 3072, lds, bid, nb);
        conv_transpose(pp->even_w_out, w_out0, 1024, 1024, lds, bid, nb);
        conv_transpose(pp->odd_w_in, w_in1, 1024, 3088, lds, bid, nb);
        conv_transpose(pp->odd_w_out, w_out1, 1024, 1024, lds, bid, nb);
        conv_transpose(pp->peer_wq, wq, 1024, 2048, lds, bid, nb);
        conv_transpose(pp->peer_wq + (size_t)1024 * 2048, wq + (size_t)2048 * 1024, 1024, 2048, lds, bid, nb);
        conv_copy(pp->peer_sk, skb, (size_t)2 * 8 * 2 * 128 * 128, bid, nb);
        conv_fp8_rows(pp->peer_u, ub, uscale, 2 * NEXP, bid, nb);
        conv_fp8_rows(pp->peer_v, vb, vscale, 2 * NEXP, bid, nb);
        phase_norm(pp->x, pp->norm_mix_g, hn, bid, nb);
    #endif
    }
    SEAM(0);
    if (IN(1)) { PHASE_ARGS(); phase_gemm_mfma(hn, w_in0, NT, 3072, MEpiQKV{qkv, 512, 1536, 2048}, lds_raw, bid, nb);
#if PROBE_DUP == 11
        phase_gemm_mfma(hn, w_in0, NT, 3072, MEpiQKV{qkv, 512, 1536, 2048}, lds_raw, bid, nb);
#endif
    }
    SEAM(1);
    if (IN(2)) { PHASE_ARGS(); phase_mix0_mfma(qkv, pp->rel_bias, pp->diff_lambda, pp->diff_ln_g, ao, (bf16_t*)(ws + WS_DPO), (float*)(ws + WS_DLSE), lds_raw, qctr + 5 * 512);
#if PROBE_DUP == 12
        phase_mix0_mfma(qkv, pp->rel_bias, pp->diff_lambda, pp->diff_ln_g, ao, lds_raw, qctr + 5 * 512 + 128);
#endif
    }
    SEAM(2);
    if (IN(3)) { PHASE_ARGS(); phase_dilated_merge((const bf16_t*)(ws + WS_DPO), (const float*)(ws + WS_DLSE), ao, bid, nb); }
    SEAM(3);
    if (IN(4)) { PHASE_ARGS(); phase_gemm_mfma(ao, w_out0, NT, 1024, MEpiBf16{qkv, 1024}, lds_raw, bid, nb); }
    SEAM(4);
    if (IN(5)) { PHASE_ARGS(); phase_res_norm(pp->x, qkv, pp->norm_ffn_g, xres, hn, bid, nb); }
    SEAM(5);
    if (IN(6)) { PHASE_ARGS(); phase_gemm_mfma(hn, wq, NT, 2048, MEpiBf16{pq, 2048}, lds_raw, bid, nb);
#if PROBE_DUP == 15
        phase_gemm_mfma(hn, wq, NT, 2048, MEpiBf16{pq, 2048}, lds_raw, bid, nb);
#endif
#if PROBE_DUP == 16
        phase_gemm_mfma(hn, wq, NT, 2048, MEpiBf16{pq, 2048}, lds_raw, bid, nb);
        phase_gemm_mfma(hn, wq, NT, 2048, MEpiBf16{pq, 2048}, lds_raw, bid, nb);
#endif
    }
    SEAM(6);
    if (IN(7)) { PHASE_ARGS(); phase_topk_mfma(pq, skb, uscale, vscale, idxb, gateb, uscb, lds_raw, bid, nb); }
    SEAM(7);
    if (IN(8)) { PHASE_ARGS(); phase_peer_dots(hn, ub, idxb, partial, qctr + 0 * 512, lds_raw, xb_xcc_id() & 7u);
#if PROBE_DUP == 6
        phase_peer_dots(hn, ub, idxb, partial, qctr + 4 * 512, lds_raw, xb_xcc_id() & 7u);
#endif
    }
    SEAM(8);
    if (IN(9)) { PHASE_ARGS(); phase_peer_weights(partial, gateb, uscb, idxb, (unsigned*)wts, bid, nb);
#if PROBE_DUP == 8
        phase_peer_weights(partial, gateb, uscb, idxb, (unsigned*)wts, bid, nb);
#endif
    }
    SEAM(9);
    if (IN(10)) { PHASE_ARGS(); phase_peer_acc2(vb, (const unsigned*)wts, hn, qctr + 1 * 512, lds_raw, xb_xcc_id() & 7u);
#if PROBE_DUP == 1
        phase_peer_acc(vb, idxb, wts, xres, qctr + 4 * 512, lds_raw, xb_xcc_id() & 7u, 0.0f);
#endif
#if PROBE_DUP == 7
        phase_peer_acc<true>(vb, idxb, wts, xres, qctr + 4 * 512, lds_raw, xb_xcc_id() & 7u, 0.0f);
#endif
    }
    SEAM(10);
    if (IN(11)) { PHASE_ARGS(); phase_res_norm(xres, hn, pp->norm_mix_g + DM, xres, hn, bid, nb);

#if PROBE_DUP == 8
        phase_norm(xres, pp->norm_mix_g + DM, hn, bid, nb);
#endif
    }
    SEAM(11);
    if (IN(12)) { PHASE_ARGS(); phase_gemm_mfma(hn, w_in1, NT, 3072, MEpiQKV{qkv, 1024, 0, 0}, lds_raw, bid, nb); phase_fg(hn, w_in1 + (size_t)3072 * 1024, pp->odd_b_f, fg, bid, nb); }
    SEAM(12);
    if (IN(13)) { PHASE_ARGS(); phase_cumsum(fg, qkv, carr, (float*)(ws + WS_CTOT), (unsigned*)(ws + WS_KMAX), bid, nb);
#if PROBE_DUP == 8
        phase_cumsum(fg, qkv, carr, (float*)(ws + WS_CTOT), (unsigned*)(ws + WS_KMAX), bid, nb);
#endif
    }
    SEAM(13);
    if (IN(14)) { PHASE_ARGS(); phase_fox_mfma(qkv, carr, (const float*)(ws + WS_CTOT), (const unsigned*)(ws + WS_KMAX), ao, lds_raw, qctr + 5 * 512 + 64);
#if PROBE_DUP == 23
        phase_fox_mfma(qkv, carr, (const float*)(ws + WS_CTOT), (const unsigned*)(ws + WS_KMAX), ao, lds_raw, qctr + 5 * 512 + 192);
#endif
    }
    SEAM(14);
    if (IN(15)) { PHASE_ARGS(); phase_gemm_mfma(ao, w_out1, NT, 1024, MEpiBf16{qkv, 1024}, lds_raw, bid, nb); }
    SEAM(15);
    if (IN(16)) { PHASE_ARGS(); phase_res_norm(xres, qkv, pp->norm_ffn_g + DM, xres, hn, bid, nb); }
    SEAM(16);
    if (IN(17)) { PHASE_ARGS(); phase_gemm_mfma(hn, wq + (size_t)2048 * 1024, NT, 2048, MEpiBf16{pq, 2048}, lds_raw, bid, nb); }
    SEAM(17);
    if (IN(18)) { PHASE_ARGS(); phase_topk_mfma(pq, skb + (size_t)8 * 2 * 128 * 128, uscale + NEXP, vscale + NEXP, idxb, gateb, uscb, lds_raw, bid, nb); }
    SEAM(18);
    if (IN(19)) { PHASE_ARGS(); phase_peer_dots(hn, ub + (size_t)NEXP * 1024, idxb, partial, qctr + 2 * 512, lds_raw, xb_xcc_id() & 7u); }
    SEAM(19);
    if (IN(20)) { PHASE_ARGS(); phase_peer_weights(partial, gateb, uscb, idxb, (unsigned*)wts, bid, nb);
#if PROBE_DUP == 8
        phase_peer_weights(partial, gateb, uscb, idxb, (unsigned*)wts, bid, nb);
#endif
    }
    SEAM(20);
    if (IN(21)) { PHASE_ARGS(); phase_peer_acc2(vb + (size_t)NEXP * 1024, (const unsigned*)wts, hn, qctr + 3 * 512, lds_raw, xb_xcc_id() & 7u); }
    SEAM(21);
    if (IN(22)) { PHASE_ARGS(); phase_final_norm(xres, hn, pp->final_g, bid, nb); }
}

extern "C" void kernel_launch(void* const* d_in, const int* in_sizes, int n_in, void* d_out, int out_size, void* d_ws, size_t ws_size, hipStream_t stream) {
    static int grid = 0;
    if (grid == 0) {
        if (n_in != 16 || out_size != NT * DM || ws_size < WS_END) { fprintf(stderr, "kernel_launch: unexpected sizes n_in %d out %d ws %zu (need %zu)\n", n_in, out_size, ws_size, (size_t)WS_END); grid = -1; return; }
        int dev = 0, cus = 0;
        (void)hipGetDevice(&dev); (void)hipDeviceGetAttribute(&cus, hipDeviceAttributeMultiprocessorCount, dev);
        if (hipFuncSetAttribute((const void*)fwd_kernel, hipFuncAttributeMaxDynamicSharedMemorySize, LDS_BYTES) != hipSuccess) { fprintf(stderr, "hipFuncSetAttribute failed\n"); grid = -1; return; }
        grid = cus > 0 ? cus : 256;
    }
    if (grid < 0) return;
    Params p{};
    p.x = (const float*)d_in[0]; p.norm_mix_g = (const float*)d_in[1]; p.norm_ffn_g = (const float*)d_in[2]; p.final_g = (const float*)d_in[3];
    p.rel_bias = (const float*)d_in[4]; p.even_w_in = (const float*)d_in[5]; p.even_w_out = (const float*)d_in[6]; p.diff_lambda = (const float*)d_in[7];
    p.diff_ln_g = (const float*)d_in[8]; p.odd_w_in = (const float*)d_in[9]; p.odd_b_f = (const float*)d_in[10]; p.odd_w_out = (const float*)d_in[11];
    p.peer_wq = (const float*)d_in[12]; p.peer_sk = (const float*)d_in[13]; p.peer_u = (const float*)d_in[14]; p.peer_v = (const float*)d_in[15];
    p.out = (float*)d_out; p.ws = (unsigned char*)d_ws;
#if defined(MK_MULTI)
    for (int k = 0; k < N_PHASES; ++k) {
        p.ph_lo = k; p.ph_hi = k + 1;
        hipLaunchKernelGGL(fwd_kernel, dim3(grid), dim3(NTHR), LDS_BYTES, stream, p);
    }
#else
    (void)hipMemsetAsync((unsigned char*)d_ws + WS_BAR, 0, WS_CTL_BYTES + 8 * 8 * 256, stream);
    p.ph_lo = 0; p.ph_hi = N_PHASES;
    hipLaunchKernelGGL(fwd_kernel, dim3(grid), dim3(NTHR), LDS_BYTES, stream, p);
#endif
}
```

```cpp
#include <hip/hip_runtime.h>
#include <stdint.h>
#include <math.h>
#include <cstdio>

typedef unsigned short bf16_t;
#define DEV static __device__ __forceinline__
#define MDEV __device__ __forceinline__

#ifndef PROBE_DUP
#define PROBE_DUP 0
#endif
constexpr int DM = 1024, NBATCH = 8, SEQ = 4096, NT = NBATCH * SEQ;
constexpr int EVEN_IN = 3072, ODD_IN = 3088;
constexpr int NEXP = 16384;
constexpr int NTHR = 512;
constexpr int LDS_BYTES = 144 * 1024;

constexpr size_t KB_ = 1024, MB_ = 1024 * 1024;
constexpr size_t WS_BAR   = 0;
constexpr size_t WS_KMAX  = 32768;
constexpr size_t WS_CTOT  = 33792;
constexpr size_t WS_WIN0  = 64 * KB_;
constexpr size_t WS_WOUT0 = WS_WIN0 + (size_t)3072 * 1024 * 2;
constexpr size_t WS_WIN1  = WS_WOUT0 + (size_t)1024 * 1024 * 2;
constexpr size_t WS_WOUT1 = WS_WIN1 + (size_t)3328 * 1024 * 2;
constexpr size_t WS_WQ    = WS_WOUT1 + (size_t)1024 * 1024 * 2;
constexpr size_t WS_SK    = WS_WQ + (size_t)2 * 2048 * 1024 * 2;
constexpr size_t WS_U     = WS_SK + (size_t)2 * 8 * 2 * 128 * 128 * 2;
constexpr size_t WS_V     = WS_U + (size_t)2 * NEXP * 1024;
constexpr size_t WS_USC   = WS_V + (size_t)2 * NEXP * 1024;
constexpr size_t WS_VSC   = WS_USC + (size_t)2 * NEXP * 4;
constexpr size_t WS_HN    = WS_VSC + (size_t)2 * NEXP * 4;
constexpr size_t WS_QKV   = WS_HN + (size_t)NT * 1024 * 2;
constexpr size_t WS_FG    = WS_QKV + (size_t)NT * 3072 * 2;
constexpr size_t WS_C     = WS_FG + (size_t)NT * 16 * 4;
constexpr size_t WS_AO    = WS_C + (size_t)NT * 16 * 4;
constexpr size_t WS_DPO   = WS_AO + (size_t)NT * 1024 * 2;
constexpr size_t WS_DLSE  = WS_HN;
constexpr size_t WS_END   = WS_DPO + (size_t)3 * NT * 512 * 2;
static_assert(WS_END <= (size_t)512 * 1024 * 1024, "workspace map exceeds the guaranteed 512 MiB");

struct Params {
    const float *x, *norm_mix_g, *norm_ffn_g, *final_g, *rel_bias, *even_w_in, *even_w_out, *diff_lambda, *diff_ln_g,
                *odd_w_in, *odd_b_f, *odd_w_out, *peer_wq, *peer_sk, *peer_u, *peer_v;
    float* out;
    unsigned char* ws;
    int ph_lo, ph_hi;
};

DEV float bf2f(bf16_t v) { return __uint_as_float(((unsigned)v) << 16); }
DEV bf16_t f2bf(float f) { unsigned u = __float_as_uint(f); u += 0x7FFFu + ((u >> 16) & 1u); return (bf16_t)(u >> 16); }
DEV unsigned pk2(float lo, float hi) { return (unsigned)f2bf(lo) | ((unsigned)f2bf(hi) << 16); }
DEV unsigned cvtpk2(float lo, float hi) { unsigned r; asm("v_cvt_pk_bf16_f32 %0, %1, %2" : "=v"(r) : "v"(lo), "v"(hi)); return r; }
DEV float bflo(unsigned w) { return __uint_as_float(w << 16); }
DEV float bfhi(unsigned w) { return __uint_as_float(w & 0xFFFF0000u); }
DEV float wave_sum(float v) {
#pragma unroll
    for (int o = 32; o >= 1; o >>= 1) v += __shfl_xor(v, o);
    return v;
}
DEV float wave_max(float v) {
#pragma unroll
    for (int o = 32; o >= 1; o >>= 1) v = fmaxf(v, __shfl_xor(v, o));
    return v;
}
DEV int opaque_tid() { int t = threadIdx.x; asm volatile("" : "+v"(t)); return t; }
typedef const __attribute__((address_space(4))) struct Params* cparams_t;
DEV cparams_t kernarg_ptr() {
#if defined(__HIP_DEVICE_COMPILE__)
    return (cparams_t)__builtin_amdgcn_kernarg_segment_ptr();
#else
    return (cparams_t)0;
#endif
}
DEV void lds_fence() { asm volatile("s_waitcnt lgkmcnt(0)" ::: "memory"); }

DEV unsigned queue_next(unsigned* q, volatile unsigned* sh) {
    __syncthreads();
    if (threadIdx.x == 0) sh[0] = __hip_atomic_fetch_add(q, 1u, __ATOMIC_RELAXED, __HIP_MEMORY_SCOPE_AGENT);
    __syncthreads();
    return sh[0];
}
DEV int t5_bucket(int d) {
    if (d < 16) return d;
    int b = 16;
    b += (d >= 22); b += (d >= 30); b += (d >= 40); b += (d >= 54); b += (d >= 73); b += (d >= 99); b += (d >= 134); b += (d >= 182);
    b += (d >= 246); b += (d >= 332); b += (d >= 450); b += (d >= 609); b += (d >= 825); b += (d >= 1117); b += (d >= 1513);
    return b;
}

DEV void conv_transpose(const float* src, bf16_t* dst, int K, int N, float* lds, int bid, int nb) {
    const int tid_ = opaque_tid();
    const int t = tid_;
    const int ntk = K / 64, ntn = (N + 63) / 64;
    for (int tile = bid; tile < ntk * ntn; tile += nb) {
        const int k0 = (tile / ntn) * 64, n0 = (tile % ntn) * 64;
        __syncthreads();
#pragma unroll
        for (int i = 0; i < 8; ++i) {
            const int r = (t >> 6) + 8 * i, c = t & 63;
            float v = 0.f;
            if (n0 + c < N) v = src[(size_t)(k0 + r) * N + n0 + c];
            lds[r * 65 + c] = v;
        }
        __syncthreads();
#pragma unroll
        for (int i = 0; i < 8; ++i) {
            const int r = (t >> 6) + 8 * i, c = t & 63;
            if (n0 + r < N) dst[(size_t)(n0 + r) * K + k0 + c] = f2bf(lds[c * 65 + r]);
        }
    }
}
DEV void conv_copy(const float* src, bf16_t* dst, size_t n, int bid, int nb) {
    const int tid_ = opaque_tid();
    const size_t n4 = n / 4;
    for (size_t i = (size_t)bid * NTHR + tid_; i < n4; i += (size_t)nb * NTHR) {
        const float4 v = ((const float4*)src)[i];
        uint2 o; o.x = pk2(v.x, v.y); o.y = pk2(v.z, v.w);
        ((uint2*)dst)[i] = o;
    }
}

DEV void conv_fp8_rows(const float* src, unsigned char* dst, float* inv, int rows, int bid, int nb) {
    const int tid_ = opaque_tid();
    const int wid = tid_ >> 6, lane = tid_ & 63;
    for (int row = bid * 8 + wid; row < rows; row += nb * 8) {
        const float4* xr = (const float4*)(src + (size_t)row * DM) + lane;
        float4 v[4]; float mx = 0.f;
#pragma unroll
        for (int i = 0; i < 4; ++i) { v[i] = xr[64 * i]; mx = fmaxf(mx, fmaxf(fmaxf(fabsf(v[i].x), fabsf(v[i].y)), fmaxf(fabsf(v[i].z), fabsf(v[i].w)))); }
        mx = wave_max(mx);
        int e = 0; if (mx > 0.f) (void)frexpf(mx, &e);
        e = min(max(e, -100), 100);
        const float sc = ldexpf(1.0f, 8 - e), isc = ldexpf(1.0f, e - 8);
        const int layer = row / NEXP, ex = row % NEXP;
#pragma unroll
        for (int i = 0; i < 4; ++i) {
            unsigned w = __builtin_amdgcn_cvt_pk_fp8_f32(v[i].x * sc, v[i].y * sc, 0, false); w = __builtin_amdgcn_cvt_pk_fp8_f32(v[i].z * sc, v[i].w * sc, w, true);
            const int col = 4 * lane + 256 * i, x = col >> 7, off = col & 127;
            *(unsigned*)(dst + (((size_t)layer * 8 + x) * NEXP + ex) * 128 + off) = w;
        }
        if (lane == 0) inv[row] = isc;
    }
}

DEV void phase_norm(const float* xin, const float* g, bf16_t* out, int bid, int nb) {
    const int tid_ = opaque_tid();
    const int wid = tid_ >> 6, lane = tid_ & 63;
    for (int row = bid * 8 + wid; row < NT; row += nb * 8) {
        const float4* xr = (const float4*)(xin + (size_t)row * DM);
        float4 v[4]; float ss = 0.f;
#pragma unroll
        for (int i = 0; i < 4; ++i) { v[i] = xr[lane + 64 * i]; ss += v[i].x * v[i].x + v[i].y * v[i].y + v[i].z * v[i].z + v[i].w * v[i].w; }
        ss = wave_sum(ss);
        const float rstd = 1.0f / sqrtf(ss * (1.0f / DM) + 1e-6f);
#pragma unroll
        for (int i = 0; i < 4; ++i) {
            const float4 gg = ((const float4*)g)[lane + 64 * i];
            uint2 o; o.x = pk2(v[i].x * rstd * gg.x, v[i].y * rstd * gg.y); o.y = pk2(v[i].z * rstd * gg.z, v[i].w * rstd * gg.w);
            ((uint2*)(out + (size_t)row * DM))[lane + 64 * i] = o;
        }
    }
}
DEV void phase_res_norm(const float* xin, const bf16_t* delta, const float* g, float* xout, bf16_t* out, int bid, int nb) {
    const int tid_ = opaque_tid();
    const int wid = tid_ >> 6, lane = tid_ & 63;
    for (int row = bid * 8 + wid; row < NT; row += nb * 8) {
        const float4* xr = (const float4*)(xin + (size_t)row * DM);
        const uint2* dr = (const uint2*)(delta + (size_t)row * DM);
        float4 v[4]; float ss = 0.f;
#pragma unroll
        for (int i = 0; i < 4; ++i) { v[i] = xr[lane + 64 * i]; const uint2 d = dr[lane + 64 * i];
            v[i].x += bflo(d.x); v[i].y += bfhi(d.x); v[i].z += bflo(d.y); v[i].w += bfhi(d.y);
            ss += v[i].x * v[i].x + v[i].y * v[i].y + v[i].z * v[i].z + v[i].w * v[i].w; }
        ss = wave_sum(ss);
        const float rstd = 1.0f / sqrtf(ss * (1.0f / DM) + 1e-6f);
#pragma unroll
        for (int i = 0; i < 4; ++i) {
            ((float4*)(xout + (size_t)row * DM))[lane + 64 * i] = v[i];
            const float4 gg = ((const float4*)g)[lane + 64 * i];
            uint2 o; o.x = pk2(v[i].x * rstd * gg.x, v[i].y * rstd * gg.y); o.y = pk2(v[i].z * rstd * gg.z, v[i].w * rstd * gg.w);
            ((uint2*)(out + (size_t)row * DM))[lane + 64 * i] = o;
        }
    }
}
DEV void phase_final_norm(float* x, const bf16_t* delta, const float* g, int bid, int nb) {
    const int tid_ = opaque_tid();
    const int wid = tid_ >> 6, lane = tid_ & 63;
    for (int row = bid * 8 + wid; row < NT; row += nb * 8) {
        float4* xr = (float4*)(x + (size_t)row * DM);
        const uint2* dr = (const uint2*)(delta + (size_t)row * DM);
        float4 v[4]; float ss = 0.f;
#pragma unroll
        for (int i = 0; i < 4; ++i) { v[i] = xr[lane + 64 * i]; const uint2 d = dr[lane + 64 * i];
            v[i].x += bflo(d.x); v[i].y += bfhi(d.x); v[i].z += bflo(d.y); v[i].w += bfhi(d.y);
            ss += v[i].x * v[i].x + v[i].y * v[i].y + v[i].z * v[i].z + v[i].w * v[i].w; }
        ss = wave_sum(ss);
        const float rstd = 1.0f / sqrtf(ss * (1.0f / DM) + 1e-6f);
#pragma unroll
        for (int i = 0; i < 4; ++i) {
            const float4 gg = ((const float4*)g)[lane + 64 * i];
            float4 o; o.x = v[i].x * rstd * gg.x; o.y = v[i].y * rstd * gg.y; o.z = v[i].z * rstd * gg.z; o.w = v[i].w * rstd * gg.w;
            xr[lane + 64 * i] = o;
        }
    }
}

struct EpiBf16 { bf16_t* out; int ld;
    MDEV void operator()(int r, int c, float v) const { out[(size_t)r * ld + c] = f2bf(v); } };
struct EpiOddIn { bf16_t* out; float* fg; const float* bfv;
    MDEV void operator()(int r, int c, float v) const { if (c < 3072) out[(size_t)r * 3072 + c] = f2bf(v); else fg[(size_t)r * 16 + (c - 3072)] = v + bfv[c - 3072]; } };
struct EpiRes { const float* xin; float* xout;
    MDEV void operator()(int r, int c, float v) const { xout[(size_t)r * DM + c] = xin[(size_t)r * DM + c] + v; } };

template <class Epi>
DEV void phase_gemm_naive(const bf16_t* A, const bf16_t* Bt, int M, int N, int K, const Epi epi, float* lds, int bid, int nb) {
    float* As = lds;
    float* Bs = lds + 16 * 132;
    const int t = threadIdx.x, tx = t & 31, ty = t >> 5;
    const int ntm = M / 128, ntn = (N + 127) / 128;
    const int lr = t >> 2, lk = (t & 3) * 4;
    for (int tile = bid; tile < ntm * ntn; tile += nb) {
        const int m0 = (tile / ntn) * 128, n0 = (tile % ntn) * 128;
        float acc[8][4];
#pragma unroll
        for (int i = 0; i < 8; ++i)
#pragma unroll
            for (int j = 0; j < 4; ++j) acc[i][j] = 0.f;
        for (int k0 = 0; k0 < K; k0 += 16) {
            const uint2 av = *(const uint2*)(A + (size_t)(m0 + lr) * K + k0 + lk);
            uint2 bv = make_uint2(0u, 0u);
            if (n0 + lr < N) bv = *(const uint2*)(Bt + (size_t)(n0 + lr) * K + k0 + lk);
            __syncthreads();
            As[(lk + 0) * 132 + lr] = bflo(av.x); As[(lk + 1) * 132 + lr] = bfhi(av.x); As[(lk + 2) * 132 + lr] = bflo(av.y); As[(lk + 3) * 132 + lr] = bfhi(av.y);
            Bs[(lk + 0) * 132 + lr] = bflo(bv.x); Bs[(lk + 1) * 132 + lr] = bfhi(bv.x); Bs[(lk + 2) * 132 + lr] = bflo(bv.y); Bs[(lk + 3) * 132 + lr] = bfhi(bv.y);
            __syncthreads();
#pragma unroll
            for (int k = 0; k < 16; ++k) {
                const float4 a0 = *(const float4*)&As[k * 132 + ty * 8], a1 = *(const float4*)&As[k * 132 + ty * 8 + 4];
                const float4 b0 = *(const float4*)&Bs[k * 132 + tx * 4];
                const float a[8] = {a0.x, a0.y, a0.z, a0.w, a1.x, a1.y, a1.z, a1.w};
                const float b[4] = {b0.x, b0.y, b0.z, b0.w};
#pragma unroll
                for (int i = 0; i < 8; ++i)
#pragma unroll
                    for (int j = 0; j < 4; ++j) acc[i][j] += a[i] * b[j];
            }
        }
#pragma unroll
        for (int i = 0; i < 8; ++i)
#pragma unroll
            for (int j = 0; j < 4; ++j) { const int row = m0 + ty * 8 + i, col = n0 + tx * 4 + j; if (col < N) epi(row, col, acc[i][j]); }
    }
}

typedef short bf16x8 __attribute__((ext_vector_type(8)));
typedef float f32x4 __attribute__((ext_vector_type(4)));
namespace g8 {
constexpr int BM = 256, BK = 64, HALF = 128, NXCD = 8, WGM = 8, HT = HALF * BK, KD = 1024;
DEV int lds_byte(int r, int c) { const int st = (r >> 4) * 2 + (c >> 5), rr = r & 15, cc = c & 31, ob = rr * 64 + cc * 2; return st * 1024 + (ob ^ (((ob >> 9) & 1) << 5)); }
DEV void stage_rc(int b, int& R, int& C) { const int st = b / 1024, sb = b % 1024, swz = sb ^ (((sb >> 9) & 1) << 5); R = (st >> 1) * 16 + swz / 64; C = (st & 1) * 32 + (swz % 64) / 2; }
}
struct MEpiBf16 { static constexpr bool PERM = true; bf16_t* out; int ld;
    MDEV void operator()(int r, int c, f32x4 v0, f32x4 v1) const { uint4 o; o.x = cvtpk2(v0[0], v0[1]); o.y = cvtpk2(v0[2], v0[3]); o.z = cvtpk2(v1[0], v1[1]); o.w = cvtpk2(v1[2], v1[3]);
        *(uint4*)(out + (size_t)r * ld + c) = o; } };
struct MEpiQKV { static constexpr bool PERM = true; bf16_t* out; int s0_hi, s1_lo, s1_hi;
    MDEV void operator()(int r, int c, f32x4 v0, f32x4 v1) const { const float sc = (c < s0_hi || (c >= s1_lo && c < s1_hi)) ? 0.125f * 1.4426950408889634f : 1.0f;
        uint4 o; o.x = cvtpk2(v0[0] * sc, v0[1] * sc); o.y = cvtpk2(v0[2] * sc, v0[3] * sc); o.z = cvtpk2(v1[0] * sc, v1[1] * sc); o.w = cvtpk2(v1[2] * sc, v1[3] * sc);
        *(uint4*)(out + (size_t)r * 3072 + c) = o; } };
struct MEpiRes { static constexpr bool PERM = false; const float* xin; float* xout;
    MDEV void operator()(int r, int c, f32x4 v) const { const f32x4 b = *(const f32x4*)(xin + (size_t)r * DM + c); *(f32x4*)(xout + (size_t)r * DM + c) = b + v; } };

template <class Epi>
DEV void phase_gemm_mfma(const bf16_t* A, const bf16_t* Bt, int M, int N, const Epi epi, unsigned char* shm_raw, int bid, int nb) {
    using namespace g8;
    typedef __attribute__((address_space(3))) unsigned char* ldsp_t;
    ldsp_t lds = (ldsp_t)shm_raw;
    constexpr int K = KD, nt = K / BK, HTB = HALF * BK * 2;
    int tid = threadIdx.x; asm volatile("" : "+v"(tid));
    const int wid = __builtin_amdgcn_readfirstlane(tid >> 6), lane = tid & 63, wr = wid >> 2, wc = wid & 3, fr = lane & 15, fq = lane >> 4;
    const int nM = M / BM, nN = N / BM, nwg = nM * nN;
    auto unit_of = [&](int i, int& pm, int& pn) -> bool {
        const long L = (long)i * nb + bid; if (L >= nwg) return false;
        int wgid = (int)L;
        { const int q = nwg / NXCD, r = nwg % NXCD, xcd = wgid % NXCD, off = wgid / NXCD; wgid = (xcd < r ? xcd * (q + 1) : r * (q + 1) + (xcd - r) * q) + off; }
        const int nig = WGM * nN, gid = wgid / nig, fm = gid * WGM, gsz = min(nM - fm, WGM);
        pm = fm + ((wgid % nig) % gsz); pn = (wgid % nig) / gsz; return true; };
    unsigned voffA[2], voffB[2];
#pragma unroll
    for (int i = 0; i < 2; ++i) { int R, C; stage_rc(tid * 16 + i * 8192, R, C); const int rho = R & 31, pr = 8 * ((rho & 15) >> 2) + 4 * (rho >> 4) + (rho & 3);
        const int Rb = Epi::PERM ? ((R & ~31) + pr) : R;
        voffA[i] = (unsigned)(R * K + C) * 2u; voffB[i] = (unsigned)(Rb * K + C) * 2u; }
    constexpr size_t kstep = (size_t)(BK * 2), hstep = (size_t)HALF * K * 2, tstep = 2 * hstep;
    const unsigned ldsw = (unsigned)wid * 1024u;
    const int aoff = lds_byte(wr * 64 + fr, fq * 8), boff = lds_byte(wc * 32 + fr, fq * 8);
#define SA(b, h) (((b) * 2 + (h)) * HTB)
#define SB(b, h) ((4 + (b) * 2 + (h)) * HTB)
#define STAGE(bufoff, gbase, voff) do { _Pragma("unroll") for (int _i = 0; _i < 2; ++_i) \
        __builtin_amdgcn_global_load_lds((const unsigned*)((const char*)(gbase) + (voff)[_i]), (__attribute__((address_space(3))) unsigned*)(lds + (bufoff) + ldsw + _i * 8192), 16, 0, 0); } while (0)
#define LDA(dst, b, h) do { _Pragma("unroll") for (int m = 0; m < 4; ++m) _Pragma("unroll") for (int k = 0; k < 2; ++k) dst[m][k] = *(const __attribute__((address_space(3))) bf16x8*)(lds + SA(b, h) + aoff + m * 2048 + k * 1024); } while (0)
#define LDB(dst, b, h) do { _Pragma("unroll") for (int n = 0; n < 2; ++n) _Pragma("unroll") for (int k = 0; k < 2; ++k) dst[n][k] = *(const __attribute__((address_space(3))) bf16x8*)(lds + SB(b, h) + boff + n * 2048 + k * 1024); } while (0)
#define MMA(ai, bj, At, Bt_) do { __builtin_amdgcn_s_setprio(1); _Pragma("unroll") for (int m = 0; m < 4; ++m) _Pragma("unroll") for (int n = 0; n < 2; ++n) _Pragma("unroll") for (int k = 0; k < 2; ++k) \
        acc[ai][bj][m][n] = __builtin_amdgcn_mfma_f32_16x16x32_bf16(Bt_[n][k], At[m][k], acc[ai][bj][m][n], 0, 0, 0); __builtin_amdgcn_s_setprio(0); } while (0)
#define WAIT_V(n) asm volatile("s_waitcnt vmcnt(" #n ")" ::: "memory")
#define WAIT_L(n) asm volatile("s_waitcnt lgkmcnt(" #n ")" ::: "memory")
#define BAR __builtin_amdgcn_s_barrier()
#define SCHED __builtin_amdgcn_sched_barrier(0)
    int cpm, cpn, npm = 0, npn = 0, ui = 0;
    if (!unit_of(0, cpm, cpn)) return;
    f32x4 acc[2][2][4][2];
#pragma unroll
    for (int a = 0; a < 2; ++a)
#pragma unroll
        for (int b = 0; b < 2; ++b)
#pragma unroll
            for (int m = 0; m < 4; ++m)
#pragma unroll
                for (int n = 0; n < 2; ++n) acc[a][b][m][n] = (f32x4){0.f, 0.f, 0.f, 0.f};
    bf16x8 At[4][2], B0[2][2], B1[2][2];
    const char* cA = (const char*)A + (size_t)cpm * tstep; const char* cB = (const char*)Bt + (size_t)cpn * tstep;
    __syncthreads();
    STAGE(SB(0, 0), cB, voffB); STAGE(SA(0, 0), cA, voffA); STAGE(SB(0, 1), cB + hstep, voffB); STAGE(SA(0, 1), cA + hstep, voffA);
    if (wr == 1) BAR;
    WAIT_V(4); BAR;
    STAGE(SB(1, 0), cB + kstep, voffB); STAGE(SA(1, 0), cA + kstep, voffA); STAGE(SB(1, 1), cB + hstep + kstep, voffB);
    WAIT_V(6); BAR;
    for (;;) {
        const bool has_next = unit_of(ui + 1, npm, npn);
        const char* nA = has_next ? (const char*)A + (size_t)npm * tstep : cA; const char* nB = has_next ? (const char*)Bt + (size_t)npn * tstep : cB;
#pragma unroll 1
        for (int t = 0; t < nt; t += 2) {
            const bool last = (t == nt - 2);
            const char* a1 = cA + (size_t)(t + 1) * kstep;
            const char* a2 = last ? nA : cA + (size_t)(t + 2) * kstep; const char* b2 = last ? nB : cB + (size_t)(t + 2) * kstep;
            const char* a3 = a2 + kstep; const char* b3 = b2 + kstep;
            LDB(B0, 0, 0); SCHED; LDA(At, 0, 0); STAGE(SA(1, 1), a1 + hstep, voffA);
            WAIT_L(8); BAR; WAIT_L(0); MMA(0, 0, At, B0); BAR; SCHED;
            LDB(B1, 0, 1); STAGE(SB(0, 0), b2, voffB);
            BAR; WAIT_L(0); MMA(0, 1, At, B1); BAR;
            LDA(At, 0, 1); STAGE(SA(0, 0), a2, voffA);
            BAR; WAIT_L(0); MMA(1, 0, At, B0); BAR; SCHED;
            STAGE(SB(0, 1), b2 + hstep, voffB);
            WAIT_V(6); BAR; MMA(1, 1, At, B1); BAR;
            LDB(B0, 1, 0); SCHED; LDA(At, 1, 0); STAGE(SA(0, 1), a2 + hstep, voffA);
            WAIT_L(8); BAR; WAIT_L(0); MMA(0, 0, At, B0); BAR; SCHED;
            LDB(B1, 1, 1); STAGE(SB(1, 0), b3, voffB);
            BAR; WAIT_L(0); MMA(0, 1, At, B1); BAR;
            LDA(At, 1, 1); STAGE(SA(1, 0), a3, voffA);
            BAR; WAIT_L(0); MMA(1, 0, At, B0); BAR; SCHED;
            STAGE(SB(1, 1), b3 + hstep, voffB);
            WAIT_V(6); BAR; MMA(1, 1, At, B1); BAR;
        }
        {
            const int brow = cpm * BM, bcol = cpn * BM;
#pragma unroll
            for (int ai = 0; ai < 2; ++ai)
#pragma unroll
                for (int m = 0; m < 4; ++m)
#pragma unroll
                    for (int bj = 0; bj < 2; ++bj) {
                        const int row = brow + ai * HALF + wr * 64 + m * 16 + fr;
                        if constexpr (Epi::PERM) epi(row, bcol + bj * HALF + wc * 32 + 8 * fq, acc[ai][bj][m][0], acc[ai][bj][m][1]);
                        else { epi(row, bcol + bj * HALF + wc * 32 + 4 * fq, acc[ai][bj][m][0]); epi(row, bcol + bj * HALF + wc * 32 + 16 + 4 * fq, acc[ai][bj][m][1]); }
                    }
        }
        if (!has_next) break;
#pragma unroll
        for (int a = 0; a < 2; ++a)
#pragma unroll
            for (int b = 0; b < 2; ++b)
#pragma unroll
                for (int m = 0; m < 4; ++m)
#pragma unroll
                    for (int n = 0; n < 2; ++n) acc[a][b][m][n] = (f32x4){0.f, 0.f, 0.f, 0.f};
        cpm = npm; cpn = npn; cA = nA; cB = nB; ++ui;
    }
    WAIT_V(0);
    if (wr == 0) BAR;
    BAR;
#undef SA
#undef SB
#undef STAGE
#undef LDA
#undef LDB
#undef MMA
#undef WAIT_V
#undef WAIT_L
#undef BAR
#undef SCHED
}

DEV void phase_fg(const bf16_t* hn, const bf16_t* wfg, const float* bfv, float* fg, int bid, int nb) {
    const int tid_ = opaque_tid();
    const int wid = tid_ >> 6, lane = tid_ & 63, fr = lane & 15, fq = lane >> 4;
    for (int task = bid * 8 + wid; task < NT / 16; task += nb * 8) {
        const int row0 = task * 16;
        f32x4 acc = (f32x4){0.f, 0.f, 0.f, 0.f};
        const bf16x8* ap = (const bf16x8*)(hn + (size_t)(row0 + fr) * DM + fq * 8);
        const bf16x8* bp = (const bf16x8*)(wfg + (size_t)fr * DM + fq * 8);
#pragma unroll 8
        for (int kk = 0; kk < 32; ++kk) acc = __builtin_amdgcn_mfma_f32_16x16x32_bf16(ap[kk * 4], bp[kk * 4], acc, 0, 0, 0);
        const float bb = bfv[fr];
#pragma unroll
        for (int j = 0; j < 4; ++j) fg[(size_t)(row0 + fq * 4 + j) * 16 + fr] = acc[j] + bb;
    }
}

typedef float f32x16 __attribute__((ext_vector_type(16)));
typedef short s16x4 __attribute__((ext_vector_type(4)));
typedef __attribute__((address_space(3))) const unsigned char* ldsc_t;
typedef __attribute__((address_space(3))) unsigned char* lptr_t;
#define MFMA32(a, b, c) __builtin_amdgcn_mfma_f32_32x32x16_bf16(a, b, c, 0, 0, 0)
constexpr float NEG_BIG = -1e30f;
constexpr float LOG2E = 1.4426950408889634f;
constexpr float QSCALE = 0.125f * LOG2E;
constexpr int ATT_LUT_OFF = 0;
constexpr int ATT_TILE_OFF = 24576;
DEV unsigned cvtpk(float lo, float hi) { unsigned r; asm("v_cvt_pk_bf16_f32 %0, %1, %2" : "=v"(r) : "v"(lo), "v"(hi)); return r; }
DEV s16x4 vtr(ldsc_t p) { typedef short v4i16_t __attribute__((ext_vector_type(4))); return __builtin_bit_cast(s16x4, __builtin_amdgcn_ds_read_tr16_b64_v4i16((__attribute__((address_space(3))) v4i16_t*)p)); }
DEV float xhalf_max(float m) { auto rr = __builtin_amdgcn_permlane32_swap(__float_as_uint(m), __float_as_uint(m), false, false); return fmaxf(__uint_as_float(rr[0]), __uint_as_float(rr[1])); }
DEV float xhalf_sum(float m) { auto rr = __builtin_amdgcn_permlane32_swap(__float_as_uint(m), __float_as_uint(m), false, false); return __uint_as_float(rr[0]) + __uint_as_float(rr[1]); }

#define MXX3(a, b, c) __builtin_fmaxf(__builtin_fmaxf((a), (b)), (c))
template <int W, int MODE, int WIN  >
DEV void attn_unit(const bf16_t* qg  , const bf16_t* kg  , const bf16_t* vg, int kt_lo, int kt_hi,
                   int qrow, int qmin, int qmax, int kmap, unsigned char* lds_raw, f32x16 (&o)[W / 32], float kbound = 0.f, int rs = 3072, float* lse_out = nullptr, int rmax = 4127) {
    constexpr bool BAND = (WIN != 0);
    constexpr bool REV = (MODE == 1);
    constexpr int NC = W / 32, ROWB = W * 2, TILEB = 64 * ROWB, CPR = W / 8, NLD = (64 * CPR) / NTHR;
    int tid = threadIdx.x; asm volatile("" : "+v"(tid));
    const int lane = tid & 63, l31 = lane & 31, hi = lane >> 5;
    ldsc_t lds = (ldsc_t)lds_raw;
    const float* lut = (const float*)(lds_raw + ATT_LUT_OFF);
    bf16x8 qf[4];
#pragma unroll
    for (int ks = 0; ks < 4; ++ks) qf[ks] = *(const bf16x8*)(qg + ks * 16 + hi * 8);
#pragma unroll
    for (int c = 0; c < NC; ++c)
#pragma unroll
        for (int r = 0; r < 16; ++r) o[c][r] = 0.f;
    float m = NEG_BIG, l = 0.f;
    float brow = 0.f; bool wdone = false;
    volatile __attribute__((address_space(3))) unsigned* flg = (volatile __attribute__((address_space(3))) unsigned*)((lptr_t)lds_raw + ATT_LUT_OFF + 20480);
    if (REV) { float ss = 0.f;
#pragma unroll
        for (int ks = 0; ks < 4; ++ks)
#pragma unroll
            for (int j = 0; j < 8; ++j) { const float v = bf2f((bf16_t)qf[ks][j]); ss += v * v; }
        brow = sqrtf(xhalf_sum(ss)) * kbound; }
    const int wv = __builtin_amdgcn_readfirstlane(tid >> 6);
    unsigned ksrc[NLD], vsrc[NLD];
#pragma unroll
    for (int i = 0; i < NLD; ++i) { const int id = tid + NTHR * i, row = id / CPR, chp = id % CPR;
        const int kch = (W == 64) ? (chp ^ ((row >> 1) & 7)) : (chp ^ (row & 15));
        const int vch = (W == 64) ? (chp ^ (((row >> 1) & 1) << 2)) : (chp ^ ((row & 3) << 2));
        ksrc[i] = (unsigned)(row * rs + kch * 8); vsrc[i] = (unsigned)(row * rs + vch * 8); }
#define stage_issue(kt_, buf_) do { _Pragma("unroll") for (int i = 0; i < NLD; ++i) { \
        __builtin_amdgcn_global_load_lds((const unsigned*)(kg + (size_t)(kt_) * 64 * rs + ksrc[i]), (__attribute__((address_space(3))) unsigned*)((lptr_t)lds_raw + ATT_TILE_OFF + (buf_) * (2 * TILEB) + (wv * 64 + NTHR * i) * 16), 16, 0, 0); \
        __builtin_amdgcn_global_load_lds((const unsigned*)(vg + (size_t)(kt_) * 64 * rs + vsrc[i]), (__attribute__((address_space(3))) unsigned*)((lptr_t)lds_raw + ATT_TILE_OFF + (buf_) * (2 * TILEB) + TILEB + (wv * 64 + NTHR * i) * 16), 16, 0, 0); } } while (0)
    int koff[4];
#pragma unroll
    for (int ks = 0; ks < 4; ++ks) { const int ch = (kmap >> 3) + 2 * ks + hi; const int kch = (W == 64) ? (ch ^ ((l31 >> 1) & 7)) : (ch ^ (l31 & 15)); koff[ks] = l31 * ROWB + kch * 16; }
    int voff[NC];
    { const int q4 = (lane & 15) >> 2, blk = (lane >> 4) & 1, p = lane & 3;
#pragma unroll
      for (int c = 0; c < NC; ++c) { const int ch = 4 * c + 2 * blk + (p >> 1); const int vch = (W == 64) ? (ch ^ (((q4 >> 1) & 1) << 2)) : (ch ^ (q4 << 2));
          voff[c] = (4 * hi + q4) * ROWB + vch * 16 + 8 * (p & 1); } }
    __syncthreads();
    stage_issue(REV ? kt_hi : kt_lo, 0);
    __syncthreads();
    const int ntile = kt_hi - kt_lo + 1;
    for (int it = 0; it < ntile; ++it) {
        const int kt = REV ? kt_hi - it : kt_lo + it, ktn = REV ? kt - 1 : kt + 1;
        const bool has_next = it + 1 < ntile;
        const int buf = it & 1;
        if (has_next) stage_issue(ktn, buf ^ 1);
        const int k0 = kt * 64;
        bool active = (k0 <= qmax);
        if (BAND) active = active && (k0 + 63 >= qmin - WIN);
        if (REV) active = active && !wdone;
        if (active) {
            ldsc_t kb_ = lds + ATT_TILE_OFF + buf * (2 * TILEB); ldsc_t vb_ = kb_ + TILEB;
            f32x16 s0, s1;
            if (MODE == 0) {
                const bool far = !BAND && (qmin - (k0 + 63) >= 1513);
                const int ib = far ? (rmax - 3000) : (rmax - (qrow - k0 - 4 * hi));
                const __attribute__((address_space(3))) float* lp = (const __attribute__((address_space(3))) float*)((lptr_t)lds_raw + ATT_LUT_OFF) + ib;
#pragma unroll
                for (int r = 0; r < 16; ++r) { const int cr = (r & 3) + 8 * (r >> 2); s0[r] = lp[cr]; s1[r] = lp[32 + cr]; }
            } else {
                const f32x4* cp = (const f32x4*)(lut + k0 + 4 * hi);
#pragma unroll
                for (int g = 0; g < 4; ++g) { const f32x4 a = cp[2 * g], b = cp[2 * g + 8];
                    s0[4 * g] = a[0]; s0[4 * g + 1] = a[1]; s0[4 * g + 2] = a[2]; s0[4 * g + 3] = a[3];
                    s1[4 * g] = b[0]; s1[4 * g + 1] = b[1]; s1[4 * g + 2] = b[2]; s1[4 * g + 3] = b[3]; }
            }
#pragma unroll
            for (int ks = 0; ks < 4; ++ks) {
                const bf16x8 k0f = *(const __attribute__((address_space(3))) bf16x8*)(kb_ + koff[ks]);
                const bf16x8 k1f = *(const __attribute__((address_space(3))) bf16x8*)(kb_ + koff[ks] + 32 * ROWB);
                s0 = MFMA32(k0f, qf[ks], s0); s1 = MFMA32(k1f, qf[ks], s1);
            }
            if (MODE == 1) {
                if (k0 + 63 > qmin) {
#pragma unroll
                    for (int r = 0; r < 16; ++r) { const int kv = k0 + 4 * hi + (r & 3) + 8 * (r >> 2); if (kv > qrow) s0[r] = NEG_BIG; if (kv + 32 > qrow) s1[r] = NEG_BIG; }
                }
            }
            float mx;
            { const float a0 = MXX3(s0[0], s0[1], s0[2]), a1 = MXX3(s0[3], s0[4], s0[5]), a2 = MXX3(s0[6], s0[7], s0[8]), a3 = MXX3(s0[9], s0[10], s0[11]), a4 = MXX3(s0[12], s0[13], s0[14]);
              const float b0 = MXX3(s1[0], s1[1], s1[2]), b1 = MXX3(s1[3], s1[4], s1[5]), b2 = MXX3(s1[6], s1[7], s1[8]), b3 = MXX3(s1[9], s1[10], s1[11]), b4 = MXX3(s1[12], s1[13], s1[14]);
              mx = MXX3(MXX3(MXX3(a0, a1, a2), MXX3(a3, a4, s0[15]), MXX3(b0, b1, b2)), MXX3(b3, b4, s1[15]), a0); }
            mx = xhalf_max(mx);
            if (!__all(mx - m <= 8.0f)) {
                const float mn = fmaxf(m, mx), alpha = __builtin_amdgcn_exp2f(m - mn);
                m = mn; l *= alpha;
#pragma unroll
                for (int c = 0; c < NC; ++c)
#pragma unroll
                    for (int r = 0; r < 16; ++r) o[c][r] *= alpha;
            }
            float ls = 0.f;
#pragma unroll
            for (int r = 0; r < 16; ++r) { s0[r] = __builtin_amdgcn_exp2f(s0[r] - m); s1[r] = __builtin_amdgcn_exp2f(s1[r] - m); ls += s0[r] + s1[r]; }
            l += ls;
            bf16x8 pf[2][2];
#pragma unroll
            for (int s_ = 0; s_ < 2; ++s_) {
                typedef unsigned u32x4_t __attribute__((ext_vector_type(4)));
                u32x4_t w0, w1;
                w0[0] = cvtpk(s0[8 * s_ + 0], s0[8 * s_ + 1]); w0[1] = cvtpk(s0[8 * s_ + 2], s0[8 * s_ + 3]); w0[2] = cvtpk(s0[8 * s_ + 4], s0[8 * s_ + 5]); w0[3] = cvtpk(s0[8 * s_ + 6], s0[8 * s_ + 7]);
                w1[0] = cvtpk(s1[8 * s_ + 0], s1[8 * s_ + 1]); w1[1] = cvtpk(s1[8 * s_ + 2], s1[8 * s_ + 3]); w1[2] = cvtpk(s1[8 * s_ + 4], s1[8 * s_ + 5]); w1[3] = cvtpk(s1[8 * s_ + 6], s1[8 * s_ + 7]);
                pf[0][s_] = __builtin_bit_cast(bf16x8, w0); pf[1][s_] = __builtin_bit_cast(bf16x8, w1);
            }
#pragma unroll
            for (int c = 0; c < NC; ++c)
#pragma unroll
                for (int kb = 0; kb < 2; ++kb)
#pragma unroll
                    for (int s_ = 0; s_ < 2; ++s_) {
                        const s16x4 lo = vtr(vb_ + voff[c] + (32 * kb + 16 * s_) * ROWB), hi4 = vtr(vb_ + voff[c] + (32 * kb + 16 * s_ + 8) * ROWB);
                        bf16x8 vf; vf[0] = lo[0]; vf[1] = lo[1]; vf[2] = lo[2]; vf[3] = lo[3]; vf[4] = hi4[0]; vf[5] = hi4[1]; vf[6] = hi4[2]; vf[7] = hi4[3];
                        o[c] = MFMA32(vf, pf[kb][s_], o[c]);
                    }
        }
        if (REV) {
            if (!wdone && has_next) { const float nb = lut[k0 - 1]; wdone = __all((m > -1e29f) && (brow + nb < m - 30.0f)); }
            if (lane == 0) flg[(it & 1) * 8 + (tid >> 6)] = wdone ? 1u : 0u;
        }
        __syncthreads();
        if (REV) { const volatile __attribute__((address_space(3))) unsigned* f = flg + (it & 1) * 8;
            if ((f[0] & f[1] & f[2] & f[3] & f[4] & f[5] & f[6] & f[7]) != 0u) break; }
    }
#undef stage_issue
    const float lt = xhalf_sum(l), inv = 1.0f / lt;
    if (lse_out) *lse_out = m + __log2f(lt);
#pragma unroll
    for (int c = 0; c < NC; ++c)
#pragma unroll
        for (int r = 0; r < 16; ++r) o[c][r] *= inv;
}

template <int NC>
DEV void attn_store(const f32x16 (&o)[NC], bf16_t* orow, int hi) {
#pragma unroll
    for (int c = 0; c < NC; ++c)
#pragma unroll
        for (int g = 0; g < 4; ++g) { uint2 w; w.x = cvtpk(o[c][4 * g], o[c][4 * g + 1]); w.y = cvtpk(o[c][4 * g + 2], o[c][4 * g + 3]);
            *(uint2*)(orow + 32 * c + 8 * g + 4 * hi) = w; }
}

DEV void phase_fox_mfma(const bf16_t* qkv, const float* cloc, const float* ctot, const unsigned* kmax_u, bf16_t* ao, unsigned char* lds_raw, unsigned* qwork) {
    const int tid_ = opaque_tid();
    const int tid = tid_, wid = tid >> 6, lane = tid & 63, l31 = lane & 31, hi = lane >> 5;
    float* nck = (float*)(lds_raw + ATT_LUT_OFF);
    volatile unsigned* qsh = (volatile unsigned*)(lds_raw + ATT_LUT_OFF + 20480 + 128);
    for (;;) {
        const unsigned u = queue_next(qwork, qsh);
        if (u >= 2048u) break;
        const int qblk = 15 - (int)(u >> 7), st = (int)(u & 127), b = st >> 4, h = st & 15;
        const int q0 = qblk * 256, qend = q0 + 255;
        __syncthreads();
        { float coff[8]; float run = 0.f;
#pragma unroll
          for (int j = 0; j < 8; ++j) { coff[j] = run; run += ctot[st * 8 + j]; }
          float cq = 0.f;
#pragma unroll
          for (int j = 0; j < 8; ++j) cq = ((qend >> 9) == j) ? coff[j] : cq;
          const float cref = cloc[(size_t)st * SEQ + qend] + cq;
          for (int i = tid; i <= qend; i += NTHR) { float co = 0.f;
#pragma unroll
              for (int j = 0; j < 8; ++j) co = ((i >> 9) == j) ? coff[j] : co;
              nck[i] = (cref - (cloc[(size_t)st * SEQ + i] + co)) * LOG2E; } }
        const float kbound = __uint_as_float(kmax_u[st]);
        const int qrow = q0 + wid * 32 + l31;
        const size_t tokb = (size_t)b * SEQ;
        f32x16 o[2];
        attn_unit<64, 1, 0>(qkv + (tokb + qrow) * 3072 + h * 64, qkv + tokb * 3072 + 1024 + h * 64, qkv + tokb * 3072 + 2048 + h * 64,
                                0, qend >> 6, qrow, q0 + wid * 32, q0 + wid * 32 + 31, 0, lds_raw, o, kbound);
        attn_store<2>(o, ao + (tokb + qrow) * DM + h * 64, hi);
    }
}

DEV void phase_mix0_mfma(const bf16_t* qkv, const float* rel_bias, const float* lamp, const float* ln_g, bf16_t* ao, bf16_t* dpo, float* dlse, unsigned char* lds_raw, unsigned* qwork) {
    const int tid_ = opaque_tid();
    const int tid = tid_, wid = tid >> 6, lane = tid & 63, l31 = lane & 31, hi = lane >> 5;
    float* lut = (float*)(lds_raw + ATT_LUT_OFF);
    volatile unsigned* qsh = (volatile unsigned*)(lds_raw + ATT_LUT_OFF + 20480 + 128);
    float lam;
    { float s1 = 0.f, s2 = 0.f;
      for (int i = 0; i < 64; ++i) { s1 += lamp[i] * lamp[64 + i]; s2 += lamp[128 + i] * lamp[192 + i]; }
      lam = expf(s1) - expf(s2) + 0.2f; }
    for (;;) {
        const unsigned uq = queue_next(qwork, qsh);
        if (uq >= 1024u + 3072u) break;
      if (uq >= 1024u) {
        const int u = (int)uq - 1024;
        const int st = u & 63, v48 = u >> 6, b = st >> 3, h = st & 7;
        int br, r, iblk;
        if (v48 < 16) { br = 0; r = 0; iblk = 15 - v48; } else if (v48 < 32) { br = 1; r = (v48 - 16) & 3; iblk = 3 - ((v48 - 16) >> 2); } else { br = 2; r = v48 - 32; iblk = 0; }
        const int dl = (br == 0) ? 1 : (br == 1) ? 4 : 16;
        const int q0 = iblk * 256, qend = q0 + 255;
        __syncthreads();
        for (int i = tid; i < 640; i += NTHR) { const int dd = 320 - i; lut[i] = (dd >= 0 && dd <= 128) ? rel_bias[t5_bucket(dl * dd) * 12 + h] * LOG2E : NEG_BIG; }
        const int qrow = q0 + wid * 32 + l31;
        const size_t tokb = (size_t)b * SEQ;
        const int klo = max(q0 - 128, 0) >> 6;
        f32x16 o[2]; float lse;
        attn_unit<64, 0, 128>(qkv + (tokb + r + (size_t)dl * qrow) * 3072 + h * 64, qkv + (tokb + r) * 3072 + 512 + h * 64, qkv + (tokb + r) * 3072 + 1024 + h * 64,
                              klo, qend >> 6, qrow, q0 + wid * 32, q0 + wid * 32 + 31, 0, lds_raw, o, 0.f, dl * 3072, &lse, 320);
        const size_t tok = tokb + r + (size_t)dl * qrow;
        attn_store<2>(o, dpo + ((size_t)br * NT + tok) * 512 + h * 64, hi);
        if (hi == 0) dlse[((size_t)br * NT + tok) * 8 + h] = lse;
      } else {
        const int u = (int)uq;
        const int qblk = 31 - (u >> 5), st = u & 31;
        const int b = st >> 2, hd = st & 3;
        const int q0 = qblk * 128, qend = q0 + 127;
        __syncthreads();
        for (int i = tid; i < 4224; i += NTHR) { const int dist = 4127 - i; lut[i] = (dist >= 0 && dist <= 4095) ? rel_bias[t5_bucket(dist) * 12 + 8 + hd] * LOG2E : NEG_BIG; }
        const int qg_ = wid >> 1, map = wid & 1;
        const int qrow = q0 + qg_ * 32 + l31;
        const size_t tokb = (size_t)b * SEQ;
        f32x16 o[4];
        attn_unit<128, 0, 0>(qkv + (tokb + qrow) * 3072 + 1536 + hd * 128 + map * 64, qkv + tokb * 3072 + 2048 + hd * 128, qkv + tokb * 3072 + 2560 + hd * 128,
                                 0, qend >> 6, qrow, q0 + qg_ * 32, q0 + qg_ * 32 + 31, map * 64, lds_raw, o);
        float* X = (float*)(lds_raw + ATT_TILE_OFF) + qg_ * 4096;
        if (map == 1) {
#pragma unroll
            for (int c = 0; c < 4; ++c)
#pragma unroll
                for (int r = 0; r < 16; ++r) X[(c * 16 + r) * 64 + lane] = lam * o[c][r];
        }
        __syncthreads();
        if (map == 0) {
            float ss = 0.f;
#pragma unroll
            for (int c = 0; c < 4; ++c)
#pragma unroll
                for (int r = 0; r < 16; ++r) { o[c][r] -= X[(c * 16 + r) * 64 + lane]; ss += o[c][r] * o[c][r]; }
            ss = xhalf_sum(ss);
            const float rstd = 0.8f / sqrtf(ss * (1.0f / 128.0f) + 1e-6f);
            bf16_t* orow = ao + (tokb + qrow) * DM + 512 + hd * 128;
#pragma unroll
            for (int c = 0; c < 4; ++c)
#pragma unroll
                for (int g = 0; g < 4; ++g) { const int d0 = 32 * c + 8 * g + 4 * hi; const f32x4 gg = *(const f32x4*)(ln_g + d0);
                    uint2 wv; wv.x = cvtpk(o[c][4 * g] * rstd * gg[0], o[c][4 * g + 1] * rstd * gg[1]); wv.y = cvtpk(o[c][4 * g + 2] * rstd * gg[2], o[c][4 * g + 3] * rstd * gg[3]);
                    *(uint2*)(orow + d0) = wv; }
        }
      }
    }
}

DEV void phase_dilated_naive(const bf16_t* qkv, const float* rel_bias, bf16_t* ao, float* lds, int bid, int nb) {
    const int t = threadIdx.x, wid = t >> 6, lane = t & 63;
    float* lut = lds;
    __syncthreads();
    for (int i = t; i < 8 * 3 * 129; i += NTHR) {
        const int h = i / (3 * 129), r = i % (3 * 129), br = r / 129, n = r % 129;
        const int dl = br == 0 ? 1 : (br == 1 ? 4 : 16);
        lut[(h * 3 + br) * 132 + n] = rel_bias[t5_bucket(dl * n) * 12 + h];
    }
    __syncthreads();
    for (int task = bid * 8 + wid; task < NT * 8; task += nb * 8) {
        const int tok = task >> 3, h = task & 7, b = tok >> 12, pos = tok & 4095;
        const float q = bf2f(qkv[(size_t)tok * 3072 + h * 64 + lane]) * 0.125f;
        float m = -INFINITY, l = 0.f, o = 0.f;
#pragma unroll
        for (int br = 0; br < 3; ++br) {
            const int dl = br == 0 ? 1 : (br == 1 ? 4 : 16);
            const int nvalid = min(128, pos / dl) + 1;
            const float* lb = lut + (h * 3 + br) * 132;
            for (int n0 = 0; n0 < nvalid; n0 += 4) {
                float kv[4], vv[4];
#pragma unroll
                for (int j = 0; j < 4; ++j) {
                    const int key = max(pos - dl * (n0 + j), 0);
                    const size_t base = (size_t)(b * SEQ + key) * 3072 + h * 64 + lane;
                    kv[j] = bf2f(qkv[base + 512]); vv[j] = bf2f(qkv[base + 1024]);
                }
#pragma unroll
                for (int j = 0; j < 4; ++j) {
                    if (n0 + j < nvalid) {
                        const float s = wave_sum(q * kv[j]) + lb[n0 + j];
                        if (s > m) { const float f = __expf(m - s); l *= f; o *= f; m = s; }
                        const float p = __expf(s - m);
                        l += p; o += p * vv[j];
                    }
                }
            }
        }
        ao[(size_t)tok * DM + h * 64 + lane] = f2bf(o / l);
    }
}

DEV void phase_diff_naive(const bf16_t* qkv, const float* rel_bias, const float* lamp, const float* ln_g, bf16_t* ao, float* lds, int bid, int nb) {
    const int t = threadIdx.x;
    float* Ks = lds;
    float* Vs = lds + 8192;
    float* lut = lds + 16384 + 512;
    float* X = lds;
    float lam;
    { float s1 = 0.f, s2 = 0.f;
      for (int i = 0; i < 64; ++i) { s1 += lamp[i] * lamp[64 + i]; s2 += lamp[128 + i] * lamp[192 + i]; }
      lam = expf(s1) - expf(s2) + 0.2f; }
    const int qi = t & 127, map = (t >> 7) & 1, vh = t >> 8;
    for (int unit = bid; unit < 1024; unit += nb) {
        const int qblk = 31 - unit / 32, bh = unit % 32, b = bh >> 2, hd = bh & 3;
        const int qpos = qblk * 128 + qi;
        const size_t tok = (size_t)b * SEQ + qpos;
        __syncthreads();
        for (int i = t; i < 4096; i += NTHR) lut[i] = rel_bias[t5_bucket(i) * 12 + 8 + hd];
        float q[64], o[64];
        { const uint4* qp = (const uint4*)(qkv + tok * 3072 + 1536 + hd * 128 + map * 64);
#pragma unroll
          for (int i = 0; i < 8; ++i) { const uint4 w = qp[i];
              q[i * 8 + 0] = bflo(w.x) * 0.125f; q[i * 8 + 1] = bfhi(w.x) * 0.125f; q[i * 8 + 2] = bflo(w.y) * 0.125f; q[i * 8 + 3] = bfhi(w.y) * 0.125f;
              q[i * 8 + 4] = bflo(w.z) * 0.125f; q[i * 8 + 5] = bfhi(w.z) * 0.125f; q[i * 8 + 6] = bflo(w.w) * 0.125f; q[i * 8 + 7] = bfhi(w.w) * 0.125f; } }
#pragma unroll
        for (int d = 0; d < 64; ++d) o[d] = 0.f;
        float m = -INFINITY, l = 0.f;
        const int nkt = 2 * qblk + 2;
        for (int kt = 0; kt < nkt; ++kt) {
            __syncthreads();
#pragma unroll
            for (int i = 0; i < 2; ++i) {
                const int e = (t + i * NTHR) * 8, j = e >> 7, d0 = e & 127;
                const size_t base = ((size_t)b * SEQ + kt * 64 + j) * 3072 + hd * 128 + d0;
                const uint4 kw = *(const uint4*)(qkv + base + 2048), vw = *(const uint4*)(qkv + base + 2560);
                float* kd = Ks + j * 128 + d0; float* vd = Vs + j * 128 + d0;
                kd[0] = bflo(kw.x); kd[1] = bfhi(kw.x); kd[2] = bflo(kw.y); kd[3] = bfhi(kw.y); kd[4] = bflo(kw.z); kd[5] = bfhi(kw.z); kd[6] = bflo(kw.w); kd[7] = bfhi(kw.w);
                vd[0] = bflo(vw.x); vd[1] = bfhi(vw.x); vd[2] = bflo(vw.y); vd[3] = bfhi(vw.y); vd[4] = bflo(vw.z); vd[5] = bfhi(vw.z); vd[6] = bflo(vw.w); vd[7] = bfhi(vw.w);
            }
            __syncthreads();
            for (int j = 0; j < 64; ++j) {
                const int key = kt * 64 + j;
                if (key <= qpos) {
                    const float4* kr = (const float4*)(Ks + j * 128 + map * 64);
                    float s = 0.f;
#pragma unroll
                    for (int d4 = 0; d4 < 16; ++d4) { const float4 kk = kr[d4]; s += q[d4 * 4] * kk.x + q[d4 * 4 + 1] * kk.y + q[d4 * 4 + 2] * kk.z + q[d4 * 4 + 3] * kk.w; }
                    s += lut[qpos - key];
                    if (s > m) { const float f = __expf(m - s); l *= f;
#pragma unroll
                        for (int d = 0; d < 64; ++d) o[d] *= f;
                        m = s; }
                    const float p = __expf(s - m);
                    l += p;
                    const float4* vr = (const float4*)(Vs + j * 128 + vh * 64);
#pragma unroll
                    for (int d4 = 0; d4 < 16; ++d4) { const float4 vv = vr[d4]; o[d4 * 4] += p * vv.x; o[d4 * 4 + 1] += p * vv.y; o[d4 * 4 + 2] += p * vv.z; o[d4 * 4 + 3] += p * vv.w; }
                }
            }
        }
        const float inv = 1.0f / l;
        __syncthreads();
        if (map == 1) {
#pragma unroll
            for (int d = 0; d < 64; ++d) X[qi * 129 + vh * 64 + d] = lam * o[d] * inv;
        }
        __syncthreads();
        if (map == 0) {
#pragma unroll
            for (int d = 0; d < 64; ++d) X[qi * 129 + vh * 64 + d] = o[d] * inv - X[qi * 129 + vh * 64 + d];
        }
        __syncthreads();
        {
            const int qq = t >> 2, part = t & 3;
            float ss = 0.f;
            for (int i = 0; i < 32; ++i) { const float v = X[qq * 129 + part * 32 + i]; ss += v * v; }
            ss += __shfl_xor(ss, 1); ss += __shfl_xor(ss, 2);
            const float rstd = 1.0f / sqrtf(ss * (1.0f / 128.0f) + 1e-6f);
            const size_t tk = (size_t)b * SEQ + qblk * 128 + qq;
            for (int i = 0; i < 32; ++i) { const int v = part * 32 + i;
                ao[tk * DM + 512 + hd * 128 + v] = f2bf(X[qq * 129 + v] * rstd * ln_g[v] * 0.8f); }
        }
    }
}

DEV void phase_dilated_merge(const bf16_t* dpo, const float* dlse, bf16_t* ao, int bid, int nb) {
    const int tid_ = opaque_tid();
    const int wid = tid_ >> 6, lane = tid_ & 63, h = lane >> 3;
    for (int tok = bid * 8 + wid; tok < NT; tok += nb * 8) {
        float ls[3]; uint4 ov[3];
#pragma unroll
        for (int br = 0; br < 3; ++br) { ls[br] = dlse[((size_t)br * NT + tok) * 8 + h]; ov[br] = *(const uint4*)(dpo + ((size_t)br * NT + tok) * 512 + lane * 8); }
        const float mx = fmaxf(fmaxf(ls[0], ls[1]), ls[2]);
        float w[3]; float sum = 0.f;
#pragma unroll
        for (int br = 0; br < 3; ++br) { w[br] = __builtin_amdgcn_exp2f(ls[br] - mx); sum += w[br]; }
        const float inv = 1.0f / sum;
        float acc[8];
#pragma unroll
        for (int i = 0; i < 8; ++i) acc[i] = 0.f;
#pragma unroll
        for (int br = 0; br < 3; ++br) { const float ww = w[br] * inv;
            acc[0] += ww * bflo(ov[br].x); acc[1] += ww * bfhi(ov[br].x); acc[2] += ww * bflo(ov[br].y); acc[3] += ww * bfhi(ov[br].y);
            acc[4] += ww * bflo(ov[br].z); acc[5] += ww * bfhi(ov[br].z); acc[6] += ww * bflo(ov[br].w); acc[7] += ww * bfhi(ov[br].w); }
        uint4 o; o.x = pk2(acc[0], acc[1]); o.y = pk2(acc[2], acc[3]); o.z = pk2(acc[4], acc[5]); o.w = pk2(acc[6], acc[7]);
        *(uint4*)(ao + (size_t)tok * DM + lane * 8) = o;
    }
}

DEV void phase_cumsum(const float* fg, const bf16_t* qkv, float* cloc, float* ctot, unsigned* kmax_u, int bid, int nb) {
    const int tid_ = opaque_tid();
    const int wid = tid_ >> 6, lane = tid_ & 63;
    for (int task = bid * 8 + wid; task < 1024; task += nb * 8) {
        const int bh = task >> 3, chunk = task & 7, b = bh >> 4, h = bh & 15;
        float carry = 0.f, kmx = 0.f;
        for (int s0 = chunk * 512; s0 < chunk * 512 + 512; s0 += 64) {
            const size_t tok = (size_t)b * SEQ + s0 + lane;
            const float xv = fg[tok * 16 + h];
            float v = fminf(xv, 0.f) - log1pf(expf(-fabsf(xv)));
#pragma unroll
            for (int o = 1; o < 64; o <<= 1) { const float u = __shfl_up(v, o); if (lane >= o) v += u; }
            v += carry;
            cloc[(size_t)bh * SEQ + s0 + lane] = v;
            carry = __shfl(v, 63);
            const uint4* kp = (const uint4*)(qkv + tok * 3072 + 1024 + h * 64);
            float ss = 0.f;
#pragma unroll
            for (int i = 0; i < 8; ++i) { const uint4 w = kp[i];
                ss += bflo(w.x) * bflo(w.x) + bfhi(w.x) * bfhi(w.x) + bflo(w.y) * bflo(w.y) + bfhi(w.y) * bfhi(w.y) + bflo(w.z) * bflo(w.z) + bfhi(w.z) * bfhi(w.z) + bflo(w.w) * bflo(w.w) + bfhi(w.w) * bfhi(w.w); }
            kmx = fmaxf(kmx, ss);
        }
        kmx = wave_max(kmx);
        if (lane == 0) { ctot[bh * 8 + chunk] = carry; atomicMax(kmax_u + bh, __float_as_uint(sqrtf(kmx) * 1.0001f)); }
    }
}

DEV void phase_fox_naive(const bf16_t* qkv, const float* carr, bf16_t* ao, float* lds, int bid, int nb) {
    const int t = threadIdx.x;
    float* Ks = lds;
    float* Vs = lds + 4096;
    float* cks = lds + 8192;
    for (int unit = bid; unit < 1024; unit += nb) {
        const int qblk = 7 - unit / 128, bh = unit % 128, b = bh >> 4, h = bh & 15;
        const int qpos = qblk * 512 + t;
        const size_t tok = (size_t)b * SEQ + qpos;
        float q[64], o[64];
        { const uint4* qp = (const uint4*)(qkv + tok * 3072 + h * 64);
#pragma unroll
          for (int i = 0; i < 8; ++i) { const uint4 w = qp[i];
              q[i * 8 + 0] = bflo(w.x) * 0.125f; q[i * 8 + 1] = bfhi(w.x) * 0.125f; q[i * 8 + 2] = bflo(w.y) * 0.125f; q[i * 8 + 3] = bfhi(w.y) * 0.125f;
              q[i * 8 + 4] = bflo(w.z) * 0.125f; q[i * 8 + 5] = bfhi(w.z) * 0.125f; q[i * 8 + 6] = bflo(w.w) * 0.125f; q[i * 8 + 7] = bfhi(w.w) * 0.125f; } }
#pragma unroll
        for (int d = 0; d < 64; ++d) o[d] = 0.f;
        const float cq = carr[(size_t)bh * SEQ + qpos];
        float m = -INFINITY, l = 0.f;
        const int nkt = (qblk + 1) * 8;
        for (int kt = 0; kt < nkt; ++kt) {
            __syncthreads();
            {
                const int e = t * 8, j = e >> 6, d0 = e & 63;
                const size_t base = ((size_t)b * SEQ + kt * 64 + j) * 3072 + h * 64 + d0;
                const uint4 kw = *(const uint4*)(qkv + base + 1024), vw = *(const uint4*)(qkv + base + 2048);
                float* kd = Ks + j * 64 + d0; float* vd = Vs + j * 64 + d0;
                kd[0] = bflo(kw.x); kd[1] = bfhi(kw.x); kd[2] = bflo(kw.y); kd[3] = bfhi(kw.y); kd[4] = bflo(kw.z); kd[5] = bfhi(kw.z); kd[6] = bflo(kw.w); kd[7] = bfhi(kw.w);
                vd[0] = bflo(vw.x); vd[1] = bfhi(vw.x); vd[2] = bflo(vw.y); vd[3] = bfhi(vw.y); vd[4] = bflo(vw.z); vd[5] = bfhi(vw.z); vd[6] = bflo(vw.w); vd[7] = bfhi(vw.w);
                if (t < 64) cks[t] = carr[(size_t)bh * SEQ + kt * 64 + t];
            }
            __syncthreads();
            for (int j = 0; j < 64; ++j) {
                const int key = kt * 64 + j;
                if (key <= qpos) {
                    const float4* kr = (const float4*)(Ks + j * 64);
                    float s = 0.f;
#pragma unroll
                    for (int d4 = 0; d4 < 16; ++d4) { const float4 kk = kr[d4]; s += q[d4 * 4] * kk.x + q[d4 * 4 + 1] * kk.y + q[d4 * 4 + 2] * kk.z + q[d4 * 4 + 3] * kk.w; }
                    s += cq - cks[j];
                    if (s > m) { const float f = __expf(m - s); l *= f;
#pragma unroll
                        for (int d = 0; d < 64; ++d) o[d] *= f;
                        m = s; }
                    const float p = __expf(s - m);
                    l += p;
                    const float4* vr = (const float4*)(Vs + j * 64);
#pragma unroll
                    for (int d4 = 0; d4 < 16; ++d4) { const float4 vv = vr[d4]; o[d4 * 4] += p * vv.x; o[d4 * 4 + 1] += p * vv.y; o[d4 * 4 + 2] += p * vv.z; o[d4 * 4 + 3] += p * vv.w; }
                }
            }
        }
        const float inv = 1.0f / l;
        uint4* op = (uint4*)(ao + tok * DM + h * 64);
#pragma unroll
        for (int i = 0; i < 8; ++i) { uint4 w; w.x = pk2(o[i * 8] * inv, o[i * 8 + 1] * inv); w.y = pk2(o[i * 8 + 2] * inv, o[i * 8 + 3] * inv);
            w.z = pk2(o[i * 8 + 4] * inv, o[i * 8 + 5] * inv); w.w = pk2(o[i * 8 + 6] * inv, o[i * 8 + 7] * inv); op[i] = w; }
    }
}

DEV void wave_argmax(float& bv, int& bi) {
#pragma unroll
    for (int o = 32; o >= 1; o >>= 1) {
        const float ov = __shfl_xor(bv, o); const int oi = __shfl_xor(bi, o);
        if (ov > bv || (ov == bv && oi < bi)) { bv = ov; bi = oi; }
    }
}
DEV void phase_topk_naive(const bf16_t* pq, const bf16_t* sk, int* idx_out, float* gate_out, float* lds, int bid, int nb) {
    const int wid = threadIdx.x >> 6, lane = threadIdx.x & 63;
    float* wq = lds + wid * 320;
    float* wts = wq + 256;
    int* wti = (int*)(wq + 288);
    for (int task = bid * 8 + wid; task < NT * 8; task += nb * 8) {
        const int tok = task >> 3, h = task & 7;
        lds_fence();
        { const uint2 r = *(const uint2*)(pq + (size_t)tok * 2048 + h * 256 + lane * 4);
          wq[lane * 4 + 0] = bflo(r.x); wq[lane * 4 + 1] = bfhi(r.x); wq[lane * 4 + 2] = bflo(r.y); wq[lane * 4 + 3] = bfhi(r.y); }
        lds_fence();
#pragma unroll 1
        for (int c = 0; c < 2; ++c) {
            float v0, v1;
            const float* qq = wq + c * 128;
            {
                const uint4* row = (const uint4*)(sk + ((size_t)(h * 2 + c) * 128 + lane) * 128);
                float s = 0.f;
#pragma unroll
                for (int i = 0; i < 16; ++i) { const uint4 w = row[i];
                    s += qq[i * 8] * bflo(w.x) + qq[i * 8 + 1] * bfhi(w.x) + qq[i * 8 + 2] * bflo(w.y) + qq[i * 8 + 3] * bfhi(w.y)
                       + qq[i * 8 + 4] * bflo(w.z) + qq[i * 8 + 5] * bfhi(w.z) + qq[i * 8 + 6] * bflo(w.w) + qq[i * 8 + 7] * bfhi(w.w); }
                v0 = s;
            }
            asm volatile("" : "+v"(v0) :: "memory");
            {
                const uint4* row = (const uint4*)(sk + ((size_t)(h * 2 + c) * 128 + lane + 64) * 128);
                float s = 0.f;
#pragma unroll
                for (int i = 0; i < 16; ++i) { const uint4 w = row[i];
                    s += qq[i * 8] * bflo(w.x) + qq[i * 8 + 1] * bfhi(w.x) + qq[i * 8 + 2] * bflo(w.y) + qq[i * 8 + 3] * bfhi(w.y)
                       + qq[i * 8 + 4] * bflo(w.z) + qq[i * 8 + 5] * bfhi(w.z) + qq[i * 8 + 6] * bflo(w.w) + qq[i * 8 + 7] * bfhi(w.w); }
                v1 = s;
            }
            asm volatile("" : "+v"(v1) :: "memory");
            float ts = 0.f; int ti = 0;
            for (int r = 0; r < 16; ++r) {
                float bv; int bi;
                if (v1 > v0) { bv = v1; bi = lane + 64; } else { bv = v0; bi = lane; }
                wave_argmax(bv, bi);
                if (lane == r) { ts = bv; ti = bi; }
                if (bi == lane) v0 = -INFINITY;
                if (bi == lane + 64) v1 = -INFINITY;
            }
            if (lane < 16) { wts[c * 16 + lane] = ts; wti[c * 16 + lane] = ti; }
        }
        lds_fence();
        float cs[4];
#pragma unroll
        for (int jj = 0; jj < 4; ++jj) { const int j = lane * 4 + jj; cs[jj] = wts[j >> 4] + wts[16 + (j & 15)]; }
        float bs = 0.f; int be = 0;
        for (int r = 0; r < 16; ++r) {
            float bv = cs[0]; int bi = lane * 4;
#pragma unroll
            for (int jj = 1; jj < 4; ++jj) if (cs[jj] > bv) { bv = cs[jj]; bi = lane * 4 + jj; }
            wave_argmax(bv, bi);
            if (lane == r) { bs = bv; be = wti[bi >> 4] * 128 + wti[16 + (bi & 15)]; }
#pragma unroll
            for (int jj = 0; jj < 4; ++jj) if (bi == lane * 4 + jj) cs[jj] = -INFINITY;
        }
        float mv = lane < 16 ? bs : -INFINITY;
        mv = wave_max(mv);
        float e = lane < 16 ? __expf(bs - mv) : 0.f;
        const float sum = wave_sum(e);
        if (lane < 16) { idx_out[(size_t)tok * 128 + h * 16 + lane] = be; gate_out[(size_t)tok * 128 + h * 16 + lane] = e / sum; }
    }
}

struct PairTab { int a[50], b[50]; };
constexpr PairTab make_pairs() { PairTab t{}; int n = 0; for (int a = 0; a < 16; ++a) for (int b = 0; b < 16; ++b) if ((a + 1) * (b + 1) <= 16) { t.a[n] = a; t.b[n] = b; ++n; } return t; }
constexpr PairTab PAIRS = make_pairs();
#define MX3(a, b, c) __builtin_fmaxf(__builtin_fmaxf((a), (b)), (c))
DEV unsigned xhalf_or(unsigned v) { auto rr = __builtin_amdgcn_permlane32_swap(v, v, false, false); return rr[0] | rr[1]; }
template <int J, int N, class T> DEV void bstage(T& v, const int k) {
#pragma clang loop unroll(full)
    for (int i = 0; i < N; ++i) { const int l = i ^ J; if (l > i) { const bool d = ((i & k) == 0); const float hi_ = fmaxf(v[i], v[l]), lo_ = fminf(v[i], v[l]); v[i] = d ? hi_ : lo_; v[l] = d ? lo_ : hi_; } }
}
template <int N, class T> DEV void bmerge_desc(T& v) {
    if constexpr (N >= 32) bstage<16, N>(v, N);
    if constexpr (N >= 16) bstage<8, N>(v, N);
    bstage<4, N>(v, N); bstage<2, N>(v, N); bstage<1, N>(v, N);
}
template <int N, class T> DEV void bsort_desc(T& v) {
    bstage<1, N>(v, 2);
    bstage<2, N>(v, 4); bstage<1, N>(v, 4);
    bstage<4, N>(v, 8); bstage<2, N>(v, 8); bstage<1, N>(v, 8);
    bstage<8, N>(v, 16); bstage<4, N>(v, 16); bstage<2, N>(v, 16); bstage<1, N>(v, 16);
    if constexpr (N >= 32) { bstage<16, N>(v, 32); bstage<8, N>(v, 32); bstage<4, N>(v, 32); bstage<2, N>(v, 32); bstage<1, N>(v, 32); }
}
template <class T> DEV void merge_top16(T& a, const T& b) {
#pragma unroll
    for (int i = 0; i < 16; ++i) a[i] = fmaxf(a[i], b[15 - i]);
    bmerge_desc<16>(a);
}
DEV float xhalf_other(float v, int hi) { auto rr = __builtin_amdgcn_permlane32_swap(__float_as_uint(v), __float_as_uint(v), false, false); return __uint_as_float(hi ? rr[0] : rr[1]); }
DEV void phase_topk_mfma(const bf16_t* pq, const bf16_t* skl, const float* uinv, const float* vinv, int* idx_out, float* gate_out, float* usc_out, unsigned char* lds_raw, int bid, int nb) {
    int tid = threadIdx.x; asm volatile("" : "+v"(tid));
    const int wid = tid >> 6, lane = tid & 63, l31 = lane & 31, hi = lane >> 5;
    ldsc_t lds = (ldsc_t)lds_raw;
    int cur_h = -1;
    for (int u = bid; u < 1024; u += nb) {
        const int h = u & 7, tg = u >> 3;
        if (h != cur_h) {
            __syncthreads();
#pragma unroll
            for (int i = 0; i < 8; ++i) { const int id = tid + NTHR * i, crow_ = id >> 4, ch = id & 15;
                const uint4 v = *(const uint4*)(skl + ((size_t)h * 256 + crow_) * 128 + ch * 8);
                *(uint4*)(lds_raw + crow_ * 256 + ((ch ^ (crow_ & 15)) * 16)) = v; }
            __syncthreads();
            cur_h = h;
        }
        const int tok = tg * 256 + wid * 32 + l31;
        const bf16_t* qp = pq + (size_t)tok * 2048 + h * 256;
        __attribute__((address_space(3))) unsigned* nt = (__attribute__((address_space(3))) unsigned*)((lptr_t)lds_raw + 65536 + wid * 8192 + l31 * 256);
#pragma unroll
        for (int c = 0; c < 2; ++c) {
            f32x16 acc[4];
#pragma unroll
            for (int kb = 0; kb < 4; ++kb)
#pragma unroll
                for (int r = 0; r < 16; ++r) acc[kb][r] = 0.f;
#pragma unroll
            for (int ks = 0; ks < 8; ++ks) {
                const bf16x8 qf = *(const bf16x8*)(qp + c * 128 + ks * 16 + hi * 8);
#pragma unroll
                for (int kb = 0; kb < 4; ++kb) {
                    const int row = c * 128 + 32 * kb + l31, ch = 2 * ks + hi;
                    const bf16x8 af = *(const __attribute__((address_space(3))) bf16x8*)(lds + row * 256 + ((ch ^ (l31 & 15)) * 16));
                    acc[kb] = MFMA32(af, qf, acc[kb]);
                }
            }
#pragma unroll
            for (int kb = 0; kb < 4; ++kb)
#pragma unroll
                for (int r = 0; r < 16; ++r) { const unsigned n = 32u * kb + (r & 3) + 8 * (r >> 2) + 4u * hi;
                    acc[kb][r] = __uint_as_float((__float_as_uint(acc[kb][r]) & ~127u) | n); }
            bsort_desc<16>(acc[0]); bsort_desc<16>(acc[1]); bsort_desc<16>(acc[2]); bsort_desc<16>(acc[3]);
            merge_top16(acc[0], acc[1]); merge_top16(acc[2], acc[3]); merge_top16(acc[0], acc[2]);
            { float t_[16];
#pragma unroll
              for (int i = 0; i < 16; ++i) t_[i] = fmaxf(acc[0][i], xhalf_other(acc[0][15 - i], hi));
              bmerge_desc<16>(t_);
#pragma unroll
              for (int i = 0; i < 16; ++i) nt[c * 16 + i] = __float_as_uint(t_[i]); }
        }
        lds_fence();
        float cs[32];
#pragma unroll
        for (int i = 0; i < 25; ++i) {
            const int ai = hi ? PAIRS.a[2 * i + 1] : PAIRS.a[2 * i], bi = hi ? PAIRS.b[2 * i + 1] : PAIRS.b[2 * i];
            const float sum = __uint_as_float(nt[ai]) + __uint_as_float(nt[16 + bi]);
            cs[i] = __uint_as_float((__float_as_uint(sum) & ~255u) | (unsigned)(ai * 16 + bi));
        }
#pragma unroll
        for (int i = 25; i < 32; ++i) cs[i] = -INFINITY;
        bsort_desc<32>(cs);
        float bs[16];
#pragma unroll
        for (int i = 0; i < 16; ++i) bs[i] = fmaxf(cs[i], xhalf_other(cs[15 - i], hi));
        bmerge_desc<16>(bs);
        unsigned be8[8]; float bs8[8];
#pragma unroll
        for (int i = 0; i < 16; ++i) (nt + 32 + 64 * 0)[i + 0] = __float_as_uint(bs[i]);
        lds_fence();
#pragma unroll
        for (int j = 0; j < 8; ++j) { const float w_ = __uint_as_float(nt[32 + 8 * hi + j]); const unsigned tg = __float_as_uint(w_) & 255u; bs8[j] = w_;
            be8[j] = (nt[tg >> 4] & 127u) * 128u + (nt[16 + (tg & 15u)] & 127u); }
        float sum = 0.f; const float bmax = bs[0];
#pragma unroll
        for (int rd = 0; rd < 16; ++rd) sum += __builtin_amdgcn_exp2f((bs[rd] - bmax) * LOG2E);
        const float inv = 1.0f / sum;
        uint4 i0, i1; float4 g0, g1;
        i0.x = be8[0]; i0.y = be8[1]; i0.z = be8[2]; i0.w = be8[3]; i1.x = be8[4]; i1.y = be8[5]; i1.z = be8[6]; i1.w = be8[7];
        g0.x = __builtin_amdgcn_exp2f((bs8[0] - bmax) * LOG2E) * inv; g0.y = __builtin_amdgcn_exp2f((bs8[1] - bmax) * LOG2E) * inv; g0.z = __builtin_amdgcn_exp2f((bs8[2] - bmax) * LOG2E) * inv; g0.w = __builtin_amdgcn_exp2f((bs8[3] - bmax) * LOG2E) * inv;
        g1.x = __builtin_amdgcn_exp2f((bs8[4] - bmax) * LOG2E) * inv; g1.y = __builtin_amdgcn_exp2f((bs8[5] - bmax) * LOG2E) * inv; g1.z = __builtin_amdgcn_exp2f((bs8[6] - bmax) * LOG2E) * inv; g1.w = __builtin_amdgcn_exp2f((bs8[7] - bmax) * LOG2E) * inv;
        float4 s0, s1;
        s0.x = uinv[i0.x]; s0.y = uinv[i0.y]; s0.z = uinv[i0.z]; s0.w = uinv[i0.w]; s1.x = uinv[i1.x]; s1.y = uinv[i1.y]; s1.z = uinv[i1.z]; s1.w = uinv[i1.w];
        g0.x *= vinv[i0.x]; g0.y *= vinv[i0.y]; g0.z *= vinv[i0.z]; g0.w *= vinv[i0.w]; g1.x *= vinv[i1.x]; g1.y *= vinv[i1.y]; g1.z *= vinv[i1.z]; g1.w *= vinv[i1.w];
        uint4* ip = (uint4*)(idx_out + (size_t)tok * 128 + h * 16 + 8 * hi); ip[0] = i0; ip[1] = i1;
        float4* gp = (float4*)(gate_out + (size_t)tok * 128 + h * 16 + 8 * hi); gp[0] = g0; gp[1] = g1;
        float4* sp = (float4*)(usc_out + (size_t)tok * 128 + h * 16 + 8 * hi); sp[0] = s0; sp[1] = s1;
    }
}

typedef __bf16 bf16x2_t __attribute__((ext_vector_type(2)));
DEV float dot2bf(unsigned a, unsigned b, float acc) { return __builtin_amdgcn_fdot2_f32_bf16(__builtin_bit_cast(bf16x2_t, a), __builtin_bit_cast(bf16x2_t, b), acc, false); }
DEV float gelu_as(float v) {
    const float av = fabsf(v), t = __builtin_amdgcn_rcpf(av * 0.2316418882f + 1.0f);
    float q = t * 0.5307027145f + (-0.7265760135f); q = q * t + 0.7107068705f; q = q * t + (-0.142248368f); q = q * t + 0.127414796f; q = q * t;
    const float e = __builtin_amdgcn_exp2f((v * v) * (-0.72134752044f));
    const float m = v * (q * e);
    return v < 0.f ? m : v - m;
}
DEV void phase_expert_v2(const bf16_t* hn, const bf16_t* ut, const bf16_t* vt, const int* idx, const float* gate, float* xres, int bid, int nb, float oscale = 1.0f) {
    const int wid = threadIdx.x >> 6, lane = threadIdx.x & 63;
    for (int tok = bid * 8 + wid; tok < NT; tok += nb * 8) {
        const uint4 h0 = *(const uint4*)(hn + (size_t)tok * DM + lane * 8), h1 = *(const uint4*)(hn + (size_t)tok * DM + 512 + lane * 8);
        float acc[16];
#pragma unroll
        for (int i = 0; i < 16; ++i) acc[i] = 0.f;
        uint4 uA[4][2], vA[4][2], uB[4][2], vB[4][2];
#define XLOAD(U, V, k_) do { _Pragma("unroll") for (int j = 0; j < 4; ++j) { const int e_ = __builtin_amdgcn_readfirstlane(idx[(size_t)tok * 128 + (k_) + j]); \
            const bf16_t* up = ut + (size_t)e_ * DM + lane * 8; const bf16_t* vp = vt + (size_t)e_ * DM + lane * 8; \
            U[j][0] = *(const uint4*)up; U[j][1] = *(const uint4*)(up + 512); V[j][0] = *(const uint4*)vp; V[j][1] = *(const uint4*)(vp + 512); } } while (0)
#define XCOMP(U, V, k_) do { float d_[4]; \
        _Pragma("unroll") for (int j = 0; j < 4; ++j) { float d = 0.f; \
            d = dot2bf(U[j][0].x, h0.x, d); d = dot2bf(U[j][0].y, h0.y, d); d = dot2bf(U[j][0].z, h0.z, d); d = dot2bf(U[j][0].w, h0.w, d); \
            d = dot2bf(U[j][1].x, h1.x, d); d = dot2bf(U[j][1].y, h1.y, d); d = dot2bf(U[j][1].z, h1.z, d); d = dot2bf(U[j][1].w, h1.w, d); d_[j] = d; } \
        { const bool b0 = lane & 1, b1 = lane & 2; \
          float x0 = b0 ? d_[1] : d_[0], y0 = b0 ? d_[0] : d_[1], x1 = b0 ? d_[3] : d_[2], y1 = b0 ? d_[2] : d_[3]; \
          x0 += __shfl_xor(y0, 1); x1 += __shfl_xor(y1, 1);                   \
          float x = b1 ? x1 : x0, y = b1 ? x0 : x1; x += __shfl_xor(y, 2);      \
          x += __shfl_xor(x, 4); x += __shfl_xor(x, 8); x += __shfl_xor(x, 16); x += __shfl_xor(x, 32); \
          const float wl = gelu_as(x) * gate[(size_t)tok * 128 + (k_) + (lane & 3)]; \
          _Pragma("unroll") for (int j = 0; j < 4; ++j) { const float w = __uint_as_float(__builtin_amdgcn_readlane(__float_as_uint(wl), j)); \
              acc[0] += w * bflo(V[j][0].x); acc[1] += w * bfhi(V[j][0].x); acc[2] += w * bflo(V[j][0].y); acc[3] += w * bfhi(V[j][0].y); \
              acc[4] += w * bflo(V[j][0].z); acc[5] += w * bfhi(V[j][0].z); acc[6] += w * bflo(V[j][0].w); acc[7] += w * bfhi(V[j][0].w); \
              acc[8] += w * bflo(V[j][1].x); acc[9] += w * bfhi(V[j][1].x); acc[10] += w * bflo(V[j][1].y); acc[11] += w * bfhi(V[j][1].y); \
              acc[12] += w * bflo(V[j][1].z); acc[13] += w * bfhi(V[j][1].z); acc[14] += w * bflo(V[j][1].w); acc[15] += w * bfhi(V[j][1].w); } } } while (0)
        XLOAD(uA, vA, 0);
#pragma unroll 1
        for (int k0 = 0; k0 < 128; k0 += 8) {
            XLOAD(uB, vB, k0 + 4);
            XCOMP(uA, vA, k0);
            if (k0 + 8 < 128) XLOAD(uA, vA, k0 + 8);
            XCOMP(uB, vB, k0 + 4);
        }
#undef XLOAD
#undef XCOMP
        float4* p0 = (float4*)(xres + (size_t)tok * DM + lane * 8); float4* p1 = (float4*)(xres + (size_t)tok * DM + 512 + lane * 8);
        float4 a = p0[0], b = p0[1], c = p1[0], d = p1[1];
        a.x += oscale * acc[0]; a.y += oscale * acc[1]; a.z += oscale * acc[2]; a.w += oscale * acc[3]; b.x += oscale * acc[4]; b.y += oscale * acc[5]; b.z += oscale * acc[6]; b.w += oscale * acc[7];
        c.x += oscale * acc[8]; c.y += oscale * acc[9]; c.z += oscale * acc[10]; c.w += oscale * acc[11]; d.x += oscale * acc[12]; d.y += oscale * acc[13]; d.z += oscale * acc[14]; d.w += oscale * acc[15];
        p0[0] = a; p0[1] = b; p1[0] = c; p1[1] = d;
    }
}

typedef float f32x2_t __attribute__((ext_vector_type(2)));
#define FP8LO(w) __builtin_amdgcn_cvt_pk_f32_fp8((int)(w), false)
#define FP8HI(w) __builtin_amdgcn_cvt_pk_f32_fp8((int)(w), true)
DEV float dot16_fp8(const uint4 u, const float (&h)[16]) {
    float d = 0.f; f32x2_t a;
    a = FP8LO(u.x); d += a[0] * h[0] + a[1] * h[1]; a = FP8HI(u.x); d += a[0] * h[2] + a[1] * h[3];
    a = FP8LO(u.y); d += a[0] * h[4] + a[1] * h[5]; a = FP8HI(u.y); d += a[0] * h[6] + a[1] * h[7];
    a = FP8LO(u.z); d += a[0] * h[8] + a[1] * h[9]; a = FP8HI(u.z); d += a[0] * h[10] + a[1] * h[11];
    a = FP8LO(u.w); d += a[0] * h[12] + a[1] * h[13]; a = FP8HI(u.w); d += a[0] * h[14] + a[1] * h[15];
    return d;
}
#define PIN4(u) asm volatile("" : "+v"((u).x), "+v"((u).y), "+v"((u).z), "+v"((u).w))
DEV void fma16_fp8(const uint4 v, const float w, float (&acc)[16]) {
    f32x2_t a;
    a = FP8LO(v.x); acc[0] += w * a[0]; acc[1] += w * a[1]; a = FP8HI(v.x); acc[2] += w * a[0]; acc[3] += w * a[1];
    a = FP8LO(v.y); acc[4] += w * a[0]; acc[5] += w * a[1]; a = FP8HI(v.y); acc[6] += w * a[0]; acc[7] += w * a[1];
    a = FP8LO(v.z); acc[8] += w * a[0]; acc[9] += w * a[1]; a = FP8HI(v.z); acc[10] += w * a[0]; acc[11] += w * a[1];
    a = FP8LO(v.w); acc[12] += w * a[0]; acc[13] += w * a[1]; a = FP8HI(v.w); acc[14] += w * a[0]; acc[15] += w * a[1];
}
template <int CTRL> DEV float dppf(float x) { return __builtin_bit_cast(float, __builtin_amdgcn_mov_dpp(__builtin_bit_cast(int, x), CTRL, 0xf, 0xf, true)); }
DEV float x1632_sum(float x) {
    auto s = __builtin_amdgcn_permlane16_swap(__float_as_uint(x), __float_as_uint(x), false, false);
    x = __uint_as_float(s[0]) + __uint_as_float(s[1]);
    auto t = __builtin_amdgcn_permlane32_swap(__float_as_uint(x), __float_as_uint(x), false, false);
    return __uint_as_float(t[0]) + __uint_as_float(t[1]);
}
DEV void phase_expert_v3(const bf16_t* hn, const unsigned char* ut, const unsigned char* vt, const int* idx, const float* gate, const float* usc, float* xres, int bid, int nb, float oscale = 1.0f) {
    constexpr int XOR1 = 0xB1, XOR2 = 0x4E, ROR4 = 0x124, ROR8 = 0x128;
    int tid = threadIdx.x; asm volatile("" : "+v"(tid));
    const unsigned wid = tid >> 6, lane = tid & 63;
    const bool b0 = lane & 1, b1 = lane & 2, b2 = lane & 4;
    for (unsigned tok = bid * 8 + wid; tok < (unsigned)NT; tok += nb * 8) {
        float hf[16], acc[16];
        { const uint4* hp = (const uint4*)((const char*)hn + (tok * 2048u + lane * 32u)); const uint4 h0 = hp[0], h1 = hp[1];
          hf[0] = bflo(h0.x); hf[1] = bfhi(h0.x); hf[2] = bflo(h0.y); hf[3] = bfhi(h0.y); hf[4] = bflo(h0.z); hf[5] = bfhi(h0.z); hf[6] = bflo(h0.w); hf[7] = bfhi(h0.w);
          hf[8] = bflo(h1.x); hf[9] = bfhi(h1.x); hf[10] = bflo(h1.y); hf[11] = bfhi(h1.y); hf[12] = bflo(h1.z); hf[13] = bfhi(h1.z); hf[14] = bflo(h1.w); hf[15] = bfhi(h1.w); }
#pragma unroll
        for (int i = 0; i < 16; ++i) acc[i] = 0.f;
        const unsigned pbase = tok * 128u;
        uint4 uA[4], vA[4], uB[4], vB[4];
#define XLOAD(U, V, k_) do { _Pragma("unroll") for (int j = 0; j < 4; ++j) { const unsigned eo_ = (unsigned)idx[pbase + (k_) + j] * 1024u + lane * 16u; U[j] = *(const uint4*)(ut + eo_); V[j] = *(const uint4*)(vt + eo_); } } while (0)
#define XCOMP(U, V, k_) do { float d_[4]; \
        _Pragma("unroll") for (int j = 0; j < 4; ++j) d_[j] = dot16_fp8(U[j], hf); \
        const float x0_ = (b0 ? d_[1] : d_[0]) + dppf<XOR1>(b0 ? d_[0] : d_[1]), x1_ = (b0 ? d_[3] : d_[2]) + dppf<XOR1>(b0 ? d_[2] : d_[3]); \
        float x = (b1 ? x1_ : x0_) + dppf<XOR2>(b1 ? x0_ : x1_);            \
        x += dppf<ROR4>(x); x += dppf<ROR8>(x); x = x1632_sum(x); \
        const unsigned o_ = pbase + (k_) + (lane & 3u); \
        const float wl = gelu_as(x * usc[o_]) * gate[o_]; \
        _Pragma("unroll") for (int j = 0; j < 4; ++j) { const float w = __uint_as_float(__builtin_amdgcn_readlane(__float_as_uint(wl), j)); fma16_fp8(V[j], w, acc); } } while (0)
        XLOAD(uA, vA, 0);
#pragma unroll 1
        for (int k0 = 0; k0 < 128; k0 += 8) {
            XLOAD(uB, vB, k0 + 4);
            XCOMP(uA, vA, k0);
            if (k0 + 8 < 128) XLOAD(uA, vA, k0 + 8);
            XCOMP(uB, vB, k0 + 4);
        }
#undef XLOAD
#undef XCOMP
        float4* p0 = (float4*)((char*)xres + (tok * 4096u + lane * 64u));
        float4 a = p0[0], b = p0[1], c = p0[2], d = p0[3];
        a.x += oscale * acc[0]; a.y += oscale * acc[1]; a.z += oscale * acc[2]; a.w += oscale * acc[3]; b.x += oscale * acc[4]; b.y += oscale * acc[5]; b.z += oscale * acc[6]; b.w += oscale * acc[7];
        c.x += oscale * acc[8]; c.y += oscale * acc[9]; c.z += oscale * acc[10]; c.w += oscale * acc[11]; d.x += oscale * acc[12]; d.y += oscale * acc[13]; d.z += oscale * acc[14]; d.w += oscale * acc[15];
        p0[0] = a; p0[1] = b; p0[2] = c; p0[3] = d;
    }
}

constexpr int PEER_UNIT_TOK = 256, PEER_UNITS = NT / PEER_UNIT_TOK, PEER_WTOK = PEER_UNIT_TOK / 8;
constexpr size_t WS_QCTR = 16384;
constexpr size_t WS_CTL_BYTES = 16384 + 32 * 256;
DEV unsigned peer_next_unit(unsigned* q, volatile unsigned* sh) { return queue_next(q, sh); }
typedef float f32x2p __attribute__((ext_vector_type(2)));
DEV float dot16_fp8_pk(const uint4 u, const f32x2p (&h)[8]) {
    f32x2p d = __builtin_amdgcn_cvt_pk_f32_fp8((int)u.x, false) * h[0];
    d = __builtin_elementwise_fma(__builtin_amdgcn_cvt_pk_f32_fp8((int)u.x, true), h[1], d);
    d = __builtin_elementwise_fma(__builtin_amdgcn_cvt_pk_f32_fp8((int)u.y, false), h[2], d);
    d = __builtin_elementwise_fma(__builtin_amdgcn_cvt_pk_f32_fp8((int)u.y, true), h[3], d);
    d = __builtin_elementwise_fma(__builtin_amdgcn_cvt_pk_f32_fp8((int)u.z, false), h[4], d);
    d = __builtin_elementwise_fma(__builtin_amdgcn_cvt_pk_f32_fp8((int)u.z, true), h[5], d);
    d = __builtin_elementwise_fma(__builtin_amdgcn_cvt_pk_f32_fp8((int)u.w, false), h[6], d);
    d = __builtin_elementwise_fma(__builtin_amdgcn_cvt_pk_f32_fp8((int)u.w, true), h[7], d);
    return d[0] + d[1];
}
DEV void fma16_fp8_pk(const uint4 v, const float w, f32x2p (&acc)[8]) {
    const f32x2p wv = {w, w};
    acc[0] = __builtin_elementwise_fma(__builtin_amdgcn_cvt_pk_f32_fp8((int)v.x, false), wv, acc[0]);
    acc[1] = __builtin_elementwise_fma(__builtin_amdgcn_cvt_pk_f32_fp8((int)v.x, true), wv, acc[1]);
    acc[2] = __builtin_elementwise_fma(__builtin_amdgcn_cvt_pk_f32_fp8((int)v.y, false), wv, acc[2]);
    acc[3] = __builtin_elementwise_fma(__builtin_amdgcn_cvt_pk_f32_fp8((int)v.y, true), wv, acc[3]);
    acc[4] = __builtin_elementwise_fma(__builtin_amdgcn_cvt_pk_f32_fp8((int)v.z, false), wv, acc[4]);
    acc[5] = __builtin_elementwise_fma(__builtin_amdgcn_cvt_pk_f32_fp8((int)v.z, true), wv, acc[5]);
    acc[6] = __builtin_elementwise_fma(__builtin_amdgcn_cvt_pk_f32_fp8((int)v.w, false), wv, acc[6]);
    acc[7] = __builtin_elementwise_fma(__builtin_amdgcn_cvt_pk_f32_fp8((int)v.w, true), wv, acc[7]);
}
DEV void phase_peer_dots(const bf16_t* hn, const unsigned char* u8s, const int* idx, float* partial, unsigned* qctr, unsigned char* lds_raw, unsigned xcc) {
    constexpr int XOR1 = 0xB1, XOR2 = 0x4E, HMIR = 0x141;
    int tid = threadIdx.x; asm volatile("" : "+v"(tid));
    const unsigned wid = tid >> 6, lane = tid & 63, g = lane >> 3, sub = lane & 7;
    volatile unsigned* sh = (volatile unsigned*)(lds_raw + 256);
    for (unsigned s_ = 0; s_ < 8; ++s_) {
        const unsigned x = (xcc + s_) & 7;
        const unsigned char* ux = u8s + (size_t)x * NEXP * 128;
        const unsigned sub16 = sub * 16u;
        for (;;) {
            const unsigned unit = peer_next_unit(qctr + 64 * x, sh);
            if (unit >= (unsigned)PEER_UNITS) break;
            const unsigned tok0 = unit * PEER_UNIT_TOK + wid * PEER_WTOK;
            uint4 ixn[4]; uint4 hn0, hn1;
            { const uint4* ip = (const uint4*)((const char*)idx + (tok0 * 512u + g * 64u)); ixn[0] = ip[0]; ixn[1] = ip[1]; ixn[2] = ip[2]; ixn[3] = ip[3];
              const uint4* hp = (const uint4*)((const char*)hn + (tok0 * 2048u + x * 256u + sub * 32u)); hn0 = hp[0]; hn1 = hp[1]; }
            uint4 Ua[8], Ub[8];
#define ROWS(U, e0, e1, e2, e3, e4, e5, e6, e7) do { U[0] = *(const uint4*)(ux + ((e0) * 128u + sub16)); U[1] = *(const uint4*)(ux + ((e1) * 128u + sub16)); U[2] = *(const uint4*)(ux + ((e2) * 128u + sub16)); \
            U[3] = *(const uint4*)(ux + ((e3) * 128u + sub16)); U[4] = *(const uint4*)(ux + ((e4) * 128u + sub16)); U[5] = *(const uint4*)(ux + ((e5) * 128u + sub16)); \
            U[6] = *(const uint4*)(ux + ((e6) * 128u + sub16)); U[7] = *(const uint4*)(ux + ((e7) * 128u + sub16)); } while (0)
            ROWS(Ua, ixn[0].x, ixn[0].y, ixn[0].z, ixn[0].w, ixn[1].x, ixn[1].y, ixn[1].z, ixn[1].w);
#pragma unroll 1
            for (unsigned i = 0; i < (unsigned)PEER_WTOK; ++i) {
                const unsigned tok = tok0 + i;
                ROWS(Ub, ixn[2].x, ixn[2].y, ixn[2].z, ixn[2].w, ixn[3].x, ixn[3].y, ixn[3].z, ixn[3].w);
                f32x2p hf[8];
                hf[0] = (f32x2p){bflo(hn0.x), bfhi(hn0.x)}; hf[1] = (f32x2p){bflo(hn0.y), bfhi(hn0.y)}; hf[2] = (f32x2p){bflo(hn0.z), bfhi(hn0.z)}; hf[3] = (f32x2p){bflo(hn0.w), bfhi(hn0.w)};
                hf[4] = (f32x2p){bflo(hn1.x), bfhi(hn1.x)}; hf[5] = (f32x2p){bflo(hn1.y), bfhi(hn1.y)}; hf[6] = (f32x2p){bflo(hn1.z), bfhi(hn1.z)}; hf[7] = (f32x2p){bflo(hn1.w), bfhi(hn1.w)};
                { const unsigned tn = (i + 1 < (unsigned)PEER_WTOK) ? tok + 1 : tok;
                  const uint4* ip = (const uint4*)((const char*)idx + (tn * 512u + g * 64u)); ixn[0] = ip[0]; ixn[1] = ip[1]; ixn[2] = ip[2]; ixn[3] = ip[3];
                  const uint4* hp = (const uint4*)((const char*)hn + (tn * 2048u + x * 256u + sub * 32u)); hn0 = hp[0]; hn1 = hp[1]; }
                float sm[16];
#pragma unroll
                for (int j = 0; j < 8; ++j) { uint4 u_ = Ua[j]; PIN4(u_); float d = dot16_fp8_pk(u_, hf); asm volatile("" : "+v"(d)); d += dppf<XOR1>(d); d += dppf<XOR2>(d); d += dppf<HMIR>(d); sm[j] = d; }
                ROWS(Ua, ixn[0].x, ixn[0].y, ixn[0].z, ixn[0].w, ixn[1].x, ixn[1].y, ixn[1].z, ixn[1].w);
#pragma unroll
                for (int j = 0; j < 8; ++j) { uint4 u_ = Ub[j]; PIN4(u_); float d = dot16_fp8_pk(u_, hf); asm volatile("" : "+v"(d)); d += dppf<XOR1>(d); d += dppf<XOR2>(d); d += dppf<HMIR>(d); sm[8 + j] = d; }
                float v0 = sm[0], v1 = sm[1];
#pragma unroll
                for (int q = 1; q < 8; ++q) { v0 = (sub == (unsigned)q) ? sm[2 * q] : v0; v1 = (sub == (unsigned)q) ? sm[2 * q + 1] : v1; }
                float2 o; o.x = v0; o.y = v1;
                *(float2*)(partial + ((size_t)x * NT + tok) * 128u + 2u * lane) = o;
            }
#undef ROWS
        }
    }
}
DEV void phase_peer_dots2(const bf16_t* hn, const unsigned char* u8s, const int* idx, float* partial, unsigned* qctr, unsigned char* lds_raw, unsigned xcc) {
    constexpr int XOR1 = 0xB1, XOR2 = 0x4E, HMIR = 0x141;
    constexpr unsigned CROW = 144, CHB = 8 * CROW;
    int tid = threadIdx.x; asm volatile("" : "+v"(tid));
    const unsigned wid = tid >> 6, lane = tid & 63, g = lane >> 3, sub = lane & 7;
    volatile unsigned* sh = (volatile unsigned*)(lds_raw + 256);
    unsigned char* lw = lds_raw + 1024 + wid * (4 * CHB);
    const unsigned st_off = g * CROW + sub * 4;
    const unsigned rd_off = g * CROW;
    const bool c0 = ((sub ^ (sub >> 2)) & 1u) != 0, c1 = (((sub >> 1) ^ (sub >> 2)) & 1u) != 0, c2 = (sub & 4u) != 0;
    const unsigned jmap = (c2 ? 4u : 0u) + (c1 ? 2u : 0u) + (c0 ? 1u : 0u);
    for (unsigned s_ = 0; s_ < 8; ++s_) {
        const unsigned x = (xcc + s_) & 7;
        const unsigned char* ux = u8s + (size_t)x * NEXP * 128;
        const unsigned sub16 = sub * 16u;
#define GROW(pn) (*(const uint4*)(ux + (((pn) << 7) | sub16)))
#define E1STEP(R, r) do { \
            const uint4 n0_ = *(const uint4*)(nxt + (r) * 32), n1_ = *(const uint4*)(nxt + (r) * 32 + 16); \
            const unsigned ns_[8] = {n0_.x, n0_.y, n0_.z, n0_.w, n1_.x, n1_.y, n1_.z, n1_.w}; float d_[8]; \
            _Pragma("unroll") for (int j = 0; j < 8; ++j) { uint4 v_ = R[j]; PIN4(v_); d_[j] = dot16_fp8_pk(v_, hf); unsigned o_ = (ns_[j] << 7) | sub16; \
                asm volatile("" : "+v"(d_[j]), "+v"(o_));     \
                R[j] = *(const uint4*)(ux + o_); } \
            float e_[4], f_[2]; \
            _Pragma("unroll") for (int m = 0; m < 4; ++m) e_[m] = (c0 ? d_[2 * m + 1] : d_[2 * m]) + dppf<XOR1>(c0 ? d_[2 * m] : d_[2 * m + 1]); \
            _Pragma("unroll") for (int n = 0; n < 2; ++n) f_[n] = (c1 ? e_[2 * n + 1] : e_[2 * n]) + dppf<XOR2>(c1 ? e_[2 * n] : e_[2 * n + 1]); \
            kp[r] = (c2 ? f_[1] : f_[0]) + dppf<HMIR>(c2 ? f_[0] : f_[1]); \
            asm volatile("" ::: "memory"); } while (0)
        for (;;) {
            const unsigned unit = peer_next_unit(qctr + 64 * x, sh);
            if (unit >= (unsigned)PEER_UNITS) break;
            const unsigned tok0 = unit * PEER_UNIT_TOK + wid * PEER_WTOK;
            const unsigned char* isrc = (const unsigned char*)idx + ((tok0 + g) * 512u + sub * 16u);
            const unsigned char* hsrc = (const unsigned char*)hn + ((tok0 + g) * 2048u + x * 256u + sub * 32u);
            uint4 hq0 = *(const uint4*)(hsrc), hq1 = *(const uint4*)(hsrc + 16);
            { const uint4 p0 = *(const uint4*)(isrc), p1 = *(const uint4*)(isrc + 128);
              *(unsigned*)(lw + st_off) = p0.x; *(unsigned*)(lw + st_off + 32) = p0.y; *(unsigned*)(lw + st_off + 64) = p0.z; *(unsigned*)(lw + st_off + 96) = p0.w;
              *(unsigned*)(lw + CHB + st_off) = p1.x; *(unsigned*)(lw + CHB + st_off + 32) = p1.y; *(unsigned*)(lw + CHB + st_off + 64) = p1.z; *(unsigned*)(lw + CHB + st_off + 96) = p1.w; }
            uint4 R0[8], R1[8], R2[8], R3[8];
            { const unsigned char* cur = lw + rd_off;
#define E1FILL(R, r) do { const uint4 n0_ = *(const uint4*)(cur + (r) * 32), n1_ = *(const uint4*)(cur + (r) * 32 + 16); \
                R[0] = GROW(n0_.x); R[1] = GROW(n0_.y); R[2] = GROW(n0_.z); R[3] = GROW(n0_.w); R[4] = GROW(n1_.x); R[5] = GROW(n1_.y); R[6] = GROW(n1_.z); R[7] = GROW(n1_.w); } while (0)
              E1FILL(R0, 0); E1FILL(R1, 1); E1FILL(R2, 2); E1FILL(R3, 3); }
#undef E1FILL
            f32x2p hf[8];
#define E1HF() do { hf[0] = (f32x2p){bflo(hq0.x), bfhi(hq0.x)}; hf[1] = (f32x2p){bflo(hq0.y), bfhi(hq0.y)}; hf[2] = (f32x2p){bflo(hq0.z), bfhi(hq0.z)}; hf[3] = (f32x2p){bflo(hq0.w), bfhi(hq0.w)}; \
                hf[4] = (f32x2p){bflo(hq1.x), bfhi(hq1.x)}; hf[5] = (f32x2p){bflo(hq1.y), bfhi(hq1.y)}; hf[6] = (f32x2p){bflo(hq1.z), bfhi(hq1.z)}; hf[7] = (f32x2p){bflo(hq1.w), bfhi(hq1.w)}; } while (0)
            E1HF();
#pragma unroll 1
            for (unsigned it = 0; it < 16; ++it) {
                const unsigned char* nxt = lw + ((it + 1) & 3) * CHB + rd_off;
                const unsigned ns = (it + 2 < 16) ? it + 2 : 15;
                const uint4 pst = *(const uint4*)(isrc + (ns >> 2) * 4096u + (ns & 3) * 128u);
                if ((it & 3) == 1) { const unsigned bn = (it < 12) ? (it >> 2) + 1 : 3; hq0 = *(const uint4*)(hsrc + bn * 16384u); hq1 = *(const uint4*)(hsrc + bn * 16384u + 16); }
                float kp[4];
                E1STEP(R0, 0); E1STEP(R1, 1); E1STEP(R2, 2); E1STEP(R3, 3);
                { unsigned char* dst = lw + ((it + 2) & 3) * CHB + st_off;
                  *(unsigned*)(dst) = pst.x; *(unsigned*)(dst + 32) = pst.y; *(unsigned*)(dst + 64) = pst.z; *(unsigned*)(dst + 96) = pst.w; }
                *(float4*)(partial + ((size_t)x * NT + tok0 + (it >> 2) * 8 + g) * 128u + (it & 3) * 32u + 4u * jmap) = make_float4(kp[0], kp[1], kp[2], kp[3]);
                if ((it & 3) == 3) E1HF();
            }
#undef E1HF
        }
#undef E1STEP
#undef GROW
    }
}
DEV void phase_peer_weights(const float* partial, const float* gate, const float* usc, const int* idx, unsigned* wpk, int bid, int nb) {
    const int tid_ = opaque_tid();
    for (unsigned i = bid * NTHR + tid_; i < (unsigned)NT * 32u; i += nb * NTHR) {
        float4 sacc = ((const float4*)partial)[i];
#pragma unroll
        for (int x = 1; x < 8; ++x) { const float4 p = ((const float4*)(partial + (size_t)x * NT * 128))[i]; sacc.x += p.x; sacc.y += p.y; sacc.z += p.z; sacc.w += p.w; }
        const float4 gt = ((const float4*)gate)[i], us = ((const float4*)usc)[i];
        float4 o; o.x = gt.x * gelu_as(sacc.x * us.x); o.y = gt.y * gelu_as(sacc.y * us.y); o.z = gt.z * gelu_as(sacc.z * us.z); o.w = gt.w * gelu_as(sacc.w * us.w);
        const uint4 ix = ((const uint4*)idx)[i];
        uint4 w; w.x = ((unsigned)f2bf(o.x) << 16) | ix.x; w.y = ((unsigned)f2bf(o.y) << 16) | ix.y; w.z = ((unsigned)f2bf(o.z) << 16) | ix.z; w.w = ((unsigned)f2bf(o.w) << 16) | ix.w;
        ((uint4*)wpk)[i] = w;
    }
}
DEV void phase_peer_acc2(const unsigned char* v8s, const unsigned* wpk, bf16_t* pdelta, unsigned* qctr, unsigned char* lds_raw, unsigned xcc) {
    constexpr unsigned CROW = 144, CHB = 8 * CROW;
    int tid = threadIdx.x; asm volatile("" : "+v"(tid));
    const unsigned wid = tid >> 6, lane = tid & 63, g = lane >> 3, sub = lane & 7;
    volatile unsigned* sh = (volatile unsigned*)(lds_raw + 256);
    unsigned char* lw = lds_raw + 1024 + wid * (4 * CHB);
    const unsigned st_off = g * CROW + sub * 16;
    const unsigned rd_off = g * CROW;
    for (unsigned s_ = 0; s_ < 8; ++s_) {
        const unsigned x = (xcc + s_) & 7;
        const unsigned char* vx = v8s + (size_t)x * NEXP * 128;
        const unsigned sub16 = sub * 16u;
#define GROW(pn) (*(const uint4*)(vx + ((((pn) & 0xFFFFu) << 7) | sub16)))
#define E2STEP(R, r) do { \
            const uint4 c0_ = *(const uint4*)(cur + (r) * 32), c1_ = *(const uint4*)(cur + (r) * 32 + 16); \
            const uint4 n0_ = *(const uint4*)(nxt + (r) * 32), n1_ = *(const uint4*)(nxt + (r) * 32 + 16); \
            const unsigned cs_[8] = {c0_.x, c0_.y, c0_.z, c0_.w, c1_.x, c1_.y, c1_.z, c1_.w}; const unsigned ns_[8] = {n0_.x, n0_.y, n0_.z, n0_.w, n1_.x, n1_.y, n1_.z, n1_.w}; \
            _Pragma("unroll") for (int j = 0; j < 8; ++j) { uint4 v_ = R[j]; PIN4(v_); fma16_fp8_pk(v_, __uint_as_float(cs_[j] & 0xFFFF0000u), acc); unsigned o_ = (((ns_[j]) & 0xFFFFu) << 7) | sub16; \
                asm volatile("" : "+v"(acc[0]), "+v"(acc[1]), "+v"(acc[2]), "+v"(acc[3]), "+v"(acc[4]), "+v"(acc[5]), "+v"(acc[6]), "+v"(acc[7]), "+v"(o_));     \
                R[j] = *(const uint4*)(vx + o_); } \
            asm volatile("" ::: "memory"); } while (0)
        for (;;) {
            const unsigned unit = peer_next_unit(qctr + 64 * x, sh);
            if (unit >= (unsigned)PEER_UNITS) break;
            const unsigned tok0 = unit * PEER_UNIT_TOK + wid * PEER_WTOK;
            const unsigned char* wsrc = (const unsigned char*)wpk + ((tok0 + g) * 512u + sub * 16u);
            { const uint4 p0 = *(const uint4*)(wsrc), p1 = *(const uint4*)(wsrc + 128);
              *(uint4*)(lw + st_off) = p0; *(uint4*)(lw + CHB + st_off) = p1; }
            uint4 R0[8], R1[8], R2[8], R3[8];
            { const unsigned char* cur = lw + rd_off;
#define E2FILL(R, r) do { const uint4 n0_ = *(const uint4*)(cur + (r) * 32), n1_ = *(const uint4*)(cur + (r) * 32 + 16); \
                R[0] = GROW(n0_.x); R[1] = GROW(n0_.y); R[2] = GROW(n0_.z); R[3] = GROW(n0_.w); R[4] = GROW(n1_.x); R[5] = GROW(n1_.y); R[6] = GROW(n1_.z); R[7] = GROW(n1_.w); } while (0)
              E2FILL(R0, 0); E2FILL(R1, 1); E2FILL(R2, 2); E2FILL(R3, 3); }
#undef E2FILL
            f32x2p acc[8];
#pragma unroll
            for (int c = 0; c < 8; ++c) acc[c] = (f32x2p){0.f, 0.f};
#pragma unroll 1
            for (unsigned it = 0; it < 16; ++it) {
                const unsigned char* cur = lw + (it & 3) * CHB + rd_off;
                const unsigned char* nxt = lw + ((it + 1) & 3) * CHB + rd_off;
                const unsigned ns = (it + 2 < 16) ? it + 2 : 15;
                const uint4 pst = *(const uint4*)(wsrc + (ns >> 2) * 4096u + (ns & 3) * 128u);
                E2STEP(R0, 0); E2STEP(R1, 1); E2STEP(R2, 2); E2STEP(R3, 3);
                *(uint4*)(lw + ((it + 2) & 3) * CHB + st_off) = pst;
                if ((it & 3) == 3) {
                    uint4* p0 = (uint4*)((char*)pdelta + ((tok0 + (it >> 2) * 8 + g) * 2048u + x * 256u + sub * 32u));
                    uint4 o0, o1;
                    o0.x = pk2(acc[0][0], acc[0][1]); o0.y = pk2(acc[1][0], acc[1][1]); o0.z = pk2(acc[2][0], acc[2][1]); o0.w = pk2(acc[3][0], acc[3][1]);
                    o1.x = pk2(acc[4][0], acc[4][1]); o1.y = pk2(acc[5][0], acc[5][1]); o1.z = pk2(acc[6][0], acc[6][1]); o1.w = pk2(acc[7][0], acc[7][1]);
                    p0[0] = o0; p0[1] = o1;
#pragma unroll
                    for (int c = 0; c < 8; ++c) acc[c] = (f32x2p){0.f, 0.f};
                }
            }
        }
#undef E2STEP
#undef GROW
    }
}
template <bool LOADONLY = false>
DEV void phase_peer_acc(const unsigned char* v8s, const int* idx, const float* wts, float* xres, unsigned* qctr, unsigned char* lds_raw, unsigned xcc, float oscale = 1.0f) {
    constexpr int ROR8 = 0x128;
    constexpr unsigned EMASK = LOADONLY ? 2047u : 0xFFFFFFFFu;
    int tid = threadIdx.x; asm volatile("" : "+v"(tid));
    const unsigned wid = tid >> 6, lane = tid & 63, g = lane >> 3, sub = lane & 7;
    volatile unsigned* sh = (volatile unsigned*)(lds_raw + 256);
    for (unsigned s_ = 0; s_ < 8; ++s_) {
        const unsigned x = (xcc + s_) & 7;
        const unsigned char* vx = v8s + (size_t)x * NEXP * 128;
        const unsigned sub16 = sub * 16u;
        for (;;) {
            const unsigned unit = peer_next_unit(qctr + 64 * x, sh);
            if (unit >= (unsigned)PEER_UNITS) break;
            const unsigned tok0 = unit * PEER_UNIT_TOK + wid * PEER_WTOK;
            uint4 ixn[4]; float4 wn[4];
            { const uint4* ip = (const uint4*)((const char*)idx + (tok0 * 512u + g * 64u)); ixn[0] = ip[0]; ixn[1] = ip[1]; ixn[2] = ip[2]; ixn[3] = ip[3];
              const float4* wp = (const float4*)((const char*)wts + (tok0 * 512u + g * 64u)); wn[0] = wp[0]; wn[1] = wp[1]; wn[2] = wp[2]; wn[3] = wp[3]; }
            uint4 Va[8], Vb[8];
#define ROWS(U, e0, e1, e2, e3, e4, e5, e6, e7) do { U[0] = *(const uint4*)(vx + ((((e0) & EMASK)) * 128u + sub16)); U[1] = *(const uint4*)(vx + ((((e1) & EMASK)) * 128u + sub16)); U[2] = *(const uint4*)(vx + ((((e2) & EMASK)) * 128u + sub16)); \
            U[3] = *(const uint4*)(vx + ((((e3) & EMASK)) * 128u + sub16)); U[4] = *(const uint4*)(vx + ((((e4) & EMASK)) * 128u + sub16)); U[5] = *(const uint4*)(vx + ((((e5) & EMASK)) * 128u + sub16)); \
            U[6] = *(const uint4*)(vx + ((((e6) & EMASK)) * 128u + sub16)); U[7] = *(const uint4*)(vx + ((((e7) & EMASK)) * 128u + sub16)); } while (0)
            ROWS(Va, ixn[0].x, ixn[0].y, ixn[0].z, ixn[0].w, ixn[1].x, ixn[1].y, ixn[1].z, ixn[1].w);
#pragma unroll 1
            for (unsigned i = 0; i < (unsigned)PEER_WTOK; ++i) {
                const unsigned tok = tok0 + i;
                ROWS(Vb, ixn[2].x, ixn[2].y, ixn[2].z, ixn[2].w, ixn[3].x, ixn[3].y, ixn[3].z, ixn[3].w);
                const float ww[16] = {wn[0].x, wn[0].y, wn[0].z, wn[0].w, wn[1].x, wn[1].y, wn[1].z, wn[1].w, wn[2].x, wn[2].y, wn[2].z, wn[2].w, wn[3].x, wn[3].y, wn[3].z, wn[3].w};
                { const unsigned tn = (i + 1 < (unsigned)PEER_WTOK) ? tok + 1 : tok;
                  const uint4* ip = (const uint4*)((const char*)idx + (tn * 512u + g * 64u)); ixn[0] = ip[0]; ixn[1] = ip[1]; ixn[2] = ip[2]; ixn[3] = ip[3];
                  const float4* wp = (const float4*)((const char*)wts + (tn * 512u + g * 64u)); wn[0] = wp[0]; wn[1] = wp[1]; wn[2] = wp[2]; wn[3] = wp[3]; }
                f32x2p acc[8];
#pragma unroll
                for (int c = 0; c < 8; ++c) acc[c] = (f32x2p){0.f, 0.f};
#pragma unroll
                for (int j = 0; j < 8; ++j) { uint4 v_ = Va[j]; PIN4(v_); if (LOADONLY) { acc[0][0] += __uint_as_float((v_.x ^ v_.y ^ v_.z ^ v_.w) & 0x007fffffu) * ww[j]; } else fma16_fp8_pk(v_, ww[j], acc); asm volatile("" : "+v"(acc[0]), "+v"(acc[7])); }
                ROWS(Va, ixn[0].x, ixn[0].y, ixn[0].z, ixn[0].w, ixn[1].x, ixn[1].y, ixn[1].z, ixn[1].w);
#pragma unroll
                for (int j = 0; j < 8; ++j) { uint4 v_ = Vb[j]; PIN4(v_); if (LOADONLY) { acc[0][0] += __uint_as_float((v_.x ^ v_.y ^ v_.z ^ v_.w) & 0x007fffffu) * ww[8 + j]; } else fma16_fp8_pk(v_, ww[8 + j], acc); asm volatile("" : "+v"(acc[0]), "+v"(acc[7])); }
                float r[16];
#pragma unroll
                for (int c = 0; c < 8; ++c) { float a0 = acc[c][0], a1 = acc[c][1]; a0 += dppf<ROR8>(a0); a1 += dppf<ROR8>(a1); r[2 * c] = x1632_sum(a0); r[2 * c + 1] = x1632_sum(a1); }
                if (g == 0) {
                    float4* p0 = (float4*)((char*)xres + (tok * 4096u + x * 512u + sub * 64u));
                    float4 a = p0[0], b = p0[1], c = p0[2], d = p0[3];
                    a.x += oscale * r[0]; a.y += oscale * r[1]; a.z += oscale * r[2]; a.w += oscale * r[3]; b.x += oscale * r[4]; b.y += oscale * r[5]; b.z += oscale * r[6]; b.w += oscale * r[7];
                    c.x += oscale * r[8]; c.y += oscale * r[9]; c.z += oscale * r[10]; c.w += oscale * r[11]; d.x += oscale * r[12]; d.y += oscale * r[13]; d.z += oscale * r[14]; d.w += oscale * r[15];
                    p0[0] = a; p0[1] = b; p0[2] = c; p0[3] = d;
                }
            }
#undef ROWS
        }
    }
}

DEV void phase_expert_naive(const bf16_t* hn, const bf16_t* ut, const bf16_t* vt, const int* idx, const float* gate, float* xres, int bid, int nb) {
    const int wid = threadIdx.x >> 6, lane = threadIdx.x & 63;
    for (int tok = bid * 8 + wid; tok < NT; tok += nb * 8) {
        float hv[16], acc[16];
#pragma unroll
        for (int i = 0; i < 4; ++i) { const uint2 r = *(const uint2*)(hn + (size_t)tok * DM + i * 256 + lane * 4);
            hv[i * 4] = bflo(r.x); hv[i * 4 + 1] = bfhi(r.x); hv[i * 4 + 2] = bflo(r.y); hv[i * 4 + 3] = bfhi(r.y); }
#pragma unroll
        for (int i = 0; i < 16; ++i) acc[i] = 0.f;
        for (int k0 = 0; k0 < 128; k0 += 4) {
            int e[4]; float g[4]; uint2 ur[4][4], vr[4][4];
#pragma unroll
            for (int j = 0; j < 4; ++j) { e[j] = __builtin_amdgcn_readfirstlane(idx[(size_t)tok * 128 + k0 + j]); g[j] = gate[(size_t)tok * 128 + k0 + j]; }
#pragma unroll
            for (int j = 0; j < 4; ++j)
#pragma unroll
                for (int i = 0; i < 4; ++i) ur[j][i] = *(const uint2*)(ut + (size_t)e[j] * DM + i * 256 + lane * 4);
#pragma unroll
            for (int j = 0; j < 4; ++j)
#pragma unroll
                for (int i = 0; i < 4; ++i) vr[j][i] = *(const uint2*)(vt + (size_t)e[j] * DM + i * 256 + lane * 4);
#pragma unroll
            for (int j = 0; j < 4; ++j) {
                float d = 0.f;
#pragma unroll
                for (int i = 0; i < 4; ++i) d += hv[i * 4] * bflo(ur[j][i].x) + hv[i * 4 + 1] * bfhi(ur[j][i].x) + hv[i * 4 + 2] * bflo(ur[j][i].y) + hv[i * 4 + 3] * bfhi(ur[j][i].y);
                d = wave_sum(d);
                const float act = 0.5f * d * (1.0f + erff(d * 0.70710678118654752f));
                const float w = g[j] * act;
#pragma unroll
                for (int i = 0; i < 4; ++i) { acc[i * 4] += w * bflo(vr[j][i].x); acc[i * 4 + 1] += w * bfhi(vr[j][i].x); acc[i * 4 + 2] += w * bflo(vr[j][i].y); acc[i * 4 + 3] += w * bfhi(vr[j][i].y); }
            }
        }
#pragma unroll
        for (int i = 0; i < 4; ++i) { float4* p = (float4*)(xres + (size_t)tok * DM + i * 256 + lane * 4); float4 v = *p;
            v.x += acc[i * 4]; v.y += acc[i * 4 + 1]; v.z += acc[i * 4 + 2]; v.w += acc[i * 4 + 3]; *p = v; }
    }
}

#define XB_TMO      128
#define XB_XCNT(j)  (256  + 64 * (j))
#define XB_XSUB(j)  (1280 + 64 * (j))
#define XB_XGEN(j)  (2304 + 64 * (j))
#define XB_TOP      3328
#define XB_TOPGEN   3392
#define XCD_BAR_WORDS 3456
#define XB_SPIN_CAP (1u << 18)
#define LAS __attribute__((address_space(3)))

__device__ __forceinline__ unsigned xb_ld(unsigned* p)              { return __hip_atomic_load(p, __ATOMIC_RELAXED, __HIP_MEMORY_SCOPE_AGENT); }
__device__ __forceinline__ unsigned xb_add(unsigned* p, unsigned v) { return __hip_atomic_fetch_add(p, v, __ATOMIC_RELAXED, __HIP_MEMORY_SCOPE_AGENT); }
__device__ __forceinline__ unsigned xb_xcc_id() { return (unsigned)__builtin_amdgcn_s_getreg((3 << 11) | 20) & 0xFu; }
#define XB_SPIN(cond, bar) do { unsigned _sp = 0; while (cond) { __builtin_amdgcn_s_sleep(1); \
    if ((++_sp & 255u) == 0u) { if (xb_ld(&(bar)[XB_TMO])) break; if (_sp > XB_SPIN_CAP) { atomicAdd(&(bar)[XB_TMO], 1u); break; } } } } while (0)

struct XcdBarrier {
    unsigned* bar; unsigned x;
    volatile LAS unsigned* st;
};

__device__ __forceinline__ XcdBarrier xcd_barrier_post(unsigned* bar, volatile LAS unsigned* st) {
    XcdBarrier b; b.bar = bar; b.x = xb_xcc_id(); b.st = st;
    if (threadIdx.x == 0) (void)xb_add(&bar[XB_XCNT(b.x)], 1u);
    return b;
}
__device__ __forceinline__ void xcd_barrier_complete(unsigned* bar, unsigned x, unsigned& nloc, unsigned& nx) {
    const unsigned G = gridDim.x * gridDim.y * gridDim.z;
    unsigned sum, cnt, mine, sp = 0u;
    for (;;) {
        sum = 0u; cnt = 0u; mine = 0u;
#pragma unroll
        for (unsigned j = 0; j < 16; ++j) { const unsigned c = xb_ld(&bar[XB_XCNT(j)]); sum += c; cnt += (c > 0u) ? 1u : 0u; mine = (j == x) ? c : mine; }
        if (sum == G) break;
        __builtin_amdgcn_s_sleep(1);
        if ((++sp & 255u) == 0u) { if (xb_ld(&bar[XB_TMO])) break; if (sp > XB_SPIN_CAP) { atomicAdd(&bar[XB_TMO], 1u); break; } }
    }
    nloc = mine > 0u ? mine : 1u; nx = cnt > 0u ? cnt : 1u;
}

__device__ __forceinline__ void xcd_barrier(const XcdBarrier& b) {
    asm volatile("s_waitcnt vmcnt(0)" ::: "memory");
    __syncthreads();
    if (threadIdx.x == 0) {
        unsigned* bar = b.bar;
        __builtin_amdgcn_s_waitcnt(0);
        unsigned nloc = b.st[0], nx = b.st[1];
        if (nloc == 0u) { xcd_barrier_complete(bar, b.x, nloc, nx); b.st[0] = nloc; b.st[1] = nx; }
        const unsigned old = xb_add(&bar[XB_XSUB(b.x)], 1u);
        const unsigned gen = old / nloc;
        if (old + 1u == (gen + 1u) * nloc) {
            __builtin_amdgcn_fence(__ATOMIC_RELEASE, "agent");
            asm volatile("s_waitcnt vmcnt(0)" ::: "memory");
            const unsigned og = xb_add(&bar[XB_TOP], 1u);
            const unsigned tg = og / nx;
            if (og + 1u == (tg + 1u) * nx) xb_add(&bar[XB_TOPGEN], 1u);
            else XB_SPIN(xb_ld(&bar[XB_TOPGEN]) == tg, bar);
            __builtin_amdgcn_fence(__ATOMIC_ACQUIRE, "agent");
            xb_add(&bar[XB_XGEN(b.x)], 1u);
            asm volatile("s_waitcnt vmcnt(0)" ::: "memory");
        } else {
            XB_SPIN(xb_ld(&bar[XB_XGEN(b.x)]) == gen, bar);
            __builtin_amdgcn_fence(__ATOMIC_ACQUIRE, "agent");
            asm volatile("s_waitcnt vmcnt(0)" ::: "memory");
        }
    }
    __syncthreads();
}


constexpr int N_PHASES = 23;
__global__ void __launch_bounds__(NTHR, 2) fwd_kernel(Params p_unused) {
    extern __shared__ __attribute__((aligned(16))) unsigned char lds_raw[];
    float* lds = (float*)lds_raw;
    const int bid = blockIdx.x, nb = gridDim.x;
#define PHASE_ARGS() cparams_t pp = kernarg_ptr(); asm volatile("" : "+s"(pp)); \
    unsigned char* ws = pp->ws; (void)ws; \
    bf16_t* w_in0 = (bf16_t*)(ws + WS_WIN0); bf16_t* w_out0 = (bf16_t*)(ws + WS_WOUT0); bf16_t* w_in1 = (bf16_t*)(ws + WS_WIN1); bf16_t* w_out1 = (bf16_t*)(ws + WS_WOUT1); \
    bf16_t* wq = (bf16_t*)(ws + WS_WQ); bf16_t* skb = (bf16_t*)(ws + WS_SK); unsigned char* ub = ws + WS_U; unsigned char* vb = ws + WS_V; \
    float* uscale = (float*)(ws + WS_USC); float* vscale = (float*)(ws + WS_VSC); \
    bf16_t* hn = (bf16_t*)(ws + WS_HN); bf16_t* qkv = (bf16_t*)(ws + WS_QKV); bf16_t* pq = (bf16_t*)(ws + WS_QKV); \
    float* fg = (float*)(ws + WS_FG); float* carr = (float*)(ws + WS_C); \
    bf16_t* ao = (bf16_t*)(ws + WS_AO); int* idxb = (int*)(ws + WS_AO); float* gateb = (float*)(ws + WS_AO + (size_t)NT * 128 * 4); float* uscb = (float*)(ws + WS_AO + (size_t)NT * 128 * 8); \
    float* xres = pp->out; unsigned* qctr = (unsigned*)(ws + WS_QCTR); \
    float* partial = (float*)(ws + WS_QKV); float* wts = (float*)(ws + WS_QKV + (size_t)8 * NT * 128 * 4); \
    (void)w_in0; (void)w_out0; (void)w_in1; (void)w_out1; (void)wq; (void)skb; (void)ub; (void)vb; (void)uscale; (void)vscale; (void)hn; (void)qkv; (void)pq; (void)fg; (void)carr; (void)ao; \
    (void)idxb; (void)gateb; (void)uscb; (void)xres; (void)qctr; (void)partial; (void)wts
    int lo, hi;
    { cparams_t pp = kernarg_ptr(); asm volatile("" : "+s"(pp)); lo = pp->ph_lo; hi = pp->ph_hi;
      volatile LAS unsigned* xbw = (volatile LAS unsigned*)(lds_raw + LDS_BYTES - 16);
      if (threadIdx.x == 0) { xbw[0] = 0u; xbw[1] = 0u; xbw[2] = 0u; xbw[3] = 0u; }
      __syncthreads();
      if (hi - lo > 1) (void)xcd_barrier_post((unsigned*)(pp->ws + WS_BAR), xbw); }
#define IN(k) (lo <= (k) && (k) < hi)
#define SEAM(k) do { if (IN(k) && IN((k) + 1)) { PHASE_ARGS(); XcdBarrier b_; b_.bar = (unsigned*)(ws + WS_BAR); b_.x = xb_xcc_id(); b_.st = (volatile LAS unsigned*)(lds_raw + LDS_BYTES - 16); xcd_barrier(b_); } } while (0)

    if (IN(0)) { PHASE_ARGS();
        conv_transpose(pp->even_w_in, w_in0, 1024, 3072, lds, bid, nb);
        conv_transpose(pp->even_w_out, w_out0, 1024, 1024, lds, bid, nb);
        conv_transpose(pp->odd_w_in, w_in1, 1024, 3088, lds, bid, nb);
        conv_transpose(pp->odd_w_out, w_out1, 1024, 1024, lds, bid, nb);
        conv_transpose(pp->peer_wq, wq, 1024, 2048, lds, bid, nb);
        conv_transpose(pp->peer_wq + (size_t)1024 * 2048, wq + (size_t)2048 * 1024, 1024, 2048, lds, bid, nb);
        conv_copy(pp->peer_sk, skb, (size_t)2 * 8 * 2 * 128 * 128, bid, nb);
        conv_fp8_rows(pp->peer_u, ub, uscale, 2 * NEXP, bid, nb);
        conv_fp8_rows(pp->peer_v, vb, vscale, 2 * NEXP, bid, nb);
        phase_norm(pp->x, pp->norm_mix_g, hn, bid, nb);
    #if PROBE_DUP == 8

        conv_transpose(pp->even_w_in, w_in0, 1024, 3072, lds, bid, nb);
        conv_transpose(pp->even_w_out, w_out0, 1024, 1024, lds, bid, nb);
        conv_transpose(pp->odd_w_in, w_in1, 1024, 3088, lds, bid, nb);
        conv_transpose(pp->odd_w_out, w_out1, 1024, 1024, lds, bid, nb);
        conv_transpose(pp->peer_wq, wq, 1024, 2048, lds, bid, nb);
        conv_transpose(pp->peer_wq + (size_t)1024 * 2048, wq + (size_t)2048 * 1024, 1024, 2048, lds, bid, nb);
        conv_copy(pp->peer_sk, skb, (size_t)2 * 8 * 2 * 128 * 128, bid, nb);
        conv_fp8_rows(pp->peer_u, ub, uscale, 2 * NEXP, bid, nb);
        conv_fp8_rows(pp->peer_v, vb, vscale, 2 * NEXP, bid, nb);
        phase_norm(pp->x, pp->norm_mix_g, hn, bid, nb);
    #endif
    }
    SEAM(0);
    if (IN(1)) { PHASE_ARGS(); phase_gemm_mfma(hn, w_in0, NT, 3072, MEpiQKV{qkv, 512, 1536, 2048}, lds_raw, bid, nb);
#if PROBE_DUP == 11
        phase_gemm_mfma(hn, w_in0, NT, 3072, MEpiQKV{qkv, 512, 1536, 2048}, lds_raw, bid, nb);
#endif
    }
    SEAM(1);
    if (IN(2)) { PHASE_ARGS(); phase_mix0_mfma(qkv, pp->rel_bias, pp->diff_lambda, pp->diff_ln_g, ao, (bf16_t*)(ws + WS_DPO), (float*)(ws + WS_DLSE), lds_raw, qctr + 5 * 512);
#if PROBE_DUP == 12
        phase_mix0_mfma(qkv, pp->rel_bias, pp->diff_lambda, pp->diff_ln_g, ao, lds_raw, qctr + 5 * 512 + 128);
#endif
    }
    SEAM(2);
    if (IN(3)) { PHASE_ARGS(); phase_dilated_merge((const bf16_t*)(ws + WS_DPO), (const float*)(ws + WS_DLSE), ao, bid, nb); }
    SEAM(3);
    if (IN(4)) { PHASE_ARGS(); phase_gemm_mfma(ao, w_out0, NT, 1024, MEpiBf16{qkv, 1024}, lds_raw, bid, nb); }
    SEAM(4);
    if (IN(5)) { PHASE_ARGS(); phase_res_norm(pp->x, qkv, pp->norm_ffn_g, xres, hn, bid, nb); }
    SEAM(5);
    if (IN(6)) { PHASE_ARGS(); phase_gemm_mfma(hn, wq, NT, 2048, MEpiBf16{pq, 2048}, lds_raw, bid, nb);
#if PROBE_DUP == 15
        phase_gemm_mfma(hn, wq, NT, 2048, MEpiBf16{pq, 2048}, lds_raw, bid, nb);
#endif
#if PROBE_DUP == 16
        phase_gemm_mfma(hn, wq, NT, 2048, MEpiBf16{pq, 2048}, lds_raw, bid, nb);
        phase_gemm_mfma(hn, wq, NT, 2048, MEpiBf16{pq, 2048}, lds_raw, bid, nb);
#endif
    }
    SEAM(6);
    if (IN(7)) { PHASE_ARGS(); phase_topk_mfma(pq, skb, uscale, vscale, idxb, gateb, uscb, lds_raw, bid, nb); }
    SEAM(7);
    if (IN(8)) { PHASE_ARGS(); phase_peer_dots2(hn, ub, idxb, partial, qctr + 0 * 512, lds_raw, xb_xcc_id() & 7u);
#if PROBE_DUP == 6
        phase_peer_dots(hn, ub, idxb, partial, qctr + 4 * 512, lds_raw, xb_xcc_id() & 7u);
#endif
    }
    SEAM(8);
    if (IN(9)) { PHASE_ARGS(); phase_peer_weights(partial, gateb, uscb, idxb, (unsigned*)wts, bid, nb);
#if PROBE_DUP == 8
        phase_peer_weights(partial, gateb, uscb, idxb, (unsigned*)wts, bid, nb);
#endif
    }
    SEAM(9);
    if (IN(10)) { PHASE_ARGS(); phase_peer_acc2(vb, (const unsigned*)wts, hn, qctr + 1 * 512, lds_raw, xb_xcc_id() & 7u);
#if PROBE_DUP == 1
        phase_peer_acc(vb, idxb, wts, xres, qctr + 4 * 512, lds_raw, xb_xcc_id() & 7u, 0.0f);
#endif
#if PROBE_DUP == 7
        phase_peer_acc<true>(vb, idxb, wts, xres, qctr + 4 * 512, lds_raw, xb_xcc_id() & 7u, 0.0f);
#endif
    }
    SEAM(10);
    if (IN(11)) { PHASE_ARGS(); phase_res_norm(xres, hn, pp->norm_mix_g + DM, xres, hn, bid, nb);

#if PROBE_DUP == 8
        phase_norm(xres, pp->norm_mix_g + DM, hn, bid, nb);
#endif
    }
    SEAM(11);
    if (IN(12)) { PHASE_ARGS(); phase_gemm_mfma(hn, w_in1, NT, 3072, MEpiQKV{qkv, 1024, 0, 0}, lds_raw, bid, nb); phase_fg(hn, w_in1 + (size_t)3072 * 1024, pp->odd_b_f, fg, bid, nb); }
    SEAM(12);
    if (IN(13)) { PHASE_ARGS(); phase_cumsum(fg, qkv, carr, (float*)(ws + WS_CTOT), (unsigned*)(ws + WS_KMAX), bid, nb);
#if PROBE_DUP == 8
        phase_cumsum(fg, qkv, carr, (float*)(ws + WS_CTOT), (unsigned*)(ws + WS_KMAX), bid, nb);
#endif
    }
    SEAM(13);
    if (IN(14)) { PHASE_ARGS(); phase_fox_mfma(qkv, carr, (const float*)(ws + WS_CTOT), (const unsigned*)(ws + WS_KMAX), ao, lds_raw, qctr + 5 * 512 + 64);
#if PROBE_DUP == 23
        phase_fox_mfma(qkv, carr, (const float*)(ws + WS_CTOT), (const unsigned*)(ws + WS_KMAX), ao, lds_raw, qctr + 5 * 512 + 192);
#endif
    }
    SEAM(14);
    if (IN(15)) { PHASE_ARGS(); phase_gemm_mfma(ao, w_out1, NT, 1024, MEpiBf16{qkv, 1024}, lds_raw, bid, nb); }
    SEAM(15);
    if (IN(16)) { PHASE_ARGS(); phase_res_norm(xres, qkv, pp->norm_ffn_g + DM, xres, hn, bid, nb); }
    SEAM(16);
    if (IN(17)) { PHASE_ARGS(); phase_gemm_mfma(hn, wq + (size_t)2048 * 1024, NT, 2048, MEpiBf16{pq, 2048}, lds_raw, bid, nb); }
    SEAM(17);
    if (IN(18)) { PHASE_ARGS(); phase_topk_mfma(pq, skb + (size_t)8 * 2 * 128 * 128, uscale + NEXP, vscale + NEXP, idxb, gateb, uscb, lds_raw, bid, nb); }
    SEAM(18);
    if (IN(19)) { PHASE_ARGS(); phase_peer_dots2(hn, ub + (size_t)NEXP * 1024, idxb, partial, qctr + 2 * 512, lds_raw, xb_xcc_id() & 7u); }
    SEAM(19);
    if (IN(20)) { PHASE_ARGS(); phase_peer_weights(partial, gateb, uscb, idxb, (unsigned*)wts, bid, nb);
#if PROBE_DUP == 8
        phase_peer_weights(partial, gateb, uscb, idxb, (unsigned*)wts, bid, nb);
#endif
    }
    SEAM(20);
    if (IN(21)) { PHASE_ARGS(); phase_peer_acc2(vb + (size_t)NEXP * 1024, (const unsigned*)wts, hn, qctr + 3 * 512, lds_raw, xb_xcc_id() & 7u); }
    SEAM(21);
    if (IN(22)) { PHASE_ARGS(); phase_final_norm(xres, hn, pp->final_g, bid, nb); }
}

extern "C" void kernel_launch(void* const* d_in, const int* in_sizes, int n_in, void* d_out, int out_size, void* d_ws, size_t ws_size, hipStream_t stream) {
    static int grid = 0;
    if (grid == 0) {
        if (n_in != 16 || out_size != NT * DM || ws_size < WS_END) { fprintf(stderr, "kernel_launch: unexpected sizes n_in %d out %d ws %zu (need %zu)\n", n_in, out_size, ws_size, (size_t)WS_END); grid = -1; return; }
        int dev = 0, cus = 0;
        (void)hipGetDevice(&dev); (void)hipDeviceGetAttribute(&cus, hipDeviceAttributeMultiprocessorCount, dev);
        if (hipFuncSetAttribute((const void*)fwd_kernel, hipFuncAttributeMaxDynamicSharedMemorySize, LDS_BYTES) != hipSuccess) { fprintf(stderr, "hipFuncSetAttribute failed\n"); grid = -1; return; }
        grid = cus > 0 ? cus : 256;
    }
    if (grid < 0) return;
    Params p{};
    p.x = (const float*)d_in[0]; p.norm_mix_g = (const float*)d_in[1]; p.norm_ffn_g = (const float*)d_in[2]; p.final_g = (const float*)d_in[3];
    p.rel_bias = (const float*)d_in[4]; p.even_w_in = (const float*)d_in[5]; p.even_w_out = (const float*)d_in[6]; p.diff_lambda = (const float*)d_in[7];
    p.diff_ln_g = (const float*)d_in[8]; p.odd_w_in = (const float*)d_in[9]; p.odd_b_f = (const float*)d_in[10]; p.odd_w_out = (const float*)d_in[11];
    p.peer_wq = (const float*)d_in[12]; p.peer_sk = (const float*)d_in[13]; p.peer_u = (const float*)d_in[14]; p.peer_v = (const float*)d_in[15];
    p.out = (float*)d_out; p.ws = (unsigned char*)d_ws;
#if defined(MK_MULTI)
    for (int k = 0; k < N_PHASES; ++k) {
        p.ph_lo = k; p.ph_hi = k + 1;
        hipLaunchKernelGGL(fwd_kernel, dim3(grid), dim3(NTHR), LDS_BYTES, stream, p);
    }
#else
    (void)hipMemsetAsync((unsigned char*)d_ws + WS_BAR, 0, WS_CTL_BYTES + 8 * 8 * 256, stream);
    p.ph_lo = 0; p.ph_hi = N_PHASES;
    hipLaunchKernelGGL(fwd_kernel, dim3(grid), dim3(NTHR), LDS_BYTES, stream, p);
#endif
}
```

```cpp
#include <hip/hip_runtime.h>
#include <stdint.h>
#include <math.h>
#include <cstdio>

typedef unsigned short bf16_t;
#define DEV static __device__ __forceinline__
#define MDEV __device__ __forceinline__

#ifndef PROBE_TMASK
#define PROBE_TMASK 0
#endif
#ifndef PROBE_TAMP
#define PROBE_TAMP 4
#endif
#ifndef PROBE_DUP
#define PROBE_DUP 0
#endif
constexpr int DM = 1024, NBATCH = 8, SEQ = 4096, NT = NBATCH * SEQ;
constexpr int EVEN_IN = 3072, ODD_IN = 3088;
constexpr int NEXP = 16384;
constexpr int NTHR = 512;
constexpr int LDS_BYTES = 160 * 1024;

constexpr size_t KB_ = 1024, MB_ = 1024 * 1024;
constexpr size_t WS_BAR   = 0;
constexpr size_t WS_KMAX  = 32768;
constexpr size_t WS_CTOT  = 33792;
constexpr size_t WS_WIN0  = 64 * KB_;
constexpr size_t WS_WOUT0 = WS_WIN0 + (size_t)3072 * 1024 * 2;
constexpr size_t WS_WIN1  = WS_WOUT0 + (size_t)1024 * 1024 * 2;
constexpr size_t WS_WOUT1 = WS_WIN1 + (size_t)3328 * 1024 * 2;
constexpr size_t WS_WQ    = WS_WOUT1 + (size_t)1024 * 1024 * 2;
constexpr size_t WS_SK    = WS_WQ + (size_t)2 * 2048 * 1024 * 2;
constexpr size_t WS_U     = WS_SK + (size_t)2 * 8 * 2 * 128 * 128 * 2;
constexpr size_t WS_V     = WS_U + (size_t)2 * NEXP * 1024;
constexpr size_t WS_USC   = WS_V + (size_t)2 * NEXP * 1024;
constexpr size_t WS_VSC   = WS_USC + (size_t)2 * NEXP * 4;
constexpr size_t WS_HN    = WS_VSC + (size_t)2 * NEXP * 4;
constexpr size_t WS_QKV   = WS_HN + (size_t)NT * 1024 * 2;
constexpr size_t WS_FG    = WS_QKV + (size_t)NT * 3072 * 2;
constexpr size_t WS_C     = WS_FG + (size_t)NT * 16 * 4;
constexpr size_t WS_AO    = WS_C + (size_t)NT * 16 * 4;
constexpr size_t WS_DPO   = WS_AO + (size_t)NT * 1024 * 2;
constexpr size_t WS_DLSE  = WS_HN;
constexpr size_t WS_END   = WS_DPO + (size_t)3 * NT * 512 * 2;
static_assert(WS_END <= (size_t)512 * 1024 * 1024, "workspace map exceeds the guaranteed 512 MiB");

struct Params {
    const float *x, *norm_mix_g, *norm_ffn_g, *final_g, *rel_bias, *even_w_in, *even_w_out, *diff_lambda, *diff_ln_g,
                *odd_w_in, *odd_b_f, *odd_w_out, *peer_wq, *peer_sk, *peer_u, *peer_v;
    float* out;
    unsigned char* ws;
    int ph_lo, ph_hi;
};

DEV float bf2f(bf16_t v) { return __uint_as_float(((unsigned)v) << 16); }
DEV bf16_t f2bf(float f) { unsigned u = __float_as_uint(f); u += 0x7FFFu + ((u >> 16) & 1u); return (bf16_t)(u >> 16); }
DEV unsigned pk2(float lo, float hi) { return (unsigned)f2bf(lo) | ((unsigned)f2bf(hi) << 16); }
typedef __bf16 bf16x2v __attribute__((ext_vector_type(2)));
typedef float f32x2v __attribute__((ext_vector_type(2)));
DEV unsigned cvtpk2(float lo, float hi) { return __builtin_bit_cast(unsigned, __builtin_convertvector((f32x2v){lo, hi}, bf16x2v)); }
DEV float bflo(unsigned w) { return __uint_as_float(w << 16); }
DEV float bfhi(unsigned w) { return __uint_as_float(w & 0xFFFF0000u); }
DEV float wave_sum(float v) {
#pragma unroll
    for (int o = 32; o >= 1; o >>= 1) v += __shfl_xor(v, o);
    return v;
}
template <int CTRL> DEV float dppf(float x) { return __builtin_bit_cast(float, __builtin_amdgcn_mov_dpp(__builtin_bit_cast(int, x), CTRL, 0xf, 0xf, true)); }
DEV float wave_max(float v) {
#pragma unroll
    for (int o = 32; o >= 1; o >>= 1) v = fmaxf(v, __shfl_xor(v, o));
    return v;
}
DEV int opaque_tid() { int t = threadIdx.x; asm volatile("" : "+v"(t)); return t; }
typedef const __attribute__((address_space(4))) struct Params* cparams_t;
DEV cparams_t kernarg_ptr() {
#if defined(__HIP_DEVICE_COMPILE__)
    return (cparams_t)__builtin_amdgcn_kernarg_segment_ptr();
#else
    return (cparams_t)0;
#endif
}
DEV void lds_fence() { asm volatile("s_waitcnt lgkmcnt(0)" ::: "memory"); }

DEV unsigned queue_next(unsigned* q, volatile unsigned* sh) {
    __syncthreads();
    if (threadIdx.x == 0) sh[0] = __hip_atomic_fetch_add(q, 1u, __ATOMIC_RELAXED, __HIP_MEMORY_SCOPE_AGENT);
    __syncthreads();
    return sh[0];
}
DEV unsigned queue_prefetch(unsigned* q) { unsigned t = 0; if (threadIdx.x == 0) t = __hip_atomic_fetch_add(q, 1u, __ATOMIC_RELAXED, __HIP_MEMORY_SCOPE_AGENT); return t; }
DEV unsigned queue_turn(unsigned t, volatile unsigned* sh) {
    __syncthreads();
    if (threadIdx.x == 0) sh[0] = t;
    __syncthreads();
    return sh[0];
}
DEV int t5_bucket(int d) {
    if (d < 16) return d;
    int b = 16;
    b += (d >= 22); b += (d >= 30); b += (d >= 40); b += (d >= 54); b += (d >= 73); b += (d >= 99); b += (d >= 134); b += (d >= 182);
    b += (d >= 246); b += (d >= 332); b += (d >= 450); b += (d >= 609); b += (d >= 825); b += (d >= 1117); b += (d >= 1513);
    return b;
}

DEV void conv_transpose(const float* src, bf16_t* dst, int K, int N, float* lds, int bid, int nb) {
    const int tid_ = opaque_tid();
    const int t = tid_;
    const int ntk = K / 64, ntn = (N + 63) / 64, ntile = ntk * ntn;
    float v[8];
#define CT_LOAD(tile_) do { const int k0_ = ((tile_) / ntn) * 64, n0_ = ((tile_) % ntn) * 64; \
        _Pragma("unroll") for (int i = 0; i < 8; ++i) { const int r = (t >> 6) + 8 * i, c = t & 63; v[i] = (n0_ + c < N) ? src[(size_t)(k0_ + r) * N + n0_ + c] : 0.f; } } while (0)
    if (bid < ntile) CT_LOAD(bid);
    for (int tile = bid; tile < ntile; tile += nb) {
        const int k0 = (tile / ntn) * 64, n0 = (tile % ntn) * 64;
        __syncthreads();
#pragma unroll
        for (int i = 0; i < 8; ++i) { const int r = (t >> 6) + 8 * i, c = t & 63; lds[r * 65 + c] = v[i]; }
        __syncthreads();
        if (tile + nb < ntile) CT_LOAD(tile + nb);
#pragma unroll
        for (int i = 0; i < 8; ++i) {
            const int r = (t >> 6) + 8 * i, c = t & 63;
            if (n0 + r < N) dst[(size_t)(n0 + r) * K + k0 + c] = f2bf(lds[c * 65 + r]);
        }
    }
#undef CT_LOAD
}
DEV void conv_copy(const float* src, bf16_t* dst, size_t n, int bid, int nb) {
    const int tid_ = opaque_tid();
    const size_t n4 = n / 4;
    for (size_t i = (size_t)bid * NTHR + tid_; i < n4; i += (size_t)nb * NTHR) {
        const float4 v = ((const float4*)src)[i];
        uint2 o; o.x = pk2(v.x, v.y); o.y = pk2(v.z, v.w);
        ((uint2*)dst)[i] = o;
    }
}

DEV unsigned q8x4(float a, float b, float c, float d) {
    const int ia = (int)rintf(a), ib = (int)rintf(b), ic = (int)rintf(c), id = (int)rintf(d);
    return (unsigned)(ia & 255) | ((unsigned)(ib & 255) << 8) | ((unsigned)(ic & 255) << 16) | ((unsigned)(id & 255) << 24);
}
template <bool I8>
DEV void conv_fp8_rows(const float* src, unsigned char* dst, float* inv, int rows, int bid, int nb, int row_base = 0) {
    const int tid_ = opaque_tid();
    constexpr int RP = 4;
    const int wid = tid_ >> 6, lane = tid_ & 63;
    for (int row0 = row_base + (bid * 8 + wid) * RP; row0 < row_base + rows; row0 += nb * 8 * RP) {
        float4 v[RP][4];
#pragma unroll
        for (int p = 0; p < RP; ++p) { const float4* xr = (const float4*)(src + (size_t)(row0 + p) * DM) + lane;
#pragma unroll
            for (int i = 0; i < 4; ++i) v[p][i] = xr[64 * i]; }
#pragma unroll
        for (int p = 0; p < RP; ++p) {
            const int row = row0 + p;
            float mx = 0.f;
#pragma unroll
            for (int i = 0; i < 4; ++i) mx = fmaxf(mx, fmaxf(fmaxf(fabsf(v[p][i].x), fabsf(v[p][i].y)), fmaxf(fabsf(v[p][i].z), fabsf(v[p][i].w))));
            mx = wave_max(mx);
            int e = 0; if (mx > 0.f) (void)frexpf(mx, &e);
            e = min(max(e, -100), 100);
            const float sc = I8 ? (mx > 0.f ? 127.0f / mx : 0.f) : ldexpf(1.0f, 8 - e), isc = I8 ? mx * (1.0f / 127.0f) : ldexpf(1.0f, e - 8);
            const int layer = row / NEXP, ex = row % NEXP;
#pragma unroll
            for (int i = 0; i < 4; ++i) {
                unsigned w;
                if (I8) w = q8x4(v[p][i].x * sc, v[p][i].y * sc, v[p][i].z * sc, v[p][i].w * sc);
                else { w = __builtin_amdgcn_cvt_pk_fp8_f32(v[p][i].x * sc, v[p][i].y * sc, 0, false); w = __builtin_amdgcn_cvt_pk_fp8_f32(v[p][i].z * sc, v[p][i].w * sc, w, true); }
                const int col = 4 * lane + 256 * i, x = col >> 7, off = col & 127;
                *(unsigned*)(dst + (((size_t)layer * 8 + x) * NEXP + ex) * 128 + off) = w;
            }
            if (lane == 0) inv[row] = isc;
        }
    }
}

DEV void phase_norm(const float* xin, const float* g, bf16_t* out, int bid, int nb) {
    const int tid_ = opaque_tid();
    constexpr int RP = 4;
    const int wid = tid_ >> 6, lane = tid_ & 63;
    for (int row0 = (bid * 8 + wid) * RP; row0 < NT; row0 += nb * 8 * RP) {
        float4 v[RP][4];
#pragma unroll
        for (int p = 0; p < RP; ++p) { const float4* xr = (const float4*)(xin + (size_t)(row0 + p) * DM);
#pragma unroll
            for (int i = 0; i < 4; ++i) v[p][i] = xr[lane + 64 * i]; }
#pragma unroll
        for (int p = 0; p < RP; ++p) {
            float ss = 0.f;
#pragma unroll
            for (int i = 0; i < 4; ++i) ss += v[p][i].x * v[p][i].x + v[p][i].y * v[p][i].y + v[p][i].z * v[p][i].z + v[p][i].w * v[p][i].w;
            ss = wave_sum(ss);
            const float rstd = 1.0f / sqrtf(ss * (1.0f / DM) + 1e-6f);
#pragma unroll
            for (int i = 0; i < 4; ++i) {
                const float4 gg = ((const float4*)g)[lane + 64 * i];
                uint2 o; o.x = pk2(v[p][i].x * rstd * gg.x, v[p][i].y * rstd * gg.y); o.y = pk2(v[p][i].z * rstd * gg.z, v[p][i].w * rstd * gg.w);
                ((uint2*)(out + (size_t)(row0 + p) * DM))[lane + 64 * i] = o;
            }
        }
    }
}
template <bool WITH_Q>
DEV void phase_res_norm(const float* xin, const bf16_t* delta, const float* g, float* xout, bf16_t* out, unsigned char* hq, float* hs, int bid, int nb) {
    const int tid_ = opaque_tid();
    const int wid = tid_ >> 6, lane = tid_ & 63;
    for (int row = bid * 8 + wid; row < NT; row += nb * 8) {
        const float4* xr = (const float4*)(xin + (size_t)row * DM);
        const uint2* dr = (const uint2*)(delta + (size_t)row * DM);
        float4 v[4]; float ss = 0.f;
#pragma unroll
        for (int i = 0; i < 4; ++i) { v[i] = xr[lane + 64 * i]; const uint2 d = dr[lane + 64 * i];
            v[i].x += bflo(d.x); v[i].y += bfhi(d.x); v[i].z += bflo(d.y); v[i].w += bfhi(d.y);
            ss += v[i].x * v[i].x + v[i].y * v[i].y + v[i].z * v[i].z + v[i].w * v[i].w; }
        ss = wave_sum(ss);
        const float rstd = 1.0f / sqrtf(ss * (1.0f / DM) + 1e-6f);
        float mx = 0.f;
#pragma unroll
        for (int i = 0; i < 4; ++i) {
            ((float4*)(xout + (size_t)row * DM))[lane + 64 * i] = v[i];
            const float4 gg = ((const float4*)g)[lane + 64 * i];
            v[i].x *= rstd * gg.x; v[i].y *= rstd * gg.y; v[i].z *= rstd * gg.z; v[i].w *= rstd * gg.w;
            uint2 o; o.x = pk2(v[i].x, v[i].y); o.y = pk2(v[i].z, v[i].w);
            ((uint2*)(out + (size_t)row * DM))[lane + 64 * i] = o;
            if (WITH_Q) mx = fmaxf(mx, fmaxf(fmaxf(fabsf(v[i].x), fabsf(v[i].y)), fmaxf(fabsf(v[i].z), fabsf(v[i].w))));
        }
        if (WITH_Q) {
            mx = wave_max(mx);
            const float sc = mx > 0.f ? 127.0f / mx : 0.f;
#pragma unroll
            for (int i = 0; i < 4; ++i) ((unsigned*)(hq + (size_t)row * DM))[lane + 64 * i] = q8x4(v[i].x * sc, v[i].y * sc, v[i].z * sc, v[i].w * sc);
            if (lane == 0) hs[row] = mx * (1.0f / 127.0f);
        }
    }
}
DEV void phase_final_norm(float* x, const bf16_t* delta, const float* g, int bid, int nb) {
    const int tid_ = opaque_tid();
    const int wid = tid_ >> 6, lane = tid_ & 63;
    for (int row = bid * 8 + wid; row < NT; row += nb * 8) {
        float4* xr = (float4*)(x + (size_t)row * DM);
        const uint2* dr = (const uint2*)(delta + (size_t)row * DM);
        float4 v[4]; float ss = 0.f;
#pragma unroll
        for (int i = 0; i < 4; ++i) { v[i] = xr[lane + 64 * i]; const uint2 d = dr[lane + 64 * i];
            v[i].x += bflo(d.x); v[i].y += bfhi(d.x); v[i].z += bflo(d.y); v[i].w += bfhi(d.y);
            ss += v[i].x * v[i].x + v[i].y * v[i].y + v[i].z * v[i].z + v[i].w * v[i].w; }
        ss = wave_sum(ss);
        const float rstd = 1.0f / sqrtf(ss * (1.0f / DM) + 1e-6f);
#pragma unroll
        for (int i = 0; i < 4; ++i) {
            const float4 gg = ((const float4*)g)[lane + 64 * i];
            float4 o; o.x = v[i].x * rstd * gg.x; o.y = v[i].y * rstd * gg.y; o.z = v[i].z * rstd * gg.z; o.w = v[i].w * rstd * gg.w;
            xr[lane + 64 * i] = o;
        }
    }
}

struct EpiBf16 { bf16_t* out; int ld;
    MDEV void operator()(int r, int c, float v) const { out[(size_t)r * ld + c] = f2bf(v); } };
struct EpiOddIn { bf16_t* out; float* fg; const float* bfv;
    MDEV void operator()(int r, int c, float v) const { if (c < 3072) out[(size_t)r * 3072 + c] = f2bf(v); else fg[(size_t)r * 16 + (c - 3072)] = v + bfv[c - 3072]; } };
struct EpiRes { const float* xin; float* xout;
    MDEV void operator()(int r, int c, float v) const { xout[(size_t)r * DM + c] = xin[(size_t)r * DM + c] + v; } };

template <class Epi>
DEV void phase_gemm_naive(const bf16_t* A, const bf16_t* Bt, int M, int N, int K, const Epi epi, float* lds, int bid, int nb) {
    float* As = lds;
    float* Bs = lds + 16 * 132;
    const int t = threadIdx.x, tx = t & 31, ty = t >> 5;
    const int ntm = M / 128, ntn = (N + 127) / 128;
    const int lr = t >> 2, lk = (t & 3) * 4;
    for (int tile = bid; tile < ntm * ntn; tile += nb) {
        const int m0 = (tile / ntn) * 128, n0 = (tile % ntn) * 128;
        float acc[8][4];
#pragma unroll
        for (int i = 0; i < 8; ++i)
#pragma unroll
            for (int j = 0; j < 4; ++j) acc[i][j] = 0.f;
        for (int k0 = 0; k0 < K; k0 += 16) {
            const uint2 av = *(const uint2*)(A + (size_t)(m0 + lr) * K + k0 + lk);
            uint2 bv = make_uint2(0u, 0u);
            if (n0 + lr < N) bv = *(const uint2*)(Bt + (size_t)(n0 + lr) * K + k0 + lk);
            __syncthreads();
            As[(lk + 0) * 132 + lr] = bflo(av.x); As[(lk + 1) * 132 + lr] = bfhi(av.x); As[(lk + 2) * 132 + lr] = bflo(av.y); As[(lk + 3) * 132 + lr] = bfhi(av.y);
            Bs[(lk + 0) * 132 + lr] = bflo(bv.x); Bs[(lk + 1) * 132 + lr] = bfhi(bv.x); Bs[(lk + 2) * 132 + lr] = bflo(bv.y); Bs[(lk + 3) * 132 + lr] = bfhi(bv.y);
            __syncthreads();
#pragma unroll
            for (int k = 0; k < 16; ++k) {
                const float4 a0 = *(const float4*)&As[k * 132 + ty * 8], a1 = *(const float4*)&As[k * 132 + ty * 8 + 4];
                const float4 b0 = *(const float4*)&Bs[k * 132 + tx * 4];
                const float a[8] = {a0.x, a0.y, a0.z, a0.w, a1.x, a1.y, a1.z, a1.w};
                const float b[4] = {b0.x, b0.y, b0.z, b0.w};
#pragma unroll
                for (int i = 0; i < 8; ++i)
#pragma unroll
                    for (int j = 0; j < 4; ++j) acc[i][j] += a[i] * b[j];
            }
        }
#pragma unroll
        for (int i = 0; i < 8; ++i)
#pragma unroll
            for (int j = 0; j < 4; ++j) { const int row = m0 + ty * 8 + i, col = n0 + tx * 4 + j; if (col < N) epi(row, col, acc[i][j]); }
    }
}

typedef short bf16x8 __attribute__((ext_vector_type(8)));
typedef float f32x4 __attribute__((ext_vector_type(4)));
namespace g8 {
constexpr int BM = 256, BK = 64, HALF = 128, NXCD = 8, WGM = 8, HT = HALF * BK, KD = 1024;
DEV int lds_byte(int r, int c) { const int st = (r >> 4) * 2 + (c >> 5), rr = r & 15, cc = c & 31, ob = rr * 64 + cc * 2; return st * 1024 + (ob ^ (((ob >> 9) & 1) << 5)); }
DEV void stage_rc(int b, int& R, int& C) { const int st = b / 1024, sb = b % 1024, swz = sb ^ (((sb >> 9) & 1) << 5); R = (st >> 1) * 16 + swz / 64; C = (st & 1) * 32 + (swz % 64) / 2; }
}
struct MEpiBf16 { static constexpr bool PERM = true; bf16_t* out; int ld;
    MDEV void operator()(int r, int c, f32x4 v0, f32x4 v1) const { uint4 o; o.x = cvtpk2(v0[0], v0[1]); o.y = cvtpk2(v0[2], v0[3]); o.z = cvtpk2(v1[0], v1[1]); o.w = cvtpk2(v1[2], v1[3]);
        *(uint4*)(out + (size_t)r * ld + c) = o; } };
struct MEpiQKV { static constexpr bool PERM = true; bf16_t* out; int s0_hi, s1_lo, s1_hi;
    MDEV void operator()(int r, int c, f32x4 v0, f32x4 v1) const { const float sc = (c < s0_hi || (c >= s1_lo && c < s1_hi)) ? 0.125f * 1.4426950408889634f : 1.0f;
        uint4 o; o.x = cvtpk2(v0[0] * sc, v0[1] * sc); o.y = cvtpk2(v0[2] * sc, v0[3] * sc); o.z = cvtpk2(v1[0] * sc, v1[1] * sc); o.w = cvtpk2(v1[2] * sc, v1[3] * sc);
        *(uint4*)(out + (size_t)r * 3072 + c) = o; } };
struct MEpiRes { static constexpr bool PERM = false; const float* xin; float* xout;
    MDEV void operator()(int r, int c, f32x4 v) const { const f32x4 b = *(const f32x4*)(xin + (size_t)r * DM + c); *(f32x4*)(xout + (size_t)r * DM + c) = b + v; } };

template <class Epi>
DEV void phase_gemm_mfma(const bf16_t* A, const bf16_t* Bt, int M, int N, const Epi epi, unsigned char* shm_raw, int bid, int nb) {
    using namespace g8;
    typedef __attribute__((address_space(3))) unsigned char* ldsp_t;
    ldsp_t lds = (ldsp_t)shm_raw;
    constexpr int K = KD, nt = K / BK, HTB = HALF * BK * 2;
    int tid = threadIdx.x; asm volatile("" : "+v"(tid));
    const int wid = __builtin_amdgcn_readfirstlane(tid >> 6), lane = tid & 63, wr = wid >> 2, wc = wid & 3, fr = lane & 15, fq = lane >> 4;
    const int nM = M / BM, nN = N / BM, nwg = nM * nN;
    auto unit_of = [&](int i, int& pm, int& pn) -> bool {
        const long L = (long)i * nb + bid; if (L >= nwg) return false;
        int wgid = (int)L;
        { const int q = nwg / NXCD, r = nwg % NXCD, xcd = wgid % NXCD, off = wgid / NXCD; wgid = (xcd < r ? xcd * (q + 1) : r * (q + 1) + (xcd - r) * q) + off; }
        const int nig = WGM * nN, gid = wgid / nig, fm = gid * WGM, gsz = min(nM - fm, WGM);
        pm = fm + ((wgid % nig) % gsz); pn = (wgid % nig) / gsz; return true; };
    unsigned voffA[2], voffB[2];
#pragma unroll
    for (int i = 0; i < 2; ++i) { int R, C; stage_rc(tid * 16 + i * 8192, R, C); const int rho = R & 31, pr = 8 * ((rho & 15) >> 2) + 4 * (rho >> 4) + (rho & 3);
        const int Rb = Epi::PERM ? ((R & ~31) + pr) : R;
        voffA[i] = (unsigned)(R * K + C) * 2u; voffB[i] = (unsigned)(Rb * K + C) * 2u; }
    constexpr size_t kstep = (size_t)(BK * 2), hstep = (size_t)HALF * K * 2, tstep = 2 * hstep;
    const unsigned ldsw = (unsigned)wid * 1024u;
    const int aoff = lds_byte(wr * 64 + fr, fq * 8), boff = lds_byte(wc * 32 + fr, fq * 8);
#define SA(b, h) (((b) * 2 + (h)) * HTB)
#define SB(b, h) ((4 + (b) * 2 + (h)) * HTB)
#define STAGE(bufoff, gbase, voff) do { _Pragma("unroll") for (int _i = 0; _i < 2; ++_i) \
        __builtin_amdgcn_global_load_lds((const unsigned*)((const char*)(gbase) + (voff)[_i]), (__attribute__((address_space(3))) unsigned*)(lds + (bufoff) + ldsw + _i * 8192), 16, 0, 0); } while (0)
#define LDA(dst, b, h) do { _Pragma("unroll") for (int m = 0; m < 4; ++m) _Pragma("unroll") for (int k = 0; k < 2; ++k) dst[m][k] = *(const __attribute__((address_space(3))) bf16x8*)(lds + SA(b, h) + aoff + m * 2048 + k * 1024); } while (0)
#define LDB(dst, b, h) do { _Pragma("unroll") for (int n = 0; n < 2; ++n) _Pragma("unroll") for (int k = 0; k < 2; ++k) dst[n][k] = *(const __attribute__((address_space(3))) bf16x8*)(lds + SB(b, h) + boff + n * 2048 + k * 1024); } while (0)
#define MMA(ai, bj, At, Bt_) do { __builtin_amdgcn_s_setprio(1); _Pragma("unroll") for (int m = 0; m < 4; ++m) _Pragma("unroll") for (int n = 0; n < 2; ++n) _Pragma("unroll") for (int k = 0; k < 2; ++k) \
        acc[ai][bj][m][n] = __builtin_amdgcn_mfma_f32_16x16x32_bf16(Bt_[n][k], At[m][k], acc[ai][bj][m][n], 0, 0, 0); __builtin_amdgcn_s_setprio(0); } while (0)
#define WAIT_V(n) asm volatile("s_waitcnt vmcnt(" #n ")" ::: "memory")
#define WAIT_L(n) asm volatile("s_waitcnt lgkmcnt(" #n ")" ::: "memory")
#define BAR __builtin_amdgcn_s_barrier()
#define SCHED __builtin_amdgcn_sched_barrier(0)
    int cpm, cpn, npm = 0, npn = 0, ui = 0;
    if (!unit_of(0, cpm, cpn)) return;
    f32x4 acc[2][2][4][2];
#pragma unroll
    for (int a = 0; a < 2; ++a)
#pragma unroll
        for (int b = 0; b < 2; ++b)
#pragma unroll
            for (int m = 0; m < 4; ++m)
#pragma unroll
                for (int n = 0; n < 2; ++n) acc[a][b][m][n] = (f32x4){0.f, 0.f, 0.f, 0.f};
    bf16x8 At[4][2], B0[2][2], B1[2][2];
    const char* cA = (const char*)A + (size_t)cpm * tstep; const char* cB = (const char*)Bt + (size_t)cpn * tstep;
    __syncthreads();
    STAGE(SB(0, 0), cB, voffB); STAGE(SA(0, 0), cA, voffA); STAGE(SB(0, 1), cB + hstep, voffB); STAGE(SA(0, 1), cA + hstep, voffA);
    if (wr == 1) BAR;
    WAIT_V(4); BAR;
    STAGE(SB(1, 0), cB + kstep, voffB); STAGE(SA(1, 0), cA + kstep, voffA); STAGE(SB(1, 1), cB + hstep + kstep, voffB);
    WAIT_V(6); BAR;
    for (;;) {
        const bool has_next = unit_of(ui + 1, npm, npn);
        const char* nA = has_next ? (const char*)A + (size_t)npm * tstep : cA; const char* nB = has_next ? (const char*)Bt + (size_t)npn * tstep : cB;
#pragma unroll 1
        for (int t = 0; t < nt; t += 2) {
            const bool last = (t == nt - 2);
            const char* a1 = cA + (size_t)(t + 1) * kstep;
            const char* a2 = last ? nA : cA + (size_t)(t + 2) * kstep; const char* b2 = last ? nB : cB + (size_t)(t + 2) * kstep;
            const char* a3 = a2 + kstep; const char* b3 = b2 + kstep;
            LDB(B0, 0, 0); SCHED; LDA(At, 0, 0); STAGE(SA(1, 1), a1 + hstep, voffA);
            WAIT_L(8); BAR; WAIT_L(0); MMA(0, 0, At, B0); BAR; SCHED;
            LDB(B1, 0, 1); STAGE(SB(0, 0), b2, voffB);
            BAR; WAIT_L(0); MMA(0, 1, At, B1); BAR;
            LDA(At, 0, 1); STAGE(SA(0, 0), a2, voffA);
            BAR; WAIT_L(0); MMA(1, 0, At, B0); BAR; SCHED;
            STAGE(SB(0, 1), b2 + hstep, voffB);
            WAIT_V(6); BAR; MMA(1, 1, At, B1); BAR;
            LDB(B0, 1, 0); SCHED; LDA(At, 1, 0); STAGE(SA(0, 1), a2 + hstep, voffA);
            WAIT_L(8); BAR; WAIT_L(0); MMA(0, 0, At, B0); BAR; SCHED;
            LDB(B1, 1, 1); STAGE(SB(1, 0), b3, voffB);
            BAR; WAIT_L(0); MMA(0, 1, At, B1); BAR;
            LDA(At, 1, 1); STAGE(SA(1, 0), a3, voffA);
            BAR; WAIT_L(0); MMA(1, 0, At, B0); BAR; SCHED;
            STAGE(SB(1, 1), b3 + hstep, voffB);
            WAIT_V(6); BAR; MMA(1, 1, At, B1); BAR;
        }
        {
            const int brow = cpm * BM, bcol = cpn * BM;
#pragma unroll
            for (int ai = 0; ai < 2; ++ai)
#pragma unroll
                for (int m = 0; m < 4; ++m)
#pragma unroll
                    for (int bj = 0; bj < 2; ++bj) {
                        const int row = brow + ai * HALF + wr * 64 + m * 16 + fr;
                        if constexpr (Epi::PERM) epi(row, bcol + bj * HALF + wc * 32 + 8 * fq, acc[ai][bj][m][0], acc[ai][bj][m][1]);
                        else { epi(row, bcol + bj * HALF + wc * 32 + 4 * fq, acc[ai][bj][m][0]); epi(row, bcol + bj * HALF + wc * 32 + 16 + 4 * fq, acc[ai][bj][m][1]); }
                    }
        }
        if (!has_next) break;
#pragma unroll
        for (int a = 0; a < 2; ++a)
#pragma unroll
            for (int b = 0; b < 2; ++b)
#pragma unroll
                for (int m = 0; m < 4; ++m)
#pragma unroll
                    for (int n = 0; n < 2; ++n) acc[a][b][m][n] = (f32x4){0.f, 0.f, 0.f, 0.f};
        cpm = npm; cpn = npn; cA = nA; cB = nB; ++ui;
    }
    WAIT_V(0);
    if (wr == 0) BAR;
    BAR;
#undef SA
#undef SB
#undef STAGE
#undef LDA
#undef LDB
#undef MMA
#undef WAIT_V
#undef WAIT_L
#undef BAR
#undef SCHED
}

DEV void phase_fg(const bf16_t* hn, const bf16_t* wfg, const float* bfv, float* fg, int bid, int nb) {
    const int tid_ = opaque_tid();
    const int wid = tid_ >> 6, lane = tid_ & 63, fr = lane & 15, fq = lane >> 4;
    for (int task = bid * 8 + wid; task < NT / 16; task += nb * 8) {
        const int row0 = task * 16;
        f32x4 acc = (f32x4){0.f, 0.f, 0.f, 0.f};
        const bf16x8* ap = (const bf16x8*)(hn + (size_t)(row0 + fr) * DM + fq * 8);
        const bf16x8* bp = (const bf16x8*)(wfg + (size_t)fr * DM + fq * 8);
#pragma unroll 8
        for (int kk = 0; kk < 32; ++kk) acc = __builtin_amdgcn_mfma_f32_16x16x32_bf16(ap[kk * 4], bp[kk * 4], acc, 0, 0, 0);
        const float bb = bfv[fr];
#pragma unroll
        for (int j = 0; j < 4; ++j) fg[(size_t)(row0 + fq * 4 + j) * 16 + fr] = acc[j] + bb;
    }
}

typedef float f32x16 __attribute__((ext_vector_type(16)));
typedef short s16x4 __attribute__((ext_vector_type(4)));
typedef __attribute__((address_space(3))) const unsigned char* ldsc_t;
typedef __attribute__((address_space(3))) unsigned char* lptr_t;
#define MFMA32(a, b, c) __builtin_amdgcn_mfma_f32_32x32x16_bf16(a, b, c, 0, 0, 0)
constexpr float NEG_BIG = -1e30f;
constexpr float LOG2E = 1.4426950408889634f;
constexpr float QSCALE = 0.125f * LOG2E;
constexpr int ATT_LUT_OFF = 0;
constexpr int ATT_TILE_OFF = 24576;
DEV unsigned cvtpk(float lo, float hi) { return cvtpk2(lo, hi); }
DEV s16x4 vtr(ldsc_t p) { typedef short v4i16_t __attribute__((ext_vector_type(4))); return __builtin_bit_cast(s16x4, __builtin_amdgcn_ds_read_tr16_b64_v4i16((__attribute__((address_space(3))) v4i16_t*)p)); }
DEV float xhalf_max(float m) { auto rr = __builtin_amdgcn_permlane32_swap(__float_as_uint(m), __float_as_uint(m), false, false); return fmaxf(__uint_as_float(rr[0]), __uint_as_float(rr[1])); }
DEV float xhalf_sum(float m) { auto rr = __builtin_amdgcn_permlane32_swap(__float_as_uint(m), __float_as_uint(m), false, false); return __uint_as_float(rr[0]) + __uint_as_float(rr[1]); }

#define MXX3(a, b, c) __builtin_fmaxf(__builtin_fmaxf((a), (b)), (c))
template <int W, int MODE, int WIN  , class PRE>
DEV void attn_unit(PRE pre  , const bf16_t* qg  , const bf16_t* kg  , const bf16_t* vg, int kt_lo, int kt_hi,
                   int qrow, int qmin, int qmax, int kmap, unsigned char* lds_raw, f32x16 (&o)[W / 32], float kbound = 0.f, int rs = 3072, float* lse_out = nullptr, int rmax = 4127) {
    constexpr bool BAND = (WIN != 0);
    constexpr bool REV = (MODE == 1);
    constexpr int NC = W / 32, ROWB = W * 2, TILEB = 64 * ROWB, CPR = W / 8, NLD = (64 * CPR) / NTHR;
    int tid = threadIdx.x; asm volatile("" : "+v"(tid));
    const int lane = tid & 63, l31 = lane & 31, hi = lane >> 5;
    ldsc_t lds = (ldsc_t)lds_raw;
    const float* lut = (const float*)(lds_raw + ATT_LUT_OFF);
    bf16x8 qf[4];
#pragma unroll
    for (int ks = 0; ks < 4; ++ks) qf[ks] = *(const bf16x8*)(qg + ks * 16 + hi * 8);
#pragma unroll
    for (int c = 0; c < NC; ++c)
#pragma unroll
        for (int r = 0; r < 16; ++r) o[c][r] = 0.f;
    float m = NEG_BIG, l = 0.f;
    float brow = 0.f; bool wdone = false;
    volatile __attribute__((address_space(3))) unsigned* flg = (volatile __attribute__((address_space(3))) unsigned*)((lptr_t)lds_raw + ATT_LUT_OFF + 20480);
    if (REV) { float ss = 0.f;
#pragma unroll
        for (int ks = 0; ks < 4; ++ks)
#pragma unroll
            for (int j = 0; j < 8; ++j) { const float v = bf2f((bf16_t)qf[ks][j]); ss += v * v; }
        brow = sqrtf(xhalf_sum(ss)) * kbound; }
    const int wv = __builtin_amdgcn_readfirstlane(tid >> 6);
    unsigned ksrc[NLD], vsrc[NLD];
#pragma unroll
    for (int i = 0; i < NLD; ++i) { const int id = tid + NTHR * i, row = id / CPR, chp = id % CPR;
        const int kch = (W == 64) ? (chp ^ ((row >> 1) & 7)) : (chp ^ (row & 15));
        const int vch = (W == 64) ? (chp ^ (((row >> 1) & 1) << 2)) : (chp ^ ((row & 3) << 2));
        ksrc[i] = (unsigned)(row * rs + kch * 8); vsrc[i] = (unsigned)(row * rs + vch * 8); }
#define stage_issue(kt_, buf_) do { _Pragma("unroll") for (int i = 0; i < NLD; ++i) { \
        __builtin_amdgcn_global_load_lds((const unsigned*)(kg + (size_t)(kt_) * 64 * rs + ksrc[i]), (__attribute__((address_space(3))) unsigned*)((lptr_t)lds_raw + ATT_TILE_OFF + (buf_) * (2 * TILEB) + (wv * 64 + NTHR * i) * 16), 16, 0, 0); \
        __builtin_amdgcn_global_load_lds((const unsigned*)(vg + (size_t)(kt_) * 64 * rs + vsrc[i]), (__attribute__((address_space(3))) unsigned*)((lptr_t)lds_raw + ATT_TILE_OFF + (buf_) * (2 * TILEB) + TILEB + (wv * 64 + NTHR * i) * 16), 16, 0, 0); } } while (0)
    int koff[4];
#pragma unroll
    for (int ks = 0; ks < 4; ++ks) { const int ch = (kmap >> 3) + 2 * ks + hi; const int kch = (W == 64) ? (ch ^ ((l31 >> 1) & 7)) : (ch ^ (l31 & 15)); koff[ks] = l31 * ROWB + kch * 16; }
    int voff[NC];
    { const int q4 = (lane & 15) >> 2, blk = (lane >> 4) & 1, p = lane & 3;
#pragma unroll
      for (int c = 0; c < NC; ++c) { const int ch = 4 * c + 2 * blk + (p >> 1); const int vch = (W == 64) ? (ch ^ (((q4 >> 1) & 1) << 2)) : (ch ^ (q4 << 2));
          voff[c] = (4 * hi + q4) * ROWB + vch * 16 + 8 * (p & 1); } }
    __syncthreads();
    stage_issue(REV ? kt_hi : kt_lo, 0);
    pre();
    asm volatile("s_waitcnt vmcnt(0)" ::: "memory");
    __syncthreads();
    const int ntile = kt_hi - kt_lo + 1;
    for (int it = 0; it < ntile; ++it) {
        const int kt = REV ? kt_hi - it : kt_lo + it, ktn = REV ? kt - 1 : kt + 1;
        const bool has_next = it + 1 < ntile;
        const int buf = it & 1;
        if (has_next) stage_issue(ktn, buf ^ 1);
        const int k0 = kt * 64;
        bool active = (k0 <= qmax);
        if (BAND) active = active && (k0 + 63 >= qmin - WIN);
        if (REV) active = active && !wdone;
        if (active) {
            ldsc_t kb_ = lds + ATT_TILE_OFF + buf * (2 * TILEB); ldsc_t vb_ = kb_ + TILEB;
            f32x16 s0, s1;
            if (MODE == 0) {
                const bool far = !BAND && (qmin - (k0 + 63) >= 1513);
                const int ib = far ? (rmax - 3000) : (rmax - (qrow - k0 - 4 * hi));
                const __attribute__((address_space(3))) float* lp = (const __attribute__((address_space(3))) float*)((lptr_t)lds_raw + ATT_LUT_OFF) + ib;
#pragma unroll
                for (int r = 0; r < 16; ++r) { const int cr = (r & 3) + 8 * (r >> 2); s0[r] = lp[cr]; s1[r] = lp[32 + cr]; }
            } else {
                const f32x4* cp = (const f32x4*)(lut + k0 + 4 * hi);
#pragma unroll
                for (int g = 0; g < 4; ++g) { const f32x4 a = cp[2 * g], b = cp[2 * g + 8];
                    s0[4 * g] = a[0]; s0[4 * g + 1] = a[1]; s0[4 * g + 2] = a[2]; s0[4 * g + 3] = a[3];
                    s1[4 * g] = b[0]; s1[4 * g + 1] = b[1]; s1[4 * g + 2] = b[2]; s1[4 * g + 3] = b[3]; }
            }
#pragma unroll
            for (int ks = 0; ks < 4; ++ks) {
                const bf16x8 k0f = *(const __attribute__((address_space(3))) bf16x8*)(kb_ + koff[ks]);
                const bf16x8 k1f = *(const __attribute__((address_space(3))) bf16x8*)(kb_ + koff[ks] + 32 * ROWB);
                s0 = MFMA32(k0f, qf[ks], s0); s1 = MFMA32(k1f, qf[ks], s1);
            }
            if (MODE == 1) {
                if (k0 + 63 > qmin) {
#pragma unroll
                    for (int r = 0; r < 16; ++r) { const int kv = k0 + 4 * hi + (r & 3) + 8 * (r >> 2); if (kv > qrow) s0[r] = NEG_BIG; if (kv + 32 > qrow) s1[r] = NEG_BIG; }
                }
            }
            float mx;
            { const float a0 = MXX3(s0[0], s0[1], s0[2]), a1 = MXX3(s0[3], s0[4], s0[5]), a2 = MXX3(s0[6], s0[7], s0[8]), a3 = MXX3(s0[9], s0[10], s0[11]), a4 = MXX3(s0[12], s0[13], s0[14]);
              const float b0 = MXX3(s1[0], s1[1], s1[2]), b1 = MXX3(s1[3], s1[4], s1[5]), b2 = MXX3(s1[6], s1[7], s1[8]), b3 = MXX3(s1[9], s1[10], s1[11]), b4 = MXX3(s1[12], s1[13], s1[14]);
              mx = MXX3(MXX3(MXX3(a0, a1, a2), MXX3(a3, a4, s0[15]), MXX3(b0, b1, b2)), MXX3(b3, b4, s1[15]), a0); }
            mx = xhalf_max(mx);
            if (!__all(mx - m <= 8.0f)) {
                const float mn = fmaxf(m, mx), alpha = __builtin_amdgcn_exp2f(m - mn);
                m = mn; l *= alpha;
#pragma unroll
                for (int c = 0; c < NC; ++c)
#pragma unroll
                    for (int r = 0; r < 16; ++r) o[c][r] *= alpha;
            }
            float ls = 0.f;
#pragma unroll
            for (int r = 0; r < 16; ++r) { s0[r] = __builtin_amdgcn_exp2f(s0[r] - m); s1[r] = __builtin_amdgcn_exp2f(s1[r] - m); ls += s0[r] + s1[r]; }
            l += ls;
            bf16x8 pf[2][2];
#pragma unroll
            for (int s_ = 0; s_ < 2; ++s_) {
                typedef unsigned u32x4_t __attribute__((ext_vector_type(4)));
                u32x4_t w0, w1;
                w0[0] = cvtpk(s0[8 * s_ + 0], s0[8 * s_ + 1]); w0[1] = cvtpk(s0[8 * s_ + 2], s0[8 * s_ + 3]); w0[2] = cvtpk(s0[8 * s_ + 4], s0[8 * s_ + 5]); w0[3] = cvtpk(s0[8 * s_ + 6], s0[8 * s_ + 7]);
                w1[0] = cvtpk(s1[8 * s_ + 0], s1[8 * s_ + 1]); w1[1] = cvtpk(s1[8 * s_ + 2], s1[8 * s_ + 3]); w1[2] = cvtpk(s1[8 * s_ + 4], s1[8 * s_ + 5]); w1[3] = cvtpk(s1[8 * s_ + 6], s1[8 * s_ + 7]);
                pf[0][s_] = __builtin_bit_cast(bf16x8, w0); pf[1][s_] = __builtin_bit_cast(bf16x8, w1);
            }
#pragma unroll
            for (int c = 0; c < NC; ++c)
#pragma unroll
                for (int kb = 0; kb < 2; ++kb)
#pragma unroll
                    for (int s_ = 0; s_ < 2; ++s_) {
                        const s16x4 lo = vtr(vb_ + voff[c] + (32 * kb + 16 * s_) * ROWB), hi4 = vtr(vb_ + voff[c] + (32 * kb + 16 * s_ + 8) * ROWB);
                        bf16x8 vf; vf[0] = lo[0]; vf[1] = lo[1]; vf[2] = lo[2]; vf[3] = lo[3]; vf[4] = hi4[0]; vf[5] = hi4[1]; vf[6] = hi4[2]; vf[7] = hi4[3];
                        o[c] = MFMA32(vf, pf[kb][s_], o[c]);
                    }
        }
        if (REV) {
            if (!wdone && has_next) { const float nb = lut[k0 - 1]; wdone = __all((m > -1e29f) && (brow + nb < m - 30.0f)); }
            if (lane == 0) flg[(it & 1) * 8 + (tid >> 6)] = wdone ? 1u : 0u;
        }
        asm volatile("s_waitcnt vmcnt(0)" ::: "memory");
        __syncthreads();
        if (REV) { const volatile __attribute__((address_space(3))) unsigned* f = flg + (it & 1) * 8;
            if ((f[0] & f[1] & f[2] & f[3] & f[4] & f[5] & f[6] & f[7]) != 0u) break; }
    }
#undef stage_issue
    const float lt = xhalf_sum(l), inv = 1.0f / lt;
    if (lse_out) *lse_out = m + __log2f(lt);
#pragma unroll
    for (int c = 0; c < NC; ++c)
#pragma unroll
        for (int r = 0; r < 16; ++r) o[c][r] *= inv;
}

template <int NC>
DEV void attn_store(const f32x16 (&o)[NC], bf16_t* orow, int hi) {
#pragma unroll
    for (int c = 0; c < NC; ++c)
#pragma unroll
        for (int g = 0; g < 4; ++g) { uint2 w; w.x = cvtpk(o[c][4 * g], o[c][4 * g + 1]); w.y = cvtpk(o[c][4 * g + 2], o[c][4 * g + 3]);
            *(uint2*)(orow + 32 * c + 8 * g + 4 * hi) = w; }
}

DEV void phase_fox_mfma(const bf16_t* qkv, const float* cloc, const float* ctot, const unsigned* kmax_u, bf16_t* ao, unsigned char* lds_raw, unsigned* qwork) {
    const int tid_ = opaque_tid();
    const int tid = tid_, wid = tid >> 6, lane = tid & 63, l31 = lane & 31, hi = lane >> 5;
    float* nck = (float*)(lds_raw + ATT_LUT_OFF);
    volatile unsigned* qsh = (volatile unsigned*)(lds_raw + ATT_LUT_OFF + 20480 + 128);
    unsigned u = queue_next(qwork, qsh);
    for (;;) {
        if (u >= 2048u) break;
        const unsigned upf = queue_prefetch(qwork);
        const int qblk = 15 - (int)(u >> 7), st = (int)(u & 127), b = st >> 4, h = st & 15;
        const int q0 = qblk * 256, qend = q0 + 255;
        auto pre_ = [&]() { float coff[8]; float run = 0.f;
          float cl[8];
#pragma unroll
          for (int k = 0; k < 8; ++k) { const int i = tid + k * NTHR; cl[k] = (i <= qend) ? cloc[(size_t)st * SEQ + i] : 0.f; }
          const float cend = cloc[(size_t)st * SEQ + qend];
#pragma unroll
          for (int j = 0; j < 8; ++j) { coff[j] = run; run += ctot[st * 8 + j]; }
          float cq = 0.f;
#pragma unroll
          for (int j = 0; j < 8; ++j) cq = ((qend >> 9) == j) ? coff[j] : cq;
          const float cref = cend + cq;
#pragma unroll
          for (int k = 0; k < 8; ++k) { const int i = tid + k * NTHR;
              if (i <= qend) nck[i] = (cref - (cl[k] + coff[k])) * LOG2E; } };
        const float kbound = __uint_as_float(kmax_u[st]);
        const int qrow = q0 + wid * 32 + l31;
        const size_t tokb = (size_t)b * SEQ;
        f32x16 o[2];
        attn_unit<64, 1, 0>(pre_, qkv + (tokb + qrow) * 3072 + h * 64, qkv + tokb * 3072 + 1024 + h * 64, qkv + tokb * 3072 + 2048 + h * 64,
                                0, qend >> 6, qrow, q0 + wid * 32, q0 + wid * 32 + 31, 0, lds_raw, o, kbound);
        attn_store<2>(o, ao + (tokb + qrow) * DM + h * 64, hi);
        u = queue_turn(upf, qsh);
    }
}

DEV void phase_mix0_mfma(const bf16_t* qkv, const float* rel_bias, const float* lamp, const float* ln_g, bf16_t* ao, bf16_t* dpo, float* dlse, unsigned char* lds_raw, unsigned* qwork) {
    const int tid_ = opaque_tid();
    const int tid = tid_, wid = tid >> 6, lane = tid & 63, l31 = lane & 31, hi = lane >> 5;
    float* lut = (float*)(lds_raw + ATT_LUT_OFF);
    volatile unsigned* qsh = (volatile unsigned*)(lds_raw + ATT_LUT_OFF + 20480 + 128);
    float lam;
    { float s1 = 0.f, s2 = 0.f;
      for (int i = 0; i < 64; ++i) { s1 += lamp[i] * lamp[64 + i]; s2 += lamp[128 + i] * lamp[192 + i]; }
      lam = expf(s1) - expf(s2) + 0.2f; }
    unsigned uq = queue_next(qwork, qsh);
    for (;;) {
        if (uq >= 1024u + 3072u) break;
        const unsigned upf = queue_prefetch(qwork);
      if (uq >= 1024u) {
        const int u = (int)uq - 1024;
        const int st = u & 63, v48 = u >> 6, b = st >> 3, h = st & 7;
        int br, r, iblk;
        if (v48 < 16) { br = 0; r = 0; iblk = 15 - v48; } else if (v48 < 32) { br = 1; r = (v48 - 16) & 3; iblk = 3 - ((v48 - 16) >> 2); } else { br = 2; r = v48 - 32; iblk = 0; }
        const int dl = (br == 0) ? 1 : (br == 1) ? 4 : 16;
        const int q0 = iblk * 256, qend = q0 + 255;
        auto pre_ = [&]() { for (int i = tid; i < 640; i += NTHR) { const int dd = 320 - i; lut[i] = (dd >= 0 && dd <= 128) ? rel_bias[t5_bucket(dl * dd) * 12 + h] * LOG2E : NEG_BIG; } };
        const int qrow = q0 + wid * 32 + l31;
        const size_t tokb = (size_t)b * SEQ;
        const int klo = max(q0 - 128, 0) >> 6;
        f32x16 o[2]; float lse;
        attn_unit<64, 0, 128>(pre_, qkv + (tokb + r + (size_t)dl * qrow) * 3072 + h * 64, qkv + (tokb + r) * 3072 + 512 + h * 64, qkv + (tokb + r) * 3072 + 1024 + h * 64,
                              klo, qend >> 6, qrow, q0 + wid * 32, q0 + wid * 32 + 31, 0, lds_raw, o, 0.f, dl * 3072, &lse, 320);
        const size_t tok = tokb + r + (size_t)dl * qrow;
        attn_store<2>(o, dpo + ((size_t)br * NT + tok) * 512 + h * 64, hi);
        if (hi == 0) dlse[((size_t)br * NT + tok) * 8 + h] = lse;
      } else {
        const int u = (int)uq;
        const int qblk = 31 - (u >> 5), st = u & 31;
        const int b = st >> 2, hd = st & 3;
        const int q0 = qblk * 128, qend = q0 + 127;
        auto pre_ = [&]() { float lv[9];
#pragma unroll
          for (int k = 0; k < 9; ++k) { const int i = tid + k * NTHR, dist = 4127 - i; lv[k] = (i < 4224 && dist >= 0 && dist <= 4095) ? rel_bias[t5_bucket(dist) * 12 + 8 + hd] * LOG2E : NEG_BIG; }
#pragma unroll
          for (int k = 0; k < 9; ++k) { const int i = tid + k * NTHR; if (i < 4224) lut[i] = lv[k]; } };
        const int qg_ = wid >> 1, map = wid & 1;
        const int qrow = q0 + qg_ * 32 + l31;
        const size_t tokb = (size_t)b * SEQ;
        f32x16 o[4];
        attn_unit<128, 0, 0>(pre_, qkv + (tokb + qrow) * 3072 + 1536 + hd * 128 + map * 64, qkv + tokb * 3072 + 2048 + hd * 128, qkv + tokb * 3072 + 2560 + hd * 128,
                                 0, qend >> 6, qrow, q0 + qg_ * 32, q0 + qg_ * 32 + 31, map * 64, lds_raw, o);
        float* X = (float*)(lds_raw + ATT_TILE_OFF) + qg_ * 4096;
        if (map == 1) {
#pragma unroll
            for (int c = 0; c < 4; ++c)
#pragma unroll
                for (int r = 0; r < 16; ++r) X[(c * 16 + r) * 64 + lane] = lam * o[c][r];
        }
        __syncthreads();
        if (map == 0) {
            float ss = 0.f;
#pragma unroll
            for (int c = 0; c < 4; ++c)
#pragma unroll
                for (int r = 0; r < 16; ++r) { o[c][r] -= X[(c * 16 + r) * 64 + lane]; ss += o[c][r] * o[c][r]; }
            ss = xhalf_sum(ss);
            const float rstd = 0.8f / sqrtf(ss * (1.0f / 128.0f) + 1e-6f);
            bf16_t* orow = ao + (tokb + qrow) * DM + 512 + hd * 128;
#pragma unroll
            for (int c = 0; c < 4; ++c)
#pragma unroll
                for (int g = 0; g < 4; ++g) { const int d0 = 32 * c + 8 * g + 4 * hi; const f32x4 gg = *(const f32x4*)(ln_g + d0);
                    uint2 wv; wv.x = cvtpk(o[c][4 * g] * rstd * gg[0], o[c][4 * g + 1] * rstd * gg[1]); wv.y = cvtpk(o[c][4 * g + 2] * rstd * gg[2], o[c][4 * g + 3] * rstd * gg[3]);
                    *(uint2*)(orow + d0) = wv; }
        }
      }
        uq = queue_turn(upf, qsh);
    }
}

DEV void phase_dilated_naive(const bf16_t* qkv, const float* rel_bias, bf16_t* ao, float* lds, int bid, int nb) {
    const int t = threadIdx.x, wid = t >> 6, lane = t & 63;
    float* lut = lds;
    __syncthreads();
    for (int i = t; i < 8 * 3 * 129; i += NTHR) {
        const int h = i / (3 * 129), r = i % (3 * 129), br = r / 129, n = r % 129;
        const int dl = br == 0 ? 1 : (br == 1 ? 4 : 16);
        lut[(h * 3 + br) * 132 + n] = rel_bias[t5_bucket(dl * n) * 12 + h];
    }
    __syncthreads();
    for (int task = bid * 8 + wid; task < NT * 8; task += nb * 8) {
        const int tok = task >> 3, h = task & 7, b = tok >> 12, pos = tok & 4095;
        const float q = bf2f(qkv[(size_t)tok * 3072 + h * 64 + lane]) * 0.125f;
        float m = -INFINITY, l = 0.f, o = 0.f;
#pragma unroll
        for (int br = 0; br < 3; ++br) {
            const int dl = br == 0 ? 1 : (br == 1 ? 4 : 16);
            const int nvalid = min(128, pos / dl) + 1;
            const float* lb = lut + (h * 3 + br) * 132;
            for (int n0 = 0; n0 < nvalid; n0 += 4) {
                float kv[4], vv[4];
#pragma unroll
                for (int j = 0; j < 4; ++j) {
                    const int key = max(pos - dl * (n0 + j), 0);
                    const size_t base = (size_t)(b * SEQ + key) * 3072 + h * 64 + lane;
                    kv[j] = bf2f(qkv[base + 512]); vv[j] = bf2f(qkv[base + 1024]);
                }
#pragma unroll
                for (int j = 0; j < 4; ++j) {
                    if (n0 + j < nvalid) {
                        const float s = wave_sum(q * kv[j]) + lb[n0 + j];
                        if (s > m) { const float f = __expf(m - s); l *= f; o *= f; m = s; }
                        const float p = __expf(s - m);
                        l += p; o += p * vv[j];
                    }
                }
            }
        }
        ao[(size_t)tok * DM + h * 64 + lane] = f2bf(o / l);
    }
}

DEV void phase_diff_naive(const bf16_t* qkv, const float* rel_bias, const float* lamp, const float* ln_g, bf16_t* ao, float* lds, int bid, int nb) {
    const int t = threadIdx.x;
    float* Ks = lds;
    float* Vs = lds + 8192;
    float* lut = lds + 16384 + 512;
    float* X = lds;
    float lam;
    { float s1 = 0.f, s2 = 0.f;
      for (int i = 0; i < 64; ++i) { s1 += lamp[i] * lamp[64 + i]; s2 += lamp[128 + i] * lamp[192 + i]; }
      lam = expf(s1) - expf(s2) + 0.2f; }
    const int qi = t & 127, map = (t >> 7) & 1, vh = t >> 8;
    for (int unit = bid; unit < 1024; unit += nb) {
        const int qblk = 31 - unit / 32, bh = unit % 32, b = bh >> 2, hd = bh & 3;
        const int qpos = qblk * 128 + qi;
        const size_t tok = (size_t)b * SEQ + qpos;
        __syncthreads();
        for (int i = t; i < 4096; i += NTHR) lut[i] = rel_bias[t5_bucket(i) * 12 + 8 + hd];
        float q[64], o[64];
        { const uint4* qp = (const uint4*)(qkv + tok * 3072 + 1536 + hd * 128 + map * 64);
#pragma unroll
          for (int i = 0; i < 8; ++i) { const uint4 w = qp[i];
              q[i * 8 + 0] = bflo(w.x) * 0.125f; q[i * 8 + 1] = bfhi(w.x) * 0.125f; q[i * 8 + 2] = bflo(w.y) * 0.125f; q[i * 8 + 3] = bfhi(w.y) * 0.125f;
              q[i * 8 + 4] = bflo(w.z) * 0.125f; q[i * 8 + 5] = bfhi(w.z) * 0.125f; q[i * 8 + 6] = bflo(w.w) * 0.125f; q[i * 8 + 7] = bfhi(w.w) * 0.125f; } }
#pragma unroll
        for (int d = 0; d < 64; ++d) o[d] = 0.f;
        float m = -INFINITY, l = 0.f;
        const int nkt = 2 * qblk + 2;
        for (int kt = 0; kt < nkt; ++kt) {
            __syncthreads();
#pragma unroll
            for (int i = 0; i < 2; ++i) {
                const int e = (t + i * NTHR) * 8, j = e >> 7, d0 = e & 127;
                const size_t base = ((size_t)b * SEQ + kt * 64 + j) * 3072 + hd * 128 + d0;
                const uint4 kw = *(const uint4*)(qkv + base + 2048), vw = *(const uint4*)(qkv + base + 2560);
                float* kd = Ks + j * 128 + d0; float* vd = Vs + j * 128 + d0;
                kd[0] = bflo(kw.x); kd[1] = bfhi(kw.x); kd[2] = bflo(kw.y); kd[3] = bfhi(kw.y); kd[4] = bflo(kw.z); kd[5] = bfhi(kw.z); kd[6] = bflo(kw.w); kd[7] = bfhi(kw.w);
                vd[0] = bflo(vw.x); vd[1] = bfhi(vw.x); vd[2] = bflo(vw.y); vd[3] = bfhi(vw.y); vd[4] = bflo(vw.z); vd[5] = bfhi(vw.z); vd[6] = bflo(vw.w); vd[7] = bfhi(vw.w);
            }
            __syncthreads();
            for (int j = 0; j < 64; ++j) {
                const int key = kt * 64 + j;
                if (key <= qpos) {
                    const float4* kr = (const float4*)(Ks + j * 128 + map * 64);
                    float s = 0.f;
#pragma unroll
                    for (int d4 = 0; d4 < 16; ++d4) { const float4 kk = kr[d4]; s += q[d4 * 4] * kk.x + q[d4 * 4 + 1] * kk.y + q[d4 * 4 + 2] * kk.z + q[d4 * 4 + 3] * kk.w; }
                    s += lut[qpos - key];
                    if (s > m) { const float f = __expf(m - s); l *= f;
#pragma unroll
                        for (int d = 0; d < 64; ++d) o[d] *= f;
                        m = s; }
                    const float p = __expf(s - m);
                    l += p;
                    const float4* vr = (const float4*)(Vs + j * 128 + vh * 64);
#pragma unroll
                    for (int d4 = 0; d4 < 16; ++d4) { const float4 vv = vr[d4]; o[d4 * 4] += p * vv.x; o[d4 * 4 + 1] += p * vv.y; o[d4 * 4 + 2] += p * vv.z; o[d4 * 4 + 3] += p * vv.w; }
                }
            }
        }
        const float inv = 1.0f / l;
        __syncthreads();
        if (map == 1) {
#pragma unroll
            for (int d = 0; d < 64; ++d) X[qi * 129 + vh * 64 + d] = lam * o[d] * inv;
        }
        __syncthreads();
        if (map == 0) {
#pragma unroll
            for (int d = 0; d < 64; ++d) X[qi * 129 + vh * 64 + d] = o[d] * inv - X[qi * 129 + vh * 64 + d];
        }
        __syncthreads();
        {
            const int qq = t >> 2, part = t & 3;
            float ss = 0.f;
            for (int i = 0; i < 32; ++i) { const float v = X[qq * 129 + part * 32 + i]; ss += v * v; }
            ss += __shfl_xor(ss, 1); ss += __shfl_xor(ss, 2);
            const float rstd = 1.0f / sqrtf(ss * (1.0f / 128.0f) + 1e-6f);
            const size_t tk = (size_t)b * SEQ + qblk * 128 + qq;
            for (int i = 0; i < 32; ++i) { const int v = part * 32 + i;
                ao[tk * DM + 512 + hd * 128 + v] = f2bf(X[qq * 129 + v] * rstd * ln_g[v] * 0.8f); }
        }
    }
}

DEV void phase_dilated_merge(const bf16_t* dpo, const float* dlse, bf16_t* ao, int bid, int nb) {
    const int tid_ = opaque_tid();
    const int wid = tid_ >> 6, lane = tid_ & 63, h = lane >> 3;
    constexpr int TP = 4;
    for (int tok0 = (bid * 8 + wid) * TP; tok0 < NT; tok0 += nb * 8 * TP) {
        float ls[TP][3]; uint4 ov[TP][3];
#pragma unroll
        for (int p = 0; p < TP; ++p)
#pragma unroll
            for (int br = 0; br < 3; ++br) { ls[p][br] = dlse[((size_t)br * NT + tok0 + p) * 8 + h]; ov[p][br] = *(const uint4*)(dpo + ((size_t)br * NT + tok0 + p) * 512 + lane * 8); }
#pragma unroll
        for (int p = 0; p < TP; ++p) {
            const float mx = fmaxf(fmaxf(ls[p][0], ls[p][1]), ls[p][2]);
            float w[3]; float sum = 0.f;
#pragma unroll
            for (int br = 0; br < 3; ++br) { w[br] = __builtin_amdgcn_exp2f(ls[p][br] - mx); sum += w[br]; }
            const float inv = 1.0f / sum;
            float acc[8];
#pragma unroll
            for (int i = 0; i < 8; ++i) acc[i] = 0.f;
#pragma unroll
            for (int br = 0; br < 3; ++br) { const float ww = w[br] * inv; const uint4 o_ = ov[p][br];
                acc[0] += ww * bflo(o_.x); acc[1] += ww * bfhi(o_.x); acc[2] += ww * bflo(o_.y); acc[3] += ww * bfhi(o_.y);
                acc[4] += ww * bflo(o_.z); acc[5] += ww * bfhi(o_.z); acc[6] += ww * bflo(o_.w); acc[7] += ww * bfhi(o_.w); }
            uint4 o; o.x = pk2(acc[0], acc[1]); o.y = pk2(acc[2], acc[3]); o.z = pk2(acc[4], acc[5]); o.w = pk2(acc[6], acc[7]);
            *(uint4*)(ao + (size_t)(tok0 + p) * DM + lane * 8) = o;
        }
    }
}

DEV void phase_cumsum(const float* fg, const bf16_t* qkv, float* cloc, float* ctot, unsigned* kmax_u, int bid, int nb) {
    constexpr int XOR1 = 0xB1, XOR2 = 0x4E, HMIR = 0x141;
    const int tid_ = opaque_tid();
    const int wid = tid_ >> 6, lane = tid_ & 63;
    for (int task = bid * 8 + wid; task < 1024; task += nb * 8) {
        const int bh = task >> 3, chunk = task & 7, b = bh >> 4, h = bh & 15;
        const size_t tokb = (size_t)b * SEQ + chunk * 512;
        float xv[8];
#pragma unroll
        for (int st = 0; st < 8; ++st) xv[st] = fg[(tokb + st * 64 + lane) * 16 + h];
        float kmx = 0.f;
        const unsigned char* kb_ = (const unsigned char*)(qkv + (tokb + (lane >> 3)) * 3072 + 1024 + h * 64) + (lane & 7) * 16;
#pragma unroll 1
        for (int g0 = 0; g0 < 64; g0 += 8) {
            uint4 w[8];
#pragma unroll
            for (int j = 0; j < 8; ++j) w[j] = *(const uint4*)(kb_ + (size_t)(g0 + j) * 8 * 3072 * 2);
#pragma unroll
            for (int j = 0; j < 8; ++j) {
                float ss = bflo(w[j].x) * bflo(w[j].x) + bfhi(w[j].x) * bfhi(w[j].x) + bflo(w[j].y) * bflo(w[j].y) + bfhi(w[j].y) * bfhi(w[j].y)
                         + bflo(w[j].z) * bflo(w[j].z) + bfhi(w[j].z) * bfhi(w[j].z) + bflo(w[j].w) * bflo(w[j].w) + bfhi(w[j].w) * bfhi(w[j].w);
                ss += dppf<XOR1>(ss); ss += dppf<XOR2>(ss); ss += dppf<HMIR>(ss);
                kmx = fmaxf(kmx, ss);
            }
        }
        float carry = 0.f;
#pragma unroll
        for (int st = 0; st < 8; ++st) {
            float v = fminf(xv[st], 0.f) - log1pf(expf(-fabsf(xv[st])));
#pragma unroll
            for (int o = 1; o < 64; o <<= 1) { const float u = __shfl_up(v, o); if (lane >= o) v += u; }
            v += carry;
            cloc[(size_t)bh * SEQ + chunk * 512 + st * 64 + lane] = v;
            carry = __shfl(v, 63);
        }
        kmx = wave_max(kmx);
        if (lane == 0) { ctot[bh * 8 + chunk] = carry; atomicMax(kmax_u + bh, __float_as_uint(sqrtf(kmx) * 1.0001f)); }
    }
}

DEV void phase_fox_naive(const bf16_t* qkv, const float* carr, bf16_t* ao, float* lds, int bid, int nb) {
    const int t = threadIdx.x;
    float* Ks = lds;
    float* Vs = lds + 4096;
    float* cks = lds + 8192;
    for (int unit = bid; unit < 1024; unit += nb) {
        const int qblk = 7 - unit / 128, bh = unit % 128, b = bh >> 4, h = bh & 15;
        const int qpos = qblk * 512 + t;
        const size_t tok = (size_t)b * SEQ + qpos;
        float q[64], o[64];
        { const uint4* qp = (const uint4*)(qkv + tok * 3072 + h * 64);
#pragma unroll
          for (int i = 0; i < 8; ++i) { const uint4 w = qp[i];
              q[i * 8 + 0] = bflo(w.x) * 0.125f; q[i * 8 + 1] = bfhi(w.x) * 0.125f; q[i * 8 + 2] = bflo(w.y) * 0.125f; q[i * 8 + 3] = bfhi(w.y) * 0.125f;
              q[i * 8 + 4] = bflo(w.z) * 0.125f; q[i * 8 + 5] = bfhi(w.z) * 0.125f; q[i * 8 + 6] = bflo(w.w) * 0.125f; q[i * 8 + 7] = bfhi(w.w) * 0.125f; } }
#pragma unroll
        for (int d = 0; d < 64; ++d) o[d] = 0.f;
        const float cq = carr[(size_t)bh * SEQ + qpos];
        float m = -INFINITY, l = 0.f;
        const int nkt = (qblk + 1) * 8;
        for (int kt = 0; kt < nkt; ++kt) {
            __syncthreads();
            {
                const int e = t * 8, j = e >> 6, d0 = e & 63;
                const size_t base = ((size_t)b * SEQ + kt * 64 + j) * 3072 + h * 64 + d0;
                const uint4 kw = *(const uint4*)(qkv + base + 1024), vw = *(const uint4*)(qkv + base + 2048);
                float* kd = Ks + j * 64 + d0; float* vd = Vs + j * 64 + d0;
                kd[0] = bflo(kw.x); kd[1] = bfhi(kw.x); kd[2] = bflo(kw.y); kd[3] = bfhi(kw.y); kd[4] = bflo(kw.z); kd[5] = bfhi(kw.z); kd[6] = bflo(kw.w); kd[7] = bfhi(kw.w);
                vd[0] = bflo(vw.x); vd[1] = bfhi(vw.x); vd[2] = bflo(vw.y); vd[3] = bfhi(vw.y); vd[4] = bflo(vw.z); vd[5] = bfhi(vw.z); vd[6] = bflo(vw.w); vd[7] = bfhi(vw.w);
                if (t < 64) cks[t] = carr[(size_t)bh * SEQ + kt * 64 + t];
            }
            __syncthreads();
            for (int j = 0; j < 64; ++j) {
                const int key = kt * 64 + j;
                if (key <= qpos) {
                    const float4* kr = (const float4*)(Ks + j * 64);
                    float s = 0.f;
#pragma unroll
                    for (int d4 = 0; d4 < 16; ++d4) { const float4 kk = kr[d4]; s += q[d4 * 4] * kk.x + q[d4 * 4 + 1] * kk.y + q[d4 * 4 + 2] * kk.z + q[d4 * 4 + 3] * kk.w; }
                    s += cq - cks[j];
                    if (s > m) { const float f = __expf(m - s); l *= f;
#pragma unroll
                        for (int d = 0; d < 64; ++d) o[d] *= f;
                        m = s; }
                    const float p = __expf(s - m);
                    l += p;
                    const float4* vr = (const float4*)(Vs + j * 64);
#pragma unroll
                    for (int d4 = 0; d4 < 16; ++d4) { const float4 vv = vr[d4]; o[d4 * 4] += p * vv.x; o[d4 * 4 + 1] += p * vv.y; o[d4 * 4 + 2] += p * vv.z; o[d4 * 4 + 3] += p * vv.w; }
                }
            }
        }
        const float inv = 1.0f / l;
        uint4* op = (uint4*)(ao + tok * DM + h * 64);
#pragma unroll
        for (int i = 0; i < 8; ++i) { uint4 w; w.x = pk2(o[i * 8] * inv, o[i * 8 + 1] * inv); w.y = pk2(o[i * 8 + 2] * inv, o[i * 8 + 3] * inv);
            w.z = pk2(o[i * 8 + 4] * inv, o[i * 8 + 5] * inv); w.w = pk2(o[i * 8 + 6] * inv, o[i * 8 + 7] * inv); op[i] = w; }
    }
}

DEV void wave_argmax(float& bv, int& bi) {
#pragma unroll
    for (int o = 32; o >= 1; o >>= 1) {
        const float ov = __shfl_xor(bv, o); const int oi = __shfl_xor(bi, o);
        if (ov > bv || (ov == bv && oi < bi)) { bv = ov; bi = oi; }
    }
}
DEV void phase_topk_naive(const bf16_t* pq, const bf16_t* sk, int* idx_out, float* gate_out, float* lds, int bid, int nb) {
    const int wid = threadIdx.x >> 6, lane = threadIdx.x & 63;
    float* wq = lds + wid * 320;
    float* wts = wq + 256;
    int* wti = (int*)(wq + 288);
    for (int task = bid * 8 + wid; task < NT * 8; task += nb * 8) {
        const int tok = task >> 3, h = task & 7;
        lds_fence();
        { const uint2 r = *(const uint2*)(pq + (size_t)tok * 2048 + h * 256 + lane * 4);
          wq[lane * 4 + 0] = bflo(r.x); wq[lane * 4 + 1] = bfhi(r.x); wq[lane * 4 + 2] = bflo(r.y); wq[lane * 4 + 3] = bfhi(r.y); }
        lds_fence();
#pragma unroll 1
        for (int c = 0; c < 2; ++c) {
            float v0, v1;
            const float* qq = wq + c * 128;
            {
                const uint4* row = (const uint4*)(sk + ((size_t)(h * 2 + c) * 128 + lane) * 128);
                float s = 0.f;
#pragma unroll
                for (int i = 0; i < 16; ++i) { const uint4 w = row[i];
                    s += qq[i * 8] * bflo(w.x) + qq[i * 8 + 1] * bfhi(w.x) + qq[i * 8 + 2] * bflo(w.y) + qq[i * 8 + 3] * bfhi(w.y)
                       + qq[i * 8 + 4] * bflo(w.z) + qq[i * 8 + 5] * bfhi(w.z) + qq[i * 8 + 6] * bflo(w.w) + qq[i * 8 + 7] * bfhi(w.w); }
                v0 = s;
            }
            asm volatile("" : "+v"(v0) :: "memory");
            {
                const uint4* row = (const uint4*)(sk + ((size_t)(h * 2 + c) * 128 + lane + 64) * 128);
                float s = 0.f;
#pragma unroll
                for (int i = 0; i < 16; ++i) { const uint4 w = row[i];
                    s += qq[i * 8] * bflo(w.x) + qq[i * 8 + 1] * bfhi(w.x) + qq[i * 8 + 2] * bflo(w.y) + qq[i * 8 + 3] * bfhi(w.y)
                       + qq[i * 8 + 4] * bflo(w.z) + qq[i * 8 + 5] * bfhi(w.z) + qq[i * 8 + 6] * bflo(w.w) + qq[i * 8 + 7] * bfhi(w.w); }
                v1 = s;
            }
            asm volatile("" : "+v"(v1) :: "memory");
            float ts = 0.f; int ti = 0;
            for (int r = 0; r < 16; ++r) {
                float bv; int bi;
                if (v1 > v0) { bv = v1; bi = lane + 64; } else { bv = v0; bi = lane; }
                wave_argmax(bv, bi);
                if (lane == r) { ts = bv; ti = bi; }
                if (bi == lane) v0 = -INFINITY;
                if (bi == lane + 64) v1 = -INFINITY;
            }
            if (lane < 16) { wts[c * 16 + lane] = ts; wti[c * 16 + lane] = ti; }
        }
        lds_fence();
        float cs[4];
#pragma unroll
        for (int jj = 0; jj < 4; ++jj) { const int j = lane * 4 + jj; cs[jj] = wts[j >> 4] + wts[16 + (j & 15)]; }
        float bs = 0.f; int be = 0;
        for (int r = 0; r < 16; ++r) {
            float bv = cs[0]; int bi = lane * 4;
#pragma unroll
            for (int jj = 1; jj < 4; ++jj) if (cs[jj] > bv) { bv = cs[jj]; bi = lane * 4 + jj; }
            wave_argmax(bv, bi);
            if (lane == r) { bs = bv; be = wti[bi >> 4] * 128 + wti[16 + (bi & 15)]; }
#pragma unroll
            for (int jj = 0; jj < 4; ++jj) if (bi == lane * 4 + jj) cs[jj] = -INFINITY;
        }
        float mv = lane < 16 ? bs : -INFINITY;
        mv = wave_max(mv);
        float e = lane < 16 ? __expf(bs - mv) : 0.f;
        const float sum = wave_sum(e);
        if (lane < 16) { idx_out[(size_t)tok * 128 + h * 16 + lane] = be; gate_out[(size_t)tok * 128 + h * 16 + lane] = e / sum; }
    }
}

struct PairTab { int a[50], b[50]; };
constexpr PairTab make_pairs() { PairTab t{}; int n = 0; for (int a = 0; a < 16; ++a) for (int b = 0; b < 16; ++b) if ((a + 1) * (b + 1) <= 16) { t.a[n] = a; t.b[n] = b; ++n; } return t; }
constexpr PairTab PAIRS = make_pairs();
#define MX3(a, b, c) __builtin_fmaxf(__builtin_fmaxf((a), (b)), (c))
DEV unsigned xhalf_or(unsigned v) { auto rr = __builtin_amdgcn_permlane32_swap(v, v, false, false); return rr[0] | rr[1]; }
template <int J, int N, class T> DEV void bstage(T& v, const int k) {
#pragma clang loop unroll(full)
    for (int i = 0; i < N; ++i) { const int l = i ^ J; if (l > i) { const bool d = ((i & k) == 0); const float hi_ = fmaxf(v[i], v[l]), lo_ = fminf(v[i], v[l]); v[i] = d ? hi_ : lo_; v[l] = d ? lo_ : hi_; } }
}
template <int N, class T> DEV void bmerge_desc(T& v) {
    if constexpr (N >= 32) bstage<16, N>(v, N);
    if constexpr (N >= 16) bstage<8, N>(v, N);
    bstage<4, N>(v, N); bstage<2, N>(v, N); bstage<1, N>(v, N);
}
template <int N, class T> DEV void bsort_desc(T& v) {
    bstage<1, N>(v, 2);
    bstage<2, N>(v, 4); bstage<1, N>(v, 4);
    bstage<4, N>(v, 8); bstage<2, N>(v, 8); bstage<1, N>(v, 8);
    bstage<8, N>(v, 16); bstage<4, N>(v, 16); bstage<2, N>(v, 16); bstage<1, N>(v, 16);
    if constexpr (N >= 32) { bstage<16, N>(v, 32); bstage<8, N>(v, 32); bstage<4, N>(v, 32); bstage<2, N>(v, 32); bstage<1, N>(v, 32); }
}
template <class T> DEV void merge_top16(T& a, const T& b) {
#pragma unroll
    for (int i = 0; i < 16; ++i) a[i] = fmaxf(a[i], b[15 - i]);
    bmerge_desc<16>(a);
}
DEV float xhalf_other(float v, int hi) { auto rr = __builtin_amdgcn_permlane32_swap(__float_as_uint(v), __float_as_uint(v), false, false); return __uint_as_float(hi ? rr[0] : rr[1]); }
DEV void phase_topk_mfma(const bf16_t* pq, const bf16_t* skl, const float* uinv, const float* vinv, int* idx_out, float* gate_out, float* usc_out, unsigned char* lds_raw, int bid, int nb) {
    int tid = threadIdx.x; asm volatile("" : "+v"(tid));
    const int wid = tid >> 6, lane = tid & 63, l31 = lane & 31, hi = lane >> 5;
    ldsc_t lds = (ldsc_t)lds_raw;
    int cur_h = -1;
    bf16x8 qf[8];
#define TK_QLOAD(u_, c_) do { const bf16_t* qp_ = pq + (size_t)(((u_) >> 3) * 256 + wid * 32 + l31) * 2048 + ((u_) & 7) * 256 + (c_) * 128 + hi * 8; \
        _Pragma("unroll") for (int ks = 0; ks < 8; ++ks) qf[ks] = *(const bf16x8*)(qp_ + ks * 16); } while (0)
    if (bid < 1024) TK_QLOAD(bid, 0);
    for (int u = bid; u < 1024; u += nb) {
        const int h = u & 7, tg = u >> 3;
        if (h != cur_h) {
            __syncthreads();
#pragma unroll
            for (int i = 0; i < 8; ++i) { const int id = tid + NTHR * i, crow_ = id >> 4, ch = id & 15;
                const uint4 v = *(const uint4*)(skl + ((size_t)h * 256 + crow_) * 128 + ch * 8);
                *(uint4*)(lds_raw + crow_ * 256 + ((ch ^ (crow_ & 15)) * 16)) = v; }
            __syncthreads();
            cur_h = h;
        }
        const int tok = tg * 256 + wid * 32 + l31;
        const bf16_t* qp = pq + (size_t)tok * 2048 + h * 256;
        __attribute__((address_space(3))) unsigned* nt = (__attribute__((address_space(3))) unsigned*)((lptr_t)lds_raw + 65536 + wid * 8320 + l31 * 260);
#pragma unroll
        for (int c = 0; c < 2; ++c) {
            f32x16 acc[4];
#pragma unroll
            for (int kb = 0; kb < 4; ++kb)
#pragma unroll
                for (int r = 0; r < 16; ++r) acc[kb][r] = 0.f;
            asm volatile("" : "+v"(qf[0]), "+v"(qf[1]), "+v"(qf[2]), "+v"(qf[3]), "+v"(qf[4]), "+v"(qf[5]), "+v"(qf[6]), "+v"(qf[7]));
#pragma unroll
            for (int ks = 0; ks < 8; ++ks) {
#pragma unroll
                for (int kb = 0; kb < 4; ++kb) {
                    const int row = c * 128 + 32 * kb + l31, ch = 2 * ks + hi;
                    const bf16x8 af = *(const __attribute__((address_space(3))) bf16x8*)(lds + row * 256 + ((ch ^ (l31 & 15)) * 16));
                    acc[kb] = MFMA32(af, qf[ks], acc[kb]);
                }
            }
            asm volatile("" ::: "memory");
            if (c == 0) TK_QLOAD(u, 1); else if (u + nb < 1024) TK_QLOAD(u + nb, 0);
            asm volatile("" ::: "memory");
#pragma unroll
            for (int kb = 0; kb < 4; ++kb)
#pragma unroll
                for (int r = 0; r < 16; ++r) { const unsigned n = 32u * kb + (r & 3) + 8 * (r >> 2) + 4u * hi;
                    acc[kb][r] = __uint_as_float((__float_as_uint(acc[kb][r]) & ~127u) | n); }
            bsort_desc<16>(acc[0]); bsort_desc<16>(acc[1]); bsort_desc<16>(acc[2]); bsort_desc<16>(acc[3]);
            merge_top16(acc[0], acc[1]); merge_top16(acc[2], acc[3]); merge_top16(acc[0], acc[2]);
            { float t_[16];
#pragma unroll
              for (int i = 0; i < 16; ++i) t_[i] = fmaxf(acc[0][i], xhalf_other(acc[0][15 - i], hi));
              bmerge_desc<16>(t_);
#pragma unroll
              for (int i = 0; i < 16; ++i) nt[c * 16 + i] = __float_as_uint(t_[i]); }
        }
        lds_fence();
        float cs[32];
#pragma unroll
        for (int i = 0; i < 25; ++i) {
            const int ai = PAIRS.a[2 * i] + hi * (PAIRS.a[2 * i + 1] - PAIRS.a[2 * i]), bi = PAIRS.b[2 * i] + hi * (PAIRS.b[2 * i + 1] - PAIRS.b[2 * i]);
            const float sum = __uint_as_float(nt[ai]) + __uint_as_float(nt[16 + bi]);
            cs[i] = __uint_as_float((__float_as_uint(sum) & ~255u) | (unsigned)(ai * 16 + bi));
        }
#pragma unroll
        for (int i = 25; i < 32; ++i) cs[i] = -INFINITY;
        bsort_desc<32>(cs);
        float bs[16];
#pragma unroll
        for (int i = 0; i < 16; ++i) bs[i] = fmaxf(cs[i], xhalf_other(cs[15 - i], hi));
        bmerge_desc<16>(bs);
        unsigned be8[8]; float bs8[8];
#pragma unroll
        for (int i = 0; i < 16; ++i) (nt + 32 + 64 * 0)[i + 0] = __float_as_uint(bs[i]);
        lds_fence();
#pragma unroll
        for (int j = 0; j < 8; ++j) { const float w_ = __uint_as_float(nt[32 + 8 * hi + j]); const unsigned tg = __float_as_uint(w_) & 255u; bs8[j] = w_;
            be8[j] = (nt[tg >> 4] & 127u) * 128u + (nt[16 + (tg & 15u)] & 127u); }
        float sum = 0.f; const float bmax = bs[0];
#pragma unroll
        for (int rd = 0; rd < 16; ++rd) sum += __builtin_amdgcn_exp2f((bs[rd] - bmax) * LOG2E);
        const float inv = 1.0f / sum;
        uint4 i0, i1; float4 g0, g1;
        i0.x = be8[0]; i0.y = be8[1]; i0.z = be8[2]; i0.w = be8[3]; i1.x = be8[4]; i1.y = be8[5]; i1.z = be8[6]; i1.w = be8[7];
        g0.x = __builtin_amdgcn_exp2f((bs8[0] - bmax) * LOG2E) * inv; g0.y = __builtin_amdgcn_exp2f((bs8[1] - bmax) * LOG2E) * inv; g0.z = __builtin_amdgcn_exp2f((bs8[2] - bmax) * LOG2E) * inv; g0.w = __builtin_amdgcn_exp2f((bs8[3] - bmax) * LOG2E) * inv;
        g1.x = __builtin_amdgcn_exp2f((bs8[4] - bmax) * LOG2E) * inv; g1.y = __builtin_amdgcn_exp2f((bs8[5] - bmax) * LOG2E) * inv; g1.z = __builtin_amdgcn_exp2f((bs8[6] - bmax) * LOG2E) * inv; g1.w = __builtin_amdgcn_exp2f((bs8[7] - bmax) * LOG2E) * inv;
        float4 s0, s1;
        s0.x = uinv[i0.x]; s0.y = uinv[i0.y]; s0.z = uinv[i0.z]; s0.w = uinv[i0.w]; s1.x = uinv[i1.x]; s1.y = uinv[i1.y]; s1.z = uinv[i1.z]; s1.w = uinv[i1.w];
        g0.x *= vinv[i0.x]; g0.y *= vinv[i0.y]; g0.z *= vinv[i0.z]; g0.w *= vinv[i0.w]; g1.x *= vinv[i1.x]; g1.y *= vinv[i1.y]; g1.z *= vinv[i1.z]; g1.w *= vinv[i1.w];
        uint4* ip = (uint4*)(idx_out + (size_t)tok * 128 + h * 16 + 8 * hi); ip[0] = i0; ip[1] = i1;
        float4* gp = (float4*)(gate_out + (size_t)tok * 128 + h * 16 + 8 * hi); gp[0] = g0; gp[1] = g1;
        float4* sp = (float4*)(usc_out + (size_t)tok * 128 + h * 16 + 8 * hi); sp[0] = s0; sp[1] = s1;
    }
}

typedef __bf16 bf16x2_t __attribute__((ext_vector_type(2)));
DEV float dot2bf(unsigned a, unsigned b, float acc) { return __builtin_amdgcn_fdot2_f32_bf16(__builtin_bit_cast(bf16x2_t, a), __builtin_bit_cast(bf16x2_t, b), acc, false); }
DEV float gelu_as(float v) {
    const float av = fabsf(v), t = __builtin_amdgcn_rcpf(av * 0.2316418882f + 1.0f);
    float q = t * 0.5307027145f + (-0.7265760135f); q = q * t + 0.7107068705f; q = q * t + (-0.142248368f); q = q * t + 0.127414796f; q = q * t;
    const float e = __builtin_amdgcn_exp2f((v * v) * (-0.72134752044f));
    const float m = v * (q * e);
    return v < 0.f ? m : v - m;
}
DEV void phase_expert_v2(const bf16_t* hn, const bf16_t* ut, const bf16_t* vt, const int* idx, const float* gate, float* xres, int bid, int nb, float oscale = 1.0f) {
    const int wid = threadIdx.x >> 6, lane = threadIdx.x & 63;
    for (int tok = bid * 8 + wid; tok < NT; tok += nb * 8) {
        const uint4 h0 = *(const uint4*)(hn + (size_t)tok * DM + lane * 8), h1 = *(const uint4*)(hn + (size_t)tok * DM + 512 + lane * 8);
        float acc[16];
#pragma unroll
        for (int i = 0; i < 16; ++i) acc[i] = 0.f;
        uint4 uA[4][2], vA[4][2], uB[4][2], vB[4][2];
#define XLOAD(U, V, k_) do { _Pragma("unroll") for (int j = 0; j < 4; ++j) { const int e_ = __builtin_amdgcn_readfirstlane(idx[(size_t)tok * 128 + (k_) + j]); \
            const bf16_t* up = ut + (size_t)e_ * DM + lane * 8; const bf16_t* vp = vt + (size_t)e_ * DM + lane * 8; \
            U[j][0] = *(const uint4*)up; U[j][1] = *(const uint4*)(up + 512); V[j][0] = *(const uint4*)vp; V[j][1] = *(const uint4*)(vp + 512); } } while (0)
#define XCOMP(U, V, k_) do { float d_[4]; \
        _Pragma("unroll") for (int j = 0; j < 4; ++j) { float d = 0.f; \
            d = dot2bf(U[j][0].x, h0.x, d); d = dot2bf(U[j][0].y, h0.y, d); d = dot2bf(U[j][0].z, h0.z, d); d = dot2bf(U[j][0].w, h0.w, d); \
            d = dot2bf(U[j][1].x, h1.x, d); d = dot2bf(U[j][1].y, h1.y, d); d = dot2bf(U[j][1].z, h1.z, d); d = dot2bf(U[j][1].w, h1.w, d); d_[j] = d; } \
        { const bool b0 = lane & 1, b1 = lane & 2; \
          float x0 = b0 ? d_[1] : d_[0], y0 = b0 ? d_[0] : d_[1], x1 = b0 ? d_[3] : d_[2], y1 = b0 ? d_[2] : d_[3]; \
          x0 += __shfl_xor(y0, 1); x1 += __shfl_xor(y1, 1);                   \
          float x = b1 ? x1 : x0, y = b1 ? x0 : x1; x += __shfl_xor(y, 2);      \
          x += __shfl_xor(x, 4); x += __shfl_xor(x, 8); x += __shfl_xor(x, 16); x += __shfl_xor(x, 32); \
          const float wl = gelu_as(x) * gate[(size_t)tok * 128 + (k_) + (lane & 3)]; \
          _Pragma("unroll") for (int j = 0; j < 4; ++j) { const float w = __uint_as_float(__builtin_amdgcn_readlane(__float_as_uint(wl), j)); \
              acc[0] += w * bflo(V[j][0].x); acc[1] += w * bfhi(V[j][0].x); acc[2] += w * bflo(V[j][0].y); acc[3] += w * bfhi(V[j][0].y); \
              acc[4] += w * bflo(V[j][0].z); acc[5] += w * bfhi(V[j][0].z); acc[6] += w * bflo(V[j][0].w); acc[7] += w * bfhi(V[j][0].w); \
              acc[8] += w * bflo(V[j][1].x); acc[9] += w * bfhi(V[j][1].x); acc[10] += w * bflo(V[j][1].y); acc[11] += w * bfhi(V[j][1].y); \
              acc[12] += w * bflo(V[j][1].z); acc[13] += w * bfhi(V[j][1].z); acc[14] += w * bflo(V[j][1].w); acc[15] += w * bfhi(V[j][1].w); } } } while (0)
        XLOAD(uA, vA, 0);
#pragma unroll 1
        for (int k0 = 0; k0 < 128; k0 += 8) {
            XLOAD(uB, vB, k0 + 4);
            XCOMP(uA, vA, k0);
            if (k0 + 8 < 128) XLOAD(uA, vA, k0 + 8);
            XCOMP(uB, vB, k0 + 4);
        }
#undef XLOAD
#undef XCOMP
        float4* p0 = (float4*)(xres + (size_t)tok * DM + lane * 8); float4* p1 = (float4*)(xres + (size_t)tok * DM + 512 + lane * 8);
        float4 a = p0[0], b = p0[1], c = p1[0], d = p1[1];
        a.x += oscale * acc[0]; a.y += oscale * acc[1]; a.z += oscale * acc[2]; a.w += oscale * acc[3]; b.x += oscale * acc[4]; b.y += oscale * acc[5]; b.z += oscale * acc[6]; b.w += oscale * acc[7];
        c.x += oscale * acc[8]; c.y += oscale * acc[9]; c.z += oscale * acc[10]; c.w += oscale * acc[11]; d.x += oscale * acc[12]; d.y += oscale * acc[13]; d.z += oscale * acc[14]; d.w += oscale * acc[15];
        p0[0] = a; p0[1] = b; p1[0] = c; p1[1] = d;
    }
}

typedef float f32x2_t __attribute__((ext_vector_type(2)));
#define FP8LO(w) __builtin_amdgcn_cvt_pk_f32_fp8((int)(w), false)
#define FP8HI(w) __builtin_amdgcn_cvt_pk_f32_fp8((int)(w), true)
DEV float dot16_fp8(const uint4 u, const float (&h)[16]) {
    float d = 0.f; f32x2_t a;
    a = FP8LO(u.x); d += a[0] * h[0] + a[1] * h[1]; a = FP8HI(u.x); d += a[0] * h[2] + a[1] * h[3];
    a = FP8LO(u.y); d += a[0] * h[4] + a[1] * h[5]; a = FP8HI(u.y); d += a[0] * h[6] + a[1] * h[7];
    a = FP8LO(u.z); d += a[0] * h[8] + a[1] * h[9]; a = FP8HI(u.z); d += a[0] * h[10] + a[1] * h[11];
    a = FP8LO(u.w); d += a[0] * h[12] + a[1] * h[13]; a = FP8HI(u.w); d += a[0] * h[14] + a[1] * h[15];
    return d;
}
#define PIN4(u) asm volatile("" : "+v"((u).x), "+v"((u).y), "+v"((u).z), "+v"((u).w))
DEV void fma16_fp8(const uint4 v, const float w, float (&acc)[16]) {
    f32x2_t a;
    a = FP8LO(v.x); acc[0] += w * a[0]; acc[1] += w * a[1]; a = FP8HI(v.x); acc[2] += w * a[0]; acc[3] += w * a[1];
    a = FP8LO(v.y); acc[4] += w * a[0]; acc[5] += w * a[1]; a = FP8HI(v.y); acc[6] += w * a[0]; acc[7] += w * a[1];
    a = FP8LO(v.z); acc[8] += w * a[0]; acc[9] += w * a[1]; a = FP8HI(v.z); acc[10] += w * a[0]; acc[11] += w * a[1];
    a = FP8LO(v.w); acc[12] += w * a[0]; acc[13] += w * a[1]; a = FP8HI(v.w); acc[14] += w * a[0]; acc[15] += w * a[1];
}
DEV float x1632_sum(float x) {
    auto s = __builtin_amdgcn_permlane16_swap(__float_as_uint(x), __float_as_uint(x), false, false);
    x = __uint_as_float(s[0]) + __uint_as_float(s[1]);
    auto t = __builtin_amdgcn_permlane32_swap(__float_as_uint(x), __float_as_uint(x), false, false);
    return __uint_as_float(t[0]) + __uint_as_float(t[1]);
}
DEV void phase_expert_v3(const bf16_t* hn, const unsigned char* ut, const unsigned char* vt, const int* idx, const float* gate, const float* usc, float* xres, int bid, int nb, float oscale = 1.0f) {
    constexpr int XOR1 = 0xB1, XOR2 = 0x4E, ROR4 = 0x124, ROR8 = 0x128;
    int tid = threadIdx.x; asm volatile("" : "+v"(tid));
    const unsigned wid = tid >> 6, lane = tid & 63;
    const bool b0 = lane & 1, b1 = lane & 2, b2 = lane & 4;
    for (unsigned tok = bid * 8 + wid; tok < (unsigned)NT; tok += nb * 8) {
        float hf[16], acc[16];
        { const uint4* hp = (const uint4*)((const char*)hn + (tok * 2048u + lane * 32u)); const uint4 h0 = hp[0], h1 = hp[1];
          hf[0] = bflo(h0.x); hf[1] = bfhi(h0.x); hf[2] = bflo(h0.y); hf[3] = bfhi(h0.y); hf[4] = bflo(h0.z); hf[5] = bfhi(h0.z); hf[6] = bflo(h0.w); hf[7] = bfhi(h0.w);
          hf[8] = bflo(h1.x); hf[9] = bfhi(h1.x); hf[10] = bflo(h1.y); hf[11] = bfhi(h1.y); hf[12] = bflo(h1.z); hf[13] = bfhi(h1.z); hf[14] = bflo(h1.w); hf[15] = bfhi(h1.w); }
#pragma unroll
        for (int i = 0; i < 16; ++i) acc[i] = 0.f;
        const unsigned pbase = tok * 128u;
        uint4 uA[4], vA[4], uB[4], vB[4];
#define XLOAD(U, V, k_) do { _Pragma("unroll") for (int j = 0; j < 4; ++j) { const unsigned eo_ = (unsigned)idx[pbase + (k_) + j] * 1024u + lane * 16u; U[j] = *(const uint4*)(ut + eo_); V[j] = *(const uint4*)(vt + eo_); } } while (0)
#define XCOMP(U, V, k_) do { float d_[4]; \
        _Pragma("unroll") for (int j = 0; j < 4; ++j) d_[j] = dot16_fp8(U[j], hf); \
        const float x0_ = (b0 ? d_[1] : d_[0]) + dppf<XOR1>(b0 ? d_[0] : d_[1]), x1_ = (b0 ? d_[3] : d_[2]) + dppf<XOR1>(b0 ? d_[2] : d_[3]); \
        float x = (b1 ? x1_ : x0_) + dppf<XOR2>(b1 ? x0_ : x1_);            \
        x += dppf<ROR4>(x); x += dppf<ROR8>(x); x = x1632_sum(x); \
        const unsigned o_ = pbase + (k_) + (lane & 3u); \
        const float wl = gelu_as(x * usc[o_]) * gate[o_]; \
        _Pragma("unroll") for (int j = 0; j < 4; ++j) { const float w = __uint_as_float(__builtin_amdgcn_readlane(__float_as_uint(wl), j)); fma16_fp8(V[j], w, acc); } } while (0)
        XLOAD(uA, vA, 0);
#pragma unroll 1
        for (int k0 = 0; k0 < 128; k0 += 8) {
            XLOAD(uB, vB, k0 + 4);
            XCOMP(uA, vA, k0);
            if (k0 + 8 < 128) XLOAD(uA, vA, k0 + 8);
            XCOMP(uB, vB, k0 + 4);
        }
#undef XLOAD
#undef XCOMP
        float4* p0 = (float4*)((char*)xres + (tok * 4096u + lane * 64u));
        float4 a = p0[0], b = p0[1], c = p0[2], d = p0[3];
        a.x += oscale * acc[0]; a.y += oscale * acc[1]; a.z += oscale * acc[2]; a.w += oscale * acc[3]; b.x += oscale * acc[4]; b.y += oscale * acc[5]; b.z += oscale * acc[6]; b.w += oscale * acc[7];
        c.x += oscale * acc[8]; c.y += oscale * acc[9]; c.z += oscale * acc[10]; c.w += oscale * acc[11]; d.x += oscale * acc[12]; d.y += oscale * acc[13]; d.z += oscale * acc[14]; d.w += oscale * acc[15];
        p0[0] = a; p0[1] = b; p0[2] = c; p0[3] = d;
    }
}

constexpr int PEER_UNIT_TOK = 512, PEER_UNITS = NT / PEER_UNIT_TOK, PEER_WTOK = PEER_UNIT_TOK / 8, PEER_NIT = PEER_WTOK / 2;
constexpr size_t WS_QCTR = 16384;
constexpr size_t WS_CTL_BYTES = 16384 + 32 * 256;
DEV unsigned peer_next_unit(unsigned* q, volatile unsigned* sh) { return queue_next(q, sh); }
typedef float f32x2p __attribute__((ext_vector_type(2)));
DEV float dot16_fp8_pk(const uint4 u, const f32x2p (&h)[8]) {
    f32x2p d = __builtin_amdgcn_cvt_pk_f32_fp8((int)u.x, false) * h[0];
    d = __builtin_elementwise_fma(__builtin_amdgcn_cvt_pk_f32_fp8((int)u.x, true), h[1], d);
    d = __builtin_elementwise_fma(__builtin_amdgcn_cvt_pk_f32_fp8((int)u.y, false), h[2], d);
    d = __builtin_elementwise_fma(__builtin_amdgcn_cvt_pk_f32_fp8((int)u.y, true), h[3], d);
    d = __builtin_elementwise_fma(__builtin_amdgcn_cvt_pk_f32_fp8((int)u.z, false), h[4], d);
    d = __builtin_elementwise_fma(__builtin_amdgcn_cvt_pk_f32_fp8((int)u.z, true), h[5], d);
    d = __builtin_elementwise_fma(__builtin_amdgcn_cvt_pk_f32_fp8((int)u.w, false), h[6], d);
    d = __builtin_elementwise_fma(__builtin_amdgcn_cvt_pk_f32_fp8((int)u.w, true), h[7], d);
    return d[0] + d[1];
}
DEV void fma16_fp8_pk(const uint4 v, const float w, f32x2p (&acc)[8]) {
    const f32x2p wv = {w, w};
    acc[0] = __builtin_elementwise_fma(__builtin_amdgcn_cvt_pk_f32_fp8((int)v.x, false), wv, acc[0]);
    acc[1] = __builtin_elementwise_fma(__builtin_amdgcn_cvt_pk_f32_fp8((int)v.x, true), wv, acc[1]);
    acc[2] = __builtin_elementwise_fma(__builtin_amdgcn_cvt_pk_f32_fp8((int)v.y, false), wv, acc[2]);
    acc[3] = __builtin_elementwise_fma(__builtin_amdgcn_cvt_pk_f32_fp8((int)v.y, true), wv, acc[3]);
    acc[4] = __builtin_elementwise_fma(__builtin_amdgcn_cvt_pk_f32_fp8((int)v.z, false), wv, acc[4]);
    acc[5] = __builtin_elementwise_fma(__builtin_amdgcn_cvt_pk_f32_fp8((int)v.z, true), wv, acc[5]);
    acc[6] = __builtin_elementwise_fma(__builtin_amdgcn_cvt_pk_f32_fp8((int)v.w, false), wv, acc[6]);
    acc[7] = __builtin_elementwise_fma(__builtin_amdgcn_cvt_pk_f32_fp8((int)v.w, true), wv, acc[7]);
}
DEV void phase_peer_dots(const bf16_t* hn, const unsigned char* u8s, const int* idx, float* partial, unsigned* qctr, unsigned char* lds_raw, unsigned xcc) {
    constexpr int XOR1 = 0xB1, XOR2 = 0x4E, HMIR = 0x141;
    int tid = threadIdx.x; asm volatile("" : "+v"(tid));
    const unsigned wid = tid >> 6, lane = tid & 63, g = lane >> 3, sub = lane & 7;
    volatile unsigned* sh = (volatile unsigned*)(lds_raw + 256);
    for (unsigned s_ = 0; s_ < 8; ++s_) {
        const unsigned x = (xcc + s_) & 7;
        const unsigned char* ux = u8s + (size_t)x * NEXP * 128;
        const unsigned sub16 = sub * 16u;
        for (;;) {
            const unsigned unit = peer_next_unit(qctr + 64 * x, sh);
            if (unit >= (unsigned)PEER_UNITS) break;
            const unsigned tok0 = unit * PEER_UNIT_TOK + wid * PEER_WTOK;
            uint4 ixn[4]; uint4 hn0, hn1;
            { const uint4* ip = (const uint4*)((const char*)idx + (tok0 * 512u + g * 64u)); ixn[0] = ip[0]; ixn[1] = ip[1]; ixn[2] = ip[2]; ixn[3] = ip[3];
              const uint4* hp = (const uint4*)((const char*)hn + (tok0 * 2048u + x * 256u + sub * 32u)); hn0 = hp[0]; hn1 = hp[1]; }
            uint4 Ua[8], Ub[8];
#define ROWS(U, e0, e1, e2, e3, e4, e5, e6, e7) do { U[0] = *(const uint4*)(ux + ((e0) * 128u + sub16)); U[1] = *(const uint4*)(ux + ((e1) * 128u + sub16)); U[2] = *(const uint4*)(ux + ((e2) * 128u + sub16)); \
            U[3] = *(const uint4*)(ux + ((e3) * 128u + sub16)); U[4] = *(const uint4*)(ux + ((e4) * 128u + sub16)); U[5] = *(const uint4*)(ux + ((e5) * 128u + sub16)); \
            U[6] = *(const uint4*)(ux + ((e6) * 128u + sub16)); U[7] = *(const uint4*)(ux + ((e7) * 128u + sub16)); } while (0)
            ROWS(Ua, ixn[0].x, ixn[0].y, ixn[0].z, ixn[0].w, ixn[1].x, ixn[1].y, ixn[1].z, ixn[1].w);
#pragma unroll 1
            for (unsigned i = 0; i < (unsigned)PEER_WTOK; ++i) {
                const unsigned tok = tok0 + i;
                ROWS(Ub, ixn[2].x, ixn[2].y, ixn[2].z, ixn[2].w, ixn[3].x, ixn[3].y, ixn[3].z, ixn[3].w);
                f32x2p hf[8];
                hf[0] = (f32x2p){bflo(hn0.x), bfhi(hn0.x)}; hf[1] = (f32x2p){bflo(hn0.y), bfhi(hn0.y)}; hf[2] = (f32x2p){bflo(hn0.z), bfhi(hn0.z)}; hf[3] = (f32x2p){bflo(hn0.w), bfhi(hn0.w)};
                hf[4] = (f32x2p){bflo(hn1.x), bfhi(hn1.x)}; hf[5] = (f32x2p){bflo(hn1.y), bfhi(hn1.y)}; hf[6] = (f32x2p){bflo(hn1.z), bfhi(hn1.z)}; hf[7] = (f32x2p){bflo(hn1.w), bfhi(hn1.w)};
                { const unsigned tn = (i + 1 < (unsigned)PEER_WTOK) ? tok + 1 : tok;
                  const uint4* ip = (const uint4*)((const char*)idx + (tn * 512u + g * 64u)); ixn[0] = ip[0]; ixn[1] = ip[1]; ixn[2] = ip[2]; ixn[3] = ip[3];
                  const uint4* hp = (const uint4*)((const char*)hn + (tn * 2048u + x * 256u + sub * 32u)); hn0 = hp[0]; hn1 = hp[1]; }
                float sm[16];
#pragma unroll
                for (int j = 0; j < 8; ++j) { uint4 u_ = Ua[j]; PIN4(u_); float d = dot16_fp8_pk(u_, hf); asm volatile("" : "+v"(d)); d += dppf<XOR1>(d); d += dppf<XOR2>(d); d += dppf<HMIR>(d); sm[j] = d; }
                ROWS(Ua, ixn[0].x, ixn[0].y, ixn[0].z, ixn[0].w, ixn[1].x, ixn[1].y, ixn[1].z, ixn[1].w);
#pragma unroll
                for (int j = 0; j < 8; ++j) { uint4 u_ = Ub[j]; PIN4(u_); float d = dot16_fp8_pk(u_, hf); asm volatile("" : "+v"(d)); d += dppf<XOR1>(d); d += dppf<XOR2>(d); d += dppf<HMIR>(d); sm[8 + j] = d; }
                float v0 = sm[0], v1 = sm[1];
#pragma unroll
                for (int q = 1; q < 8; ++q) { v0 = (sub == (unsigned)q) ? sm[2 * q] : v0; v1 = (sub == (unsigned)q) ? sm[2 * q + 1] : v1; }
                float2 o; o.x = v0; o.y = v1;
                *(float2*)(partial + ((size_t)x * NT + tok) * 128u + 2u * lane) = o;
            }
#undef ROWS
        }
    }
}
template <int CTRL> DEV int dppi(int x) { return __builtin_amdgcn_mov_dpp(x, CTRL, 0xf, 0xf, true); }
DEV void phase_peer_dots2(const unsigned char* hq, const unsigned char* u8s, const int* idx, float* partial, unsigned* qctr, unsigned char* lds_raw, unsigned xcc) {
    constexpr int XOR1 = 0xB1, XOR2 = 0x4E, HMIR = 0x141;
    constexpr unsigned CROW = 144, CHB = 8 * CROW;
    int tid = threadIdx.x; asm volatile("" : "+v"(tid));
    const unsigned wid = tid >> 6, lane = tid & 63, g = lane >> 3, sub = lane & 7;
    volatile unsigned* sh = (volatile unsigned*)(lds_raw + 256);
    unsigned char* lw = lds_raw + 1024 + wid * (4 * CHB);
    const unsigned st_off = g * CROW + sub * 4;
    const unsigned rd_off = g * CROW;
    const bool c0 = ((sub ^ (sub >> 2)) & 1u) != 0, c1 = (((sub >> 1) ^ (sub >> 2)) & 1u) != 0, c2 = (sub & 4u) != 0;
    const unsigned jmap = (c2 ? 4u : 0u) + (c1 ? 2u : 0u) + (c0 ? 1u : 0u);
    for (unsigned s_ = 0; s_ < 8; ++s_) {
        const unsigned x = (xcc + s_) & 7;
        const unsigned char* ux = u8s + (size_t)x * NEXP * 128;
        const unsigned sub16 = sub * 16u;
#define GROW(pn) (*(const uint4*)(ux + (((pn) << 7) | sub16)))
#define E1STEP(R, r) do { \
            const uint4 n0_ = *(const uint4*)(nxt + (r) * 32), n1_ = *(const uint4*)(nxt + (r) * 32 + 16); \
            const unsigned ns_[8] = {n0_.x, n0_.y, n0_.z, n0_.w, n1_.x, n1_.y, n1_.z, n1_.w}; int d_[8]; \
            _Pragma("unroll") for (int j = 0; j < 8; ++j) { uint4 v_ = R[j]; PIN4(v_); \
                d_[j] = __builtin_amdgcn_sdot4((int)v_.w, (int)hc.w, __builtin_amdgcn_sdot4((int)v_.z, (int)hc.z, __builtin_amdgcn_sdot4((int)v_.y, (int)hc.y, __builtin_amdgcn_sdot4((int)v_.x, (int)hc.x, 0, false), false), false), false); \
                unsigned o_ = (ns_[j] << 7) | sub16; \
                asm volatile("" : "+v"(d_[j]), "+v"(o_));     \
                R[j] = *(const uint4*)(ux + o_); } \
            int e_[4], f_[2]; \
            _Pragma("unroll") for (int m = 0; m < 4; ++m) e_[m] = (c0 ? d_[2 * m + 1] : d_[2 * m]) + dppi<XOR1>(c0 ? d_[2 * m] : d_[2 * m + 1]); \
            _Pragma("unroll") for (int n = 0; n < 2; ++n) f_[n] = (c1 ? e_[2 * n + 1] : e_[2 * n]) + dppi<XOR2>(c1 ? e_[2 * n] : e_[2 * n + 1]); \
            kp[r] = (c2 ? f_[1] : f_[0]) + dppi<HMIR>(c2 ? f_[0] : f_[1]); \
            asm volatile("" ::: "memory"); } while (0)
        for (;;) {
            const unsigned unit = peer_next_unit(qctr + 64 * x, sh);
            if (unit >= (unsigned)PEER_UNITS) break;
            const unsigned tok0 = unit * PEER_UNIT_TOK + wid * PEER_WTOK;
            const unsigned char* isrc = (const unsigned char*)idx + ((tok0 + g) * 512u + sub * 16u);
            const unsigned char* hsrc = hq + ((tok0 + g) * 1024u + x * 128u + sub * 16u);
            uint4 hn_ = *(const uint4*)(hsrc);
            { const uint4 p0 = *(const uint4*)(isrc), p1 = *(const uint4*)(isrc + 128);
              *(unsigned*)(lw + st_off) = p0.x; *(unsigned*)(lw + st_off + 32) = p0.y; *(unsigned*)(lw + st_off + 64) = p0.z; *(unsigned*)(lw + st_off + 96) = p0.w;
              *(unsigned*)(lw + CHB + st_off) = p1.x; *(unsigned*)(lw + CHB + st_off + 32) = p1.y; *(unsigned*)(lw + CHB + st_off + 64) = p1.z; *(unsigned*)(lw + CHB + st_off + 96) = p1.w; }
            uint4 R0[8], R1[8], R2[8], R3[8];
            { const unsigned char* cur = lw + rd_off;
#define E1FILL(R, r) do { const uint4 n0_ = *(const uint4*)(cur + (r) * 32), n1_ = *(const uint4*)(cur + (r) * 32 + 16); \
                R[0] = GROW(n0_.x); R[1] = GROW(n0_.y); R[2] = GROW(n0_.z); R[3] = GROW(n0_.w); R[4] = GROW(n1_.x); R[5] = GROW(n1_.y); R[6] = GROW(n1_.z); R[7] = GROW(n1_.w); } while (0)
              E1FILL(R0, 0); E1FILL(R1, 1); E1FILL(R2, 2); E1FILL(R3, 3); }
#undef E1FILL
            uint4 hc = hn_;
#pragma unroll 1
            for (unsigned it = 0; it < (unsigned)PEER_NIT; ++it) {
                const unsigned char* nxt = lw + ((it + 1) & 3) * CHB + rd_off;
                const unsigned ns = (it + 2 < (unsigned)PEER_NIT) ? it + 2 : PEER_NIT - 1;
                const uint4 pst = *(const uint4*)(isrc + (ns >> 2) * 4096u + (ns & 3) * 128u);
                if ((it & 3) == 1) { const unsigned bn = (it < (unsigned)PEER_NIT - 4) ? (it >> 2) + 1 : PEER_NIT / 4 - 1; hn_ = *(const uint4*)(hsrc + bn * 8192u); }
                int kp[4];
                E1STEP(R0, 0); E1STEP(R1, 1); E1STEP(R2, 2); E1STEP(R3, 3);
                { unsigned char* dst = lw + ((it + 2) & 3) * CHB + st_off;
                  *(unsigned*)(dst) = pst.x; *(unsigned*)(dst + 32) = pst.y; *(unsigned*)(dst + 64) = pst.z; *(unsigned*)(dst + 96) = pst.w; }
                *(float4*)(partial + ((size_t)x * NT + tok0 + (it >> 2) * 8 + g) * 128u + (it & 3) * 32u + 4u * jmap) = make_float4((float)kp[0], (float)kp[1], (float)kp[2], (float)kp[3]);
                if ((it & 3) == 3) hc = hn_;
            }
        }
#undef E1STEP
#undef GROW
    }
}
template <int MODE>
DEV void phase_peer_fused(const unsigned char* hq, const float* hs, const unsigned char* u8s, const unsigned char* v8s, const int* idx, const float* gate, const float* usc,
                          float* xres, bf16_t* pdelta, const float* gnext, bf16_t* hn_out, float* wts_g, unsigned* offs_g, unsigned char* lds_raw, int bid, int nb) {
    constexpr bool FINAL = MODE == 1;
    constexpr int XOR1 = 0xB1, XOR2 = 0x4E, HMIR = 0x141;
    constexpr unsigned CROW = 144, CHB = 8 * CROW;
    int tid0 = threadIdx.x;
#define EF_LANE() int tid = tid0; asm volatile("" : "+v"(tid));     \
    const unsigned wid = tid >> 6, lane = tid & 63, g = lane >> 3, sub = lane & 7; \
    unsigned char* lw = lds_raw + 1024 + wid * (16 * CHB);       \
    const unsigned st_off = g * CROW + sub * 4, rd_off = g * CROW, sub16 = sub * 16u; \
    const bool c0 = ((sub ^ (sub >> 2)) & 1u) != 0, c1 = (((sub >> 1) ^ (sub >> 2)) & 1u) != 0, c2 = (sub & 4u) != 0; (void)lane; (void)st_off
#define EFSTEP(R, r, NXT, BASE, ACC) do { \
        const uint4 n0_ = *(const uint4*)((NXT) + (r) * 32), n1_ = *(const uint4*)((NXT) + (r) * 32 + 16); \
        const unsigned ns_[8] = {n0_.x, n0_.y, n0_.z, n0_.w, n1_.x, n1_.y, n1_.z, n1_.w}; int e_[4], f_[2]; \
        _Pragma("unroll") for (int m = 0; m < 4; ++m) { int d_[2]; \
            _Pragma("unroll") for (int jj = 0; jj < 2; ++jj) { const int j = 2 * m + jj; uint4 v_ = R[j]; PIN4(v_); \
                d_[jj] = __builtin_amdgcn_sdot4((int)v_.w, (int)hc.w, __builtin_amdgcn_sdot4((int)v_.z, (int)hc.z, __builtin_amdgcn_sdot4((int)v_.y, (int)hc.y, __builtin_amdgcn_sdot4((int)v_.x, (int)hc.x, 0, false), false), false), false); \
                unsigned o_ = (ns_[j] << 7) | sub16; \
                asm volatile("" : "+v"(d_[jj]), "+v"(o_));     \
                R[j] = *(const uint4*)((BASE) + o_); } \
            e_[m] = (c0 ? d_[1] : d_[0]) + dppi<XOR1>(c0 ? d_[0] : d_[1]); }        \
        _Pragma("unroll") for (int n = 0; n < 2; ++n) f_[n] = (c1 ? e_[2 * n + 1] : e_[2 * n]) + dppi<XOR2>(c1 ? e_[2 * n] : e_[2 * n + 1]); \
        ACC += (c2 ? f_[1] : f_[0]) + dppi<HMIR>(c2 ? f_[0] : f_[1]); \
        asm volatile("" ::: "memory"); } while (0)
#define EFITER(NC, BASE, A) do { const unsigned char* nx_ = lw + (NC) * CHB + rd_off; \
        EFSTEP(R0, 0, nx_, BASE, A[0]); EFSTEP(R1, 1, nx_, BASE, A[1]); EFSTEP(R2, 2, nx_, BASE, A[2]); EFSTEP(R3, 3, nx_, BASE, A[3]); } while (0)
    for (int grp = bid; grp < NT / 128; grp += nb) {
        EF_LANE();
        const unsigned tok0 = grp * 128 + wid * 16;
        { uint4 p[8];
#pragma unroll
          for (int c = 0; c < 8; ++c) p[c] = *(const uint4*)((const unsigned char*)idx + ((tok0 + 8 * (c >> 2) + g) * 512u + (c & 3) * 128u + sub * 16u));
          unsigned so_ = st_off; asm volatile("" : "+v"(so_));
          unsigned char* d = lw + so_;
#pragma unroll
          for (int c = 0; c < 8; ++c) { *(unsigned*)(d + c * CHB) = p[c].x; *(unsigned*)(d + c * CHB + 32) = p[c].y; *(unsigned*)(d + c * CHB + 64) = p[c].z; *(unsigned*)(d + c * CHB + 96) = p[c].w; } }
        const unsigned char* hsrc = hq + ((tok0 + g) * 1024u + sub * 16u);
        uint4 hc = *(const uint4*)(hsrc), hn_ = hc;
        uint4 R0[8], R1[8], R2[8], R3[8];
        { const unsigned char* cur = lw + rd_off;
#define EFFILL(R, r) do { const uint4 n0_ = *(const uint4*)(cur + (r) * 32), n1_ = *(const uint4*)(cur + (r) * 32 + 16); \
            R[0] = *(const uint4*)(u8s + ((n0_.x << 7) | sub16)); R[1] = *(const uint4*)(u8s + ((n0_.y << 7) | sub16)); R[2] = *(const uint4*)(u8s + ((n0_.z << 7) | sub16)); R[3] = *(const uint4*)(u8s + ((n0_.w << 7) | sub16)); \
            R[4] = *(const uint4*)(u8s + ((n1_.x << 7) | sub16)); R[5] = *(const uint4*)(u8s + ((n1_.y << 7) | sub16)); R[6] = *(const uint4*)(u8s + ((n1_.z << 7) | sub16)); R[7] = *(const uint4*)(u8s + ((n1_.w << 7) | sub16)); } while (0)
          EFFILL(R0, 0); EFFILL(R1, 1); EFFILL(R2, 2); EFFILL(R3, 3); }
#undef EFFILL
        int pa[8][4];
#pragma unroll
        for (int c = 0; c < 8; ++c)
#pragma unroll
            for (int r = 0; r < 4; ++r) pa[c][r] = 0;
#pragma unroll 1
        for (unsigned x = 0; x < 8; ++x) {
            const unsigned char* ux = u8s + (size_t)x * NEXP * 128;
            const unsigned xn = x < 7 ? x + 1 : 7;
            const unsigned char* un = u8s + (size_t)xn * NEXP * 128;
            hn_ = *(const uint4*)(hsrc + 8192u + x * 128u);
            EFITER(1, ux, pa[0]); EFITER(2, ux, pa[1]); EFITER(3, ux, pa[2]); EFITER(4, ux, pa[3]);
            hc = hn_;
            hn_ = *(const uint4*)(hsrc + xn * 128u);
            EFITER(5, ux, pa[4]); EFITER(6, ux, pa[5]); EFITER(7, ux, pa[6]); EFITER(0, un, pa[7]);
            hc = hn_;
        }
        const unsigned t2_ = (unsigned)opaque_tid(), g2_ = (t2_ >> 3) & 7u, s2_ = t2_ & 7u, tok2_ = (unsigned)grp * 128u + (t2_ >> 6) * 16u;
        const unsigned jm2_ = (s2_ & 4u) + ((((s2_ >> 1) ^ (s2_ >> 2)) & 1u) << 1) + ((s2_ ^ (s2_ >> 2)) & 1u);
#pragma unroll
        for (int c = 0; c < 8; ++c) {
            const unsigned tok = tok2_ + 8 * (c >> 2) + g2_; const size_t o4 = (size_t)tok * 32 + (c & 3) * 8 + jm2_;
            const float4 gt = ((const float4*)gate)[o4]; float4 us = ((const float4*)usc)[o4];
            const float hsc = hs[tok]; us.x *= hsc; us.y *= hsc; us.z *= hsc; us.w *= hsc;
            const float w0_ = gt.x * gelu_as((float)pa[c][0] * us.x), w1_ = gt.y * gelu_as((float)pa[c][1] * us.y), w2_ = gt.z * gelu_as((float)pa[c][2] * us.z), w3_ = gt.w * gelu_as((float)pa[c][3] * us.w);
            if (MODE == 2) {
                ((float4*)wts_g)[o4] = make_float4(w0_, w1_, w2_, w3_);
                const uint4 ix = ((const uint4*)idx)[o4]; uint4 of; of.x = ix.x << 7; of.y = ix.y << 7; of.z = ix.z << 7; of.w = ix.w << 7;
                ((uint4*)offs_g)[o4] = of;
            } else {
                float* wd = (float*)(lw + (8 + c) * CHB + g2_ * CROW + jm2_ * 4);
                wd[0] = w0_; wd[8] = w1_; wd[16] = w2_; wd[24] = w3_; }
        }
        if (MODE == 2) continue;
        {
#define E2FSTEP(R, r, CW, NI, BASE) do { \
            const uint4 c0_ = *(const uint4*)((CW) + (r) * 32), c1_ = *(const uint4*)((CW) + (r) * 32 + 16); \
            const uint4 n0_ = *(const uint4*)((NI) + (r) * 32), n1_ = *(const uint4*)((NI) + (r) * 32 + 16); \
            const unsigned cs_[8] = {c0_.x, c0_.y, c0_.z, c0_.w, c1_.x, c1_.y, c1_.z, c1_.w}; const unsigned ns_[8] = {n0_.x, n0_.y, n0_.z, n0_.w, n1_.x, n1_.y, n1_.z, n1_.w}; \
            _Pragma("unroll") for (int j = 0; j < 8; ++j) { uint4 v_ = R[j]; PIN4(v_); fma16_fp8_pk(v_, __uint_as_float(cs_[j]), acc); unsigned o_ = (ns_[j] << 7) | sub16; \
                asm volatile("" : "+v"(acc[0]), "+v"(acc[1]), "+v"(acc[2]), "+v"(acc[3]), "+v"(acc[4]), "+v"(acc[5]), "+v"(acc[6]), "+v"(acc[7]), "+v"(o_)); \
                R[j] = *(const uint4*)((BASE) + o_); } \
            asm volatile("" ::: "memory"); } while (0)
#define E2FITER(C, NC, BASE) do { const unsigned char* cw_ = lw + (8 + (C)) * CHB + rd_off; const unsigned char* ni_ = lw + (NC) * CHB + rd_off; \
            E2FSTEP(R0, 0, cw_, ni_, BASE); E2FSTEP(R1, 1, cw_, ni_, BASE); E2FSTEP(R2, 2, cw_, ni_, BASE); E2FSTEP(R3, 3, cw_, ni_, BASE); } while (0)
#define E2FOUT(B) do { unsigned s16_ = sub16; asm volatile("" : "+v"(s16_));     \
            uint4* p0 = (uint4*)((char*)pdelta + ((tok0 + (B) * 8 + g) * 2048u + x * 256u + s16_ * 2u)); uint4 o0, o1; \
            o0.x = pk2(acc[0][0], acc[0][1]); o0.y = pk2(acc[1][0], acc[1][1]); o0.z = pk2(acc[2][0], acc[2][1]); o0.w = pk2(acc[3][0], acc[3][1]); \
            o1.x = pk2(acc[4][0], acc[4][1]); o1.y = pk2(acc[5][0], acc[5][1]); o1.z = pk2(acc[6][0], acc[6][1]); o1.w = pk2(acc[7][0], acc[7][1]); \
            p0[0] = o0; p0[1] = o1; \
            _Pragma("unroll") for (int c = 0; c < 8; ++c) acc[c] = (f32x2p){0.f, 0.f}; } while (0)
            { const unsigned char* cur = lw + rd_off;
#define E2FFILL(R, r) do { const uint4 n0_ = *(const uint4*)(cur + (r) * 32), n1_ = *(const uint4*)(cur + (r) * 32 + 16); \
                R[0] = *(const uint4*)(v8s + ((n0_.x << 7) | sub16)); R[1] = *(const uint4*)(v8s + ((n0_.y << 7) | sub16)); R[2] = *(const uint4*)(v8s + ((n0_.z << 7) | sub16)); R[3] = *(const uint4*)(v8s + ((n0_.w << 7) | sub16)); \
                R[4] = *(const uint4*)(v8s + ((n1_.x << 7) | sub16)); R[5] = *(const uint4*)(v8s + ((n1_.y << 7) | sub16)); R[6] = *(const uint4*)(v8s + ((n1_.z << 7) | sub16)); R[7] = *(const uint4*)(v8s + ((n1_.w << 7) | sub16)); } while (0)
              E2FFILL(R0, 0); E2FFILL(R1, 1); E2FFILL(R2, 2); E2FFILL(R3, 3); }
#undef E2FFILL
            f32x2p acc[8];
#pragma unroll
            for (int c = 0; c < 8; ++c) acc[c] = (f32x2p){0.f, 0.f};
#pragma unroll 1
            for (unsigned it = 0; it < 64; ++it) {
                const unsigned c = it & 7, x = it >> 3;
                const unsigned xb = (c == 7) ? (x < 7 ? x + 1 : 7) : x;
                const unsigned char* vb_ = v8s + (size_t)xb * NEXP * 128;
                E2FITER(c, (it + 1) & 7, vb_);
                if ((it & 3) == 3) E2FOUT((it >> 2) & 1);
            }
#undef E2FOUT
#undef E2FITER
#undef E2FSTEP
        }
        asm volatile("s_waitcnt vmcnt(0)" ::: "memory");
        __builtin_amdgcn_fence(__ATOMIC_ACQUIRE, "agent");
        {
            const unsigned t3_ = (unsigned)opaque_tid(), ln_ = t3_ & 63u, row00 = (unsigned)grp * 128u + (t3_ >> 6) * 16u;
#pragma unroll 1
            for (unsigned rb = 0; rb < 16; rb += 4) {
                float4 v[4][4];
#pragma unroll
                for (int p = 0; p < 4; ++p) { const size_t row = row00 + rb + p; const float4* xr = (const float4*)(xres + row * DM); const uint2* dr = (const uint2*)(pdelta + row * DM);
#pragma unroll
                    for (int i = 0; i < 4; ++i) { v[p][i] = xr[ln_ + 64 * i]; const uint2 d = dr[ln_ + 64 * i];
                        v[p][i].x += bflo(d.x); v[p][i].y += bfhi(d.x); v[p][i].z += bflo(d.y); v[p][i].w += bfhi(d.y); } }
#pragma unroll
                for (int p = 0; p < 4; ++p) { const size_t row = row00 + rb + p;
                    float ss = 0.f;
#pragma unroll
                    for (int i = 0; i < 4; ++i) ss += v[p][i].x * v[p][i].x + v[p][i].y * v[p][i].y + v[p][i].z * v[p][i].z + v[p][i].w * v[p][i].w;
                    ss = wave_sum(ss);
                    const float rstd = 1.0f / sqrtf(ss * (1.0f / DM) + 1e-6f);
#pragma unroll
                    for (int i = 0; i < 4; ++i) { const float4 gg = ((const float4*)gnext)[ln_ + 64 * i];
                        if (FINAL) { float4 o; o.x = v[p][i].x * rstd * gg.x; o.y = v[p][i].y * rstd * gg.y; o.z = v[p][i].z * rstd * gg.z; o.w = v[p][i].w * rstd * gg.w;
                            ((float4*)(xres + row * DM))[ln_ + 64 * i] = o; }
                        else { ((float4*)(xres + row * DM))[ln_ + 64 * i] = v[p][i];
                            uint2 o; o.x = pk2(v[p][i].x * rstd * gg.x, v[p][i].y * rstd * gg.y); o.y = pk2(v[p][i].z * rstd * gg.z, v[p][i].w * rstd * gg.w);
                            ((uint2*)(hn_out + row * DM))[ln_ + 64 * i] = o; } }
                }
            }
        }
    }
#undef EFITER
#undef EFSTEP
#undef EF_LANE
}
DEV void phase_peer_weights(const float* partial, const float* gate, const float* usc, const float* hs, const int* idx, float* wts, unsigned* offs, int bid, int nb) {
    const int tid_ = opaque_tid();
    for (unsigned i = bid * NTHR + tid_; i < (unsigned)NT * 32u; i += nb * NTHR) {
        float4 sacc = ((const float4*)partial)[i];
#pragma unroll
        for (int x = 1; x < 8; ++x) { const float4 p = ((const float4*)(partial + (size_t)x * NT * 128))[i]; sacc.x += p.x; sacc.y += p.y; sacc.z += p.z; sacc.w += p.w; }
        const float4 gt = ((const float4*)gate)[i]; float4 us = ((const float4*)usc)[i];
        { const float hsc = hs[i >> 5]; us.x *= hsc; us.y *= hsc; us.z *= hsc; us.w *= hsc; }
        float4 o; o.x = gt.x * gelu_as(sacc.x * us.x); o.y = gt.y * gelu_as(sacc.y * us.y); o.z = gt.z * gelu_as(sacc.z * us.z); o.w = gt.w * gelu_as(sacc.w * us.w);
        ((float4*)wts)[i] = o;
        const uint4 ix = ((const uint4*)idx)[i];
        uint4 of; of.x = ix.x << 7; of.y = ix.y << 7; of.z = ix.z << 7; of.w = ix.w << 7;
        ((uint4*)offs)[i] = of;
    }
}
DEV void phase_peer_acc2(const unsigned char* v8s, const float* wts, const unsigned* offs, bf16_t* pdelta, unsigned* qctr, unsigned char* lds_raw, unsigned xcc) {
    constexpr unsigned CROW = 144, CHB = 8 * CROW;
    int tid = threadIdx.x; asm volatile("" : "+v"(tid));
    const unsigned wid = tid >> 6, lane = tid & 63, g = lane >> 3, sub = lane & 7;
    volatile unsigned* sh = (volatile unsigned*)(lds_raw + 256);
    unsigned char* lw = lds_raw + 1024 + wid * (8 * CHB);
    const unsigned st_off = g * CROW + sub * 16;
    const unsigned rd_off = g * CROW;
    for (unsigned s_ = 0; s_ < 8; ++s_) {
        const unsigned x = (xcc + s_) & 7;
        const unsigned char* vx = v8s + (size_t)x * NEXP * 128;
        const unsigned sub16 = sub * 16u;
#define GROW(pn) (*(const uint4*)(vx + ((pn) | sub16)))
#define E2STEP(R, r) do { \
            const uint4 c0_ = *(const uint4*)(cur + (r) * 32), c1_ = *(const uint4*)(cur + (r) * 32 + 16); \
            const uint4 n0_ = *(const uint4*)(nxt + 4 * CHB + (r) * 32), n1_ = *(const uint4*)(nxt + 4 * CHB + (r) * 32 + 16); \
            const unsigned cs_[8] = {c0_.x, c0_.y, c0_.z, c0_.w, c1_.x, c1_.y, c1_.z, c1_.w}; const unsigned ns_[8] = {n0_.x, n0_.y, n0_.z, n0_.w, n1_.x, n1_.y, n1_.z, n1_.w}; \
            _Pragma("unroll") for (int j = 0; j < 8; ++j) { uint4 v_ = R[j]; PIN4(v_); fma16_fp8_pk(v_, __uint_as_float(cs_[j]), acc); unsigned o_ = ns_[j] | sub16; \
                asm volatile("" : "+v"(acc[0]), "+v"(acc[1]), "+v"(acc[2]), "+v"(acc[3]), "+v"(acc[4]), "+v"(acc[5]), "+v"(acc[6]), "+v"(acc[7]), "+v"(o_));     \
                R[j] = *(const uint4*)(vx + o_); } \
            asm volatile("" ::: "memory"); } while (0)
        for (;;) {
            const unsigned unit = peer_next_unit(qctr + 64 * x, sh);
            if (unit >= (unsigned)PEER_UNITS) break;
            const unsigned tok0 = unit * PEER_UNIT_TOK + wid * PEER_WTOK;
            const unsigned wgo = (tok0 + g) * 512u + sub * 16u;
            const unsigned char* wsrc = (const unsigned char*)wts + wgo; const unsigned char* osrc = (const unsigned char*)offs + wgo;
            { const uint4 p0 = *(const uint4*)(wsrc), p1 = *(const uint4*)(wsrc + 128), q0 = *(const uint4*)(osrc), q1 = *(const uint4*)(osrc + 128);
              *(uint4*)(lw + st_off) = p0; *(uint4*)(lw + CHB + st_off) = p1; *(uint4*)(lw + 4 * CHB + st_off) = q0; *(uint4*)(lw + 5 * CHB + st_off) = q1; }
            uint4 R0[8], R1[8], R2[8], R3[8];
            { const unsigned char* cur = lw + 4 * CHB + rd_off;
#define E2FILL(R, r) do { const uint4 n0_ = *(const uint4*)(cur + (r) * 32), n1_ = *(const uint4*)(cur + (r) * 32 + 16); \
                R[0] = GROW(n0_.x); R[1] = GROW(n0_.y); R[2] = GROW(n0_.z); R[3] = GROW(n0_.w); R[4] = GROW(n1_.x); R[5] = GROW(n1_.y); R[6] = GROW(n1_.z); R[7] = GROW(n1_.w); } while (0)
              E2FILL(R0, 0); E2FILL(R1, 1); E2FILL(R2, 2); E2FILL(R3, 3); }
#undef E2FILL
            f32x2p acc[8];
#pragma unroll
            for (int c = 0; c < 8; ++c) acc[c] = (f32x2p){0.f, 0.f};
#pragma unroll 1
            for (unsigned it = 0; it < (unsigned)PEER_NIT; ++it) {
                const unsigned char* cur = lw + (it & 3) * CHB + rd_off;
                const unsigned char* nxt = lw + ((it + 1) & 3) * CHB + rd_off;
                const unsigned ns = (it + 2 < (unsigned)PEER_NIT) ? it + 2 : PEER_NIT - 1;
                const uint4 pst = *(const uint4*)(wsrc + (ns >> 2) * 4096u + (ns & 3) * 128u), pso = *(const uint4*)(osrc + (ns >> 2) * 4096u + (ns & 3) * 128u);
                E2STEP(R0, 0); E2STEP(R1, 1); E2STEP(R2, 2); E2STEP(R3, 3);
                *(uint4*)(lw + ((it + 2) & 3) * CHB + st_off) = pst; *(uint4*)(lw + (4 + ((it + 2) & 3)) * CHB + st_off) = pso;
                if ((it & 3) == 3) {
                    uint4* p0 = (uint4*)((char*)pdelta + ((tok0 + (it >> 2) * 8 + g) * 2048u + x * 256u + sub * 32u));
                    uint4 o0, o1;
                    o0.x = pk2(acc[0][0], acc[0][1]); o0.y = pk2(acc[1][0], acc[1][1]); o0.z = pk2(acc[2][0], acc[2][1]); o0.w = pk2(acc[3][0], acc[3][1]);
                    o1.x = pk2(acc[4][0], acc[4][1]); o1.y = pk2(acc[5][0], acc[5][1]); o1.z = pk2(acc[6][0], acc[6][1]); o1.w = pk2(acc[7][0], acc[7][1]);
                    p0[0] = o0; p0[1] = o1;
#pragma unroll
                    for (int c = 0; c < 8; ++c) acc[c] = (f32x2p){0.f, 0.f};
                }
            }
        }
#undef E2STEP
#undef GROW
    }
}
template <bool LOADONLY = false>
DEV void phase_peer_acc(const unsigned char* v8s, const int* idx, const float* wts, float* xres, unsigned* qctr, unsigned char* lds_raw, unsigned xcc, float oscale = 1.0f) {
    constexpr int ROR8 = 0x128;
    constexpr unsigned EMASK = LOADONLY ? 2047u : 0xFFFFFFFFu;
    int tid = threadIdx.x; asm volatile("" : "+v"(tid));
    const unsigned wid = tid >> 6, lane = tid & 63, g = lane >> 3, sub = lane & 7;
    volatile unsigned* sh = (volatile unsigned*)(lds_raw + 256);
    for (unsigned s_ = 0; s_ < 8; ++s_) {
        const unsigned x = (xcc + s_) & 7;
        const unsigned char* vx = v8s + (size_t)x * NEXP * 128;
        const unsigned sub16 = sub * 16u;
        for (;;) {
            const unsigned unit = peer_next_unit(qctr + 64 * x, sh);
            if (unit >= (unsigned)PEER_UNITS) break;
            const unsigned tok0 = unit * PEER_UNIT_TOK + wid * PEER_WTOK;
            uint4 ixn[4]; float4 wn[4];
            { const uint4* ip = (const uint4*)((const char*)idx + (tok0 * 512u + g * 64u)); ixn[0] = ip[0]; ixn[1] = ip[1]; ixn[2] = ip[2]; ixn[3] = ip[3];
              const float4* wp = (const float4*)((const char*)wts + (tok0 * 512u + g * 64u)); wn[0] = wp[0]; wn[1] = wp[1]; wn[2] = wp[2]; wn[3] = wp[3]; }
            uint4 Va[8], Vb[8];
#define ROWS(U, e0, e1, e2, e3, e4, e5, e6, e7) do { U[0] = *(const uint4*)(vx + ((((e0) & EMASK)) * 128u + sub16)); U[1] = *(const uint4*)(vx + ((((e1) & EMASK)) * 128u + sub16)); U[2] = *(const uint4*)(vx + ((((e2) & EMASK)) * 128u + sub16)); \
            U[3] = *(const uint4*)(vx + ((((e3) & EMASK)) * 128u + sub16)); U[4] = *(const uint4*)(vx + ((((e4) & EMASK)) * 128u + sub16)); U[5] = *(const uint4*)(vx + ((((e5) & EMASK)) * 128u + sub16)); \
            U[6] = *(const uint4*)(vx + ((((e6) & EMASK)) * 128u + sub16)); U[7] = *(const uint4*)(vx + ((((e7) & EMASK)) * 128u + sub16)); } while (0)
            ROWS(Va, ixn[0].x, ixn[0].y, ixn[0].z, ixn[0].w, ixn[1].x, ixn[1].y, ixn[1].z, ixn[1].w);
#pragma unroll 1
            for (unsigned i = 0; i < (unsigned)PEER_WTOK; ++i) {
                const unsigned tok = tok0 + i;
                ROWS(Vb, ixn[2].x, ixn[2].y, ixn[2].z, ixn[2].w, ixn[3].x, ixn[3].y, ixn[3].z, ixn[3].w);
                const float ww[16] = {wn[0].x, wn[0].y, wn[0].z, wn[0].w, wn[1].x, wn[1].y, wn[1].z, wn[1].w, wn[2].x, wn[2].y, wn[2].z, wn[2].w, wn[3].x, wn[3].y, wn[3].z, wn[3].w};
                { const unsigned tn = (i + 1 < (unsigned)PEER_WTOK) ? tok + 1 : tok;
                  const uint4* ip = (const uint4*)((const char*)idx + (tn * 512u + g * 64u)); ixn[0] = ip[0]; ixn[1] = ip[1]; ixn[2] = ip[2]; ixn[3] = ip[3];
                  const float4* wp = (const float4*)((const char*)wts + (tn * 512u + g * 64u)); wn[0] = wp[0]; wn[1] = wp[1]; wn[2] = wp[2]; wn[3] = wp[3]; }
                f32x2p acc[8];
#pragma unroll
                for (int c = 0; c < 8; ++c) acc[c] = (f32x2p){0.f, 0.f};
#pragma unroll
                for (int j = 0; j < 8; ++j) { uint4 v_ = Va[j]; PIN4(v_); if (LOADONLY) { acc[0][0] += __uint_as_float((v_.x ^ v_.y ^ v_.z ^ v_.w) & 0x007fffffu) * ww[j]; } else fma16_fp8_pk(v_, ww[j], acc); asm volatile("" : "+v"(acc[0]), "+v"(acc[7])); }
                ROWS(Va, ixn[0].x, ixn[0].y, ixn[0].z, ixn[0].w, ixn[1].x, ixn[1].y, ixn[1].z, ixn[1].w);
#pragma unroll
                for (int j = 0; j < 8; ++j) { uint4 v_ = Vb[j]; PIN4(v_); if (LOADONLY) { acc[0][0] += __uint_as_float((v_.x ^ v_.y ^ v_.z ^ v_.w) & 0x007fffffu) * ww[8 + j]; } else fma16_fp8_pk(v_, ww[8 + j], acc); asm volatile("" : "+v"(acc[0]), "+v"(acc[7])); }
                float r[16];
#pragma unroll
                for (int c = 0; c < 8; ++c) { float a0 = acc[c][0], a1 = acc[c][1]; a0 += dppf<ROR8>(a0); a1 += dppf<ROR8>(a1); r[2 * c] = x1632_sum(a0); r[2 * c + 1] = x1632_sum(a1); }
                if (g == 0) {
                    float4* p0 = (float4*)((char*)xres + (tok * 4096u + x * 512u + sub * 64u));
                    float4 a = p0[0], b = p0[1], c = p0[2], d = p0[3];
                    a.x += oscale * r[0]; a.y += oscale * r[1]; a.z += oscale * r[2]; a.w += oscale * r[3]; b.x += oscale * r[4]; b.y += oscale * r[5]; b.z += oscale * r[6]; b.w += oscale * r[7];
                    c.x += oscale * r[8]; c.y += oscale * r[9]; c.z += oscale * r[10]; c.w += oscale * r[11]; d.x += oscale * r[12]; d.y += oscale * r[13]; d.z += oscale * r[14]; d.w += oscale * r[15];
                    p0[0] = a; p0[1] = b; p0[2] = c; p0[3] = d;
                }
            }
#undef ROWS
        }
    }
}

DEV void phase_expert_naive(const bf16_t* hn, const bf16_t* ut, const bf16_t* vt, const int* idx, const float* gate, float* xres, int bid, int nb) {
    const int wid = threadIdx.x >> 6, lane = threadIdx.x & 63;
    for (int tok = bid * 8 + wid; tok < NT; tok += nb * 8) {
        float hv[16], acc[16];
#pragma unroll
        for (int i = 0; i < 4; ++i) { const uint2 r = *(const uint2*)(hn + (size_t)tok * DM + i * 256 + lane * 4);
            hv[i * 4] = bflo(r.x); hv[i * 4 + 1] = bfhi(r.x); hv[i * 4 + 2] = bflo(r.y); hv[i * 4 + 3] = bfhi(r.y); }
#pragma unroll
        for (int i = 0; i < 16; ++i) acc[i] = 0.f;
        for (int k0 = 0; k0 < 128; k0 += 4) {
            int e[4]; float g[4]; uint2 ur[4][4], vr[4][4];
#pragma unroll
            for (int j = 0; j < 4; ++j) { e[j] = __builtin_amdgcn_readfirstlane(idx[(size_t)tok * 128 + k0 + j]); g[j] = gate[(size_t)tok * 128 + k0 + j]; }
#pragma unroll
            for (int j = 0; j < 4; ++j)
#pragma unroll
                for (int i = 0; i < 4; ++i) ur[j][i] = *(const uint2*)(ut + (size_t)e[j] * DM + i * 256 + lane * 4);
#pragma unroll
            for (int j = 0; j < 4; ++j)
#pragma unroll
                for (int i = 0; i < 4; ++i) vr[j][i] = *(const uint2*)(vt + (size_t)e[j] * DM + i * 256 + lane * 4);
#pragma unroll
            for (int j = 0; j < 4; ++j) {
                float d = 0.f;
#pragma unroll
                for (int i = 0; i < 4; ++i) d += hv[i * 4] * bflo(ur[j][i].x) + hv[i * 4 + 1] * bfhi(ur[j][i].x) + hv[i * 4 + 2] * bflo(ur[j][i].y) + hv[i * 4 + 3] * bfhi(ur[j][i].y);
                d = wave_sum(d);
                const float act = 0.5f * d * (1.0f + erff(d * 0.70710678118654752f));
                const float w = g[j] * act;
#pragma unroll
                for (int i = 0; i < 4; ++i) { acc[i * 4] += w * bflo(vr[j][i].x); acc[i * 4 + 1] += w * bfhi(vr[j][i].x); acc[i * 4 + 2] += w * bflo(vr[j][i].y); acc[i * 4 + 3] += w * bfhi(vr[j][i].y); }
            }
        }
#pragma unroll
        for (int i = 0; i < 4; ++i) { float4* p = (float4*)(xres + (size_t)tok * DM + i * 256 + lane * 4); float4 v = *p;
            v.x += acc[i * 4]; v.y += acc[i * 4 + 1]; v.z += acc[i * 4 + 2]; v.w += acc[i * 4 + 3]; *p = v; }
    }
}

#define XB_TMO      128
#define XB_XCNT(j)  (256  + 64 * (j))
#define XB_XSUB(j)  (1280 + 64 * (j))
#define XB_XGEN(j)  (2304 + 64 * (j))
#define XB_TOP      3328
#define XB_TOPGEN   3392
#define XCD_BAR_WORDS 3456
#define XB_SPIN_CAP (1u << 18)
#define LAS __attribute__((address_space(3)))

__device__ __forceinline__ unsigned xb_ld(unsigned* p)              { return __hip_atomic_load(p, __ATOMIC_RELAXED, __HIP_MEMORY_SCOPE_AGENT); }
__device__ __forceinline__ unsigned xb_add(unsigned* p, unsigned v) { return __hip_atomic_fetch_add(p, v, __ATOMIC_RELAXED, __HIP_MEMORY_SCOPE_AGENT); }
__device__ __forceinline__ unsigned xb_xcc_id() { return (unsigned)__builtin_amdgcn_s_getreg((3 << 11) | 20) & 0xFu; }
#define XB_SPIN(cond, bar) do { unsigned _sp = 0; while (cond) { __builtin_amdgcn_s_sleep(1); \
    if ((++_sp & 255u) == 0u) { if (xb_ld(&(bar)[XB_TMO])) break; if (_sp > XB_SPIN_CAP) { atomicAdd(&(bar)[XB_TMO], 1u); break; } } } } while (0)

struct XcdBarrier {
    unsigned* bar; unsigned x;
    volatile LAS unsigned* st;
};

__device__ __forceinline__ XcdBarrier xcd_barrier_post(unsigned* bar, volatile LAS unsigned* st) {
    XcdBarrier b; b.bar = bar; b.x = xb_xcc_id(); b.st = st;
    if (threadIdx.x == 0) (void)xb_add(&bar[XB_XCNT(b.x)], 1u);
    return b;
}
__device__ __forceinline__ void xcd_barrier_complete(unsigned* bar, unsigned x, unsigned& nloc, unsigned& nx) {
    const unsigned G = gridDim.x * gridDim.y * gridDim.z;
    unsigned sum, cnt, mine, sp = 0u;
    for (;;) {
        sum = 0u; cnt = 0u; mine = 0u;
#pragma unroll
        for (unsigned j = 0; j < 16; ++j) { const unsigned c = xb_ld(&bar[XB_XCNT(j)]); sum += c; cnt += (c > 0u) ? 1u : 0u; mine = (j == x) ? c : mine; }
        if (sum == G) break;
        __builtin_amdgcn_s_sleep(1);
        if ((++sp & 255u) == 0u) { if (xb_ld(&bar[XB_TMO])) break; if (sp > XB_SPIN_CAP) { atomicAdd(&bar[XB_TMO], 1u); break; } }
    }
    nloc = mine > 0u ? mine : 1u; nx = cnt > 0u ? cnt : 1u;
}

__device__ __forceinline__ void xcd_barrier(const XcdBarrier& b) {
    asm volatile("s_waitcnt vmcnt(0)" ::: "memory");
    __syncthreads();
    if (threadIdx.x == 0) {
        unsigned* bar = b.bar;
        __builtin_amdgcn_s_waitcnt(0);
        unsigned nloc = b.st[0], nx = b.st[1];
        if (nloc == 0u) { xcd_barrier_complete(bar, b.x, nloc, nx); b.st[0] = nloc; b.st[1] = nx; }
        const unsigned old = xb_add(&bar[XB_XSUB(b.x)], 1u);
        const unsigned gen = old / nloc;
        if (old + 1u == (gen + 1u) * nloc) {
            __builtin_amdgcn_fence(__ATOMIC_RELEASE, "agent");
            asm volatile("s_waitcnt vmcnt(0)" ::: "memory");
            const unsigned og = xb_add(&bar[XB_TOP], 1u);
            const unsigned tg = og / nx;
            if (og + 1u == (tg + 1u) * nx) xb_add(&bar[XB_TOPGEN], 1u);
            else XB_SPIN(xb_ld(&bar[XB_TOPGEN]) == tg, bar);
            __builtin_amdgcn_fence(__ATOMIC_ACQUIRE, "agent");
            xb_add(&bar[XB_XGEN(b.x)], 1u);
            asm volatile("s_waitcnt vmcnt(0)" ::: "memory");
        } else {
            XB_SPIN(xb_ld(&bar[XB_XGEN(b.x)]) == gen, bar);
            __builtin_amdgcn_fence(__ATOMIC_ACQUIRE, "agent");
            asm volatile("s_waitcnt vmcnt(0)" ::: "memory");
        }
    }
    __syncthreads();
}


constexpr int N_PHASES = 23;
__global__ void __launch_bounds__(NTHR, 2) fwd_kernel(Params p_unused) {
    extern __shared__ __attribute__((aligned(16))) unsigned char lds_raw[];
    float* lds = (float*)lds_raw;
    const int bid = blockIdx.x, nb = gridDim.x;
#define PHASE_ARGS() cparams_t pp = kernarg_ptr(); asm volatile("" : "+s"(pp)); \
    unsigned char* ws = pp->ws; (void)ws; \
    bf16_t* w_in0 = (bf16_t*)(ws + WS_WIN0); bf16_t* w_out0 = (bf16_t*)(ws + WS_WOUT0); bf16_t* w_in1 = (bf16_t*)(ws + WS_WIN1); bf16_t* w_out1 = (bf16_t*)(ws + WS_WOUT1); \
    bf16_t* wq = (bf16_t*)(ws + WS_WQ); bf16_t* skb = (bf16_t*)(ws + WS_SK); unsigned char* ub = ws + WS_U; unsigned char* vb = ws + WS_V; \
    float* uscale = (float*)(ws + WS_USC); float* vscale = (float*)(ws + WS_VSC); \
    bf16_t* hn = (bf16_t*)(ws + WS_HN); bf16_t* qkv = (bf16_t*)(ws + WS_QKV); bf16_t* pq = (bf16_t*)(ws + WS_QKV); \
    float* fg = (float*)(ws + WS_FG); float* carr = (float*)(ws + WS_C); \
    bf16_t* ao = (bf16_t*)(ws + WS_AO); int* idxb = (int*)(ws + WS_AO); float* gateb = (float*)(ws + WS_AO + (size_t)NT * 128 * 4); float* uscb = (float*)(ws + WS_AO + (size_t)NT * 128 * 8); \
    float* xres = pp->out; unsigned* qctr = (unsigned*)(ws + WS_QCTR); \
    float* partial = (float*)(ws + WS_QKV); float* wts = (float*)(ws + WS_QKV + (size_t)8 * NT * 128 * 4); \
    (void)w_in0; (void)w_out0; (void)w_in1; (void)w_out1; (void)wq; (void)skb; (void)ub; (void)vb; (void)uscale; (void)vscale; (void)hn; (void)qkv; (void)pq; (void)fg; (void)carr; (void)ao; \
    (void)idxb; (void)gateb; (void)uscb; (void)xres; (void)qctr; (void)partial; (void)wts
    int lo, hi;
    { cparams_t pp = kernarg_ptr(); asm volatile("" : "+s"(pp)); lo = pp->ph_lo; hi = pp->ph_hi;
      volatile LAS unsigned* xbw = (volatile LAS unsigned*)(lds_raw + LDS_BYTES - 16);
      if (threadIdx.x == 0) { xbw[0] = 0u; xbw[1] = 0u; xbw[2] = 0u; xbw[3] = 0u; }
      __syncthreads();
      if (hi - lo > 1) (void)xcd_barrier_post((unsigned*)(pp->ws + WS_BAR), xbw); }
#define IN(k) (lo <= (k) && (k) < hi)
#if PROBE_TMASK
    if (threadIdx.x == 0) { volatile long long* tp_ = (volatile long long*)(lds_raw + LDS_BYTES - 64); tp_[0] = (long long)wall_clock64(); tp_[1] = 0; }
#define TSTAMP(k) do { if (threadIdx.x == 0) { volatile long long* tp_ = (volatile long long*)(lds_raw + LDS_BYTES - 64); const long long now_ = (long long)wall_clock64(); if ((PROBE_TMASK >> (k)) & 1) tp_[1] += now_ - tp_[0]; tp_[0] = now_; } } while (0)
#else
#define TSTAMP(k) do {} while (0)
#endif
#define SEAM(k) do { if (IN(k) && IN((k) + 1)) { PHASE_ARGS(); XcdBarrier b_; b_.bar = (unsigned*)(ws + WS_BAR); b_.x = xb_xcc_id(); b_.st = (volatile LAS unsigned*)(lds_raw + LDS_BYTES - 16); xcd_barrier(b_); } TSTAMP(k); } while (0)

    if (IN(0)) { PHASE_ARGS();
        conv_transpose(pp->even_w_in, w_in0, 1024, 3072, lds, bid, nb);
        conv_transpose(pp->even_w_out, w_out0, 1024, 1024, lds, bid, nb);
        conv_transpose(pp->odd_w_in, w_in1, 1024, 3088, lds, bid, nb);
        conv_transpose(pp->odd_w_out, w_out1, 1024, 1024, lds, bid, nb);
        conv_transpose(pp->peer_wq, wq, 1024, 2048, lds, bid, nb);
        conv_transpose(pp->peer_wq + (size_t)1024 * 2048, wq + (size_t)2048 * 1024, 1024, 2048, lds, bid, nb);
        conv_copy(pp->peer_sk, skb, (size_t)2 * 8 * 2 * 128 * 128, bid, nb);
        conv_fp8_rows<true>(pp->peer_u, ub, uscale, NEXP, bid, nb);
        conv_fp8_rows<false>(pp->peer_v, vb, vscale, NEXP, bid, nb);
        phase_norm(pp->x, pp->norm_mix_g, hn, bid, nb);
    #if PROBE_DUP == 8

        conv_transpose(pp->even_w_in, w_in0, 1024, 3072, lds, bid, nb);
        conv_transpose(pp->even_w_out, w_out0, 1024, 1024, lds, bid, nb);
        conv_transpose(pp->odd_w_in, w_in1, 1024, 3088, lds, bid, nb);
        conv_transpose(pp->odd_w_out, w_out1, 1024, 1024, lds, bid, nb);
        conv_transpose(pp->peer_wq, wq, 1024, 2048, lds, bid, nb);
        conv_transpose(pp->peer_wq + (size_t)1024 * 2048, wq + (size_t)2048 * 1024, 1024, 2048, lds, bid, nb);
        conv_copy(pp->peer_sk, skb, (size_t)2 * 8 * 2 * 128 * 128, bid, nb);
        conv_fp8_rows<true>(pp->peer_u, ub, uscale, 2 * NEXP, bid, nb);
        conv_fp8_rows<false>(pp->peer_v, vb, vscale, 2 * NEXP, bid, nb);
        phase_norm(pp->x, pp->norm_mix_g, hn, bid, nb);
    #endif
    }
    SEAM(0);
    if (IN(1)) { PHASE_ARGS(); phase_gemm_mfma(hn, w_in0, NT, 3072, MEpiQKV{qkv, 512, 1536, 2048}, lds_raw, bid, nb);
#if PROBE_DUP == 11
        phase_gemm_mfma(hn, w_in0, NT, 3072, MEpiQKV{qkv, 512, 1536, 2048}, lds_raw, bid, nb);
#endif
    }
    SEAM(1);
    if (IN(2)) { PHASE_ARGS(); phase_mix0_mfma(qkv, pp->rel_bias, pp->diff_lambda, pp->diff_ln_g, ao, (bf16_t*)(ws + WS_DPO), (float*)(ws + WS_DLSE), lds_raw, qctr + 5 * 512);
#if PROBE_DUP == 12
        phase_mix0_mfma(qkv, pp->rel_bias, pp->diff_lambda, pp->diff_ln_g, ao, lds_raw, qctr + 5 * 512 + 128);
#endif
    }
    SEAM(2);
    if (IN(3)) { PHASE_ARGS(); phase_dilated_merge((const bf16_t*)(ws + WS_DPO), (const float*)(ws + WS_DLSE), ao, bid, nb); }
    SEAM(3);
    if (IN(4)) { PHASE_ARGS(); phase_gemm_mfma(ao, w_out0, NT, 1024, MEpiBf16{qkv, 1024}, lds_raw, bid, nb); }
    SEAM(4);
    if (IN(5)) { PHASE_ARGS(); phase_res_norm<true>(pp->x, qkv, pp->norm_ffn_g, xres, hn, ws + WS_DPO, (float*)(ws + WS_DPO + (size_t)NT * 1024), bid, nb); }
    SEAM(5);
    if (IN(6)) { PHASE_ARGS(); phase_gemm_mfma(hn, wq, NT, 2048, MEpiBf16{pq, 2048}, lds_raw, bid, nb);
#if PROBE_DUP == 15
        phase_gemm_mfma(hn, wq, NT, 2048, MEpiBf16{pq, 2048}, lds_raw, bid, nb);
#endif
#if PROBE_DUP == 16
        phase_gemm_mfma(hn, wq, NT, 2048, MEpiBf16{pq, 2048}, lds_raw, bid, nb);
        phase_gemm_mfma(hn, wq, NT, 2048, MEpiBf16{pq, 2048}, lds_raw, bid, nb);
#endif
    }
    SEAM(6);
    if (IN(7)) { PHASE_ARGS(); phase_topk_mfma(pq, skb, uscale, vscale, idxb, gateb, uscb, lds_raw, bid, nb); }
    SEAM(7);
    if (IN(8)) { PHASE_ARGS(); phase_peer_fused<0>(ws + WS_DPO, (const float*)(ws + WS_DPO + (size_t)NT * 1024), ub, vb, idxb, gateb, uscb, xres, hn, pp->norm_mix_g + DM, hn, nullptr, nullptr, lds_raw, bid, nb);
        { volatile unsigned* sh_ = (volatile unsigned*)(lds_raw + 256);
          for (;;) { const unsigned t_ = queue_next(qctr + 6 * 512, sh_); if (t_ >= 512u) break;
              const int rb_ = NEXP + (int)(t_ & 255u) * 64;
              if (t_ < 256u) conv_fp8_rows<true>(pp->peer_u, ub, uscale, 64, 0, 1, rb_); else conv_fp8_rows<false>(pp->peer_v, vb, vscale, 64, 0, 1, rb_); } }
    }
    SEAM(11);
    if (IN(12)) { PHASE_ARGS(); phase_gemm_mfma(hn, w_in1, NT, 3072, MEpiQKV{qkv, 1024, 0, 0}, lds_raw, bid, nb); phase_fg(hn, w_in1 + (size_t)3072 * 1024, pp->odd_b_f, fg, bid, nb); }
    SEAM(12);
    if (IN(13)) { PHASE_ARGS(); phase_cumsum(fg, qkv, carr, (float*)(ws + WS_CTOT), (unsigned*)(ws + WS_KMAX), bid, nb);
#if PROBE_DUP == 8
        phase_cumsum(fg, qkv, carr, (float*)(ws + WS_CTOT), (unsigned*)(ws + WS_KMAX), bid, nb);
#endif
    }
    SEAM(13);
    if (IN(14)) { PHASE_ARGS(); phase_fox_mfma(qkv, carr, (const float*)(ws + WS_CTOT), (const unsigned*)(ws + WS_KMAX), ao, lds_raw, qctr + 5 * 512 + 64);
#if PROBE_DUP == 23
        phase_fox_mfma(qkv, carr, (const float*)(ws + WS_CTOT), (const unsigned*)(ws + WS_KMAX), ao, lds_raw, qctr + 5 * 512 + 192);
#endif
    }
    SEAM(14);
    if (IN(15)) { PHASE_ARGS(); phase_gemm_mfma(ao, w_out1, NT, 1024, MEpiBf16{qkv, 1024}, lds_raw, bid, nb); }
    SEAM(15);
    if (IN(16)) { PHASE_ARGS(); phase_res_norm<true>(xres, qkv, pp->norm_ffn_g + DM, xres, hn, ws + WS_DPO, (float*)(ws + WS_DPO + (size_t)NT * 1024), bid, nb); }
    SEAM(16);
    if (IN(17)) { PHASE_ARGS(); phase_gemm_mfma(hn, wq + (size_t)2048 * 1024, NT, 2048, MEpiBf16{pq, 2048}, lds_raw, bid, nb); }
    SEAM(17);
    if (IN(18)) { PHASE_ARGS(); phase_topk_mfma(pq, skb + (size_t)8 * 2 * 128 * 128, uscale + NEXP, vscale + NEXP, idxb, gateb, uscb, lds_raw, bid, nb); }
    SEAM(18);
    if (IN(19)) { PHASE_ARGS(); phase_peer_fused<2>(ws + WS_DPO, (const float*)(ws + WS_DPO + (size_t)NT * 1024), ub + (size_t)NEXP * 1024, nullptr, idxb, gateb, uscb, nullptr, nullptr, nullptr, nullptr, wts, (unsigned*)(ws + WS_QKV + (size_t)9 * NT * 128 * 4), lds_raw, bid, nb); }
    SEAM(20);
    if (IN(21)) { PHASE_ARGS(); phase_peer_acc2(vb + (size_t)NEXP * 1024, wts, (const unsigned*)(ws + WS_QKV + (size_t)9 * NT * 128 * 4), hn, qctr + 3 * 512, lds_raw, xb_xcc_id() & 7u); }
    SEAM(21);
    if (IN(22)) { PHASE_ARGS(); phase_final_norm(xres, hn, pp->final_g, bid, nb); }
#if PROBE_TMASK
    if (bid == 0 && threadIdx.x == 0) { const long long tp_acc = ((volatile long long*)(lds_raw + LDS_BYTES - 64))[1]; const long long t0_ = (long long)wall_clock64(); while ((long long)wall_clock64() - t0_ < (long long)PROBE_TAMP * tp_acc) __builtin_amdgcn_s_sleep(32); }
#endif
}

extern "C" void kernel_launch(void* const* d_in, const int* in_sizes, int n_in, void* d_out, int out_size, void* d_ws, size_t ws_size, hipStream_t stream) {
    static int grid = 0;
    if (grid == 0) {
        if (n_in != 16 || out_size != NT * DM || ws_size < WS_END) { fprintf(stderr, "kernel_launch: unexpected sizes n_in %d out %d ws %zu (need %zu)\n", n_in, out_size, ws_size, (size_t)WS_END); grid = -1; return; }
        int dev = 0, cus = 0;
        (void)hipGetDevice(&dev); (void)hipDeviceGetAttribute(&cus, hipDeviceAttributeMultiprocessorCount, dev);
        if (hipFuncSetAttribute((const void*)fwd_kernel, hipFuncAttributeMaxDynamicSharedMemorySize, LDS_BYTES) != hipSuccess) { fprintf(stderr, "hipFuncSetAttribute failed\n"); grid = -1; return; }
        grid = cus > 0 ? cus : 256;
    }
    if (grid < 0) return;
    Params p{};
    p.x = (const float*)d_in[0]; p.norm_mix_g = (const float*)d_in[1]; p.norm_ffn_g = (const float*)d_in[2]; p.final_g = (const float*)d_in[3];
    p.rel_bias = (const float*)d_in[4]; p.even_w_in = (const float*)d_in[5]; p.even_w_out = (const float*)d_in[6]; p.diff_lambda = (const float*)d_in[7];
    p.diff_ln_g = (const float*)d_in[8]; p.odd_w_in = (const float*)d_in[9]; p.odd_b_f = (const float*)d_in[10]; p.odd_w_out = (const float*)d_in[11];
    p.peer_wq = (const float*)d_in[12]; p.peer_sk = (const float*)d_in[13]; p.peer_u = (const float*)d_in[14]; p.peer_v = (const float*)d_in[15];
    p.out = (float*)d_out; p.ws = (unsigned char*)d_ws;
#if defined(MK_MULTI)
    for (int k = 0; k < N_PHASES; ++k) {
        p.ph_lo = k; p.ph_hi = k + 1;
        hipLaunchKernelGGL(fwd_kernel, dim3(grid), dim3(NTHR), LDS_BYTES, stream, p);
    }
#else
    (void)hipMemsetAsync((unsigned char*)d_ws + WS_BAR, 0, WS_CTL_BYTES + 8 * 8 * 256, stream);
    p.ph_lo = 0; p.ph_hi = N_PHASES;
    hipLaunchKernelGGL(fwd_kernel, dim3(grid), dim3(NTHR), LDS_BYTES, stream, p);
#endif
}
```

```cpp
#include <hip/hip_runtime.h>
#include <stdint.h>
#include <math.h>
#include <cstdio>

typedef unsigned short bf16_t;
#define DEV static __device__ __forceinline__
#define MDEV __device__ __forceinline__

#ifndef PROBE_TMASK
#define PROBE_TMASK 0
#endif
#ifndef PROBE_TAMP
#define PROBE_TAMP 4
#endif
#ifndef PROBE_DUP
#define PROBE_DUP 0
#endif
constexpr int DM = 1024, NBATCH = 8, SEQ = 4096, NT = NBATCH * SEQ;
constexpr int EVEN_IN = 3072, ODD_IN = 3088;
constexpr int NEXP = 16384;
constexpr int NTHR = 512;
constexpr int LDS_BYTES = 160 * 1024;

constexpr size_t KB_ = 1024, MB_ = 1024 * 1024;
constexpr size_t WS_BAR   = 0;
constexpr size_t WS_KMAX  = 32768;
constexpr size_t WS_CTOT  = 33792;
constexpr size_t WS_WIN0  = 64 * KB_;
constexpr size_t WS_WOUT0 = WS_WIN0 + (size_t)3072 * 1024 * 2;
constexpr size_t WS_WIN1  = WS_WOUT0 + (size_t)1024 * 1024 * 2;
constexpr size_t WS_WOUT1 = WS_WIN1 + (size_t)3328 * 1024 * 2;
constexpr size_t WS_WQ    = WS_WOUT1 + (size_t)1024 * 1024 * 2;
constexpr size_t WS_SK    = WS_WQ + (size_t)2 * 2048 * 1024 * 2;
constexpr size_t WS_U     = WS_SK + (size_t)2 * 8 * 2 * 128 * 128 * 2;
constexpr size_t WS_V     = WS_U + (size_t)2 * NEXP * 1024;
constexpr size_t WS_USC   = WS_V + (size_t)2 * NEXP * 1024;
constexpr size_t WS_VSC   = WS_USC + (size_t)2 * NEXP * 4;
constexpr size_t WS_HN    = WS_VSC + (size_t)2 * NEXP * 4;
constexpr size_t WS_QKV   = WS_HN + (size_t)NT * 1024 * 2;
constexpr size_t WS_FG    = WS_QKV + (size_t)NT * 3072 * 2;
constexpr size_t WS_C     = WS_FG + (size_t)NT * 16 * 4;
constexpr size_t WS_AO    = WS_C + (size_t)NT * 16 * 4;
constexpr size_t WS_DPO   = WS_AO + (size_t)NT * 1024 * 2;
constexpr size_t WS_DLSE  = WS_HN;
constexpr size_t WS_END   = WS_DPO + (size_t)3 * NT * 512 * 2;
static_assert(WS_END <= (size_t)512 * 1024 * 1024, "workspace map exceeds the guaranteed 512 MiB");

struct Params {
    const float *x, *norm_mix_g, *norm_ffn_g, *final_g, *rel_bias, *even_w_in, *even_w_out, *diff_lambda, *diff_ln_g,
                *odd_w_in, *odd_b_f, *odd_w_out, *peer_wq, *peer_sk, *peer_u, *peer_v;
    float* out;
    unsigned char* ws;
    int ph_lo, ph_hi;
};

DEV float bf2f(bf16_t v) { return __uint_as_float(((unsigned)v) << 16); }
DEV bf16_t f2bf(float f) { unsigned u = __float_as_uint(f); u += 0x7FFFu + ((u >> 16) & 1u); return (bf16_t)(u >> 16); }
DEV unsigned pk2(float lo, float hi) { return (unsigned)f2bf(lo) | ((unsigned)f2bf(hi) << 16); }
typedef __bf16 bf16x2v __attribute__((ext_vector_type(2)));
typedef float f32x2v __attribute__((ext_vector_type(2)));
DEV unsigned cvtpk2(float lo, float hi) { return __builtin_bit_cast(unsigned, __builtin_convertvector((f32x2v){lo, hi}, bf16x2v)); }
DEV float bflo(unsigned w) { return __uint_as_float(w << 16); }
DEV float bfhi(unsigned w) { return __uint_as_float(w & 0xFFFF0000u); }
DEV float wave_sum(float v) {
#pragma unroll
    for (int o = 32; o >= 1; o >>= 1) v += __shfl_xor(v, o);
    return v;
}
template <int CTRL> DEV float dppf(float x) { return __builtin_bit_cast(float, __builtin_amdgcn_mov_dpp(__builtin_bit_cast(int, x), CTRL, 0xf, 0xf, true)); }
DEV float wave_max(float v) {
#pragma unroll
    for (int o = 32; o >= 1; o >>= 1) v = fmaxf(v, __shfl_xor(v, o));
    return v;
}
DEV int opaque_tid() { int t = threadIdx.x; asm volatile("" : "+v"(t)); return t; }
typedef const __attribute__((address_space(4))) struct Params* cparams_t;
DEV cparams_t kernarg_ptr() {
#if defined(__HIP_DEVICE_COMPILE__)
    return (cparams_t)__builtin_amdgcn_kernarg_segment_ptr();
#else
    return (cparams_t)0;
#endif
}
DEV void lds_fence() { asm volatile("s_waitcnt lgkmcnt(0)" ::: "memory"); }

DEV unsigned queue_next(unsigned* q, volatile unsigned* sh) {
    __syncthreads();
    if (threadIdx.x == 0) sh[0] = __hip_atomic_fetch_add(q, 1u, __ATOMIC_RELAXED, __HIP_MEMORY_SCOPE_AGENT);
    __syncthreads();
    return sh[0];
}
DEV unsigned queue_prefetch(unsigned* q) { unsigned t = 0; if (threadIdx.x == 0) t = __hip_atomic_fetch_add(q, 1u, __ATOMIC_RELAXED, __HIP_MEMORY_SCOPE_AGENT); return t; }
DEV unsigned queue_turn(unsigned t, volatile unsigned* sh) {
    __syncthreads();
    if (threadIdx.x == 0) sh[0] = t;
    __syncthreads();
    return sh[0];
}
DEV int t5_bucket(int d) {
    if (d < 16) return d;
    int b = 16;
    b += (d >= 22); b += (d >= 30); b += (d >= 40); b += (d >= 54); b += (d >= 73); b += (d >= 99); b += (d >= 134); b += (d >= 182);
    b += (d >= 246); b += (d >= 332); b += (d >= 450); b += (d >= 609); b += (d >= 825); b += (d >= 1117); b += (d >= 1513);
    return b;
}

DEV void conv_transpose(const float* src, bf16_t* dst, int K, int N, float* lds, int bid, int nb) {
    const int tid_ = opaque_tid();
    const int t = tid_;
    const int ntk = K / 64, ntn = (N + 63) / 64, ntile = ntk * ntn;
    float v[8];
#define CT_LOAD(tile_) do { const int k0_ = ((tile_) / ntn) * 64, n0_ = ((tile_) % ntn) * 64; \
        _Pragma("unroll") for (int i = 0; i < 8; ++i) { const int r = (t >> 6) + 8 * i, c = t & 63; v[i] = (n0_ + c < N) ? src[(size_t)(k0_ + r) * N + n0_ + c] : 0.f; } } while (0)
    if (bid < ntile) CT_LOAD(bid);
    for (int tile = bid; tile < ntile; tile += nb) {
        const int k0 = (tile / ntn) * 64, n0 = (tile % ntn) * 64;
        __syncthreads();
#pragma unroll
        for (int i = 0; i < 8; ++i) { const int r = (t >> 6) + 8 * i, c = t & 63; lds[r * 65 + c] = v[i]; }
        __syncthreads();
        if (tile + nb < ntile) CT_LOAD(tile + nb);
#pragma unroll
        for (int i = 0; i < 8; ++i) {
            const int r = (t >> 6) + 8 * i, c = t & 63;
            if (n0 + r < N) dst[(size_t)(n0 + r) * K + k0 + c] = f2bf(lds[c * 65 + r]);
        }
    }
#undef CT_LOAD
}
DEV void conv_copy(const float* src, bf16_t* dst, size_t n, int bid, int nb) {
    const int tid_ = opaque_tid();
    const size_t n4 = n / 4;
    for (size_t i = (size_t)bid * NTHR + tid_; i < n4; i += (size_t)nb * NTHR) {
        const float4 v = ((const float4*)src)[i];
        uint2 o; o.x = pk2(v.x, v.y); o.y = pk2(v.z, v.w);
        ((uint2*)dst)[i] = o;
    }
}

DEV unsigned q8x4(float a, float b, float c, float d) {
    const int ia = (int)rintf(a), ib = (int)rintf(b), ic = (int)rintf(c), id = (int)rintf(d);
    return (unsigned)(ia & 255) | ((unsigned)(ib & 255) << 8) | ((unsigned)(ic & 255) << 16) | ((unsigned)(id & 255) << 24);
}
template <bool I8>
DEV void conv_fp8_rows(const float* src, unsigned char* dst, float* inv, int rows, int bid, int nb) {
    const int tid_ = opaque_tid();
    constexpr int RP = 4;
    const int wid = tid_ >> 6, lane = tid_ & 63;
    for (int row0 = (bid * 8 + wid) * RP; row0 < rows; row0 += nb * 8 * RP) {
        float4 v[RP][4];
#pragma unroll
        for (int p = 0; p < RP; ++p) { const float4* xr = (const float4*)(src + (size_t)(row0 + p) * DM) + lane;
#pragma unroll
            for (int i = 0; i < 4; ++i) v[p][i] = xr[64 * i]; }
#pragma unroll
        for (int p = 0; p < RP; ++p) {
            const int row = row0 + p;
            float mx = 0.f;
#pragma unroll
            for (int i = 0; i < 4; ++i) mx = fmaxf(mx, fmaxf(fmaxf(fabsf(v[p][i].x), fabsf(v[p][i].y)), fmaxf(fabsf(v[p][i].z), fabsf(v[p][i].w))));
            mx = wave_max(mx);
            int e = 0; if (mx > 0.f) (void)frexpf(mx, &e);
            e = min(max(e, -100), 100);
            const float sc = I8 ? (mx > 0.f ? 127.0f / mx : 0.f) : ldexpf(1.0f, 8 - e), isc = I8 ? mx * (1.0f / 127.0f) : ldexpf(1.0f, e - 8);
            const int layer = row / NEXP, ex = row % NEXP;
#pragma unroll
            for (int i = 0; i < 4; ++i) {
                unsigned w;
                if (I8) w = q8x4(v[p][i].x * sc, v[p][i].y * sc, v[p][i].z * sc, v[p][i].w * sc);
                else { w = __builtin_amdgcn_cvt_pk_fp8_f32(v[p][i].x * sc, v[p][i].y * sc, 0, false); w = __builtin_amdgcn_cvt_pk_fp8_f32(v[p][i].z * sc, v[p][i].w * sc, w, true); }
                const int col = 4 * lane + 256 * i, x = col >> 7, off = col & 127;
                *(unsigned*)(dst + (((size_t)layer * 8 + x) * NEXP + ex) * 128 + off) = w;
            }
            if (lane == 0) inv[row] = isc;
        }
    }
}

DEV void phase_norm(const float* xin, const float* g, bf16_t* out, int bid, int nb) {
    const int tid_ = opaque_tid();
    constexpr int RP = 4;
    const int wid = tid_ >> 6, lane = tid_ & 63;
    for (int row0 = (bid * 8 + wid) * RP; row0 < NT; row0 += nb * 8 * RP) {
        float4 v[RP][4];
#pragma unroll
        for (int p = 0; p < RP; ++p) { const float4* xr = (const float4*)(xin + (size_t)(row0 + p) * DM);
#pragma unroll
            for (int i = 0; i < 4; ++i) v[p][i] = xr[lane + 64 * i]; }
#pragma unroll
        for (int p = 0; p < RP; ++p) {
            float ss = 0.f;
#pragma unroll
            for (int i = 0; i < 4; ++i) ss += v[p][i].x * v[p][i].x + v[p][i].y * v[p][i].y + v[p][i].z * v[p][i].z + v[p][i].w * v[p][i].w;
            ss = wave_sum(ss);
            const float rstd = 1.0f / sqrtf(ss * (1.0f / DM) + 1e-6f);
#pragma unroll
            for (int i = 0; i < 4; ++i) {
                const float4 gg = ((const float4*)g)[lane + 64 * i];
                uint2 o; o.x = pk2(v[p][i].x * rstd * gg.x, v[p][i].y * rstd * gg.y); o.y = pk2(v[p][i].z * rstd * gg.z, v[p][i].w * rstd * gg.w);
                ((uint2*)(out + (size_t)(row0 + p) * DM))[lane + 64 * i] = o;
            }
        }
    }
}
template <bool WITH_Q>
DEV void phase_res_norm(const float* xin, const bf16_t* delta, const float* g, float* xout, bf16_t* out, unsigned char* hq, float* hs, int bid, int nb) {
    const int tid_ = opaque_tid();
    const int wid = tid_ >> 6, lane = tid_ & 63;
    for (int row = bid * 8 + wid; row < NT; row += nb * 8) {
        const float4* xr = (const float4*)(xin + (size_t)row * DM);
        const uint2* dr = (const uint2*)(delta + (size_t)row * DM);
        float4 v[4]; float ss = 0.f;
#pragma unroll
        for (int i = 0; i < 4; ++i) { v[i] = xr[lane + 64 * i]; const uint2 d = dr[lane + 64 * i];
            v[i].x += bflo(d.x); v[i].y += bfhi(d.x); v[i].z += bflo(d.y); v[i].w += bfhi(d.y);
            ss += v[i].x * v[i].x + v[i].y * v[i].y + v[i].z * v[i].z + v[i].w * v[i].w; }
        ss = wave_sum(ss);
        const float rstd = 1.0f / sqrtf(ss * (1.0f / DM) + 1e-6f);
        float mx = 0.f;
#pragma unroll
        for (int i = 0; i < 4; ++i) {
            ((float4*)(xout + (size_t)row * DM))[lane + 64 * i] = v[i];
            const float4 gg = ((const float4*)g)[lane + 64 * i];
            v[i].x *= rstd * gg.x; v[i].y *= rstd * gg.y; v[i].z *= rstd * gg.z; v[i].w *= rstd * gg.w;
            uint2 o; o.x = pk2(v[i].x, v[i].y); o.y = pk2(v[i].z, v[i].w);
            ((uint2*)(out + (size_t)row * DM))[lane + 64 * i] = o;
            if (WITH_Q) mx = fmaxf(mx, fmaxf(fmaxf(fabsf(v[i].x), fabsf(v[i].y)), fmaxf(fabsf(v[i].z), fabsf(v[i].w))));
        }
        if (WITH_Q) {
            mx = wave_max(mx);
            const float sc = mx > 0.f ? 127.0f / mx : 0.f;
#pragma unroll
            for (int i = 0; i < 4; ++i) ((unsigned*)(hq + (size_t)row * DM))[lane + 64 * i] = q8x4(v[i].x * sc, v[i].y * sc, v[i].z * sc, v[i].w * sc);
            if (lane == 0) hs[row] = mx * (1.0f / 127.0f);
        }
    }
}
DEV void phase_final_norm(float* x, const bf16_t* delta, const float* g, int bid, int nb) {
    const int tid_ = opaque_tid();
    const int wid = tid_ >> 6, lane = tid_ & 63;
    for (int row = bid * 8 + wid; row < NT; row += nb * 8) {
        float4* xr = (float4*)(x + (size_t)row * DM);
        const uint2* dr = (const uint2*)(delta + (size_t)row * DM);
        float4 v[4]; float ss = 0.f;
#pragma unroll
        for (int i = 0; i < 4; ++i) { v[i] = xr[lane + 64 * i]; const uint2 d = dr[lane + 64 * i];
            v[i].x += bflo(d.x); v[i].y += bfhi(d.x); v[i].z += bflo(d.y); v[i].w += bfhi(d.y);
            ss += v[i].x * v[i].x + v[i].y * v[i].y + v[i].z * v[i].z + v[i].w * v[i].w; }
        ss = wave_sum(ss);
        const float rstd = 1.0f / sqrtf(ss * (1.0f / DM) + 1e-6f);
#pragma unroll
        for (int i = 0; i < 4; ++i) {
            const float4 gg = ((const float4*)g)[lane + 64 * i];
            float4 o; o.x = v[i].x * rstd * gg.x; o.y = v[i].y * rstd * gg.y; o.z = v[i].z * rstd * gg.z; o.w = v[i].w * rstd * gg.w;
            xr[lane + 64 * i] = o;
        }
    }
}

struct EpiBf16 { bf16_t* out; int ld;
    MDEV void operator()(int r, int c, float v) const { out[(size_t)r * ld + c] = f2bf(v); } };
struct EpiOddIn { bf16_t* out; float* fg; const float* bfv;
    MDEV void operator()(int r, int c, float v) const { if (c < 3072) out[(size_t)r * 3072 + c] = f2bf(v); else fg[(size_t)r * 16 + (c - 3072)] = v + bfv[c - 3072]; } };
struct EpiRes { const float* xin; float* xout;
    MDEV void operator()(int r, int c, float v) const { xout[(size_t)r * DM + c] = xin[(size_t)r * DM + c] + v; } };

template <class Epi>
DEV void phase_gemm_naive(const bf16_t* A, const bf16_t* Bt, int M, int N, int K, const Epi epi, float* lds, int bid, int nb) {
    float* As = lds;
    float* Bs = lds + 16 * 132;
    const int t = threadIdx.x, tx = t & 31, ty = t >> 5;
    const int ntm = M / 128, ntn = (N + 127) / 128;
    const int lr = t >> 2, lk = (t & 3) * 4;
    for (int tile = bid; tile < ntm * ntn; tile += nb) {
        const int m0 = (tile / ntn) * 128, n0 = (tile % ntn) * 128;
        float acc[8][4];
#pragma unroll
        for (int i = 0; i < 8; ++i)
#pragma unroll
            for (int j = 0; j < 4; ++j) acc[i][j] = 0.f;
        for (int k0 = 0; k0 < K; k0 += 16) {
            const uint2 av = *(const uint2*)(A + (size_t)(m0 + lr) * K + k0 + lk);
            uint2 bv = make_uint2(0u, 0u);
            if (n0 + lr < N) bv = *(const uint2*)(Bt + (size_t)(n0 + lr) * K + k0 + lk);
            __syncthreads();
            As[(lk + 0) * 132 + lr] = bflo(av.x); As[(lk + 1) * 132 + lr] = bfhi(av.x); As[(lk + 2) * 132 + lr] = bflo(av.y); As[(lk + 3) * 132 + lr] = bfhi(av.y);
            Bs[(lk + 0) * 132 + lr] = bflo(bv.x); Bs[(lk + 1) * 132 + lr] = bfhi(bv.x); Bs[(lk + 2) * 132 + lr] = bflo(bv.y); Bs[(lk + 3) * 132 + lr] = bfhi(bv.y);
            __syncthreads();
#pragma unroll
            for (int k = 0; k < 16; ++k) {
                const float4 a0 = *(const float4*)&As[k * 132 + ty * 8], a1 = *(const float4*)&As[k * 132 + ty * 8 + 4];
                const float4 b0 = *(const float4*)&Bs[k * 132 + tx * 4];
                const float a[8] = {a0.x, a0.y, a0.z, a0.w, a1.x, a1.y, a1.z, a1.w};
                const float b[4] = {b0.x, b0.y, b0.z, b0.w};
#pragma unroll
                for (int i = 0; i < 8; ++i)
#pragma unroll
                    for (int j = 0; j < 4; ++j) acc[i][j] += a[i] * b[j];
            }
        }
#pragma unroll
        for (int i = 0; i < 8; ++i)
#pragma unroll
            for (int j = 0; j < 4; ++j) { const int row = m0 + ty * 8 + i, col = n0 + tx * 4 + j; if (col < N) epi(row, col, acc[i][j]); }
    }
}

typedef short bf16x8 __attribute__((ext_vector_type(8)));
typedef float f32x4 __attribute__((ext_vector_type(4)));
namespace g8 {
constexpr int BM = 256, BK = 64, HALF = 128, NXCD = 8, WGM = 8, HT = HALF * BK, KD = 1024;
DEV int lds_byte(int r, int c) { const int st = (r >> 4) * 2 + (c >> 5), rr = r & 15, cc = c & 31, ob = rr * 64 + cc * 2; return st * 1024 + (ob ^ (((ob >> 9) & 1) << 5)); }
DEV void stage_rc(int b, int& R, int& C) { const int st = b / 1024, sb = b % 1024, swz = sb ^ (((sb >> 9) & 1) << 5); R = (st >> 1) * 16 + swz / 64; C = (st & 1) * 32 + (swz % 64) / 2; }
}
struct MEpiBf16 { static constexpr bool PERM = true; bf16_t* out; int ld;
    MDEV void operator()(int r, int c, f32x4 v0, f32x4 v1) const { uint4 o; o.x = cvtpk2(v0[0], v0[1]); o.y = cvtpk2(v0[2], v0[3]); o.z = cvtpk2(v1[0], v1[1]); o.w = cvtpk2(v1[2], v1[3]);
        *(uint4*)(out + (size_t)r * ld + c) = o; } };
struct MEpiQKV { static constexpr bool PERM = true; bf16_t* out; int s0_hi, s1_lo, s1_hi;
    MDEV void operator()(int r, int c, f32x4 v0, f32x4 v1) const { const float sc = (c < s0_hi || (c >= s1_lo && c < s1_hi)) ? 0.125f * 1.4426950408889634f : 1.0f;
        uint4 o; o.x = cvtpk2(v0[0] * sc, v0[1] * sc); o.y = cvtpk2(v0[2] * sc, v0[3] * sc); o.z = cvtpk2(v1[0] * sc, v1[1] * sc); o.w = cvtpk2(v1[2] * sc, v1[3] * sc);
        *(uint4*)(out + (size_t)r * 3072 + c) = o; } };
struct MEpiRes { static constexpr bool PERM = false; const float* xin; float* xout;
    MDEV void operator()(int r, int c, f32x4 v) const { const f32x4 b = *(const f32x4*)(xin + (size_t)r * DM + c); *(f32x4*)(xout + (size_t)r * DM + c) = b + v; } };

template <class Epi>
DEV void phase_gemm_mfma(const bf16_t* A, const bf16_t* Bt, int M, int N, const Epi epi, unsigned char* shm_raw, int bid, int nb) {
    using namespace g8;
    typedef __attribute__((address_space(3))) unsigned char* ldsp_t;
    ldsp_t lds = (ldsp_t)shm_raw;
    constexpr int K = KD, nt = K / BK, HTB = HALF * BK * 2;
    int tid = threadIdx.x; asm volatile("" : "+v"(tid));
    const int wid = __builtin_amdgcn_readfirstlane(tid >> 6), lane = tid & 63, wr = wid >> 2, wc = wid & 3, fr = lane & 15, fq = lane >> 4;
    const int nM = M / BM, nN = N / BM, nwg = nM * nN;
    auto unit_of = [&](int i, int& pm, int& pn) -> bool {
        const long L = (long)i * nb + bid; if (L >= nwg) return false;
        int wgid = (int)L;
        { const int q = nwg / NXCD, r = nwg % NXCD, xcd = wgid % NXCD, off = wgid / NXCD; wgid = (xcd < r ? xcd * (q + 1) : r * (q + 1) + (xcd - r) * q) + off; }
        const int nig = WGM * nN, gid = wgid / nig, fm = gid * WGM, gsz = min(nM - fm, WGM);
        pm = fm + ((wgid % nig) % gsz); pn = (wgid % nig) / gsz; return true; };
    unsigned voffA[2], voffB[2];
#pragma unroll
    for (int i = 0; i < 2; ++i) { int R, C; stage_rc(tid * 16 + i * 8192, R, C); const int rho = R & 31, pr = 8 * ((rho & 15) >> 2) + 4 * (rho >> 4) + (rho & 3);
        const int Rb = Epi::PERM ? ((R & ~31) + pr) : R;
        voffA[i] = (unsigned)(R * K + C) * 2u; voffB[i] = (unsigned)(Rb * K + C) * 2u; }
    constexpr size_t kstep = (size_t)(BK * 2), hstep = (size_t)HALF * K * 2, tstep = 2 * hstep;
    const unsigned ldsw = (unsigned)wid * 1024u;
    const int aoff = lds_byte(wr * 64 + fr, fq * 8), boff = lds_byte(wc * 32 + fr, fq * 8);
#define SA(b, h) (((b) * 2 + (h)) * HTB)
#define SB(b, h) ((4 + (b) * 2 + (h)) * HTB)
#define STAGE(bufoff, gbase, voff) do { _Pragma("unroll") for (int _i = 0; _i < 2; ++_i) \
        __builtin_amdgcn_global_load_lds((const unsigned*)((const char*)(gbase) + (voff)[_i]), (__attribute__((address_space(3))) unsigned*)(lds + (bufoff) + ldsw + _i * 8192), 16, 0, 0); } while (0)
#define LDA(dst, b, h) do { _Pragma("unroll") for (int m = 0; m < 4; ++m) _Pragma("unroll") for (int k = 0; k < 2; ++k) dst[m][k] = *(const __attribute__((address_space(3))) bf16x8*)(lds + SA(b, h) + aoff + m * 2048 + k * 1024); } while (0)
#define LDB(dst, b, h) do { _Pragma("unroll") for (int n = 0; n < 2; ++n) _Pragma("unroll") for (int k = 0; k < 2; ++k) dst[n][k] = *(const __attribute__((address_space(3))) bf16x8*)(lds + SB(b, h) + boff + n * 2048 + k * 1024); } while (0)
#define MMA(ai, bj, At, Bt_) do { __builtin_amdgcn_s_setprio(1); _Pragma("unroll") for (int m = 0; m < 4; ++m) _Pragma("unroll") for (int n = 0; n < 2; ++n) _Pragma("unroll") for (int k = 0; k < 2; ++k) \
        acc[ai][bj][m][n] = __builtin_amdgcn_mfma_f32_16x16x32_bf16(Bt_[n][k], At[m][k], acc[ai][bj][m][n], 0, 0, 0); __builtin_amdgcn_s_setprio(0); } while (0)
#define WAIT_V(n) asm volatile("s_waitcnt vmcnt(" #n ")" ::: "memory")
#define WAIT_L(n) asm volatile("s_waitcnt lgkmcnt(" #n ")" ::: "memory")
#define BAR __builtin_amdgcn_s_barrier()
#define SCHED __builtin_amdgcn_sched_barrier(0)
    int cpm, cpn, npm = 0, npn = 0, ui = 0;
    if (!unit_of(0, cpm, cpn)) return;
    f32x4 acc[2][2][4][2];
#pragma unroll
    for (int a = 0; a < 2; ++a)
#pragma unroll
        for (int b = 0; b < 2; ++b)
#pragma unroll
            for (int m = 0; m < 4; ++m)
#pragma unroll
                for (int n = 0; n < 2; ++n) acc[a][b][m][n] = (f32x4){0.f, 0.f, 0.f, 0.f};
    bf16x8 At[4][2], B0[2][2], B1[2][2];
    const char* cA = (const char*)A + (size_t)cpm * tstep; const char* cB = (const char*)Bt + (size_t)cpn * tstep;
    __syncthreads();
    STAGE(SB(0, 0), cB, voffB); STAGE(SA(0, 0), cA, voffA); STAGE(SB(0, 1), cB + hstep, voffB); STAGE(SA(0, 1), cA + hstep, voffA);
    if (wr == 1) BAR;
    WAIT_V(4); BAR;
    STAGE(SB(1, 0), cB + kstep, voffB); STAGE(SA(1, 0), cA + kstep, voffA); STAGE(SB(1, 1), cB + hstep + kstep, voffB);
    WAIT_V(6); BAR;
    for (;;) {
        const bool has_next = unit_of(ui + 1, npm, npn);
        const char* nA = has_next ? (const char*)A + (size_t)npm * tstep : cA; const char* nB = has_next ? (const char*)Bt + (size_t)npn * tstep : cB;
#pragma unroll 1
        for (int t = 0; t < nt; t += 2) {
            const bool last = (t == nt - 2);
            const char* a1 = cA + (size_t)(t + 1) * kstep;
            const char* a2 = last ? nA : cA + (size_t)(t + 2) * kstep; const char* b2 = last ? nB : cB + (size_t)(t + 2) * kstep;
            const char* a3 = a2 + kstep; const char* b3 = b2 + kstep;
            LDB(B0, 0, 0); SCHED; LDA(At, 0, 0); STAGE(SA(1, 1), a1 + hstep, voffA);
            WAIT_L(8); BAR; WAIT_L(0); MMA(0, 0, At, B0); BAR; SCHED;
            LDB(B1, 0, 1); STAGE(SB(0, 0), b2, voffB);
            BAR; WAIT_L(0); MMA(0, 1, At, B1); BAR;
            LDA(At, 0, 1); STAGE(SA(0, 0), a2, voffA);
            BAR; WAIT_L(0); MMA(1, 0, At, B0); BAR; SCHED;
            STAGE(SB(0, 1), b2 + hstep, voffB);
            WAIT_V(6); BAR; MMA(1, 1, At, B1); BAR;
            LDB(B0, 1, 0); SCHED; LDA(At, 1, 0); STAGE(SA(0, 1), a2 + hstep, voffA);
            WAIT_L(8); BAR; WAIT_L(0); MMA(0, 0, At, B0); BAR; SCHED;
            LDB(B1, 1, 1); STAGE(SB(1, 0), b3, voffB);
            BAR; WAIT_L(0); MMA(0, 1, At, B1); BAR;
            LDA(At, 1, 1); STAGE(SA(1, 0), a3, voffA);
            BAR; WAIT_L(0); MMA(1, 0, At, B0); BAR; SCHED;
            STAGE(SB(1, 1), b3 + hstep, voffB);
            WAIT_V(6); BAR; MMA(1, 1, At, B1); BAR;
        }
        {
            const int brow = cpm * BM, bcol = cpn * BM;
#pragma unroll
            for (int ai = 0; ai < 2; ++ai)
#pragma unroll
                for (int m = 0; m < 4; ++m)
#pragma unroll
                    for (int bj = 0; bj < 2; ++bj) {
                        const int row = brow + ai * HALF + wr * 64 + m * 16 + fr;
                        if constexpr (Epi::PERM) epi(row, bcol + bj * HALF + wc * 32 + 8 * fq, acc[ai][bj][m][0], acc[ai][bj][m][1]);
                        else { epi(row, bcol + bj * HALF + wc * 32 + 4 * fq, acc[ai][bj][m][0]); epi(row, bcol + bj * HALF + wc * 32 + 16 + 4 * fq, acc[ai][bj][m][1]); }
                    }
        }
        if (!has_next) break;
#pragma unroll
        for (int a = 0; a < 2; ++a)
#pragma unroll
            for (int b = 0; b < 2; ++b)
#pragma unroll
                for (int m = 0; m < 4; ++m)
#pragma unroll
                    for (int n = 0; n < 2; ++n) acc[a][b][m][n] = (f32x4){0.f, 0.f, 0.f, 0.f};
        cpm = npm; cpn = npn; cA = nA; cB = nB; ++ui;
    }
    WAIT_V(0);
    if (wr == 0) BAR;
    BAR;
#undef SA
#undef SB
#undef STAGE
#undef LDA
#undef LDB
#undef MMA
#undef WAIT_V
#undef WAIT_L
#undef BAR
#undef SCHED
}

DEV void phase_fg(const bf16_t* hn, const bf16_t* wfg, const float* bfv, float* fg, int bid, int nb) {
    const int tid_ = opaque_tid();
    const int wid = tid_ >> 6, lane = tid_ & 63, fr = lane & 15, fq = lane >> 4;
    for (int task = bid * 8 + wid; task < NT / 16; task += nb * 8) {
        const int row0 = task * 16;
        f32x4 acc = (f32x4){0.f, 0.f, 0.f, 0.f};
        const bf16x8* ap = (const bf16x8*)(hn + (size_t)(row0 + fr) * DM + fq * 8);
        const bf16x8* bp = (const bf16x8*)(wfg + (size_t)fr * DM + fq * 8);
#pragma unroll 8
        for (int kk = 0; kk < 32; ++kk) acc = __builtin_amdgcn_mfma_f32_16x16x32_bf16(ap[kk * 4], bp[kk * 4], acc, 0, 0, 0);
        const float bb = bfv[fr];
#pragma unroll
        for (int j = 0; j < 4; ++j) fg[(size_t)(row0 + fq * 4 + j) * 16 + fr] = acc[j] + bb;
    }
}

typedef float f32x16 __attribute__((ext_vector_type(16)));
typedef short s16x4 __attribute__((ext_vector_type(4)));
typedef __attribute__((address_space(3))) const unsigned char* ldsc_t;
typedef __attribute__((address_space(3))) unsigned char* lptr_t;
#define MFMA32(a, b, c) __builtin_amdgcn_mfma_f32_32x32x16_bf16(a, b, c, 0, 0, 0)
constexpr float NEG_BIG = -1e30f;
constexpr float LOG2E = 1.4426950408889634f;
constexpr float QSCALE = 0.125f * LOG2E;
constexpr int ATT_LUT_OFF = 0;
constexpr int ATT_TILE_OFF = 24576;
DEV unsigned cvtpk(float lo, float hi) { return cvtpk2(lo, hi); }
DEV s16x4 vtr(ldsc_t p) { typedef short v4i16_t __attribute__((ext_vector_type(4))); return __builtin_bit_cast(s16x4, __builtin_amdgcn_ds_read_tr16_b64_v4i16((__attribute__((address_space(3))) v4i16_t*)p)); }
DEV float xhalf_max(float m) { auto rr = __builtin_amdgcn_permlane32_swap(__float_as_uint(m), __float_as_uint(m), false, false); return fmaxf(__uint_as_float(rr[0]), __uint_as_float(rr[1])); }
DEV float xhalf_sum(float m) { auto rr = __builtin_amdgcn_permlane32_swap(__float_as_uint(m), __float_as_uint(m), false, false); return __uint_as_float(rr[0]) + __uint_as_float(rr[1]); }

#define MXX3(a, b, c) __builtin_fmaxf(__builtin_fmaxf((a), (b)), (c))
template <int W, int MODE, int WIN  , class PRE>
DEV void attn_unit(PRE pre  , const bf16_t* qg  , const bf16_t* kg  , const bf16_t* vg, int kt_lo, int kt_hi,
                   int qrow, int qmin, int qmax, int kmap, unsigned char* lds_raw, f32x16 (&o)[W / 32], float kbound = 0.f, int rs = 3072, float* lse_out = nullptr, int rmax = 4127) {
    constexpr bool BAND = (WIN != 0);
    constexpr bool REV = (MODE == 1);
    constexpr int NC = W / 32, ROWB = W * 2, TILEB = 64 * ROWB, CPR = W / 8, NLD = (64 * CPR) / NTHR;
    int tid = threadIdx.x; asm volatile("" : "+v"(tid));
    const int lane = tid & 63, l31 = lane & 31, hi = lane >> 5;
    ldsc_t lds = (ldsc_t)lds_raw;
    const float* lut = (const float*)(lds_raw + ATT_LUT_OFF);
    bf16x8 qf[4];
#pragma unroll
    for (int ks = 0; ks < 4; ++ks) qf[ks] = *(const bf16x8*)(qg + ks * 16 + hi * 8);
#pragma unroll
    for (int c = 0; c < NC; ++c)
#pragma unroll
        for (int r = 0; r < 16; ++r) o[c][r] = 0.f;
    float m = NEG_BIG, l = 0.f;
    float brow = 0.f; bool wdone = false;
    volatile __attribute__((address_space(3))) unsigned* flg = (volatile __attribute__((address_space(3))) unsigned*)((lptr_t)lds_raw + ATT_LUT_OFF + 20480);
    if (REV) { float ss = 0.f;
#pragma unroll
        for (int ks = 0; ks < 4; ++ks)
#pragma unroll
            for (int j = 0; j < 8; ++j) { const float v = bf2f((bf16_t)qf[ks][j]); ss += v * v; }
        brow = sqrtf(xhalf_sum(ss)) * kbound; }
    const int wv = __builtin_amdgcn_readfirstlane(tid >> 6);
    unsigned ksrc[NLD], vsrc[NLD];
#pragma unroll
    for (int i = 0; i < NLD; ++i) { const int id = tid + NTHR * i, row = id / CPR, chp = id % CPR;
        const int kch = (W == 64) ? (chp ^ ((row >> 1) & 7)) : (chp ^ (row & 15));
        const int vch = (W == 64) ? (chp ^ (((row >> 1) & 1) << 2)) : (chp ^ ((row & 3) << 2));
        ksrc[i] = (unsigned)(row * rs + kch * 8); vsrc[i] = (unsigned)(row * rs + vch * 8); }
#define stage_issue(kt_, buf_) do { _Pragma("unroll") for (int i = 0; i < NLD; ++i) { \
        __builtin_amdgcn_global_load_lds((const unsigned*)(kg + (size_t)(kt_) * 64 * rs + ksrc[i]), (__attribute__((address_space(3))) unsigned*)((lptr_t)lds_raw + ATT_TILE_OFF + (buf_) * (2 * TILEB) + (wv * 64 + NTHR * i) * 16), 16, 0, 0); \
        __builtin_amdgcn_global_load_lds((const unsigned*)(vg + (size_t)(kt_) * 64 * rs + vsrc[i]), (__attribute__((address_space(3))) unsigned*)((lptr_t)lds_raw + ATT_TILE_OFF + (buf_) * (2 * TILEB) + TILEB + (wv * 64 + NTHR * i) * 16), 16, 0, 0); } } while (0)
    int koff[4];
#pragma unroll
    for (int ks = 0; ks < 4; ++ks) { const int ch = (kmap >> 3) + 2 * ks + hi; const int kch = (W == 64) ? (ch ^ ((l31 >> 1) & 7)) : (ch ^ (l31 & 15)); koff[ks] = l31 * ROWB + kch * 16; }
    int voff[NC];
    { const int q4 = (lane & 15) >> 2, blk = (lane >> 4) & 1, p = lane & 3;
#pragma unroll
      for (int c = 0; c < NC; ++c) { const int ch = 4 * c + 2 * blk + (p >> 1); const int vch = (W == 64) ? (ch ^ (((q4 >> 1) & 1) << 2)) : (ch ^ (q4 << 2));
          voff[c] = (4 * hi + q4) * ROWB + vch * 16 + 8 * (p & 1); } }
    __syncthreads();
    stage_issue(REV ? kt_hi : kt_lo, 0);
    pre();
    asm volatile("s_waitcnt vmcnt(0)" ::: "memory");
    __syncthreads();
    const int ntile = kt_hi - kt_lo + 1;
    for (int it = 0; it < ntile; ++it) {
        const int kt = REV ? kt_hi - it : kt_lo + it, ktn = REV ? kt - 1 : kt + 1;
        const bool has_next = it + 1 < ntile;
        const int buf = it & 1;
        if (has_next) stage_issue(ktn, buf ^ 1);
        const int k0 = kt * 64;
        bool active = (k0 <= qmax);
        if (BAND) active = active && (k0 + 63 >= qmin - WIN);
        if (REV) active = active && !wdone;
        if (active) {
            ldsc_t kb_ = lds + ATT_TILE_OFF + buf * (2 * TILEB); ldsc_t vb_ = kb_ + TILEB;
            f32x16 s0, s1;
            if (MODE == 0) {
                const bool far = !BAND && (qmin - (k0 + 63) >= 1513);
                const int ib = far ? (rmax - 3000) : (rmax - (qrow - k0 - 4 * hi));
                const __attribute__((address_space(3))) float* lp = (const __attribute__((address_space(3))) float*)((lptr_t)lds_raw + ATT_LUT_OFF) + ib;
#pragma unroll
                for (int r = 0; r < 16; ++r) { const int cr = (r & 3) + 8 * (r >> 2); s0[r] = lp[cr]; s1[r] = lp[32 + cr]; }
            } else {
                const f32x4* cp = (const f32x4*)(lut + k0 + 4 * hi);
#pragma unroll
                for (int g = 0; g < 4; ++g) { const f32x4 a = cp[2 * g], b = cp[2 * g + 8];
                    s0[4 * g] = a[0]; s0[4 * g + 1] = a[1]; s0[4 * g + 2] = a[2]; s0[4 * g + 3] = a[3];
                    s1[4 * g] = b[0]; s1[4 * g + 1] = b[1]; s1[4 * g + 2] = b[2]; s1[4 * g + 3] = b[3]; }
            }
#pragma unroll
            for (int ks = 0; ks < 4; ++ks) {
                const bf16x8 k0f = *(const __attribute__((address_space(3))) bf16x8*)(kb_ + koff[ks]);
                const bf16x8 k1f = *(const __attribute__((address_space(3))) bf16x8*)(kb_ + koff[ks] + 32 * ROWB);
                s0 = MFMA32(k0f, qf[ks], s0); s1 = MFMA32(k1f, qf[ks], s1);
            }
            if (MODE == 1) {
                if (k0 + 63 > qmin) {
#pragma unroll
                    for (int r = 0; r < 16; ++r) { const int kv = k0 + 4 * hi + (r & 3) + 8 * (r >> 2); if (kv > qrow) s0[r] = NEG_BIG; if (kv + 32 > qrow) s1[r] = NEG_BIG; }
                }
            }
            float mx;
            { const float a0 = MXX3(s0[0], s0[1], s0[2]), a1 = MXX3(s0[3], s0[4], s0[5]), a2 = MXX3(s0[6], s0[7], s0[8]), a3 = MXX3(s0[9], s0[10], s0[11]), a4 = MXX3(s0[12], s0[13], s0[14]);
              const float b0 = MXX3(s1[0], s1[1], s1[2]), b1 = MXX3(s1[3], s1[4], s1[5]), b2 = MXX3(s1[6], s1[7], s1[8]), b3 = MXX3(s1[9], s1[10], s1[11]), b4 = MXX3(s1[12], s1[13], s1[14]);
              mx = MXX3(MXX3(MXX3(a0, a1, a2), MXX3(a3, a4, s0[15]), MXX3(b0, b1, b2)), MXX3(b3, b4, s1[15]), a0); }
            mx = xhalf_max(mx);
            if (!(REV && __all(mx < m - 24.0f))) {
            if (!__all(mx - m <= 8.0f)) {
                const float mn = fmaxf(m, mx), alpha = __builtin_amdgcn_exp2f(m - mn);
                m = mn; l *= alpha;
#pragma unroll
                for (int c = 0; c < NC; ++c)
#pragma unroll
                    for (int r = 0; r < 16; ++r) o[c][r] *= alpha;
            }
            float ls = 0.f;
#pragma unroll
            for (int r = 0; r < 16; ++r) { s0[r] = __builtin_amdgcn_exp2f(s0[r] - m); s1[r] = __builtin_amdgcn_exp2f(s1[r] - m); ls += s0[r] + s1[r]; }
            l += ls;
            bf16x8 pf[2][2];
#pragma unroll
            for (int s_ = 0; s_ < 2; ++s_) {
                typedef unsigned u32x4_t __attribute__((ext_vector_type(4)));
                u32x4_t w0, w1;
                w0[0] = cvtpk(s0[8 * s_ + 0], s0[8 * s_ + 1]); w0[1] = cvtpk(s0[8 * s_ + 2], s0[8 * s_ + 3]); w0[2] = cvtpk(s0[8 * s_ + 4], s0[8 * s_ + 5]); w0[3] = cvtpk(s0[8 * s_ + 6], s0[8 * s_ + 7]);
                w1[0] = cvtpk(s1[8 * s_ + 0], s1[8 * s_ + 1]); w1[1] = cvtpk(s1[8 * s_ + 2], s1[8 * s_ + 3]); w1[2] = cvtpk(s1[8 * s_ + 4], s1[8 * s_ + 5]); w1[3] = cvtpk(s1[8 * s_ + 6], s1[8 * s_ + 7]);
                pf[0][s_] = __builtin_bit_cast(bf16x8, w0); pf[1][s_] = __builtin_bit_cast(bf16x8, w1);
            }
#pragma unroll
            for (int c = 0; c < NC; ++c)
#pragma unroll
                for (int kb = 0; kb < 2; ++kb)
#pragma unroll
                    for (int s_ = 0; s_ < 2; ++s_) {
                        const s16x4 lo = vtr(vb_ + voff[c] + (32 * kb + 16 * s_) * ROWB), hi4 = vtr(vb_ + voff[c] + (32 * kb + 16 * s_ + 8) * ROWB);
                        bf16x8 vf; vf[0] = lo[0]; vf[1] = lo[1]; vf[2] = lo[2]; vf[3] = lo[3]; vf[4] = hi4[0]; vf[5] = hi4[1]; vf[6] = hi4[2]; vf[7] = hi4[3];
                        o[c] = MFMA32(vf, pf[kb][s_], o[c]);
                    }
            }
        }
        if (REV) {
            if (!wdone && has_next) { const float nb = lut[k0 - 1]; wdone = __all((m > -1e29f) && (brow + nb < m - 24.0f)); }
            if (lane == 0) flg[(it & 1) * 8 + (tid >> 6)] = wdone ? 1u : 0u;
        }
        asm volatile("s_waitcnt vmcnt(0)" ::: "memory");
        __syncthreads();
        if (REV) { const volatile __attribute__((address_space(3))) unsigned* f = flg + (it & 1) * 8;
            if ((f[0] & f[1] & f[2] & f[3] & f[4] & f[5] & f[6] & f[7]) != 0u) break; }
    }
#undef stage_issue
    const float lt = xhalf_sum(l), inv = 1.0f / lt;
    if (lse_out) *lse_out = m + __log2f(lt);
#pragma unroll
    for (int c = 0; c < NC; ++c)
#pragma unroll
        for (int r = 0; r < 16; ++r) o[c][r] *= inv;
}

template <int NC>
DEV void attn_store(const f32x16 (&o)[NC], bf16_t* orow, int hi) {
#pragma unroll
    for (int c = 0; c < NC; ++c)
#pragma unroll
        for (int g = 0; g < 4; ++g) { uint2 w; w.x = cvtpk(o[c][4 * g], o[c][4 * g + 1]); w.y = cvtpk(o[c][4 * g + 2], o[c][4 * g + 3]);
            *(uint2*)(orow + 32 * c + 8 * g + 4 * hi) = w; }
}

DEV void phase_fox_mfma(const bf16_t* qkv, const float* cloc, const float* ctot, const unsigned* kmax_u, bf16_t* ao, unsigned char* lds_raw, unsigned* qwork) {
    const int tid_ = opaque_tid();
    const int tid = tid_, wid = tid >> 6, lane = tid & 63, l31 = lane & 31, hi = lane >> 5;
    float* nck = (float*)(lds_raw + ATT_LUT_OFF);
    volatile unsigned* qsh = (volatile unsigned*)(lds_raw + ATT_LUT_OFF + 20480 + 128);
    unsigned u = queue_next(qwork, qsh);
    for (;;) {
        if (u >= 2048u) break;
        const unsigned upf = queue_prefetch(qwork);
        const int qblk = 15 - (int)(u >> 7), st = (int)(u & 127), b = st >> 4, h = st & 15;
        const int q0 = qblk * 256, qend = q0 + 255;
        auto pre_ = [&]() { float coff[8]; float run = 0.f;
          float cl[8];
#pragma unroll
          for (int k = 0; k < 8; ++k) { const int i = tid + k * NTHR; cl[k] = (i <= qend) ? cloc[(size_t)st * SEQ + i] : 0.f; }
          const float cend = cloc[(size_t)st * SEQ + qend];
#pragma unroll
          for (int j = 0; j < 8; ++j) { coff[j] = run; run += ctot[st * 8 + j]; }
          float cq = 0.f;
#pragma unroll
          for (int j = 0; j < 8; ++j) cq = ((qend >> 9) == j) ? coff[j] : cq;
          const float cref = cend + cq;
#pragma unroll
          for (int k = 0; k < 8; ++k) { const int i = tid + k * NTHR;
              if (i <= qend) nck[i] = (cref - (cl[k] + coff[k])) * LOG2E; } };
        const float kbound = __uint_as_float(kmax_u[st]);
        const int qrow = q0 + wid * 32 + l31;
        const size_t tokb = (size_t)b * SEQ;
        f32x16 o[2];
        attn_unit<64, 1, 0>(pre_, qkv + (tokb + qrow) * 3072 + h * 64, qkv + tokb * 3072 + 1024 + h * 64, qkv + tokb * 3072 + 2048 + h * 64,
                                0, qend >> 6, qrow, q0 + wid * 32, q0 + wid * 32 + 31, 0, lds_raw, o, kbound);
        attn_store<2>(o, ao + (tokb + qrow) * DM + h * 64, hi);
        u = queue_turn(upf, qsh);
    }
}

DEV void phase_mix0_mfma(const bf16_t* qkv, const float* rel_bias, const float* lamp, const float* ln_g, bf16_t* ao, bf16_t* dpo, float* dlse, unsigned char* lds_raw, unsigned* qwork) {
    const int tid_ = opaque_tid();
    const int tid = tid_, wid = tid >> 6, lane = tid & 63, l31 = lane & 31, hi = lane >> 5;
    float* lut = (float*)(lds_raw + ATT_LUT_OFF);
    volatile unsigned* qsh = (volatile unsigned*)(lds_raw + ATT_LUT_OFF + 20480 + 128);
    float lam;
    { float s1 = 0.f, s2 = 0.f;
      for (int i = 0; i < 64; ++i) { s1 += lamp[i] * lamp[64 + i]; s2 += lamp[128 + i] * lamp[192 + i]; }
      lam = expf(s1) - expf(s2) + 0.2f; }
    unsigned uq = queue_next(qwork, qsh);
    for (;;) {
        if (uq >= 1024u + 3072u) break;
        const unsigned upf = queue_prefetch(qwork);
      if (uq >= 1024u) {
        const int u = (int)uq - 1024;
        const int st = u & 63, v48 = u >> 6, b = st >> 3, h = st & 7;
        int br, r, iblk;
        if (v48 < 16) { br = 0; r = 0; iblk = 15 - v48; } else if (v48 < 32) { br = 1; r = (v48 - 16) & 3; iblk = 3 - ((v48 - 16) >> 2); } else { br = 2; r = v48 - 32; iblk = 0; }
        const int dl = (br == 0) ? 1 : (br == 1) ? 4 : 16;
        const int q0 = iblk * 256, qend = q0 + 255;
        auto pre_ = [&]() { for (int i = tid; i < 640; i += NTHR) { const int dd = 320 - i; lut[i] = (dd >= 0 && dd <= 128) ? rel_bias[t5_bucket(dl * dd) * 12 + h] * LOG2E : NEG_BIG; } };
        const int qrow = q0 + wid * 32 + l31;
        const size_t tokb = (size_t)b * SEQ;
        const int klo = max(q0 - 128, 0) >> 6;
        f32x16 o[2]; float lse;
        attn_unit<64, 0, 128>(pre_, qkv + (tokb + r + (size_t)dl * qrow) * 3072 + h * 64, qkv + (tokb + r) * 3072 + 512 + h * 64, qkv + (tokb + r) * 3072 + 1024 + h * 64,
                              klo, qend >> 6, qrow, q0 + wid * 32, q0 + wid * 32 + 31, 0, lds_raw, o, 0.f, dl * 3072, &lse, 320);
        const size_t tok = tokb + r + (size_t)dl * qrow;
        attn_store<2>(o, dpo + ((size_t)br * NT + tok) * 512 + h * 64, hi);
        if (hi == 0) dlse[((size_t)br * NT + tok) * 8 + h] = lse;
      } else {
        const int u = (int)uq;
        const int qblk = 31 - (u >> 5), st = u & 31;
        const int b = st >> 2, hd = st & 3;
        const int q0 = qblk * 128, qend = q0 + 127;
        auto pre_ = [&]() { float lv[9];
#pragma unroll
          for (int k = 0; k < 9; ++k) { const int i = tid + k * NTHR, dist = 4127 - i; lv[k] = (i < 4224 && dist >= 0 && dist <= 4095) ? rel_bias[t5_bucket(dist) * 12 + 8 + hd] * LOG2E : NEG_BIG; }
#pragma unroll
          for (int k = 0; k < 9; ++k) { const int i = tid + k * NTHR; if (i < 4224) lut[i] = lv[k]; } };
        const int qg_ = wid >> 1, map = wid & 1;
        const int qrow = q0 + qg_ * 32 + l31;
        const size_t tokb = (size_t)b * SEQ;
        f32x16 o[4];
        attn_unit<128, 0, 0>(pre_, qkv + (tokb + qrow) * 3072 + 1536 + hd * 128 + map * 64, qkv + tokb * 3072 + 2048 + hd * 128, qkv + tokb * 3072 + 2560 + hd * 128,
                                 0, qend >> 6, qrow, q0 + qg_ * 32, q0 + qg_ * 32 + 31, map * 64, lds_raw, o);
        float* X = (float*)(lds_raw + ATT_TILE_OFF) + qg_ * 4096;
        if (map == 1) {
#pragma unroll
            for (int c = 0; c < 4; ++c)
#pragma unroll
                for (int r = 0; r < 16; ++r) X[(c * 16 + r) * 64 + lane] = lam * o[c][r];
        }
        __syncthreads();
        if (map == 0) {
            float ss = 0.f;
#pragma unroll
            for (int c = 0; c < 4; ++c)
#pragma unroll
                for (int r = 0; r < 16; ++r) { o[c][r] -= X[(c * 16 + r) * 64 + lane]; ss += o[c][r] * o[c][r]; }
            ss = xhalf_sum(ss);
            const float rstd = 0.8f / sqrtf(ss * (1.0f / 128.0f) + 1e-6f);
            bf16_t* orow = ao + (tokb + qrow) * DM + 512 + hd * 128;
#pragma unroll
            for (int c = 0; c < 4; ++c)
#pragma unroll
                for (int g = 0; g < 4; ++g) { const int d0 = 32 * c + 8 * g + 4 * hi; const f32x4 gg = *(const f32x4*)(ln_g + d0);
                    uint2 wv; wv.x = cvtpk(o[c][4 * g] * rstd * gg[0], o[c][4 * g + 1] * rstd * gg[1]); wv.y = cvtpk(o[c][4 * g + 2] * rstd * gg[2], o[c][4 * g + 3] * rstd * gg[3]);
                    *(uint2*)(orow + d0) = wv; }
        }
      }
        uq = queue_turn(upf, qsh);
    }
}

DEV void phase_dilated_naive(const bf16_t* qkv, const float* rel_bias, bf16_t* ao, float* lds, int bid, int nb) {
    const int t = threadIdx.x, wid = t >> 6, lane = t & 63;
    float* lut = lds;
    __syncthreads();
    for (int i = t; i < 8 * 3 * 129; i += NTHR) {
        const int h = i / (3 * 129), r = i % (3 * 129), br = r / 129, n = r % 129;
        const int dl = br == 0 ? 1 : (br == 1 ? 4 : 16);
        lut[(h * 3 + br) * 132 + n] = rel_bias[t5_bucket(dl * n) * 12 + h];
    }
    __syncthreads();
    for (int task = bid * 8 + wid; task < NT * 8; task += nb * 8) {
        const int tok = task >> 3, h = task & 7, b = tok >> 12, pos = tok & 4095;
        const float q = bf2f(qkv[(size_t)tok * 3072 + h * 64 + lane]) * 0.125f;
        float m = -INFINITY, l = 0.f, o = 0.f;
#pragma unroll
        for (int br = 0; br < 3; ++br) {
            const int dl = br == 0 ? 1 : (br == 1 ? 4 : 16);
            const int nvalid = min(128, pos / dl) + 1;
            const float* lb = lut + (h * 3 + br) * 132;
            for (int n0 = 0; n0 < nvalid; n0 += 4) {
                float kv[4], vv[4];
#pragma unroll
                for (int j = 0; j < 4; ++j) {
                    const int key = max(pos - dl * (n0 + j), 0);
                    const size_t base = (size_t)(b * SEQ + key) * 3072 + h * 64 + lane;
                    kv[j] = bf2f(qkv[base + 512]); vv[j] = bf2f(qkv[base + 1024]);
                }
#pragma unroll
                for (int j = 0; j < 4; ++j) {
                    if (n0 + j < nvalid) {
                        const float s = wave_sum(q * kv[j]) + lb[n0 + j];
                        if (s > m) { const float f = __expf(m - s); l *= f; o *= f; m = s; }
                        const float p = __expf(s - m);
                        l += p; o += p * vv[j];
                    }
                }
            }
        }
        ao[(size_t)tok * DM + h * 64 + lane] = f2bf(o / l);
    }
}

DEV void phase_diff_naive(const bf16_t* qkv, const float* rel_bias, const float* lamp, const float* ln_g, bf16_t* ao, float* lds, int bid, int nb) {
    const int t = threadIdx.x;
    float* Ks = lds;
    float* Vs = lds + 8192;
    float* lut = lds + 16384 + 512;
    float* X = lds;
    float lam;
    { float s1 = 0.f, s2 = 0.f;
      for (int i = 0; i < 64; ++i) { s1 += lamp[i] * lamp[64 + i]; s2 += lamp[128 + i] * lamp[192 + i]; }
      lam = expf(s1) - expf(s2) + 0.2f; }
    const int qi = t & 127, map = (t >> 7) & 1, vh = t >> 8;
    for (int unit = bid; unit < 1024; unit += nb) {
        const int qblk = 31 - unit / 32, bh = unit % 32, b = bh >> 2, hd = bh & 3;
        const int qpos = qblk * 128 + qi;
        const size_t tok = (size_t)b * SEQ + qpos;
        __syncthreads();
        for (int i = t; i < 4096; i += NTHR) lut[i] = rel_bias[t5_bucket(i) * 12 + 8 + hd];
        float q[64], o[64];
        { const uint4* qp = (const uint4*)(qkv + tok * 3072 + 1536 + hd * 128 + map * 64);
#pragma unroll
          for (int i = 0; i < 8; ++i) { const uint4 w = qp[i];
              q[i * 8 + 0] = bflo(w.x) * 0.125f; q[i * 8 + 1] = bfhi(w.x) * 0.125f; q[i * 8 + 2] = bflo(w.y) * 0.125f; q[i * 8 + 3] = bfhi(w.y) * 0.125f;
              q[i * 8 + 4] = bflo(w.z) * 0.125f; q[i * 8 + 5] = bfhi(w.z) * 0.125f; q[i * 8 + 6] = bflo(w.w) * 0.125f; q[i * 8 + 7] = bfhi(w.w) * 0.125f; } }
#pragma unroll
        for (int d = 0; d < 64; ++d) o[d] = 0.f;
        float m = -INFINITY, l = 0.f;
        const int nkt = 2 * qblk + 2;
        for (int kt = 0; kt < nkt; ++kt) {
            __syncthreads();
#pragma unroll
            for (int i = 0; i < 2; ++i) {
                const int e = (t + i * NTHR) * 8, j = e >> 7, d0 = e & 127;
                const size_t base = ((size_t)b * SEQ + kt * 64 + j) * 3072 + hd * 128 + d0;
                const uint4 kw = *(const uint4*)(qkv + base + 2048), vw = *(const uint4*)(qkv + base + 2560);
                float* kd = Ks + j * 128 + d0; float* vd = Vs + j * 128 + d0;
                kd[0] = bflo(kw.x); kd[1] = bfhi(kw.x); kd[2] = bflo(kw.y); kd[3] = bfhi(kw.y); kd[4] = bflo(kw.z); kd[5] = bfhi(kw.z); kd[6] = bflo(kw.w); kd[7] = bfhi(kw.w);
                vd[0] = bflo(vw.x); vd[1] = bfhi(vw.x); vd[2] = bflo(vw.y); vd[3] = bfhi(vw.y); vd[4] = bflo(vw.z); vd[5] = bfhi(vw.z); vd[6] = bflo(vw.w); vd[7] = bfhi(vw.w);
            }
            __syncthreads();
            for (int j = 0; j < 64; ++j) {
                const int key = kt * 64 + j;
                if (key <= qpos) {
                    const float4* kr = (const float4*)(Ks + j * 128 + map * 64);
                    float s = 0.f;
#pragma unroll
                    for (int d4 = 0; d4 < 16; ++d4) { const float4 kk = kr[d4]; s += q[d4 * 4] * kk.x + q[d4 * 4 + 1] * kk.y + q[d4 * 4 + 2] * kk.z + q[d4 * 4 + 3] * kk.w; }
                    s += lut[qpos - key];
                    if (s > m) { const float f = __expf(m - s); l *= f;
#pragma unroll
                        for (int d = 0; d < 64; ++d) o[d] *= f;
                        m = s; }
                    const float p = __expf(s - m);
                    l += p;
                    const float4* vr = (const float4*)(Vs + j * 128 + vh * 64);
#pragma unroll
                    for (int d4 = 0; d4 < 16; ++d4) { const float4 vv = vr[d4]; o[d4 * 4] += p * vv.x; o[d4 * 4 + 1] += p * vv.y; o[d4 * 4 + 2] += p * vv.z; o[d4 * 4 + 3] += p * vv.w; }
                }
            }
        }
        const float inv = 1.0f / l;
        __syncthreads();
        if (map == 1) {
#pragma unroll
            for (int d = 0; d < 64; ++d) X[qi * 129 + vh * 64 + d] = lam * o[d] * inv;
        }
        __syncthreads();
        if (map == 0) {
#pragma unroll
            for (int d = 0; d < 64; ++d) X[qi * 129 + vh * 64 + d] = o[d] * inv - X[qi * 129 + vh * 64 + d];
        }
        __syncthreads();
        {
            const int qq = t >> 2, part = t & 3;
            float ss = 0.f;
            for (int i = 0; i < 32; ++i) { const float v = X[qq * 129 + part * 32 + i]; ss += v * v; }
            ss += __shfl_xor(ss, 1); ss += __shfl_xor(ss, 2);
            const float rstd = 1.0f / sqrtf(ss * (1.0f / 128.0f) + 1e-6f);
            const size_t tk = (size_t)b * SEQ + qblk * 128 + qq;
            for (int i = 0; i < 32; ++i) { const int v = part * 32 + i;
                ao[tk * DM + 512 + hd * 128 + v] = f2bf(X[qq * 129 + v] * rstd * ln_g[v] * 0.8f); }
        }
    }
}

DEV void phase_dilated_merge(const bf16_t* dpo, const float* dlse, bf16_t* ao, int bid, int nb) {
    const int tid_ = opaque_tid();
    const int wid = tid_ >> 6, lane = tid_ & 63, h = lane >> 3;
    constexpr int TP = 4;
    for (int tok0 = (bid * 8 + wid) * TP; tok0 < NT; tok0 += nb * 8 * TP) {
        float ls[TP][3]; uint4 ov[TP][3];
#pragma unroll
        for (int p = 0; p < TP; ++p)
#pragma unroll
            for (int br = 0; br < 3; ++br) { ls[p][br] = dlse[((size_t)br * NT + tok0 + p) * 8 + h]; ov[p][br] = *(const uint4*)(dpo + ((size_t)br * NT + tok0 + p) * 512 + lane * 8); }
#pragma unroll
        for (int p = 0; p < TP; ++p) {
            const float mx = fmaxf(fmaxf(ls[p][0], ls[p][1]), ls[p][2]);
            float w[3]; float sum = 0.f;
#pragma unroll
            for (int br = 0; br < 3; ++br) { w[br] = __builtin_amdgcn_exp2f(ls[p][br] - mx); sum += w[br]; }
            const float inv = 1.0f / sum;
            float acc[8];
#pragma unroll
            for (int i = 0; i < 8; ++i) acc[i] = 0.f;
#pragma unroll
            for (int br = 0; br < 3; ++br) { const float ww = w[br] * inv; const uint4 o_ = ov[p][br];
                acc[0] += ww * bflo(o_.x); acc[1] += ww * bfhi(o_.x); acc[2] += ww * bflo(o_.y); acc[3] += ww * bfhi(o_.y);
                acc[4] += ww * bflo(o_.z); acc[5] += ww * bfhi(o_.z); acc[6] += ww * bflo(o_.w); acc[7] += ww * bfhi(o_.w); }
            uint4 o; o.x = pk2(acc[0], acc[1]); o.y = pk2(acc[2], acc[3]); o.z = pk2(acc[4], acc[5]); o.w = pk2(acc[6], acc[7]);
            *(uint4*)(ao + (size_t)(tok0 + p) * DM + lane * 8) = o;
        }
    }
}

DEV void phase_cumsum(const float* fg, const bf16_t* qkv, float* cloc, float* ctot, unsigned* kmax_u, int bid, int nb) {
    constexpr int XOR1 = 0xB1, XOR2 = 0x4E, HMIR = 0x141;
    const int tid_ = opaque_tid();
    const int wid = tid_ >> 6, lane = tid_ & 63;
    for (int task = bid * 8 + wid; task < 1024; task += nb * 8) {
        const int bh = task >> 3, chunk = task & 7, b = bh >> 4, h = bh & 15;
        const size_t tokb = (size_t)b * SEQ + chunk * 512;
        float xv[8];
#pragma unroll
        for (int st = 0; st < 8; ++st) xv[st] = fg[(tokb + st * 64 + lane) * 16 + h];
        float kmx = 0.f;
        const unsigned char* kb_ = (const unsigned char*)(qkv + (tokb + (lane >> 3)) * 3072 + 1024 + h * 64) + (lane & 7) * 16;
#pragma unroll 1
        for (int g0 = 0; g0 < 64; g0 += 8) {
            uint4 w[8];
#pragma unroll
            for (int j = 0; j < 8; ++j) w[j] = *(const uint4*)(kb_ + (size_t)(g0 + j) * 8 * 3072 * 2);
#pragma unroll
            for (int j = 0; j < 8; ++j) {
                float ss = bflo(w[j].x) * bflo(w[j].x) + bfhi(w[j].x) * bfhi(w[j].x) + bflo(w[j].y) * bflo(w[j].y) + bfhi(w[j].y) * bfhi(w[j].y)
                         + bflo(w[j].z) * bflo(w[j].z) + bfhi(w[j].z) * bfhi(w[j].z) + bflo(w[j].w) * bflo(w[j].w) + bfhi(w[j].w) * bfhi(w[j].w);
                ss += dppf<XOR1>(ss); ss += dppf<XOR2>(ss); ss += dppf<HMIR>(ss);
                kmx = fmaxf(kmx, ss);
            }
        }
        float carry = 0.f;
#pragma unroll
        for (int st = 0; st < 8; ++st) {
            float v = fminf(xv[st], 0.f) - log1pf(expf(-fabsf(xv[st])));
#pragma unroll
            for (int o = 1; o < 64; o <<= 1) { const float u = __shfl_up(v, o); if (lane >= o) v += u; }
            v += carry;
            cloc[(size_t)bh * SEQ + chunk * 512 + st * 64 + lane] = v;
            carry = __shfl(v, 63);
        }
        kmx = wave_max(kmx);
        if (lane == 0) { ctot[bh * 8 + chunk] = carry; atomicMax(kmax_u + bh, __float_as_uint(sqrtf(kmx) * 1.0001f)); }
    }
}

DEV void phase_fox_naive(const bf16_t* qkv, const float* carr, bf16_t* ao, float* lds, int bid, int nb) {
    const int t = threadIdx.x;
    float* Ks = lds;
    float* Vs = lds + 4096;
    float* cks = lds + 8192;
    for (int unit = bid; unit < 1024; unit += nb) {
        const int qblk = 7 - unit / 128, bh = unit % 128, b = bh >> 4, h = bh & 15;
        const int qpos = qblk * 512 + t;
        const size_t tok = (size_t)b * SEQ + qpos;
        float q[64], o[64];
        { const uint4* qp = (const uint4*)(qkv + tok * 3072 + h * 64);
#pragma unroll
          for (int i = 0; i < 8; ++i) { const uint4 w = qp[i];
              q[i * 8 + 0] = bflo(w.x) * 0.125f; q[i * 8 + 1] = bfhi(w.x) * 0.125f; q[i * 8 + 2] = bflo(w.y) * 0.125f; q[i * 8 + 3] = bfhi(w.y) * 0.125f;
              q[i * 8 + 4] = bflo(w.z) * 0.125f; q[i * 8 + 5] = bfhi(w.z) * 0.125f; q[i * 8 + 6] = bflo(w.w) * 0.125f; q[i * 8 + 7] = bfhi(w.w) * 0.125f; } }
#pragma unroll
        for (int d = 0; d < 64; ++d) o[d] = 0.f;
        const float cq = carr[(size_t)bh * SEQ + qpos];
        float m = -INFINITY, l = 0.f;
        const int nkt = (qblk + 1) * 8;
        for (int kt = 0; kt < nkt; ++kt) {
            __syncthreads();
            {
                const int e = t * 8, j = e >> 6, d0 = e & 63;
                const size_t base = ((size_t)b * SEQ + kt * 64 + j) * 3072 + h * 64 + d0;
                const uint4 kw = *(const uint4*)(qkv + base + 1024), vw = *(const uint4*)(qkv + base + 2048);
                float* kd = Ks + j * 64 + d0; float* vd = Vs + j * 64 + d0;
                kd[0] = bflo(kw.x); kd[1] = bfhi(kw.x); kd[2] = bflo(kw.y); kd[3] = bfhi(kw.y); kd[4] = bflo(kw.z); kd[5] = bfhi(kw.z); kd[6] = bflo(kw.w); kd[7] = bfhi(kw.w);
                vd[0] = bflo(vw.x); vd[1] = bfhi(vw.x); vd[2] = bflo(vw.y); vd[3] = bfhi(vw.y); vd[4] = bflo(vw.z); vd[5] = bfhi(vw.z); vd[6] = bflo(vw.w); vd[7] = bfhi(vw.w);
                if (t < 64) cks[t] = carr[(size_t)bh * SEQ + kt * 64 + t];
            }
            __syncthreads();
            for (int j = 0; j < 64; ++j) {
                const int key = kt * 64 + j;
                if (key <= qpos) {
                    const float4* kr = (const float4*)(Ks + j * 64);
                    float s = 0.f;
#pragma unroll
                    for (int d4 = 0; d4 < 16; ++d4) { const float4 kk = kr[d4]; s += q[d4 * 4] * kk.x + q[d4 * 4 + 1] * kk.y + q[d4 * 4 + 2] * kk.z + q[d4 * 4 + 3] * kk.w; }
                    s += cq - cks[j];
                    if (s > m) { const float f = __expf(m - s); l *= f;
#pragma unroll
                        for (int d = 0; d < 64; ++d) o[d] *= f;
                        m = s; }
                    const float p = __expf(s - m);
                    l += p;
                    const float4* vr = (const float4*)(Vs + j * 64);
#pragma unroll
                    for (int d4 = 0; d4 < 16; ++d4) { const float4 vv = vr[d4]; o[d4 * 4] += p * vv.x; o[d4 * 4 + 1] += p * vv.y; o[d4 * 4 + 2] += p * vv.z; o[d4 * 4 + 3] += p * vv.w; }
                }
            }
        }
        const float inv = 1.0f / l;
        uint4* op = (uint4*)(ao + tok * DM + h * 64);
#pragma unroll
        for (int i = 0; i < 8; ++i) { uint4 w; w.x = pk2(o[i * 8] * inv, o[i * 8 + 1] * inv); w.y = pk2(o[i * 8 + 2] * inv, o[i * 8 + 3] * inv);
            w.z = pk2(o[i * 8 + 4] * inv, o[i * 8 + 5] * inv); w.w = pk2(o[i * 8 + 6] * inv, o[i * 8 + 7] * inv); op[i] = w; }
    }
}

DEV void wave_argmax(float& bv, int& bi) {
#pragma unroll
    for (int o = 32; o >= 1; o >>= 1) {
        const float ov = __shfl_xor(bv, o); const int oi = __shfl_xor(bi, o);
        if (ov > bv || (ov == bv && oi < bi)) { bv = ov; bi = oi; }
    }
}
DEV void phase_topk_naive(const bf16_t* pq, const bf16_t* sk, int* idx_out, float* gate_out, float* lds, int bid, int nb) {
    const int wid = threadIdx.x >> 6, lane = threadIdx.x & 63;
    float* wq = lds + wid * 320;
    float* wts = wq + 256;
    int* wti = (int*)(wq + 288);
    for (int task = bid * 8 + wid; task < NT * 8; task += nb * 8) {
        const int tok = task >> 3, h = task & 7;
        lds_fence();
        { const uint2 r = *(const uint2*)(pq + (size_t)tok * 2048 + h * 256 + lane * 4);
          wq[lane * 4 + 0] = bflo(r.x); wq[lane * 4 + 1] = bfhi(r.x); wq[lane * 4 + 2] = bflo(r.y); wq[lane * 4 + 3] = bfhi(r.y); }
        lds_fence();
#pragma unroll 1
        for (int c = 0; c < 2; ++c) {
            float v0, v1;
            const float* qq = wq + c * 128;
            {
                const uint4* row = (const uint4*)(sk + ((size_t)(h * 2 + c) * 128 + lane) * 128);
                float s = 0.f;
#pragma unroll
                for (int i = 0; i < 16; ++i) { const uint4 w = row[i];
                    s += qq[i * 8] * bflo(w.x) + qq[i * 8 + 1] * bfhi(w.x) + qq[i * 8 + 2] * bflo(w.y) + qq[i * 8 + 3] * bfhi(w.y)
                       + qq[i * 8 + 4] * bflo(w.z) + qq[i * 8 + 5] * bfhi(w.z) + qq[i * 8 + 6] * bflo(w.w) + qq[i * 8 + 7] * bfhi(w.w); }
                v0 = s;
            }
            asm volatile("" : "+v"(v0) :: "memory");
            {
                const uint4* row = (const uint4*)(sk + ((size_t)(h * 2 + c) * 128 + lane + 64) * 128);
                float s = 0.f;
#pragma unroll
                for (int i = 0; i < 16; ++i) { const uint4 w = row[i];
                    s += qq[i * 8] * bflo(w.x) + qq[i * 8 + 1] * bfhi(w.x) + qq[i * 8 + 2] * bflo(w.y) + qq[i * 8 + 3] * bfhi(w.y)
                       + qq[i * 8 + 4] * bflo(w.z) + qq[i * 8 + 5] * bfhi(w.z) + qq[i * 8 + 6] * bflo(w.w) + qq[i * 8 + 7] * bfhi(w.w); }
                v1 = s;
            }
            asm volatile("" : "+v"(v1) :: "memory");
            float ts = 0.f; int ti = 0;
            for (int r = 0; r < 16; ++r) {
                float bv; int bi;
                if (v1 > v0) { bv = v1; bi = lane + 64; } else { bv = v0; bi = lane; }
                wave_argmax(bv, bi);
                if (lane == r) { ts = bv; ti = bi; }
                if (bi == lane) v0 = -INFINITY;
                if (bi == lane + 64) v1 = -INFINITY;
            }
            if (lane < 16) { wts[c * 16 + lane] = ts; wti[c * 16 + lane] = ti; }
        }
        lds_fence();
        float cs[4];
#pragma unroll
        for (int jj = 0; jj < 4; ++jj) { const int j = lane * 4 + jj; cs[jj] = wts[j >> 4] + wts[16 + (j & 15)]; }
        float bs = 0.f; int be = 0;
        for (int r = 0; r < 16; ++r) {
            float bv = cs[0]; int bi = lane * 4;
#pragma unroll
            for (int jj = 1; jj < 4; ++jj) if (cs[jj] > bv) { bv = cs[jj]; bi = lane * 4 + jj; }
            wave_argmax(bv, bi);
            if (lane == r) { bs = bv; be = wti[bi >> 4] * 128 + wti[16 + (bi & 15)]; }
#pragma unroll
            for (int jj = 0; jj < 4; ++jj) if (bi == lane * 4 + jj) cs[jj] = -INFINITY;
        }
        float mv = lane < 16 ? bs : -INFINITY;
        mv = wave_max(mv);
        float e = lane < 16 ? __expf(bs - mv) : 0.f;
        const float sum = wave_sum(e);
        if (lane < 16) { idx_out[(size_t)tok * 128 + h * 16 + lane] = be; gate_out[(size_t)tok * 128 + h * 16 + lane] = e / sum; }
    }
}

struct PairTab { int a[50], b[50]; };
constexpr PairTab make_pairs() { PairTab t{}; int n = 0; for (int a = 0; a < 16; ++a) for (int b = 0; b < 16; ++b) if ((a + 1) * (b + 1) <= 16) { t.a[n] = a; t.b[n] = b; ++n; } return t; }
constexpr PairTab PAIRS = make_pairs();
#define MX3(a, b, c) __builtin_fmaxf(__builtin_fmaxf((a), (b)), (c))
DEV unsigned xhalf_or(unsigned v) { auto rr = __builtin_amdgcn_permlane32_swap(v, v, false, false); return rr[0] | rr[1]; }
template <int J, int N, class T> DEV void bstage(T& v, const int k) {
#pragma clang loop unroll(full)
    for (int i = 0; i < N; ++i) { const int l = i ^ J; if (l > i) { const bool d = ((i & k) == 0); const float hi_ = fmaxf(v[i], v[l]), lo_ = fminf(v[i], v[l]); v[i] = d ? hi_ : lo_; v[l] = d ? lo_ : hi_; } }
}
template <int N, class T> DEV void bmerge_desc(T& v) {
    if constexpr (N >= 32) bstage<16, N>(v, N);
    if constexpr (N >= 16) bstage<8, N>(v, N);
    bstage<4, N>(v, N); bstage<2, N>(v, N); bstage<1, N>(v, N);
}
template <int N, class T> DEV void bsort_desc(T& v) {
    bstage<1, N>(v, 2);
    bstage<2, N>(v, 4); bstage<1, N>(v, 4);
    bstage<4, N>(v, 8); bstage<2, N>(v, 8); bstage<1, N>(v, 8);
    bstage<8, N>(v, 16); bstage<4, N>(v, 16); bstage<2, N>(v, 16); bstage<1, N>(v, 16);
    if constexpr (N >= 32) { bstage<16, N>(v, 32); bstage<8, N>(v, 32); bstage<4, N>(v, 32); bstage<2, N>(v, 32); bstage<1, N>(v, 32); }
}
template <class T> DEV void sort16_desc(T& v) {
#define CE16(i, j) do { const float hi_ = fmaxf(v[i], v[j]), lo_ = fminf(v[i], v[j]); v[i] = hi_; v[j] = lo_; } while (0)
    CE16(0, 13); CE16(1, 12); CE16(2, 15); CE16(3, 14); CE16(4, 8); CE16(5, 6); CE16(7, 11); CE16(9, 10);
    CE16(0, 5); CE16(1, 7); CE16(2, 9); CE16(3, 4); CE16(6, 13); CE16(8, 14); CE16(10, 15); CE16(11, 12);
    CE16(0, 1); CE16(2, 3); CE16(4, 5); CE16(6, 8); CE16(7, 9); CE16(10, 11); CE16(12, 13); CE16(14, 15);
    CE16(0, 2); CE16(1, 3); CE16(4, 10); CE16(5, 11); CE16(6, 7); CE16(8, 9); CE16(12, 14); CE16(13, 15);
    CE16(1, 2); CE16(3, 12); CE16(4, 6); CE16(5, 7); CE16(8, 10); CE16(9, 11); CE16(13, 14);
    CE16(1, 4); CE16(2, 6); CE16(5, 8); CE16(7, 10); CE16(9, 13); CE16(11, 14);
    CE16(2, 4); CE16(3, 6); CE16(9, 12); CE16(11, 13);
    CE16(3, 5); CE16(6, 8); CE16(7, 9); CE16(10, 12);
    CE16(3, 4); CE16(5, 6); CE16(7, 8); CE16(9, 10); CE16(11, 12);
    CE16(6, 7); CE16(8, 9);
#undef CE16
}
template <class T> DEV void merge_top16(T& a, const T& b) {
#pragma unroll
    for (int i = 0; i < 16; ++i) a[i] = fmaxf(a[i], b[15 - i]);
    bmerge_desc<16>(a);
}
DEV float xhalf_other(float v, int hi) { auto rr = __builtin_amdgcn_permlane32_swap(__float_as_uint(v), __float_as_uint(v), false, false); return __uint_as_float(hi ? rr[0] : rr[1]); }
DEV void phase_topk_mfma(const bf16_t* pq, const bf16_t* skl, const float* uinv, const float* vinv, int* idx_out, float* gate_out, float* usc_out, unsigned char* lds_raw, int bid, int nb) {
    int tid = threadIdx.x; asm volatile("" : "+v"(tid));
    const int wid = tid >> 6, lane = tid & 63, l31 = lane & 31, hi = lane >> 5;
    ldsc_t lds = (ldsc_t)lds_raw;
    int cur_h = -1;
    bf16x8 qf[8];
#define TK_QLOAD(u_, c_) do { const bf16_t* qp_ = pq + (size_t)(((u_) >> 3) * 256 + wid * 32 + l31) * 2048 + ((u_) & 7) * 256 + (c_) * 128 + hi * 8; \
        _Pragma("unroll") for (int ks = 0; ks < 8; ++ks) qf[ks] = *(const bf16x8*)(qp_ + ks * 16); } while (0)
    if (bid < 1024) TK_QLOAD(bid, 0);
    for (int u = bid; u < 1024; u += nb) {
        const int h = u & 7, tg = u >> 3;
        if (h != cur_h) {
            __syncthreads();
#pragma unroll
            for (int i = 0; i < 8; ++i) { const int id = tid + NTHR * i, crow_ = id >> 4, ch = id & 15;
                const uint4 v = *(const uint4*)(skl + ((size_t)h * 256 + crow_) * 128 + ch * 8);
                *(uint4*)(lds_raw + crow_ * 256 + ((ch ^ (crow_ & 15)) * 16)) = v; }
            __syncthreads();
            cur_h = h;
        }
        const int tok = tg * 256 + wid * 32 + l31;
        const bf16_t* qp = pq + (size_t)tok * 2048 + h * 256;
        __attribute__((address_space(3))) unsigned* nt = (__attribute__((address_space(3))) unsigned*)((lptr_t)lds_raw + 65536 + wid * 8320 + l31 * 260);
#pragma unroll
        for (int c = 0; c < 2; ++c) {
            f32x16 acc[4];
#pragma unroll
            for (int kb = 0; kb < 4; ++kb)
#pragma unroll
                for (int r = 0; r < 16; ++r) acc[kb][r] = 0.f;
            asm volatile("" : "+v"(qf[0]), "+v"(qf[1]), "+v"(qf[2]), "+v"(qf[3]), "+v"(qf[4]), "+v"(qf[5]), "+v"(qf[6]), "+v"(qf[7]));
#pragma unroll
            for (int ks = 0; ks < 8; ++ks) {
#pragma unroll
                for (int kb = 0; kb < 4; ++kb) {
                    const int row = c * 128 + 32 * kb + l31, ch = 2 * ks + hi;
                    const bf16x8 af = *(const __attribute__((address_space(3))) bf16x8*)(lds + row * 256 + ((ch ^ (l31 & 15)) * 16));
                    acc[kb] = MFMA32(af, qf[ks], acc[kb]);
                }
            }
            asm volatile("" ::: "memory");
            if (c == 0) TK_QLOAD(u, 1); else if (u + nb < 1024) TK_QLOAD(u + nb, 0);
            asm volatile("" ::: "memory");
#pragma unroll
            for (int kb = 0; kb < 4; ++kb)
#pragma unroll
                for (int r = 0; r < 16; ++r) { const unsigned n = 32u * kb + (r & 3) + 8 * (r >> 2) + 4u * hi;
                    acc[kb][r] = __uint_as_float((__float_as_uint(acc[kb][r]) & ~127u) | n); }
            sort16_desc(acc[0]); sort16_desc(acc[1]); sort16_desc(acc[2]); sort16_desc(acc[3]);
            merge_top16(acc[0], acc[1]); merge_top16(acc[2], acc[3]); merge_top16(acc[0], acc[2]);
            { float t_[16];
#pragma unroll
              for (int i = 0; i < 16; ++i) t_[i] = fmaxf(acc[0][i], xhalf_other(acc[0][15 - i], hi));
              bmerge_desc<16>(t_);
#pragma unroll
              for (int i = 0; i < 16; ++i) nt[c * 16 + i] = __float_as_uint(t_[i]); }
        }
        lds_fence();
        float cs[32];
#pragma unroll
        for (int i = 0; i < 25; ++i) {
            const int ai = PAIRS.a[2 * i] + hi * (PAIRS.a[2 * i + 1] - PAIRS.a[2 * i]), bi = PAIRS.b[2 * i] + hi * (PAIRS.b[2 * i + 1] - PAIRS.b[2 * i]);
            const float sum = __uint_as_float(nt[ai]) + __uint_as_float(nt[16 + bi]);
            cs[i] = __uint_as_float((__float_as_uint(sum) & ~255u) | (unsigned)(ai * 16 + bi));
        }
#pragma unroll
        for (int i = 25; i < 32; ++i) cs[i] = -INFINITY;
        { float* c_lo = cs; float* c_hi = cs + 16;
          sort16_desc(c_lo); sort16_desc(c_hi); merge_top16(c_lo, c_hi); }
        float bs[16];
#pragma unroll
        for (int i = 0; i < 16; ++i) bs[i] = fmaxf(cs[i], xhalf_other(cs[15 - i], hi));
        bmerge_desc<16>(bs);
        unsigned be8[8]; float bs8[8];
#pragma unroll
        for (int i = 0; i < 16; ++i) (nt + 32 + 64 * 0)[i + 0] = __float_as_uint(bs[i]);
        lds_fence();
#pragma unroll
        for (int j = 0; j < 8; ++j) { const float w_ = __uint_as_float(nt[32 + 8 * hi + j]); const unsigned tg = __float_as_uint(w_) & 255u; bs8[j] = w_;
            be8[j] = (nt[tg >> 4] & 127u) * 128u + (nt[16 + (tg & 15u)] & 127u); }
        float sum = 0.f; const float bmax = bs[0];
#pragma unroll
        for (int rd = 0; rd < 16; ++rd) sum += __builtin_amdgcn_exp2f((bs[rd] - bmax) * LOG2E);
        const float inv = 1.0f / sum;
        uint4 i0, i1; float4 g0, g1;
        i0.x = be8[0]; i0.y = be8[1]; i0.z = be8[2]; i0.w = be8[3]; i1.x = be8[4]; i1.y = be8[5]; i1.z = be8[6]; i1.w = be8[7];
        g0.x = __builtin_amdgcn_exp2f((bs8[0] - bmax) * LOG2E) * inv; g0.y = __builtin_amdgcn_exp2f((bs8[1] - bmax) * LOG2E) * inv; g0.z = __builtin_amdgcn_exp2f((bs8[2] - bmax) * LOG2E) * inv; g0.w = __builtin_amdgcn_exp2f((bs8[3] - bmax) * LOG2E) * inv;
        g1.x = __builtin_amdgcn_exp2f((bs8[4] - bmax) * LOG2E) * inv; g1.y = __builtin_amdgcn_exp2f((bs8[5] - bmax) * LOG2E) * inv; g1.z = __builtin_amdgcn_exp2f((bs8[6] - bmax) * LOG2E) * inv; g1.w = __builtin_amdgcn_exp2f((bs8[7] - bmax) * LOG2E) * inv;
        float4 s0, s1;
        s0.x = uinv[i0.x]; s0.y = uinv[i0.y]; s0.z = uinv[i0.z]; s0.w = uinv[i0.w]; s1.x = uinv[i1.x]; s1.y = uinv[i1.y]; s1.z = uinv[i1.z]; s1.w = uinv[i1.w];
        g0.x *= vinv[i0.x]; g0.y *= vinv[i0.y]; g0.z *= vinv[i0.z]; g0.w *= vinv[i0.w]; g1.x *= vinv[i1.x]; g1.y *= vinv[i1.y]; g1.z *= vinv[i1.z]; g1.w *= vinv[i1.w];
        uint4* ip = (uint4*)(idx_out + (size_t)tok * 128 + h * 16 + 8 * hi); ip[0] = i0; ip[1] = i1;
        float4* gp = (float4*)(gate_out + (size_t)tok * 128 + h * 16 + 8 * hi); gp[0] = g0; gp[1] = g1;
        float4* sp = (float4*)(usc_out + (size_t)tok * 128 + h * 16 + 8 * hi); sp[0] = s0; sp[1] = s1;
    }
}

typedef __bf16 bf16x2_t __attribute__((ext_vector_type(2)));
DEV float dot2bf(unsigned a, unsigned b, float acc) { return __builtin_amdgcn_fdot2_f32_bf16(__builtin_bit_cast(bf16x2_t, a), __builtin_bit_cast(bf16x2_t, b), acc, false); }
DEV float gelu_as(float v) {
    const float av = fabsf(v), t = __builtin_amdgcn_rcpf(av * 0.2316418882f + 1.0f);
    float q = t * 0.5307027145f + (-0.7265760135f); q = q * t + 0.7107068705f; q = q * t + (-0.142248368f); q = q * t + 0.127414796f; q = q * t;
    const float e = __builtin_amdgcn_exp2f((v * v) * (-0.72134752044f));
    const float m = v * (q * e);
    return v < 0.f ? m : v - m;
}
DEV void phase_expert_v2(const bf16_t* hn, const bf16_t* ut, const bf16_t* vt, const int* idx, const float* gate, float* xres, int bid, int nb, float oscale = 1.0f) {
    const int wid = threadIdx.x >> 6, lane = threadIdx.x & 63;
    for (int tok = bid * 8 + wid; tok < NT; tok += nb * 8) {
        const uint4 h0 = *(const uint4*)(hn + (size_t)tok * DM + lane * 8), h1 = *(const uint4*)(hn + (size_t)tok * DM + 512 + lane * 8);
        float acc[16];
#pragma unroll
        for (int i = 0; i < 16; ++i) acc[i] = 0.f;
        uint4 uA[4][2], vA[4][2], uB[4][2], vB[4][2];
#define XLOAD(U, V, k_) do { _Pragma("unroll") for (int j = 0; j < 4; ++j) { const int e_ = __builtin_amdgcn_readfirstlane(idx[(size_t)tok * 128 + (k_) + j]); \
            const bf16_t* up = ut + (size_t)e_ * DM + lane * 8; const bf16_t* vp = vt + (size_t)e_ * DM + lane * 8; \
            U[j][0] = *(const uint4*)up; U[j][1] = *(const uint4*)(up + 512); V[j][0] = *(const uint4*)vp; V[j][1] = *(const uint4*)(vp + 512); } } while (0)
#define XCOMP(U, V, k_) do { float d_[4]; \
        _Pragma("unroll") for (int j = 0; j < 4; ++j) { float d = 0.f; \
            d = dot2bf(U[j][0].x, h0.x, d); d = dot2bf(U[j][0].y, h0.y, d); d = dot2bf(U[j][0].z, h0.z, d); d = dot2bf(U[j][0].w, h0.w, d); \
            d = dot2bf(U[j][1].x, h1.x, d); d = dot2bf(U[j][1].y, h1.y, d); d = dot2bf(U[j][1].z, h1.z, d); d = dot2bf(U[j][1].w, h1.w, d); d_[j] = d; } \
        { const bool b0 = lane & 1, b1 = lane & 2; \
          float x0 = b0 ? d_[1] : d_[0], y0 = b0 ? d_[0] : d_[1], x1 = b0 ? d_[3] : d_[2], y1 = b0 ? d_[2] : d_[3]; \
          x0 += __shfl_xor(y0, 1); x1 += __shfl_xor(y1, 1);                   \
          float x = b1 ? x1 : x0, y = b1 ? x0 : x1; x += __shfl_xor(y, 2);      \
          x += __shfl_xor(x, 4); x += __shfl_xor(x, 8); x += __shfl_xor(x, 16); x += __shfl_xor(x, 32); \
          const float wl = gelu_as(x) * gate[(size_t)tok * 128 + (k_) + (lane & 3)]; \
          _Pragma("unroll") for (int j = 0; j < 4; ++j) { const float w = __uint_as_float(__builtin_amdgcn_readlane(__float_as_uint(wl), j)); \
              acc[0] += w * bflo(V[j][0].x); acc[1] += w * bfhi(V[j][0].x); acc[2] += w * bflo(V[j][0].y); acc[3] += w * bfhi(V[j][0].y); \
              acc[4] += w * bflo(V[j][0].z); acc[5] += w * bfhi(V[j][0].z); acc[6] += w * bflo(V[j][0].w); acc[7] += w * bfhi(V[j][0].w); \
              acc[8] += w * bflo(V[j][1].x); acc[9] += w * bfhi(V[j][1].x); acc[10] += w * bflo(V[j][1].y); acc[11] += w * bfhi(V[j][1].y); \
              acc[12] += w * bflo(V[j][1].z); acc[13] += w * bfhi(V[j][1].z); acc[14] += w * bflo(V[j][1].w); acc[15] += w * bfhi(V[j][1].w); } } } while (0)
        XLOAD(uA, vA, 0);
#pragma unroll 1
        for (int k0 = 0; k0 < 128; k0 += 8) {
            XLOAD(uB, vB, k0 + 4);
            XCOMP(uA, vA, k0);
            if (k0 + 8 < 128) XLOAD(uA, vA, k0 + 8);
            XCOMP(uB, vB, k0 + 4);
        }
#undef XLOAD
#undef XCOMP
        float4* p0 = (float4*)(xres + (size_t)tok * DM + lane * 8); float4* p1 = (float4*)(xres + (size_t)tok * DM + 512 + lane * 8);
        float4 a = p0[0], b = p0[1], c = p1[0], d = p1[1];
        a.x += oscale * acc[0]; a.y += oscale * acc[1]; a.z += oscale * acc[2]; a.w += oscale * acc[3]; b.x += oscale * acc[4]; b.y += oscale * acc[5]; b.z += oscale * acc[6]; b.w += oscale * acc[7];
        c.x += oscale * acc[8]; c.y += oscale * acc[9]; c.z += oscale * acc[10]; c.w += oscale * acc[11]; d.x += oscale * acc[12]; d.y += oscale * acc[13]; d.z += oscale * acc[14]; d.w += oscale * acc[15];
        p0[0] = a; p0[1] = b; p1[0] = c; p1[1] = d;
    }
}

typedef float f32x2_t __attribute__((ext_vector_type(2)));
#define FP8LO(w) __builtin_amdgcn_cvt_pk_f32_fp8((int)(w), false)
#define FP8HI(w) __builtin_amdgcn_cvt_pk_f32_fp8((int)(w), true)
DEV float dot16_fp8(const uint4 u, const float (&h)[16]) {
    float d = 0.f; f32x2_t a;
    a = FP8LO(u.x); d += a[0] * h[0] + a[1] * h[1]; a = FP8HI(u.x); d += a[0] * h[2] + a[1] * h[3];
    a = FP8LO(u.y); d += a[0] * h[4] + a[1] * h[5]; a = FP8HI(u.y); d += a[0] * h[6] + a[1] * h[7];
    a = FP8LO(u.z); d += a[0] * h[8] + a[1] * h[9]; a = FP8HI(u.z); d += a[0] * h[10] + a[1] * h[11];
    a = FP8LO(u.w); d += a[0] * h[12] + a[1] * h[13]; a = FP8HI(u.w); d += a[0] * h[14] + a[1] * h[15];
    return d;
}
#define PIN4(u) asm volatile("" : "+v"((u).x), "+v"((u).y), "+v"((u).z), "+v"((u).w))
DEV void fma16_fp8(const uint4 v, const float w, float (&acc)[16]) {
    f32x2_t a;
    a = FP8LO(v.x); acc[0] += w * a[0]; acc[1] += w * a[1]; a = FP8HI(v.x); acc[2] += w * a[0]; acc[3] += w * a[1];
    a = FP8LO(v.y); acc[4] += w * a[0]; acc[5] += w * a[1]; a = FP8HI(v.y); acc[6] += w * a[0]; acc[7] += w * a[1];
    a = FP8LO(v.z); acc[8] += w * a[0]; acc[9] += w * a[1]; a = FP8HI(v.z); acc[10] += w * a[0]; acc[11] += w * a[1];
    a = FP8LO(v.w); acc[12] += w * a[0]; acc[13] += w * a[1]; a = FP8HI(v.w); acc[14] += w * a[0]; acc[15] += w * a[1];
}
DEV float x1632_sum(float x) {
    auto s = __builtin_amdgcn_permlane16_swap(__float_as_uint(x), __float_as_uint(x), false, false);
    x = __uint_as_float(s[0]) + __uint_as_float(s[1]);
    auto t = __builtin_amdgcn_permlane32_swap(__float_as_uint(x), __float_as_uint(x), false, false);
    return __uint_as_float(t[0]) + __uint_as_float(t[1]);
}
DEV void phase_expert_v3(const bf16_t* hn, const unsigned char* ut, const unsigned char* vt, const int* idx, const float* gate, const float* usc, float* xres, int bid, int nb, float oscale = 1.0f) {
    constexpr int XOR1 = 0xB1, XOR2 = 0x4E, ROR4 = 0x124, ROR8 = 0x128;
    int tid = threadIdx.x; asm volatile("" : "+v"(tid));
    const unsigned wid = tid >> 6, lane = tid & 63;
    const bool b0 = lane & 1, b1 = lane & 2, b2 = lane & 4;
    for (unsigned tok = bid * 8 + wid; tok < (unsigned)NT; tok += nb * 8) {
        float hf[16], acc[16];
        { const uint4* hp = (const uint4*)((const char*)hn + (tok * 2048u + lane * 32u)); const uint4 h0 = hp[0], h1 = hp[1];
          hf[0] = bflo(h0.x); hf[1] = bfhi(h0.x); hf[2] = bflo(h0.y); hf[3] = bfhi(h0.y); hf[4] = bflo(h0.z); hf[5] = bfhi(h0.z); hf[6] = bflo(h0.w); hf[7] = bfhi(h0.w);
          hf[8] = bflo(h1.x); hf[9] = bfhi(h1.x); hf[10] = bflo(h1.y); hf[11] = bfhi(h1.y); hf[12] = bflo(h1.z); hf[13] = bfhi(h1.z); hf[14] = bflo(h1.w); hf[15] = bfhi(h1.w); }
#pragma unroll
        for (int i = 0; i < 16; ++i) acc[i] = 0.f;
        const unsigned pbase = tok * 128u;
        uint4 uA[4], vA[4], uB[4], vB[4];
#define XLOAD(U, V, k_) do { _Pragma("unroll") for (int j = 0; j < 4; ++j) { const unsigned eo_ = (unsigned)idx[pbase + (k_) + j] * 1024u + lane * 16u; U[j] = *(const uint4*)(ut + eo_); V[j] = *(const uint4*)(vt + eo_); } } while (0)
#define XCOMP(U, V, k_) do { float d_[4]; \
        _Pragma("unroll") for (int j = 0; j < 4; ++j) d_[j] = dot16_fp8(U[j], hf); \
        const float x0_ = (b0 ? d_[1] : d_[0]) + dppf<XOR1>(b0 ? d_[0] : d_[1]), x1_ = (b0 ? d_[3] : d_[2]) + dppf<XOR1>(b0 ? d_[2] : d_[3]); \
        float x = (b1 ? x1_ : x0_) + dppf<XOR2>(b1 ? x0_ : x1_);            \
        x += dppf<ROR4>(x); x += dppf<ROR8>(x); x = x1632_sum(x); \
        const unsigned o_ = pbase + (k_) + (lane & 3u); \
        const float wl = gelu_as(x * usc[o_]) * gate[o_]; \
        _Pragma("unroll") for (int j = 0; j < 4; ++j) { const float w = __uint_as_float(__builtin_amdgcn_readlane(__float_as_uint(wl), j)); fma16_fp8(V[j], w, acc); } } while (0)
        XLOAD(uA, vA, 0);
#pragma unroll 1
        for (int k0 = 0; k0 < 128; k0 += 8) {
            XLOAD(uB, vB, k0 + 4);
            XCOMP(uA, vA, k0);
            if (k0 + 8 < 128) XLOAD(uA, vA, k0 + 8);
            XCOMP(uB, vB, k0 + 4);
        }
#undef XLOAD
#undef XCOMP
        float4* p0 = (float4*)((char*)xres + (tok * 4096u + lane * 64u));
        float4 a = p0[0], b = p0[1], c = p0[2], d = p0[3];
        a.x += oscale * acc[0]; a.y += oscale * acc[1]; a.z += oscale * acc[2]; a.w += oscale * acc[3]; b.x += oscale * acc[4]; b.y += oscale * acc[5]; b.z += oscale * acc[6]; b.w += oscale * acc[7];
        c.x += oscale * acc[8]; c.y += oscale * acc[9]; c.z += oscale * acc[10]; c.w += oscale * acc[11]; d.x += oscale * acc[12]; d.y += oscale * acc[13]; d.z += oscale * acc[14]; d.w += oscale * acc[15];
        p0[0] = a; p0[1] = b; p0[2] = c; p0[3] = d;
    }
}

constexpr int PEER_UNIT_TOK = 1024, PEER_UNITS = NT / PEER_UNIT_TOK, PEER_WTOK = PEER_UNIT_TOK / 8, PEER_NIT = PEER_WTOK / 2;
constexpr size_t WS_QCTR = 16384;
constexpr size_t WS_CTL_BYTES = 16384 + 32 * 256;
DEV unsigned peer_next_unit(unsigned* q, volatile unsigned* sh) { return queue_next(q, sh); }
typedef float f32x2p __attribute__((ext_vector_type(2)));
DEV float dot16_fp8_pk(const uint4 u, const f32x2p (&h)[8]) {
    f32x2p d = __builtin_amdgcn_cvt_pk_f32_fp8((int)u.x, false) * h[0];
    d = __builtin_elementwise_fma(__builtin_amdgcn_cvt_pk_f32_fp8((int)u.x, true), h[1], d);
    d = __builtin_elementwise_fma(__builtin_amdgcn_cvt_pk_f32_fp8((int)u.y, false), h[2], d);
    d = __builtin_elementwise_fma(__builtin_amdgcn_cvt_pk_f32_fp8((int)u.y, true), h[3], d);
    d = __builtin_elementwise_fma(__builtin_amdgcn_cvt_pk_f32_fp8((int)u.z, false), h[4], d);
    d = __builtin_elementwise_fma(__builtin_amdgcn_cvt_pk_f32_fp8((int)u.z, true), h[5], d);
    d = __builtin_elementwise_fma(__builtin_amdgcn_cvt_pk_f32_fp8((int)u.w, false), h[6], d);
    d = __builtin_elementwise_fma(__builtin_amdgcn_cvt_pk_f32_fp8((int)u.w, true), h[7], d);
    return d[0] + d[1];
}
DEV void fma16_fp8_pk(const uint4 v, const float w, f32x2p (&acc)[8]) {
    const f32x2p wv = {w, w};
    acc[0] = __builtin_elementwise_fma(__builtin_amdgcn_cvt_pk_f32_fp8((int)v.x, false), wv, acc[0]);
    acc[1] = __builtin_elementwise_fma(__builtin_amdgcn_cvt_pk_f32_fp8((int)v.x, true), wv, acc[1]);
    acc[2] = __builtin_elementwise_fma(__builtin_amdgcn_cvt_pk_f32_fp8((int)v.y, false), wv, acc[2]);
    acc[3] = __builtin_elementwise_fma(__builtin_amdgcn_cvt_pk_f32_fp8((int)v.y, true), wv, acc[3]);
    acc[4] = __builtin_elementwise_fma(__builtin_amdgcn_cvt_pk_f32_fp8((int)v.z, false), wv, acc[4]);
    acc[5] = __builtin_elementwise_fma(__builtin_amdgcn_cvt_pk_f32_fp8((int)v.z, true), wv, acc[5]);
    acc[6] = __builtin_elementwise_fma(__builtin_amdgcn_cvt_pk_f32_fp8((int)v.w, false), wv, acc[6]);
    acc[7] = __builtin_elementwise_fma(__builtin_amdgcn_cvt_pk_f32_fp8((int)v.w, true), wv, acc[7]);
}
DEV void phase_peer_dots(const bf16_t* hn, const unsigned char* u8s, const int* idx, float* partial, unsigned* qctr, unsigned char* lds_raw, unsigned xcc) {
    constexpr int XOR1 = 0xB1, XOR2 = 0x4E, HMIR = 0x141;
    int tid = threadIdx.x; asm volatile("" : "+v"(tid));
    const unsigned wid = tid >> 6, lane = tid & 63, g = lane >> 3, sub = lane & 7;
    volatile unsigned* sh = (volatile unsigned*)(lds_raw + 256);
    for (unsigned s_ = 0; s_ < 8; ++s_) {
        const unsigned x = (xcc + s_) & 7;
        const unsigned char* ux = u8s + (size_t)x * NEXP * 128;
        const unsigned sub16 = sub * 16u;
        for (;;) {
            const unsigned unit = peer_next_unit(qctr + 64 * x, sh);
            if (unit >= (unsigned)PEER_UNITS) break;
            const unsigned tok0 = unit * PEER_UNIT_TOK + wid * PEER_WTOK;
            uint4 ixn[4]; uint4 hn0, hn1;
            { const uint4* ip = (const uint4*)((const char*)idx + (tok0 * 512u + g * 64u)); ixn[0] = ip[0]; ixn[1] = ip[1]; ixn[2] = ip[2]; ixn[3] = ip[3];
              const uint4* hp = (const uint4*)((const char*)hn + (tok0 * 2048u + x * 256u + sub * 32u)); hn0 = hp[0]; hn1 = hp[1]; }
            uint4 Ua[8], Ub[8];
#define ROWS(U, e0, e1, e2, e3, e4, e5, e6, e7) do { U[0] = *(const uint4*)(ux + ((e0) * 128u + sub16)); U[1] = *(const uint4*)(ux + ((e1) * 128u + sub16)); U[2] = *(const uint4*)(ux + ((e2) * 128u + sub16)); \
            U[3] = *(const uint4*)(ux + ((e3) * 128u + sub16)); U[4] = *(const uint4*)(ux + ((e4) * 128u + sub16)); U[5] = *(const uint4*)(ux + ((e5) * 128u + sub16)); \
            U[6] = *(const uint4*)(ux + ((e6) * 128u + sub16)); U[7] = *(const uint4*)(ux + ((e7) * 128u + sub16)); } while (0)
            ROWS(Ua, ixn[0].x, ixn[0].y, ixn[0].z, ixn[0].w, ixn[1].x, ixn[1].y, ixn[1].z, ixn[1].w);
#pragma unroll 1
            for (unsigned i = 0; i < (unsigned)PEER_WTOK; ++i) {
                const unsigned tok = tok0 + i;
                ROWS(Ub, ixn[2].x, ixn[2].y, ixn[2].z, ixn[2].w, ixn[3].x, ixn[3].y, ixn[3].z, ixn[3].w);
                f32x2p hf[8];
                hf[0] = (f32x2p){bflo(hn0.x), bfhi(hn0.x)}; hf[1] = (f32x2p){bflo(hn0.y), bfhi(hn0.y)}; hf[2] = (f32x2p){bflo(hn0.z), bfhi(hn0.z)}; hf[3] = (f32x2p){bflo(hn0.w), bfhi(hn0.w)};
                hf[4] = (f32x2p){bflo(hn1.x), bfhi(hn1.x)}; hf[5] = (f32x2p){bflo(hn1.y), bfhi(hn1.y)}; hf[6] = (f32x2p){bflo(hn1.z), bfhi(hn1.z)}; hf[7] = (f32x2p){bflo(hn1.w), bfhi(hn1.w)};
                { const unsigned tn = (i + 1 < (unsigned)PEER_WTOK) ? tok + 1 : tok;
                  const uint4* ip = (const uint4*)((const char*)idx + (tn * 512u + g * 64u)); ixn[0] = ip[0]; ixn[1] = ip[1]; ixn[2] = ip[2]; ixn[3] = ip[3];
                  const uint4* hp = (const uint4*)((const char*)hn + (tn * 2048u + x * 256u + sub * 32u)); hn0 = hp[0]; hn1 = hp[1]; }
                float sm[16];
#pragma unroll
                for (int j = 0; j < 8; ++j) { uint4 u_ = Ua[j]; PIN4(u_); float d = dot16_fp8_pk(u_, hf); asm volatile("" : "+v"(d)); d += dppf<XOR1>(d); d += dppf<XOR2>(d); d += dppf<HMIR>(d); sm[j] = d; }
                ROWS(Ua, ixn[0].x, ixn[0].y, ixn[0].z, ixn[0].w, ixn[1].x, ixn[1].y, ixn[1].z, ixn[1].w);
#pragma unroll
                for (int j = 0; j < 8; ++j) { uint4 u_ = Ub[j]; PIN4(u_); float d = dot16_fp8_pk(u_, hf); asm volatile("" : "+v"(d)); d += dppf<XOR1>(d); d += dppf<XOR2>(d); d += dppf<HMIR>(d); sm[8 + j] = d; }
                float v0 = sm[0], v1 = sm[1];
#pragma unroll
                for (int q = 1; q < 8; ++q) { v0 = (sub == (unsigned)q) ? sm[2 * q] : v0; v1 = (sub == (unsigned)q) ? sm[2 * q + 1] : v1; }
                float2 o; o.x = v0; o.y = v1;
                *(float2*)(partial + ((size_t)x * NT + tok) * 128u + 2u * lane) = o;
            }
#undef ROWS
        }
    }
}
template <int CTRL> DEV int dppi(int x) { return __builtin_amdgcn_mov_dpp(x, CTRL, 0xf, 0xf, true); }
DEV void phase_peer_dots2(const unsigned char* hq, const unsigned char* u8s, const int* idx, float* partial, unsigned* qctr, unsigned char* lds_raw, unsigned xcc) {
    constexpr int XOR1 = 0xB1, XOR2 = 0x4E, HMIR = 0x141;
    constexpr unsigned CROW = 144, CHB = 8 * CROW;
    int tid = threadIdx.x; asm volatile("" : "+v"(tid));
    const unsigned wid = tid >> 6, lane = tid & 63, g = lane >> 3, sub = lane & 7;
    volatile unsigned* sh = (volatile unsigned*)(lds_raw + 256);
    unsigned char* lw = lds_raw + 1024 + wid * (4 * CHB);
    const unsigned st_off = g * CROW + sub * 4;
    const unsigned rd_off = g * CROW;
    const bool c0 = ((sub ^ (sub >> 2)) & 1u) != 0, c1 = (((sub >> 1) ^ (sub >> 2)) & 1u) != 0, c2 = (sub & 4u) != 0;
    const unsigned jmap = (c2 ? 4u : 0u) + (c1 ? 2u : 0u) + (c0 ? 1u : 0u);
    for (unsigned s_ = 0; s_ < 8; ++s_) {
        const unsigned x = (xcc + s_) & 7;
        const unsigned char* ux = u8s + (size_t)x * NEXP * 128;
        const unsigned sub16 = sub * 16u;
#define GROW(pn) (*(const uint4*)(ux + (((pn) << 7) | sub16)))
#define E1STEP(R, r) do { \
            const uint4 n0_ = *(const uint4*)(nxt + (r) * 32), n1_ = *(const uint4*)(nxt + (r) * 32 + 16); \
            const unsigned ns_[8] = {n0_.x, n0_.y, n0_.z, n0_.w, n1_.x, n1_.y, n1_.z, n1_.w}; int d_[8]; \
            _Pragma("unroll") for (int j = 0; j < 8; ++j) { uint4 v_ = R[j]; PIN4(v_); \
                d_[j] = __builtin_amdgcn_sdot4((int)v_.w, (int)hc.w, __builtin_amdgcn_sdot4((int)v_.z, (int)hc.z, __builtin_amdgcn_sdot4((int)v_.y, (int)hc.y, __builtin_amdgcn_sdot4((int)v_.x, (int)hc.x, 0, false), false), false), false); \
                unsigned o_ = (ns_[j] << 7) | sub16; \
                asm volatile("" : "+v"(d_[j]), "+v"(o_));     \
                R[j] = *(const uint4*)(ux + o_); } \
            int e_[4], f_[2]; \
            _Pragma("unroll") for (int m = 0; m < 4; ++m) e_[m] = (c0 ? d_[2 * m + 1] : d_[2 * m]) + dppi<XOR1>(c0 ? d_[2 * m] : d_[2 * m + 1]); \
            _Pragma("unroll") for (int n = 0; n < 2; ++n) f_[n] = (c1 ? e_[2 * n + 1] : e_[2 * n]) + dppi<XOR2>(c1 ? e_[2 * n] : e_[2 * n + 1]); \
            kp[r] = (c2 ? f_[1] : f_[0]) + dppi<HMIR>(c2 ? f_[0] : f_[1]); \
            asm volatile("" ::: "memory"); } while (0)
        for (;;) {
            const unsigned unit = peer_next_unit(qctr + 64 * x, sh);
            if (unit >= (unsigned)PEER_UNITS) break;
            const unsigned tok0 = unit * PEER_UNIT_TOK + wid * PEER_WTOK;
            const unsigned char* isrc = (const unsigned char*)idx + ((tok0 + g) * 512u + sub * 16u);
            const unsigned char* hsrc = hq + ((tok0 + g) * 1024u + x * 128u + sub * 16u);
            uint4 hn_ = *(const uint4*)(hsrc);
            { const uint4 p0 = *(const uint4*)(isrc), p1 = *(const uint4*)(isrc + 128);
              *(unsigned*)(lw + st_off) = p0.x; *(unsigned*)(lw + st_off + 32) = p0.y; *(unsigned*)(lw + st_off + 64) = p0.z; *(unsigned*)(lw + st_off + 96) = p0.w;
              *(unsigned*)(lw + CHB + st_off) = p1.x; *(unsigned*)(lw + CHB + st_off + 32) = p1.y; *(unsigned*)(lw + CHB + st_off + 64) = p1.z; *(unsigned*)(lw + CHB + st_off + 96) = p1.w; }
            uint4 R0[8], R1[8], R2[8], R3[8];
            { const unsigned char* cur = lw + rd_off;
#define E1FILL(R, r) do { const uint4 n0_ = *(const uint4*)(cur + (r) * 32), n1_ = *(const uint4*)(cur + (r) * 32 + 16); \
                R[0] = GROW(n0_.x); R[1] = GROW(n0_.y); R[2] = GROW(n0_.z); R[3] = GROW(n0_.w); R[4] = GROW(n1_.x); R[5] = GROW(n1_.y); R[6] = GROW(n1_.z); R[7] = GROW(n1_.w); } while (0)
              E1FILL(R0, 0); E1FILL(R1, 1); E1FILL(R2, 2); E1FILL(R3, 3); }
#undef E1FILL
            uint4 hc = hn_;
#pragma unroll 1
            for (unsigned it = 0; it < (unsigned)PEER_NIT; ++it) {
                const unsigned char* nxt = lw + ((it + 1) & 3) * CHB + rd_off;
                const unsigned ns = (it + 2 < (unsigned)PEER_NIT) ? it + 2 : PEER_NIT - 1;
                const uint4 pst = *(const uint4*)(isrc + (ns >> 2) * 4096u + (ns & 3) * 128u);
                if ((it & 3) == 1) { const unsigned bn = (it < (unsigned)PEER_NIT - 4) ? (it >> 2) + 1 : PEER_NIT / 4 - 1; hn_ = *(const uint4*)(hsrc + bn * 8192u); }
                int kp[4];
                E1STEP(R0, 0); E1STEP(R1, 1); E1STEP(R2, 2); E1STEP(R3, 3);
                { unsigned char* dst = lw + ((it + 2) & 3) * CHB + st_off;
                  *(unsigned*)(dst) = pst.x; *(unsigned*)(dst + 32) = pst.y; *(unsigned*)(dst + 64) = pst.z; *(unsigned*)(dst + 96) = pst.w; }
                *(float4*)(partial + ((size_t)x * NT + tok0 + (it >> 2) * 8 + g) * 128u + (it & 3) * 32u + 4u * jmap) = make_float4((float)kp[0], (float)kp[1], (float)kp[2], (float)kp[3]);
                if ((it & 3) == 3) hc = hn_;
            }
        }
#undef E1STEP
#undef GROW
    }
}
template <int MODE>
DEV void phase_peer_fused(const unsigned char* hq, const float* hs, const unsigned char* u8s, const unsigned char* v8s, const int* idx, const float* gate, const float* usc,
                          float* xres, bf16_t* pdelta, const float* gnext, bf16_t* hn_out, float* wts_g, unsigned* offs_g, unsigned char* lds_raw, int bid, int nb) {
    constexpr bool FINAL = MODE == 1;
    constexpr int XOR1 = 0xB1, XOR2 = 0x4E, HMIR = 0x141;
    constexpr unsigned CROW = 144, CHB = 8 * CROW;
    int tid0 = threadIdx.x;
#define EF_LANE() int tid = tid0; asm volatile("" : "+v"(tid));     \
    const unsigned wid = tid >> 6, lane = tid & 63, g = lane >> 3, sub = lane & 7; \
    unsigned char* lw = lds_raw + 1024 + wid * (16 * CHB);       \
    const unsigned st_off = g * CROW + sub * 4, rd_off = g * CROW, sub16 = sub * 16u; \
    const bool c0 = ((sub ^ (sub >> 2)) & 1u) != 0, c1 = (((sub >> 1) ^ (sub >> 2)) & 1u) != 0, c2 = (sub & 4u) != 0; (void)lane; (void)st_off
#define EFSTEP(R, r, NXT, BASE, ACC) do { \
        const uint4 n0_ = *(const uint4*)((NXT) + (r) * 32), n1_ = *(const uint4*)((NXT) + (r) * 32 + 16); \
        const unsigned ns_[8] = {n0_.x, n0_.y, n0_.z, n0_.w, n1_.x, n1_.y, n1_.z, n1_.w}; int e_[4], f_[2]; \
        _Pragma("unroll") for (int m = 0; m < 4; ++m) { int d_[2]; \
            _Pragma("unroll") for (int jj = 0; jj < 2; ++jj) { const int j = 2 * m + jj; uint4 v_ = R[j]; PIN4(v_); \
                d_[jj] = __builtin_amdgcn_sdot4((int)v_.w, (int)hc.w, __builtin_amdgcn_sdot4((int)v_.z, (int)hc.z, __builtin_amdgcn_sdot4((int)v_.y, (int)hc.y, __builtin_amdgcn_sdot4((int)v_.x, (int)hc.x, 0, false), false), false), false); \
                unsigned o_ = (ns_[j] << 7) | sub16; \
                asm volatile("" : "+v"(d_[jj]), "+v"(o_));     \
                R[j] = *(const uint4*)((BASE) + o_); } \
            e_[m] = (c0 ? d_[1] : d_[0]) + dppi<XOR1>(c0 ? d_[0] : d_[1]); }        \
        _Pragma("unroll") for (int n = 0; n < 2; ++n) f_[n] = (c1 ? e_[2 * n + 1] : e_[2 * n]) + dppi<XOR2>(c1 ? e_[2 * n] : e_[2 * n + 1]); \
        ACC += (c2 ? f_[1] : f_[0]) + dppi<HMIR>(c2 ? f_[0] : f_[1]); \
        asm volatile("" ::: "memory"); } while (0)
#define EFITER(NC, BASE, A) do { const unsigned char* nx_ = lw + (NC) * CHB + rd_off; \
        EFSTEP(R0, 0, nx_, BASE, A[0]); EFSTEP(R1, 1, nx_, BASE, A[1]); EFSTEP(R2, 2, nx_, BASE, A[2]); EFSTEP(R3, 3, nx_, BASE, A[3]); } while (0)
    for (int grp = bid; grp < NT / 128; grp += nb) {
        EF_LANE();
        const unsigned tok0 = grp * 128 + wid * 16;
        { uint4 p[8];
#pragma unroll
          for (int c = 0; c < 8; ++c) p[c] = *(const uint4*)((const unsigned char*)idx + ((tok0 + 8 * (c >> 2) + g) * 512u + (c & 3) * 128u + sub * 16u));
          unsigned so_ = st_off; asm volatile("" : "+v"(so_));
          unsigned char* d = lw + so_;
#pragma unroll
          for (int c = 0; c < 8; ++c) { *(unsigned*)(d + c * CHB) = p[c].x; *(unsigned*)(d + c * CHB + 32) = p[c].y; *(unsigned*)(d + c * CHB + 64) = p[c].z; *(unsigned*)(d + c * CHB + 96) = p[c].w; } }
        const unsigned char* hsrc = hq + ((tok0 + g) * 1024u + sub * 16u);
        uint4 hc = *(const uint4*)(hsrc), hn_ = hc;
        uint4 R0[8], R1[8], R2[8], R3[8];
        { const unsigned char* cur = lw + rd_off;
#define EFFILL(R, r) do { const uint4 n0_ = *(const uint4*)(cur + (r) * 32), n1_ = *(const uint4*)(cur + (r) * 32 + 16); \
            R[0] = *(const uint4*)(u8s + ((n0_.x << 7) | sub16)); R[1] = *(const uint4*)(u8s + ((n0_.y << 7) | sub16)); R[2] = *(const uint4*)(u8s + ((n0_.z << 7) | sub16)); R[3] = *(const uint4*)(u8s + ((n0_.w << 7) | sub16)); \
            R[4] = *(const uint4*)(u8s + ((n1_.x << 7) | sub16)); R[5] = *(const uint4*)(u8s + ((n1_.y << 7) | sub16)); R[6] = *(const uint4*)(u8s + ((n1_.z << 7) | sub16)); R[7] = *(const uint4*)(u8s + ((n1_.w << 7) | sub16)); } while (0)
          EFFILL(R0, 0); EFFILL(R1, 1); EFFILL(R2, 2); EFFILL(R3, 3); }
#undef EFFILL
        int pa[8][4];
#pragma unroll
        for (int c = 0; c < 8; ++c)
#pragma unroll
            for (int r = 0; r < 4; ++r) pa[c][r] = 0;
#pragma unroll 1
        for (unsigned x = 0; x < 8; ++x) {
            const unsigned char* ux = u8s + (size_t)x * NEXP * 128;
            const unsigned xn = x < 7 ? x + 1 : 7;
            const unsigned char* un = u8s + (size_t)xn * NEXP * 128;
            hn_ = *(const uint4*)(hsrc + 8192u + x * 128u);
            EFITER(1, ux, pa[0]); EFITER(2, ux, pa[1]); EFITER(3, ux, pa[2]); EFITER(4, ux, pa[3]);
            hc = hn_;
            hn_ = *(const uint4*)(hsrc + xn * 128u);
            EFITER(5, ux, pa[4]); EFITER(6, ux, pa[5]); EFITER(7, ux, pa[6]); EFITER(0, un, pa[7]);
            hc = hn_;
        }
        const unsigned t2_ = (unsigned)opaque_tid(), g2_ = (t2_ >> 3) & 7u, s2_ = t2_ & 7u, tok2_ = (unsigned)grp * 128u + (t2_ >> 6) * 16u;
        const unsigned jm2_ = (s2_ & 4u) + ((((s2_ >> 1) ^ (s2_ >> 2)) & 1u) << 1) + ((s2_ ^ (s2_ >> 2)) & 1u);
#pragma unroll
        for (int c = 0; c < 8; ++c) {
            const unsigned tok = tok2_ + 8 * (c >> 2) + g2_; const size_t o4 = (size_t)tok * 32 + (c & 3) * 8 + jm2_;
            const float4 gt = ((const float4*)gate)[o4]; float4 us = ((const float4*)usc)[o4];
            const float hsc = hs[tok]; us.x *= hsc; us.y *= hsc; us.z *= hsc; us.w *= hsc;
            const float w0_ = gt.x * gelu_as((float)pa[c][0] * us.x), w1_ = gt.y * gelu_as((float)pa[c][1] * us.y), w2_ = gt.z * gelu_as((float)pa[c][2] * us.z), w3_ = gt.w * gelu_as((float)pa[c][3] * us.w);
            if (MODE == 2) {
                ((float4*)wts_g)[o4] = make_float4(w0_, w1_, w2_, w3_);
                const uint4 ix = ((const uint4*)idx)[o4]; uint4 of; of.x = ix.x << 7; of.y = ix.y << 7; of.z = ix.z << 7; of.w = ix.w << 7;
                ((uint4*)offs_g)[o4] = of;
            } else {
                float* wd = (float*)(lw + (8 + c) * CHB + g2_ * CROW + jm2_ * 4);
                wd[0] = w0_; wd[8] = w1_; wd[16] = w2_; wd[24] = w3_; }
        }
        if (MODE == 2) continue;
        {
#define E2FSTEP(R, r, CW, NI, BASE) do { \
            const uint4 c0_ = *(const uint4*)((CW) + (r) * 32), c1_ = *(const uint4*)((CW) + (r) * 32 + 16); \
            const uint4 n0_ = *(const uint4*)((NI) + (r) * 32), n1_ = *(const uint4*)((NI) + (r) * 32 + 16); \
            const unsigned cs_[8] = {c0_.x, c0_.y, c0_.z, c0_.w, c1_.x, c1_.y, c1_.z, c1_.w}; const unsigned ns_[8] = {n0_.x, n0_.y, n0_.z, n0_.w, n1_.x, n1_.y, n1_.z, n1_.w}; \
            _Pragma("unroll") for (int j = 0; j < 8; ++j) { uint4 v_ = R[j]; PIN4(v_); fma16_fp8_pk(v_, __uint_as_float(cs_[j]), acc); unsigned o_ = (ns_[j] << 7) | sub16; \
                asm volatile("" : "+v"(acc[0]), "+v"(acc[1]), "+v"(acc[2]), "+v"(acc[3]), "+v"(acc[4]), "+v"(acc[5]), "+v"(acc[6]), "+v"(acc[7]), "+v"(o_)); \
                R[j] = *(const uint4*)((BASE) + o_); } \
            asm volatile("" ::: "memory"); } while (0)
#define E2FITER(C, NC, BASE) do { const unsigned char* cw_ = lw + (8 + (C)) * CHB + rd_off; const unsigned char* ni_ = lw + (NC) * CHB + rd_off; \
            E2FSTEP(R0, 0, cw_, ni_, BASE); E2FSTEP(R1, 1, cw_, ni_, BASE); E2FSTEP(R2, 2, cw_, ni_, BASE); E2FSTEP(R3, 3, cw_, ni_, BASE); } while (0)
#define E2FOUT(B) do { unsigned s16_ = sub16; asm volatile("" : "+v"(s16_));     \
            uint4* p0 = (uint4*)((char*)pdelta + ((tok0 + (B) * 8 + g) * 2048u + x * 256u + s16_ * 2u)); uint4 o0, o1; \
            o0.x = pk2(acc[0][0], acc[0][1]); o0.y = pk2(acc[1][0], acc[1][1]); o0.z = pk2(acc[2][0], acc[2][1]); o0.w = pk2(acc[3][0], acc[3][1]); \
            o1.x = pk2(acc[4][0], acc[4][1]); o1.y = pk2(acc[5][0], acc[5][1]); o1.z = pk2(acc[6][0], acc[6][1]); o1.w = pk2(acc[7][0], acc[7][1]); \
            p0[0] = o0; p0[1] = o1; \
            _Pragma("unroll") for (int c = 0; c < 8; ++c) acc[c] = (f32x2p){0.f, 0.f}; } while (0)
            { const unsigned char* cur = lw + rd_off;
#define E2FFILL(R, r) do { const uint4 n0_ = *(const uint4*)(cur + (r) * 32), n1_ = *(const uint4*)(cur + (r) * 32 + 16); \
                R[0] = *(const uint4*)(v8s + ((n0_.x << 7) | sub16)); R[1] = *(const uint4*)(v8s + ((n0_.y << 7) | sub16)); R[2] = *(const uint4*)(v8s + ((n0_.z << 7) | sub16)); R[3] = *(const uint4*)(v8s + ((n0_.w << 7) | sub16)); \
                R[4] = *(const uint4*)(v8s + ((n1_.x << 7) | sub16)); R[5] = *(const uint4*)(v8s + ((n1_.y << 7) | sub16)); R[6] = *(const uint4*)(v8s + ((n1_.z << 7) | sub16)); R[7] = *(const uint4*)(v8s + ((n1_.w << 7) | sub16)); } while (0)
              E2FFILL(R0, 0); E2FFILL(R1, 1); E2FFILL(R2, 2); E2FFILL(R3, 3); }
#undef E2FFILL
            f32x2p acc[8];
#pragma unroll
            for (int c = 0; c < 8; ++c) acc[c] = (f32x2p){0.f, 0.f};
#pragma unroll 1
            for (unsigned it = 0; it < 64; ++it) {
                const unsigned c = it & 7, x = it >> 3;
                const unsigned xb = (c == 7) ? (x < 7 ? x + 1 : 7) : x;
                const unsigned char* vb_ = v8s + (size_t)xb * NEXP * 128;
                E2FITER(c, (it + 1) & 7, vb_);
                if ((it & 3) == 3) E2FOUT((it >> 2) & 1);
            }
#undef E2FOUT
#undef E2FITER
#undef E2FSTEP
        }
        asm volatile("s_waitcnt vmcnt(0)" ::: "memory");
        __builtin_amdgcn_fence(__ATOMIC_ACQUIRE, "agent");
        {
            const unsigned t3_ = (unsigned)opaque_tid(), ln_ = t3_ & 63u, row00 = (unsigned)grp * 128u + (t3_ >> 6) * 16u;
#pragma unroll 1
            for (unsigned rb = 0; rb < 16; rb += 4) {
                float4 v[4][4];
#pragma unroll
                for (int p = 0; p < 4; ++p) { const size_t row = row00 + rb + p; const float4* xr = (const float4*)(xres + row * DM); const uint2* dr = (const uint2*)(pdelta + row * DM);
#pragma unroll
                    for (int i = 0; i < 4; ++i) { v[p][i] = xr[ln_ + 64 * i]; const uint2 d = dr[ln_ + 64 * i];
                        v[p][i].x += bflo(d.x); v[p][i].y += bfhi(d.x); v[p][i].z += bflo(d.y); v[p][i].w += bfhi(d.y); } }
#pragma unroll
                for (int p = 0; p < 4; ++p) { const size_t row = row00 + rb + p;
                    float ss = 0.f;
#pragma unroll
                    for (int i = 0; i < 4; ++i) ss += v[p][i].x * v[p][i].x + v[p][i].y * v[p][i].y + v[p][i].z * v[p][i].z + v[p][i].w * v[p][i].w;
                    ss = wave_sum(ss);
                    const float rstd = 1.0f / sqrtf(ss * (1.0f / DM) + 1e-6f);
#pragma unroll
                    for (int i = 0; i < 4; ++i) { const float4 gg = ((const float4*)gnext)[ln_ + 64 * i];
                        if (FINAL) { float4 o; o.x = v[p][i].x * rstd * gg.x; o.y = v[p][i].y * rstd * gg.y; o.z = v[p][i].z * rstd * gg.z; o.w = v[p][i].w * rstd * gg.w;
                            ((float4*)(xres + row * DM))[ln_ + 64 * i] = o; }
                        else { ((float4*)(xres + row * DM))[ln_ + 64 * i] = v[p][i];
                            uint2 o; o.x = pk2(v[p][i].x * rstd * gg.x, v[p][i].y * rstd * gg.y); o.y = pk2(v[p][i].z * rstd * gg.z, v[p][i].w * rstd * gg.w);
                            ((uint2*)(hn_out + row * DM))[ln_ + 64 * i] = o; } }
                }
            }
        }
    }
#undef EFITER
#undef EFSTEP
#undef EF_LANE
}
DEV void phase_peer_weights(const float* partial, const float* gate, const float* usc, const float* hs, const int* idx, float* wts, unsigned* offs, int bid, int nb) {
    const int tid_ = opaque_tid();
    for (unsigned i = bid * NTHR + tid_; i < (unsigned)NT * 32u; i += nb * NTHR) {
        float4 sacc = ((const float4*)partial)[i];
#pragma unroll
        for (int x = 1; x < 8; ++x) { const float4 p = ((const float4*)(partial + (size_t)x * NT * 128))[i]; sacc.x += p.x; sacc.y += p.y; sacc.z += p.z; sacc.w += p.w; }
        const float4 gt = ((const float4*)gate)[i]; float4 us = ((const float4*)usc)[i];
        { const float hsc = hs[i >> 5]; us.x *= hsc; us.y *= hsc; us.z *= hsc; us.w *= hsc; }
        float4 o; o.x = gt.x * gelu_as(sacc.x * us.x); o.y = gt.y * gelu_as(sacc.y * us.y); o.z = gt.z * gelu_as(sacc.z * us.z); o.w = gt.w * gelu_as(sacc.w * us.w);
        ((float4*)wts)[i] = o;
        const uint4 ix = ((const uint4*)idx)[i];
        uint4 of; of.x = ix.x << 7; of.y = ix.y << 7; of.z = ix.z << 7; of.w = ix.w << 7;
        ((uint4*)offs)[i] = of;
    }
}
DEV void phase_peer_acc2(const unsigned char* v8s, const float* wts, const unsigned* offs, bf16_t* pdelta, unsigned* qctr, unsigned char* lds_raw, unsigned xcc) {
    constexpr unsigned CROW = 144, CHB = 8 * CROW;
    int tid = threadIdx.x; asm volatile("" : "+v"(tid));
    const unsigned wid = tid >> 6, lane = tid & 63, g = lane >> 3, sub = lane & 7;
    volatile unsigned* sh = (volatile unsigned*)(lds_raw + 256);
    unsigned char* lw = lds_raw + 1024 + wid * (8 * CHB);
    const unsigned st_off = g * CROW + sub * 16;
    const unsigned rd_off = g * CROW;
    for (unsigned s_ = 0; s_ < 8; ++s_) {
        const unsigned x = (xcc + s_) & 7;
        const unsigned char* vx = v8s + (size_t)x * NEXP * 128;
        const unsigned sub16 = sub * 16u;
#define GROW(pn) (*(const uint4*)(vx + ((pn) | sub16)))
#define E2STEP(R, r) do { \
            const uint4 c0_ = *(const uint4*)(cur + (r) * 32), c1_ = *(const uint4*)(cur + (r) * 32 + 16); \
            const uint4 n0_ = *(const uint4*)(nxt + 4 * CHB + (r) * 32), n1_ = *(const uint4*)(nxt + 4 * CHB + (r) * 32 + 16); \
            const unsigned cs_[8] = {c0_.x, c0_.y, c0_.z, c0_.w, c1_.x, c1_.y, c1_.z, c1_.w}; const unsigned ns_[8] = {n0_.x, n0_.y, n0_.z, n0_.w, n1_.x, n1_.y, n1_.z, n1_.w}; \
            _Pragma("unroll") for (int j = 0; j < 8; ++j) { uint4 v_ = R[j]; PIN4(v_); fma16_fp8_pk(v_, __uint_as_float(cs_[j]), acc); unsigned o_ = ns_[j] | sub16; \
                asm volatile("" : "+v"(acc[0]), "+v"(acc[1]), "+v"(acc[2]), "+v"(acc[3]), "+v"(acc[4]), "+v"(acc[5]), "+v"(acc[6]), "+v"(acc[7]), "+v"(o_));     \
                R[j] = *(const uint4*)(vx + o_); } \
            asm volatile("" ::: "memory"); } while (0)
        for (;;) {
            const unsigned unit = peer_next_unit(qctr + 64 * x, sh);
            if (unit >= (unsigned)PEER_UNITS) break;
            const unsigned tok0 = unit * PEER_UNIT_TOK + wid * PEER_WTOK;
            const unsigned wgo = (tok0 + g) * 512u + sub * 16u;
            const unsigned char* wsrc = (const unsigned char*)wts + wgo; const unsigned char* osrc = (const unsigned char*)offs + wgo;
            { const uint4 p0 = *(const uint4*)(wsrc), p1 = *(const uint4*)(wsrc + 128), q0 = *(const uint4*)(osrc), q1 = *(const uint4*)(osrc + 128);
              *(uint4*)(lw + st_off) = p0; *(uint4*)(lw + CHB + st_off) = p1; *(uint4*)(lw + 4 * CHB + st_off) = q0; *(uint4*)(lw + 5 * CHB + st_off) = q1; }
            uint4 R0[8], R1[8], R2[8], R3[8];
            { const unsigned char* cur = lw + 4 * CHB + rd_off;
#define E2FILL(R, r) do { const uint4 n0_ = *(const uint4*)(cur + (r) * 32), n1_ = *(const uint4*)(cur + (r) * 32 + 16); \
                R[0] = GROW(n0_.x); R[1] = GROW(n0_.y); R[2] = GROW(n0_.z); R[3] = GROW(n0_.w); R[4] = GROW(n1_.x); R[5] = GROW(n1_.y); R[6] = GROW(n1_.z); R[7] = GROW(n1_.w); } while (0)
              E2FILL(R0, 0); E2FILL(R1, 1); E2FILL(R2, 2); E2FILL(R3, 3); }
#undef E2FILL
            f32x2p acc[8];
#pragma unroll
            for (int c = 0; c < 8; ++c) acc[c] = (f32x2p){0.f, 0.f};
#pragma unroll 1
            for (unsigned it = 0; it < (unsigned)PEER_NIT; ++it) {
                const unsigned char* cur = lw + (it & 3) * CHB + rd_off;
                const unsigned char* nxt = lw + ((it + 1) & 3) * CHB + rd_off;
                const unsigned ns = (it + 2 < (unsigned)PEER_NIT) ? it + 2 : PEER_NIT - 1;
                const uint4 pst = *(const uint4*)(wsrc + (ns >> 2) * 4096u + (ns & 3) * 128u), pso = *(const uint4*)(osrc + (ns >> 2) * 4096u + (ns & 3) * 128u);
                E2STEP(R0, 0); E2STEP(R1, 1); E2STEP(R2, 2); E2STEP(R3, 3);
                *(uint4*)(lw + ((it + 2) & 3) * CHB + st_off) = pst; *(uint4*)(lw + (4 + ((it + 2) & 3)) * CHB + st_off) = pso;
                if ((it & 3) == 3) {
                    uint4* p0 = (uint4*)((char*)pdelta + ((tok0 + (it >> 2) * 8 + g) * 2048u + x * 256u + sub * 32u));
                    uint4 o0, o1;
                    o0.x = pk2(acc[0][0], acc[0][1]); o0.y = pk2(acc[1][0], acc[1][1]); o0.z = pk2(acc[2][0], acc[2][1]); o0.w = pk2(acc[3][0], acc[3][1]);
                    o1.x = pk2(acc[4][0], acc[4][1]); o1.y = pk2(acc[5][0], acc[5][1]); o1.z = pk2(acc[6][0], acc[6][1]); o1.w = pk2(acc[7][0], acc[7][1]);
                    p0[0] = o0; p0[1] = o1;
#pragma unroll
                    for (int c = 0; c < 8; ++c) acc[c] = (f32x2p){0.f, 0.f};
                }
            }
        }
#undef E2STEP
#undef GROW
    }
}
template <bool LOADONLY = false>
DEV void phase_peer_acc(const unsigned char* v8s, const int* idx, const float* wts, float* xres, unsigned* qctr, unsigned char* lds_raw, unsigned xcc, float oscale = 1.0f) {
    constexpr int ROR8 = 0x128;
    constexpr unsigned EMASK = LOADONLY ? 2047u : 0xFFFFFFFFu;
    int tid = threadIdx.x; asm volatile("" : "+v"(tid));
    const unsigned wid = tid >> 6, lane = tid & 63, g = lane >> 3, sub = lane & 7;
    volatile unsigned* sh = (volatile unsigned*)(lds_raw + 256);
    for (unsigned s_ = 0; s_ < 8; ++s_) {
        const unsigned x = (xcc + s_) & 7;
        const unsigned char* vx = v8s + (size_t)x * NEXP * 128;
        const unsigned sub16 = sub * 16u;
        for (;;) {
            const unsigned unit = peer_next_unit(qctr + 64 * x, sh);
            if (unit >= (unsigned)PEER_UNITS) break;
            const unsigned tok0 = unit * PEER_UNIT_TOK + wid * PEER_WTOK;
            uint4 ixn[4]; float4 wn[4];
            { const uint4* ip = (const uint4*)((const char*)idx + (tok0 * 512u + g * 64u)); ixn[0] = ip[0]; ixn[1] = ip[1]; ixn[2] = ip[2]; ixn[3] = ip[3];
              const float4* wp = (const float4*)((const char*)wts + (tok0 * 512u + g * 64u)); wn[0] = wp[0]; wn[1] = wp[1]; wn[2] = wp[2]; wn[3] = wp[3]; }
            uint4 Va[8], Vb[8];
#define ROWS(U, e0, e1, e2, e3, e4, e5, e6, e7) do { U[0] = *(const uint4*)(vx + ((((e0) & EMASK)) * 128u + sub16)); U[1] = *(const uint4*)(vx + ((((e1) & EMASK)) * 128u + sub16)); U[2] = *(const uint4*)(vx + ((((e2) & EMASK)) * 128u + sub16)); \
            U[3] = *(const uint4*)(vx + ((((e3) & EMASK)) * 128u + sub16)); U[4] = *(const uint4*)(vx + ((((e4) & EMASK)) * 128u + sub16)); U[5] = *(const uint4*)(vx + ((((e5) & EMASK)) * 128u + sub16)); \
            U[6] = *(const uint4*)(vx + ((((e6) & EMASK)) * 128u + sub16)); U[7] = *(const uint4*)(vx + ((((e7) & EMASK)) * 128u + sub16)); } while (0)
            ROWS(Va, ixn[0].x, ixn[0].y, ixn[0].z, ixn[0].w, ixn[1].x, ixn[1].y, ixn[1].z, ixn[1].w);
#pragma unroll 1
            for (unsigned i = 0; i < (unsigned)PEER_WTOK; ++i) {
                const unsigned tok = tok0 + i;
                ROWS(Vb, ixn[2].x, ixn[2].y, ixn[2].z, ixn[2].w, ixn[3].x, ixn[3].y, ixn[3].z, ixn[3].w);
                const float ww[16] = {wn[0].x, wn[0].y, wn[0].z, wn[0].w, wn[1].x, wn[1].y, wn[1].z, wn[1].w, wn[2].x, wn[2].y, wn[2].z, wn[2].w, wn[3].x, wn[3].y, wn[3].z, wn[3].w};
                { const unsigned tn = (i + 1 < (unsigned)PEER_WTOK) ? tok + 1 : tok;
                  const uint4* ip = (const uint4*)((const char*)idx + (tn * 512u + g * 64u)); ixn[0] = ip[0]; ixn[1] = ip[1]; ixn[2] = ip[2]; ixn[3] = ip[3];
                  const float4* wp = (const float4*)((const char*)wts + (tn * 512u + g * 64u)); wn[0] = wp[0]; wn[1] = wp[1]; wn[2] = wp[2]; wn[3] = wp[3]; }
                f32x2p acc[8];
#pragma unroll
                for (int c = 0; c < 8; ++c) acc[c] = (f32x2p){0.f, 0.f};
#pragma unroll
                for (int j = 0; j < 8; ++j) { uint4 v_ = Va[j]; PIN4(v_); if (LOADONLY) { acc[0][0] += __uint_as_float((v_.x ^ v_.y ^ v_.z ^ v_.w) & 0x007fffffu) * ww[j]; } else fma16_fp8_pk(v_, ww[j], acc); asm volatile("" : "+v"(acc[0]), "+v"(acc[7])); }
                ROWS(Va, ixn[0].x, ixn[0].y, ixn[0].z, ixn[0].w, ixn[1].x, ixn[1].y, ixn[1].z, ixn[1].w);
#pragma unroll
                for (int j = 0; j < 8; ++j) { uint4 v_ = Vb[j]; PIN4(v_); if (LOADONLY) { acc[0][0] += __uint_as_float((v_.x ^ v_.y ^ v_.z ^ v_.w) & 0x007fffffu) * ww[8 + j]; } else fma16_fp8_pk(v_, ww[8 + j], acc); asm volatile("" : "+v"(acc[0]), "+v"(acc[7])); }
                float r[16];
#pragma unroll
                for (int c = 0; c < 8; ++c) { float a0 = acc[c][0], a1 = acc[c][1]; a0 += dppf<ROR8>(a0); a1 += dppf<ROR8>(a1); r[2 * c] = x1632_sum(a0); r[2 * c + 1] = x1632_sum(a1); }
                if (g == 0) {
                    float4* p0 = (float4*)((char*)xres + (tok * 4096u + x * 512u + sub * 64u));
                    float4 a = p0[0], b = p0[1], c = p0[2], d = p0[3];
                    a.x += oscale * r[0]; a.y += oscale * r[1]; a.z += oscale * r[2]; a.w += oscale * r[3]; b.x += oscale * r[4]; b.y += oscale * r[5]; b.z += oscale * r[6]; b.w += oscale * r[7];
                    c.x += oscale * r[8]; c.y += oscale * r[9]; c.z += oscale * r[10]; c.w += oscale * r[11]; d.x += oscale * r[12]; d.y += oscale * r[13]; d.z += oscale * r[14]; d.w += oscale * r[15];
                    p0[0] = a; p0[1] = b; p0[2] = c; p0[3] = d;
                }
            }
#undef ROWS
        }
    }
}

DEV void phase_expert_naive(const bf16_t* hn, const bf16_t* ut, const bf16_t* vt, const int* idx, const float* gate, float* xres, int bid, int nb) {
    const int wid = threadIdx.x >> 6, lane = threadIdx.x & 63;
    for (int tok = bid * 8 + wid; tok < NT; tok += nb * 8) {
        float hv[16], acc[16];
#pragma unroll
        for (int i = 0; i < 4; ++i) { const uint2 r = *(const uint2*)(hn + (size_t)tok * DM + i * 256 + lane * 4);
            hv[i * 4] = bflo(r.x); hv[i * 4 + 1] = bfhi(r.x); hv[i * 4 + 2] = bflo(r.y); hv[i * 4 + 3] = bfhi(r.y); }
#pragma unroll
        for (int i = 0; i < 16; ++i) acc[i] = 0.f;
        for (int k0 = 0; k0 < 128; k0 += 4) {
            int e[4]; float g[4]; uint2 ur[4][4], vr[4][4];
#pragma unroll
            for (int j = 0; j < 4; ++j) { e[j] = __builtin_amdgcn_readfirstlane(idx[(size_t)tok * 128 + k0 + j]); g[j] = gate[(size_t)tok * 128 + k0 + j]; }
#pragma unroll
            for (int j = 0; j < 4; ++j)
#pragma unroll
                for (int i = 0; i < 4; ++i) ur[j][i] = *(const uint2*)(ut + (size_t)e[j] * DM + i * 256 + lane * 4);
#pragma unroll
            for (int j = 0; j < 4; ++j)
#pragma unroll
                for (int i = 0; i < 4; ++i) vr[j][i] = *(const uint2*)(vt + (size_t)e[j] * DM + i * 256 + lane * 4);
#pragma unroll
            for (int j = 0; j < 4; ++j) {
                float d = 0.f;
#pragma unroll
                for (int i = 0; i < 4; ++i) d += hv[i * 4] * bflo(ur[j][i].x) + hv[i * 4 + 1] * bfhi(ur[j][i].x) + hv[i * 4 + 2] * bflo(ur[j][i].y) + hv[i * 4 + 3] * bfhi(ur[j][i].y);
                d = wave_sum(d);
                const float act = 0.5f * d * (1.0f + erff(d * 0.70710678118654752f));
                const float w = g[j] * act;
#pragma unroll
                for (int i = 0; i < 4; ++i) { acc[i * 4] += w * bflo(vr[j][i].x); acc[i * 4 + 1] += w * bfhi(vr[j][i].x); acc[i * 4 + 2] += w * bflo(vr[j][i].y); acc[i * 4 + 3] += w * bfhi(vr[j][i].y); }
            }
        }
#pragma unroll
        for (int i = 0; i < 4; ++i) { float4* p = (float4*)(xres + (size_t)tok * DM + i * 256 + lane * 4); float4 v = *p;
            v.x += acc[i * 4]; v.y += acc[i * 4 + 1]; v.z += acc[i * 4 + 2]; v.w += acc[i * 4 + 3]; *p = v; }
    }
}

#define XB_TMO      128
#define XB_XCNT(j)  (256  + 64 * (j))
#define XB_XSUB(j)  (1280 + 64 * (j))
#define XB_XGEN(j)  (2304 + 64 * (j))
#define XB_TOP      3328
#define XB_TOPGEN   3392
#define XCD_BAR_WORDS 3456
#define XB_SPIN_CAP (1u << 18)
#define LAS __attribute__((address_space(3)))

__device__ __forceinline__ unsigned xb_ld(unsigned* p)              { return __hip_atomic_load(p, __ATOMIC_RELAXED, __HIP_MEMORY_SCOPE_AGENT); }
__device__ __forceinline__ unsigned xb_add(unsigned* p, unsigned v) { return __hip_atomic_fetch_add(p, v, __ATOMIC_RELAXED, __HIP_MEMORY_SCOPE_AGENT); }
__device__ __forceinline__ unsigned xb_xcc_id() { return (unsigned)__builtin_amdgcn_s_getreg((3 << 11) | 20) & 0xFu; }
#define XB_SPIN(cond, bar) do { unsigned _sp = 0; while (cond) { __builtin_amdgcn_s_sleep(1); \
    if ((++_sp & 255u) == 0u) { if (xb_ld(&(bar)[XB_TMO])) break; if (_sp > XB_SPIN_CAP) { atomicAdd(&(bar)[XB_TMO], 1u); break; } } } } while (0)

struct XcdBarrier {
    unsigned* bar; unsigned x;
    volatile LAS unsigned* st;
};

__device__ __forceinline__ XcdBarrier xcd_barrier_post(unsigned* bar, volatile LAS unsigned* st) {
    XcdBarrier b; b.bar = bar; b.x = xb_xcc_id(); b.st = st;
    if (threadIdx.x == 0) (void)xb_add(&bar[XB_XCNT(b.x)], 1u);
    return b;
}
__device__ __forceinline__ void xcd_barrier_complete(unsigned* bar, unsigned x, unsigned& nloc, unsigned& nx) {
    const unsigned G = gridDim.x * gridDim.y * gridDim.z;
    unsigned sum, cnt, mine, sp = 0u;
    for (;;) {
        sum = 0u; cnt = 0u; mine = 0u;
#pragma unroll
        for (unsigned j = 0; j < 16; ++j) { const unsigned c = xb_ld(&bar[XB_XCNT(j)]); sum += c; cnt += (c > 0u) ? 1u : 0u; mine = (j == x) ? c : mine; }
        if (sum == G) break;
        __builtin_amdgcn_s_sleep(1);
        if ((++sp & 255u) == 0u) { if (xb_ld(&bar[XB_TMO])) break; if (sp > XB_SPIN_CAP) { atomicAdd(&bar[XB_TMO], 1u); break; } }
    }
    nloc = mine > 0u ? mine : 1u; nx = cnt > 0u ? cnt : 1u;
}

__device__ __forceinline__ void xcd_barrier(const XcdBarrier& b) {
    asm volatile("s_waitcnt vmcnt(0)" ::: "memory");
    __syncthreads();
    if (threadIdx.x == 0) {
        unsigned* bar = b.bar;
        __builtin_amdgcn_s_waitcnt(0);
        unsigned nloc = b.st[0], nx = b.st[1];
        if (nloc == 0u) { xcd_barrier_complete(bar, b.x, nloc, nx); b.st[0] = nloc; b.st[1] = nx; }
        const unsigned old = xb_add(&bar[XB_XSUB(b.x)], 1u);
        const unsigned gen = old / nloc;
        if (old + 1u == (gen + 1u) * nloc) {
            __builtin_amdgcn_fence(__ATOMIC_RELEASE, "agent");
            asm volatile("s_waitcnt vmcnt(0)" ::: "memory");
            const unsigned og = xb_add(&bar[XB_TOP], 1u);
            const unsigned tg = og / nx;
            if (og + 1u == (tg + 1u) * nx) xb_add(&bar[XB_TOPGEN], 1u);
            else XB_SPIN(xb_ld(&bar[XB_TOPGEN]) == tg, bar);
            __builtin_amdgcn_fence(__ATOMIC_ACQUIRE, "agent");
            xb_add(&bar[XB_XGEN(b.x)], 1u);
            asm volatile("s_waitcnt vmcnt(0)" ::: "memory");
        } else {
            XB_SPIN(xb_ld(&bar[XB_XGEN(b.x)]) == gen, bar);
            __builtin_amdgcn_fence(__ATOMIC_ACQUIRE, "agent");
            asm volatile("s_waitcnt vmcnt(0)" ::: "memory");
        }
    }
    __syncthreads();
}


constexpr int N_PHASES = 23;
__global__ void __launch_bounds__(NTHR, 2) fwd_kernel(Params p_unused) {
    extern __shared__ __attribute__((aligned(16))) unsigned char lds_raw[];
    float* lds = (float*)lds_raw;
    const int bid = blockIdx.x, nb = gridDim.x;
#define PHASE_ARGS() cparams_t pp = kernarg_ptr(); asm volatile("" : "+s"(pp)); \
    unsigned char* ws = pp->ws; (void)ws; \
    bf16_t* w_in0 = (bf16_t*)(ws + WS_WIN0); bf16_t* w_out0 = (bf16_t*)(ws + WS_WOUT0); bf16_t* w_in1 = (bf16_t*)(ws + WS_WIN1); bf16_t* w_out1 = (bf16_t*)(ws + WS_WOUT1); \
    bf16_t* wq = (bf16_t*)(ws + WS_WQ); bf16_t* skb = (bf16_t*)(ws + WS_SK); unsigned char* ub = ws + WS_U; unsigned char* vb = ws + WS_V; \
    float* uscale = (float*)(ws + WS_USC); float* vscale = (float*)(ws + WS_VSC); \
    bf16_t* hn = (bf16_t*)(ws + WS_HN); bf16_t* qkv = (bf16_t*)(ws + WS_QKV); bf16_t* pq = (bf16_t*)(ws + WS_QKV); \
    float* fg = (float*)(ws + WS_FG); float* carr = (float*)(ws + WS_C); \
    bf16_t* ao = (bf16_t*)(ws + WS_AO); int* idxb = (int*)(ws + WS_AO); float* gateb = (float*)(ws + WS_AO + (size_t)NT * 128 * 4); float* uscb = (float*)(ws + WS_AO + (size_t)NT * 128 * 8); \
    float* xres = pp->out; unsigned* qctr = (unsigned*)(ws + WS_QCTR); \
    float* partial = (float*)(ws + WS_QKV); float* wts = (float*)(ws + WS_QKV + (size_t)8 * NT * 128 * 4); \
    (void)w_in0; (void)w_out0; (void)w_in1; (void)w_out1; (void)wq; (void)skb; (void)ub; (void)vb; (void)uscale; (void)vscale; (void)hn; (void)qkv; (void)pq; (void)fg; (void)carr; (void)ao; \
    (void)idxb; (void)gateb; (void)uscb; (void)xres; (void)qctr; (void)partial; (void)wts
    int lo, hi;
    { cparams_t pp = kernarg_ptr(); asm volatile("" : "+s"(pp)); lo = pp->ph_lo; hi = pp->ph_hi;
      volatile LAS unsigned* xbw = (volatile LAS unsigned*)(lds_raw + LDS_BYTES - 16);
      if (threadIdx.x == 0) { xbw[0] = 0u; xbw[1] = 0u; xbw[2] = 0u; xbw[3] = 0u; }
      __syncthreads();
      if (hi - lo > 1) (void)xcd_barrier_post((unsigned*)(pp->ws + WS_BAR), xbw); }
#define IN(k) (lo <= (k) && (k) < hi)
#if PROBE_TMASK
    if (threadIdx.x == 0) { volatile long long* tp_ = (volatile long long*)(lds_raw + LDS_BYTES - 64); tp_[0] = (long long)wall_clock64(); tp_[1] = 0; }
#define TSTAMP(k) do { if (threadIdx.x == 0) { volatile long long* tp_ = (volatile long long*)(lds_raw + LDS_BYTES - 64); const long long now_ = (long long)wall_clock64(); if ((PROBE_TMASK >> (k)) & 1) tp_[1] += now_ - tp_[0]; tp_[0] = now_; } } while (0)
#else
#define TSTAMP(k) do {} while (0)
#endif
#define SEAM(k) do { if (IN(k) && IN((k) + 1)) { PHASE_ARGS(); XcdBarrier b_; b_.bar = (unsigned*)(ws + WS_BAR); b_.x = xb_xcc_id(); b_.st = (volatile LAS unsigned*)(lds_raw + LDS_BYTES - 16); xcd_barrier(b_); } TSTAMP(k); } while (0)

    if (IN(0)) { PHASE_ARGS();
        conv_transpose(pp->even_w_in, w_in0, 1024, 3072, lds, bid, nb);
        conv_transpose(pp->even_w_out, w_out0, 1024, 1024, lds, bid, nb);
        conv_transpose(pp->odd_w_in, w_in1, 1024, 3088, lds, bid, nb);
        conv_transpose(pp->odd_w_out, w_out1, 1024, 1024, lds, bid, nb);
        conv_transpose(pp->peer_wq, wq, 1024, 2048, lds, bid, nb);
        conv_transpose(pp->peer_wq + (size_t)1024 * 2048, wq + (size_t)2048 * 1024, 1024, 2048, lds, bid, nb);
        conv_copy(pp->peer_sk, skb, (size_t)2 * 8 * 2 * 128 * 128, bid, nb);
        conv_fp8_rows<true>(pp->peer_u, ub, uscale, 2 * NEXP, bid, nb);
        conv_fp8_rows<false>(pp->peer_v, vb, vscale, 2 * NEXP, bid, nb);
        phase_norm(pp->x, pp->norm_mix_g, hn, bid, nb);
    #if PROBE_DUP == 8

        conv_transpose(pp->even_w_in, w_in0, 1024, 3072, lds, bid, nb);
        conv_transpose(pp->even_w_out, w_out0, 1024, 1024, lds, bid, nb);
        conv_transpose(pp->odd_w_in, w_in1, 1024, 3088, lds, bid, nb);
        conv_transpose(pp->odd_w_out, w_out1, 1024, 1024, lds, bid, nb);
        conv_transpose(pp->peer_wq, wq, 1024, 2048, lds, bid, nb);
        conv_transpose(pp->peer_wq + (size_t)1024 * 2048, wq + (size_t)2048 * 1024, 1024, 2048, lds, bid, nb);
        conv_copy(pp->peer_sk, skb, (size_t)2 * 8 * 2 * 128 * 128, bid, nb);
        conv_fp8_rows<true>(pp->peer_u, ub, uscale, 2 * NEXP, bid, nb);
        conv_fp8_rows<false>(pp->peer_v, vb, vscale, 2 * NEXP, bid, nb);
        phase_norm(pp->x, pp->norm_mix_g, hn, bid, nb);
    #endif
    }
    SEAM(0);
    if (IN(1)) { PHASE_ARGS(); phase_gemm_mfma(hn, w_in0, NT, 3072, MEpiQKV{qkv, 512, 1536, 2048}, lds_raw, bid, nb);
#if PROBE_DUP == 11
        phase_gemm_mfma(hn, w_in0, NT, 3072, MEpiQKV{qkv, 512, 1536, 2048}, lds_raw, bid, nb);
#endif
    }
    SEAM(1);
    if (IN(2)) { PHASE_ARGS(); phase_mix0_mfma(qkv, pp->rel_bias, pp->diff_lambda, pp->diff_ln_g, ao, (bf16_t*)(ws + WS_DPO), (float*)(ws + WS_DLSE), lds_raw, qctr + 5 * 512);
#if PROBE_DUP == 12
        phase_mix0_mfma(qkv, pp->rel_bias, pp->diff_lambda, pp->diff_ln_g, ao, lds_raw, qctr + 5 * 512 + 128);
#endif
    }
    SEAM(2);
    if (IN(3)) { PHASE_ARGS(); phase_dilated_merge((const bf16_t*)(ws + WS_DPO), (const float*)(ws + WS_DLSE), ao, bid, nb); }
    SEAM(3);
    if (IN(4)) { PHASE_ARGS(); phase_gemm_mfma(ao, w_out0, NT, 1024, MEpiBf16{qkv, 1024}, lds_raw, bid, nb); }
    SEAM(4);
    if (IN(5)) { PHASE_ARGS(); phase_res_norm<true>(pp->x, qkv, pp->norm_ffn_g, xres, hn, ws + WS_DPO, (float*)(ws + WS_DPO + (size_t)NT * 1024), bid, nb); }
    SEAM(5);
    if (IN(6)) { PHASE_ARGS(); phase_gemm_mfma(hn, wq, NT, 2048, MEpiBf16{pq, 2048}, lds_raw, bid, nb);
#if PROBE_DUP == 15
        phase_gemm_mfma(hn, wq, NT, 2048, MEpiBf16{pq, 2048}, lds_raw, bid, nb);
#endif
#if PROBE_DUP == 16
        phase_gemm_mfma(hn, wq, NT, 2048, MEpiBf16{pq, 2048}, lds_raw, bid, nb);
        phase_gemm_mfma(hn, wq, NT, 2048, MEpiBf16{pq, 2048}, lds_raw, bid, nb);
#endif
    }
    SEAM(6);
    if (IN(7)) { PHASE_ARGS(); phase_topk_mfma(pq, skb, uscale, vscale, idxb, gateb, uscb, lds_raw, bid, nb); }
    SEAM(7);
    if (IN(8)) { PHASE_ARGS(); phase_peer_fused<0>(ws + WS_DPO, (const float*)(ws + WS_DPO + (size_t)NT * 1024), ub, vb, idxb, gateb, uscb, xres, hn, pp->norm_mix_g + DM, hn, nullptr, nullptr, lds_raw, bid, nb); }
    SEAM(11);
    if (IN(12)) { PHASE_ARGS(); phase_gemm_mfma(hn, w_in1, NT, 3072, MEpiQKV{qkv, 1024, 0, 0}, lds_raw, bid, nb); phase_fg(hn, w_in1 + (size_t)3072 * 1024, pp->odd_b_f, fg, bid, nb); }
    SEAM(12);
    if (IN(13)) { PHASE_ARGS(); phase_cumsum(fg, qkv, carr, (float*)(ws + WS_CTOT), (unsigned*)(ws + WS_KMAX), bid, nb);
#if PROBE_DUP == 8
        phase_cumsum(fg, qkv, carr, (float*)(ws + WS_CTOT), (unsigned*)(ws + WS_KMAX), bid, nb);
#endif
    }
    SEAM(13);
    if (IN(14)) { PHASE_ARGS(); phase_fox_mfma(qkv, carr, (const float*)(ws + WS_CTOT), (const unsigned*)(ws + WS_KMAX), ao, lds_raw, qctr + 5 * 512 + 64);
#if PROBE_DUP == 23
        phase_fox_mfma(qkv, carr, (const float*)(ws + WS_CTOT), (const unsigned*)(ws + WS_KMAX), ao, lds_raw, qctr + 5 * 512 + 192);
#endif
    }
    SEAM(14);
    if (IN(15)) { PHASE_ARGS(); phase_gemm_mfma(ao, w_out1, NT, 1024, MEpiBf16{qkv, 1024}, lds_raw, bid, nb); }
    SEAM(15);
    if (IN(16)) { PHASE_ARGS(); phase_res_norm<true>(xres, qkv, pp->norm_ffn_g + DM, xres, hn, ws + WS_DPO, (float*)(ws + WS_DPO + (size_t)NT * 1024), bid, nb); }
    SEAM(16);
    if (IN(17)) { PHASE_ARGS(); phase_gemm_mfma(hn, wq + (size_t)2048 * 1024, NT, 2048, MEpiBf16{pq, 2048}, lds_raw, bid, nb); }
    SEAM(17);
    if (IN(18)) { PHASE_ARGS(); phase_topk_mfma(pq, skb + (size_t)8 * 2 * 128 * 128, uscale + NEXP, vscale + NEXP, idxb, gateb, uscb, lds_raw, bid, nb); }
    SEAM(18);
    if (IN(19)) { PHASE_ARGS(); phase_peer_fused<1>(ws + WS_DPO, (const float*)(ws + WS_DPO + (size_t)NT * 1024), ub + (size_t)NEXP * 1024, vb + (size_t)NEXP * 1024, idxb, gateb, uscb, xres, hn, pp->final_g, hn, nullptr, nullptr, lds_raw, bid, nb); }
#if PROBE_TMASK
    if (bid == 0 && threadIdx.x == 0) { const long long tp_acc = ((volatile long long*)(lds_raw + LDS_BYTES - 64))[1]; const long long t0_ = (long long)wall_clock64(); while ((long long)wall_clock64() - t0_ < (long long)PROBE_TAMP * tp_acc) __builtin_amdgcn_s_sleep(32); }
#endif
}

extern "C" void kernel_launch(void* const* d_in, const int* in_sizes, int n_in, void* d_out, int out_size, void* d_ws, size_t ws_size, hipStream_t stream) {
    static int grid = 0;
    if (grid == 0) {
        if (n_in != 16 || out_size != NT * DM || ws_size < WS_END) { fprintf(stderr, "kernel_launch: unexpected sizes n_in %d out %d ws %zu (need %zu)\n", n_in, out_size, ws_size, (size_t)WS_END); grid = -1; return; }
        int dev = 0, cus = 0;
        (void)hipGetDevice(&dev); (void)hipDeviceGetAttribute(&cus, hipDeviceAttributeMultiprocessorCount, dev);
        if (hipFuncSetAttribute((const void*)fwd_kernel, hipFuncAttributeMaxDynamicSharedMemorySize, LDS_BYTES) != hipSuccess) { fprintf(stderr, "hipFuncSetAttribute failed\n"); grid = -1; return; }
        grid = cus > 0 ? cus : 256;
    }
    if (grid < 0) return;
    Params p{};
    p.x = (const float*)d_in[0]; p.norm_mix_g = (const float*)d_in[1]; p.norm_ffn_g = (const float*)d_in[2]; p.final_g = (const float*)d_in[3];
    p.rel_bias = (const float*)d_in[4]; p.even_w_in = (const float*)d_in[5]; p.even_w_out = (const float*)d_in[6]; p.diff_lambda = (const float*)d_in[7];
    p.diff_ln_g = (const float*)d_in[8]; p.odd_w_in = (const float*)d_in[9]; p.odd_b_f = (const float*)d_in[10]; p.odd_w_out = (const float*)d_in[11];
    p.peer_wq = (const float*)d_in[12]; p.peer_sk = (const float*)d_in[13]; p.peer_u = (const float*)d_in[14]; p.peer_v = (const float*)d_in[15];
    p.out = (float*)d_out; p.ws = (unsigned char*)d_ws;
#if defined(MK_MULTI)
    for (int k = 0; k < N_PHASES; ++k) {
        p.ph_lo = k; p.ph_hi = k + 1;
        hipLaunchKernelGGL(fwd_kernel, dim3(grid), dim3(NTHR), LDS_BYTES, stream, p);
    }
#else
    (void)hipMemsetAsync((unsigned char*)d_ws + WS_BAR, 0, WS_CTL_BYTES + 8 * 8 * 256, stream);
    p.ph_lo = 0; p.ph_hi = N_PHASES;
    hipLaunchKernelGGL(fwd_kernel, dim3(grid), dim3(NTHR), LDS_BYTES, stream, p);
#endif
}
```
